# Optimizing an MI355X kernel written in HIP

```python
import jax
import jax.numpy as jnp
from jax import lax
import numpy as np

D_MODEL = 1024
BATCH = 16
SEQ = 256
DEPTH = 4
DEC_BATCH = 8
DEC_SEQ = 1024
PAST_LEN = 512

GRID_W = 64
Q_BLOCK = 128
ROPE_THETA = 10000.0
NORM_EPS = 1e-6
NEG_INF = -1e30
N_MIXERS = 4
N_MOD = 6
D_FF = 4 * D_MODEL

ATTN_HEADS = 8
ATTN_KV_HEADS = 2
ATTN_HEAD_DIM = D_MODEL // ATTN_HEADS
MLA_HEADS = 16
MLA_Q_LORA = 384
MLA_KV_LORA = 256
MLA_NOPE = 64
MLA_ROPE = 32
MLA_V_DIM = 64
MLA_SCALE = (MLA_NOPE + MLA_ROPE) ** -0.5
SWA_HEADS = 16
SWA_KV_HEADS = 4
SWA_HEAD_DIM = D_MODEL // SWA_HEADS
SWA_WINDOW = 128
NAT_HEADS = 16
NAT_HEAD_DIM = D_MODEL // NAT_HEADS
NAT_WIN_R = 8
NAT_WIN_C = 16

kernel_name = 'hybrid_dit_prefix_context_step'


def rmsnorm(x, g):
    xf = x.astype(jnp.float32)
    y = xf * lax.rsqrt(jnp.mean(xf * xf, axis=-1, keepdims=True) + NORM_EPS)
    return (y * g.astype(jnp.float32)).astype(x.dtype)


def axial_rope(x):
    S, dim = x.shape[1], x.shape[-1]
    quarter = dim // 4
    t = jnp.arange(S)
    pos = jnp.stack([t // GRID_W, t % GRID_W], axis=-1).astype(jnp.float32)
    inv = ROPE_THETA ** (-jnp.arange(quarter, dtype=jnp.float32) / quarter)
    ang = pos[:, :, None] * inv
    bshape = (S,) + (1,) * (x.ndim - 3) + (2, quarter)
    cos = jnp.cos(ang).reshape(bshape).astype(x.dtype)
    sin = jnp.sin(ang).reshape(bshape).astype(x.dtype)
    xr = x.reshape(x.shape[:-1] + (2, 2, quarter))
    x1, x2 = xr[..., 0, :], xr[..., 1, :]
    out = jnp.stack([x1 * cos - x2 * sin, x2 * cos + x1 * sin], axis=-2)
    return out.reshape(x.shape)


def attend(q, segments, scale, sink=None):
    logits = []
    for k, _, bias in segments:
        eq = 'bqhgd,bqkhd->bhgqk' if k.ndim == 5 else 'bqhgd,bkhd->bhgqk'
        s = jnp.einsum(eq, q, k, preferred_element_type=jnp.float32) * scale
        if bias is not None:
            s = s + bias
        logits.append(s)
    sizes = [s.shape[-1] for s in logits]
    if sink is not None:
        B, Q = q.shape[:2]
        logits.append(jnp.broadcast_to(sink.astype(jnp.float32)[None, :, :, None, None],
                                       (B,) + sink.shape + (Q, 1)))
    p = jax.nn.softmax(jnp.concatenate(logits, axis=-1), axis=-1)
    out = None
    off = 0
    for (_, v, _), n in zip(segments, sizes):
        pv = p[..., off:off + n].astype(v.dtype)
        eq = 'bhgqk,bqkhd->bqhgd' if v.ndim == 5 else 'bhgqk,bkhd->bqhgd'
        o = jnp.einsum(eq, pv, v)
        out = o if out is None else out + o
        off += n
    return out


def map_query_blocks(fn, q, *block_inputs):
    B, S = q.shape[:2]
    nb = S // Q_BLOCK
    qb = jnp.moveaxis(q.reshape((B, nb, Q_BLOCK) + q.shape[2:]), 1, 0)
    out = lax.map(lambda xs: fn(*xs), (jnp.arange(nb), qb) + tuple(block_inputs))
    return jnp.moveaxis(out, 0, 1).reshape((B, S) + out.shape[3:])


def gqa_split(z, n_heads, n_kv, hd):
    B, T = z.shape[:2]
    q, k, v = jnp.split(z, [n_heads * hd, (n_heads + n_kv) * hd], axis=-1)
    return (q.reshape(B, T, n_kv, n_heads // n_kv, hd),
            k.reshape(B, T, n_kv, hd), v.reshape(B, T, n_kv, hd))


def attn_context(h, w_qkv, q_norm, k_norm, w_o):
    B, L = h.shape[:2]
    q, k, v = gqa_split(h @ w_qkv, ATTN_HEADS, ATTN_KV_HEADS, ATTN_HEAD_DIM)
    q, k = rmsnorm(q, q_norm), rmsnorm(k, k_norm)
    o = attend(q, [(k, v, None)], ATTN_HEAD_DIM ** -0.5)
    return o.reshape(B, L, -1) @ w_o, (k, v)


def attn_latent(h, k_ctx, v_ctx, w_qkv, q_norm, k_norm, w_o):
    B, S = h.shape[:2]
    q, k, v = gqa_split(h @ w_qkv, ATTN_HEADS, ATTN_KV_HEADS, ATTN_HEAD_DIM)
    q, k = axial_rope(rmsnorm(q, q_norm)), axial_rope(rmsnorm(k, k_norm))

    def block(b, qb):
        return attend(qb, [(k, v, None), (k_ctx, v_ctx, None)], ATTN_HEAD_DIM ** -0.5)

    o = map_query_blocks(block, q)
    return o.reshape(B, S, -1) @ w_o


def mla_project(h, w_in, q_norm, kv_norm, w_uq):
    B, T = h.shape[:2]
    cq, ckv, k_pe = jnp.split(h @ w_in, [MLA_Q_LORA, MLA_Q_LORA + MLA_KV_LORA], axis=-1)
    q = (rmsnorm(cq, q_norm) @ w_uq).reshape(B, T, MLA_HEADS, 1, MLA_NOPE + MLA_ROPE)
    return q, rmsnorm(ckv, kv_norm), k_pe


def mla_expand(ckv, k_pe, w_ukv):
    B, T = ckv.shape[:2]
    kv = (ckv @ w_ukv).reshape(B, T, MLA_HEADS, MLA_NOPE + MLA_V_DIM)
    k_nope, v = jnp.split(kv, [MLA_NOPE], axis=-1)
    k_rope = jnp.broadcast_to(k_pe[:, :, None, :], (B, T, MLA_HEADS, MLA_ROPE))
    return jnp.concatenate([k_nope, k_rope], axis=-1), v


def mla_context(h, w_in, q_norm, kv_norm, w_uq, w_ukv, w_o):
    B, L = h.shape[:2]
    q, ckv, k_pe = mla_project(h, w_in, q_norm, kv_norm, w_uq)
    k, v = mla_expand(ckv, k_pe, w_ukv)
    o = attend(q, [(k, v, None)], MLA_SCALE)
    return o.reshape(B, L, -1) @ w_o, (ckv, k_pe)


def mla_latent(h, ckv_ctx, kpe_ctx, w_in, q_norm, kv_norm, w_uq, w_ukv, w_o):
    B, S = h.shape[:2]
    q, ckv, k_pe = mla_project(h, w_in, q_norm, kv_norm, w_uq)
    q = jnp.concatenate([q[..., :MLA_NOPE], axial_rope(q[..., MLA_NOPE:])], axis=-1)
    k, v = mla_expand(ckv, axial_rope(k_pe[:, :, None, :])[:, :, 0, :], w_ukv)
    k_ctx, v_ctx = mla_expand(ckv_ctx, kpe_ctx, w_ukv)

    def block(b, qb):
        return attend(qb, [(k, v, None), (k_ctx, v_ctx, None)], MLA_SCALE)

    o = map_query_blocks(block, q)
    return o.reshape(B, S, -1) @ w_o


def swa_context(h, w_qkv, sink, w_o):
    B, L = h.shape[:2]
    q, k, v = gqa_split(h @ w_qkv, SWA_HEADS, SWA_KV_HEADS, SWA_HEAD_DIM)
    o = attend(q, [(k, v, None)], SWA_HEAD_DIM ** -0.5, sink.reshape(SWA_KV_HEADS, -1))
    return o.reshape(B, L, -1) @ w_o, (k, v)


def swa_latent(h, k_ctx, v_ctx, w_qkv, sink, w_o):
    B, S = h.shape[:2]
    q, k, v = gqa_split(h @ w_qkv, SWA_HEADS, SWA_KV_HEADS, SWA_HEAD_DIM)
    q, k = axial_rope(q), axial_rope(k)
    pad = ((0, 0), (SWA_WINDOW, SWA_WINDOW), (0, 0), (0, 0))
    kp, vp = jnp.pad(k, pad), jnp.pad(v, pad)
    band = Q_BLOCK + 2 * SWA_WINDOW
    sink_g = sink.reshape(SWA_KV_HEADS, -1)

    def block(b, qb):
        start = b * Q_BLOCK
        kb = lax.dynamic_slice_in_dim(kp, start, band, axis=1)
        vb = lax.dynamic_slice_in_dim(vp, start, band, axis=1)
        qpos = start + jnp.arange(Q_BLOCK)
        kpos = start - SWA_WINDOW + jnp.arange(band)
        valid = (kpos[None, :] >= 0) & (kpos[None, :] < S) & (jnp.abs(qpos[:, None] - kpos[None, :]) <= SWA_WINDOW)
        bias = jnp.where(valid, 0.0, NEG_INF).astype(jnp.float32)
        return attend(qb, [(kb, vb, bias), (k_ctx, v_ctx, None)], SWA_HEAD_DIM ** -0.5, sink_g)

    o = map_query_blocks(block, q)
    return o.reshape(B, S, -1) @ w_o


def neighbourhood_tables(S, rpb):
    rows = S // GRID_W
    wr = min(NAT_WIN_R, rows)
    t = jnp.arange(S)
    r, c = t // GRID_W, t % GRID_W
    r0 = jnp.clip(r - wr // 2, 0, rows - wr)
    c0 = jnp.clip(c - NAT_WIN_C // 2, 0, GRID_W - NAT_WIN_C)
    kr = jnp.broadcast_to(r0[:, None, None] + jnp.arange(wr)[None, :, None], (S, wr, NAT_WIN_C)).reshape(S, -1)
    kc = jnp.broadcast_to(c0[:, None, None] + jnp.arange(NAT_WIN_C)[None, None, :], (S, wr, NAT_WIN_C)).reshape(S, -1)
    idx = kr * GRID_W + kc
    bias = rpb[:, kr - r[:, None] + NAT_WIN_R - 1, kc - c[:, None] + NAT_WIN_C - 1]
    return idx, bias


def nat_context(h, w_qkv, w_o):
    B, L = h.shape[:2]
    q, k, v = gqa_split(h @ w_qkv, NAT_HEADS, NAT_HEADS, NAT_HEAD_DIM)
    o = attend(q, [(k, v, None)], NAT_HEAD_DIM ** -0.5)
    return o.reshape(B, L, -1) @ w_o, (k, v)


def nat_latent(h, k_ctx, v_ctx, w_qkv, rpb, w_o):
    B, S = h.shape[:2]
    q, k, v = gqa_split(h @ w_qkv, NAT_HEADS, NAT_HEADS, NAT_HEAD_DIM)
    idx, bias = neighbourhood_tables(S, rpb)
    nb = S // Q_BLOCK
    idx_blocks = idx.reshape(nb, Q_BLOCK, -1)
    bias_blocks = jnp.moveaxis(bias.reshape(NAT_HEADS, nb, Q_BLOCK, -1), 1, 0)

    def block(b, qb, idx_b, bias_b):
        kg = jnp.take(k, idx_b, axis=1)
        vg = jnp.take(v, idx_b, axis=1)
        return attend(qb, [(kg, vg, bias_b[None, :, None].astype(jnp.float32)), (k_ctx, v_ctx, None)],
                      NAT_HEAD_DIM ** -0.5)

    o = map_query_blocks(block, q, idx_blocks, bias_blocks)
    return o.reshape(B, S, -1) @ w_o


def sandwich_layer(x, cond, ada_w, ada_b, norm_g, w1, w2, mix):
    m = jax.nn.silu(cond) @ ada_w + ada_b
    shift1, scale1, gate1, shift2, scale2, gate2 = jnp.split(m[:, None, :], N_MOD, axis=-1)
    out, extra = mix(rmsnorm(x, norm_g[0]) * (1 + scale1) + shift1)
    x = x + gate1 * rmsnorm(out, norm_g[1])
    h = rmsnorm(x, norm_g[2]) * (1 + scale2) + shift2
    ff = jnp.square(jax.nn.relu(h @ w1)) @ w2
    x = x + gate2 * rmsnorm(ff, norm_g[3])
    return x, extra


def setup_inputs(seed: int = 0) -> dict:
    key = jax.random.key(seed)
    ks = iter(jax.random.split(key, 40))

    def nrm(shape, scale=1.0):
        return scale * jax.random.normal(next(ks), shape, jnp.float32)

    D = D_MODEL
    return {
        'x_prompt': nrm((BATCH, SEQ, D)),
        'x_sample': nrm((DEC_BATCH, DEC_SEQ, D)),
        'cache_l0_k': nrm((DEC_BATCH, PAST_LEN, ATTN_KV_HEADS, ATTN_HEAD_DIM)),
        'cache_l0_v': nrm((DEC_BATCH, PAST_LEN, ATTN_KV_HEADS, ATTN_HEAD_DIM)),
        'cache_l1_ckv': nrm((DEC_BATCH, PAST_LEN, MLA_KV_LORA)),
        'cache_l1_kpe': nrm((DEC_BATCH, PAST_LEN, MLA_ROPE)),
        'cache_l2_k': nrm((DEC_BATCH, PAST_LEN, SWA_KV_HEADS, SWA_HEAD_DIM)),
        'cache_l2_v': nrm((DEC_BATCH, PAST_LEN, SWA_KV_HEADS, SWA_HEAD_DIM)),
        'cache_l3_k': nrm((DEC_BATCH, PAST_LEN, NAT_HEADS, NAT_HEAD_DIM)),
        'cache_l3_v': nrm((DEC_BATCH, PAST_LEN, NAT_HEADS, NAT_HEAD_DIM)),
        'c': nrm((DEC_BATCH, D)),
        'c_ctx': nrm((D,)),
        'ada_w': nrm((DEPTH, D, N_MOD * D), 0.5 * D ** -0.5),
        'ada_b': nrm((DEPTH, N_MOD * D), 0.01),
        'norm_g': 1.0 + nrm((DEPTH, 4, D), 0.05),
        'mlp_w1': nrm((DEPTH, D, D_FF), D ** -0.5),
        'mlp_w2': nrm((DEPTH, D_FF, D), D_FF ** -0.5),
        'attn_w_qkv': nrm((D, (ATTN_HEADS + 2 * ATTN_KV_HEADS) * ATTN_HEAD_DIM), D ** -0.5),
        'attn_q_norm': 1.0 + nrm((ATTN_HEAD_DIM,), 0.05),
        'attn_k_norm': 1.0 + nrm((ATTN_HEAD_DIM,), 0.05),
        'attn_w_o': nrm((ATTN_HEADS * ATTN_HEAD_DIM, D), (ATTN_HEADS * ATTN_HEAD_DIM) ** -0.5),
        'mla_w_in': nrm((D, MLA_Q_LORA + MLA_KV_LORA + MLA_ROPE), D ** -0.5),
        'mla_q_norm': 1.0 + nrm((MLA_Q_LORA,), 0.05),
        'mla_kv_norm': 1.0 + nrm((MLA_KV_LORA,), 0.05),
        'mla_w_uq': nrm((MLA_Q_LORA, MLA_HEADS * (MLA_NOPE + MLA_ROPE)), MLA_Q_LORA ** -0.5),
        'mla_w_ukv': nrm((MLA_KV_LORA, MLA_HEADS * (MLA_NOPE + MLA_V_DIM)), MLA_KV_LORA ** -0.5),
        'mla_w_o': nrm((MLA_HEADS * MLA_V_DIM, D), (MLA_HEADS * MLA_V_DIM) ** -0.5),
        'swa_w_qkv': nrm((D, (SWA_HEADS + 2 * SWA_KV_HEADS) * SWA_HEAD_DIM), D ** -0.5),
        'swa_sink': nrm((SWA_HEADS,), 0.5),
        'swa_w_o': nrm((SWA_HEADS * SWA_HEAD_DIM, D), (SWA_HEADS * SWA_HEAD_DIM) ** -0.5),
        'nat_w_qkv': nrm((D, 3 * NAT_HEADS * NAT_HEAD_DIM), D ** -0.5),
        'nat_rpb': nrm((NAT_HEADS, 2 * NAT_WIN_R - 1, 2 * NAT_WIN_C - 1), 0.1),
        'nat_w_o': nrm((NAT_HEADS * NAT_HEAD_DIM, D), (NAT_HEADS * NAT_HEAD_DIM) ** -0.5),
    }


def reference(x_prompt, x_sample, cache_l0_k, cache_l0_v, cache_l1_ckv, cache_l1_kpe,
              cache_l2_k, cache_l2_v, cache_l3_k, cache_l3_v, c, c_ctx,
              ada_w, ada_b, norm_g, mlp_w1, mlp_w2,
              attn_w_qkv, attn_q_norm, attn_k_norm, attn_w_o,
              mla_w_in, mla_q_norm, mla_kv_norm, mla_w_uq, mla_w_ukv, mla_w_o,
              swa_w_qkv, swa_sink, swa_w_o,
              nat_w_qkv, nat_rpb, nat_w_o):
    context_mixers = [
        lambda h: attn_context(h, attn_w_qkv, attn_q_norm, attn_k_norm, attn_w_o),
        lambda h: mla_context(h, mla_w_in, mla_q_norm, mla_kv_norm, mla_w_uq, mla_w_ukv, mla_w_o),
        lambda h: swa_context(h, swa_w_qkv, swa_sink, swa_w_o),
        lambda h: nat_context(h, nat_w_qkv, nat_w_o),
    ]
    latent_mixers = [
        lambda h, st: attn_latent(h, st[0], st[1], attn_w_qkv, attn_q_norm, attn_k_norm, attn_w_o),
        lambda h, st: mla_latent(h, st[0], st[1], mla_w_in, mla_q_norm, mla_kv_norm, mla_w_uq, mla_w_ukv, mla_w_o),
        lambda h, st: swa_latent(h, st[0], st[1], swa_w_qkv, swa_sink, swa_w_o),
        lambda h, st: nat_latent(h, st[0], st[1], nat_w_qkv, nat_rpb, nat_w_o),
    ]
    cached = [(cache_l0_k, cache_l0_v), (cache_l1_ckv, cache_l1_kpe),
              (cache_l2_k, cache_l2_v), (cache_l3_k, cache_l3_v)]
    xp, xs = x_prompt, x_sample
    new_state = []
    for i in range(DEPTH):
        kind = i % N_MIXERS
        layer_w = (ada_w[i], ada_b[i], norm_g[i], mlp_w1[i], mlp_w2[i])
        xp, st = sandwich_layer(xp, c_ctx[None, :], *layer_w, context_mixers[kind])
        new_state.append(st)
        xs, _ = sandwich_layer(xs, c, *layer_w, lambda h: (latent_mixers[kind](h, cached[i]), None))
    (l0_k, l0_v), (l1_ckv, l1_kpe), (l2_k, l2_v), (l3_k, l3_v) = new_state
    return (xp, xs, l0_k, l0_v, l1_ckv, l1_kpe, l2_k, l2_v, l3_k, l3_v)
```

```cpp
#include <hip/hip_runtime.h>
#include <hip/hip_cooperative_groups.h>
#include <cstdio>
namespace cg = cooperative_groups;

typedef unsigned short u16;
typedef short bf16x8 __attribute__((ext_vector_type(8)));
typedef short s16x4 __attribute__((ext_vector_type(4)));
typedef float f32x16 __attribute__((ext_vector_type(16)));
typedef float f32x2 __attribute__((ext_vector_type(2)));
typedef __bf16 bfx2 __attribute__((ext_vector_type(2)));
#define DI __device__ __forceinline__
#define MFMA(a, b, c) __builtin_amdgcn_mfma_f32_32x32x16_bf16((a), (b), (c), 0, 0, 0)
#define LDS3 __attribute__((address_space(3)))

#ifndef N_LAUNCH_MODE
#define N_LAUNCH_MODE 0
#endif

constexpr int NTOK = 12288, NCTX = 4096;
constexpr float LOG2E = 1.4426950408889634f;

constexpr size_t O_L0K = 12582912, O_L0V = 13631488, O_L1CKV = 14680064, O_L1KPE = 15728640,
                 O_L2K = 15859712, O_L2V = 16908288, O_L3K = 17956864, O_L3V = 22151168;

constexpr size_t OFF_W1T = 0;
constexpr size_t OFF_W2T = OFF_W1T + 4ull * 4096 * 1024 * 2;
constexpr size_t OFF_AQKV = OFF_W2T + 4ull * 4096 * 1024 * 2;
constexpr size_t OFF_AO_W = OFF_AQKV + 1536ull * 1024 * 2;
constexpr size_t OFF_MIN = OFF_AO_W + 1024ull * 1024 * 2;
constexpr size_t OFF_MUQ = OFF_MIN + 768ull * 1024 * 2;
constexpr size_t OFF_MUKV = OFF_MUQ + 1536ull * 384 * 2;
constexpr size_t OFF_MO = OFF_MUKV + 2048ull * 256 * 2;
constexpr size_t OFF_SQKV = OFF_MO + 1024ull * 1024 * 2;
constexpr size_t OFF_SO = OFF_SQKV + 1536ull * 1024 * 2;
constexpr size_t OFF_NQKV = OFF_SO + 1024ull * 1024 * 2;
constexpr size_t OFF_NO = OFF_NQKV + 3072ull * 1024 * 2;
constexpr size_t OFF_MOD = OFF_NO + 1024ull * 1024 * 2;
constexpr size_t OFF_ROPE = OFF_MOD + 4ull * 9 * 6144 * 4;
constexpr size_t OFF_HAO = OFF_ROPE + 3ull * 64 * 32 * 2 * 4;
constexpr size_t OFF_UZ = OFF_HAO + 12288ull * 1024 * 2;
constexpr size_t OFF_QO = OFF_UZ + 12288ull * 4096 * 2;
constexpr size_t OFF_CQ = OFF_QO + 12288ull * 3072 * 2;
constexpr size_t OFF_CKV = OFF_CQ + 12288ull * 384 * 2;
constexpr size_t OFF_KPE = OFF_CKV + 16384ull * 256 * 2;
constexpr size_t OFF_KV = OFF_KPE + 16384ull * 32 * 2;
constexpr size_t OFF_CK = OFF_KV;
constexpr size_t OFF_CV = OFF_KV + 2097152;
constexpr size_t OFF_C3K = OFF_KV + 4194304;
constexpr size_t OFF_C3V = OFF_C3K + 8388608;
constexpr size_t WS_NEED = OFF_KV + 16384ull * 2048 * 2;

struct Params {
  const float* in[33];
  float* out;
  char* ws;
  int ph0, ph1;
};

DI unsigned pack2(float a, float b) { f32x2 f = {a, b}; bfx2 v = __builtin_convertvector(f, bfx2); return __builtin_bit_cast(unsigned, v); }
DI u16 f2bf(float a) { return (u16)(pack2(a, a) & 0xffffu); }
DI float wave_sum(float v) {
#pragma unroll
  for (int o = 32; o; o >>= 1) v += __shfl_xor(v, o, 64);
  return v;
}
DI int ltid() { int t = threadIdx.x; asm volatile("" : "+v"(t)); return t; }
DI int crow(int i, int h) { return (i & 3) + 8 * (i >> 2) + 4 * h; }

__device__ const long long TJ[18][6] = {
  {15, 0ll * 1024 * 4096, 1024, 4096, 4096, (long long)(OFF_W1T + 0ull * 8388608)},
  {15, 1ll * 1024 * 4096, 1024, 4096, 4096, (long long)(OFF_W1T + 1ull * 8388608)},
  {15, 2ll * 1024 * 4096, 1024, 4096, 4096, (long long)(OFF_W1T + 2ull * 8388608)},
  {15, 3ll * 1024 * 4096, 1024, 4096, 4096, (long long)(OFF_W1T + 3ull * 8388608)},
  {16, 0ll * 1024 * 4096, 4096, 1024, 1024, (long long)(OFF_W2T + 0ull * 8388608)},
  {16, 1ll * 1024 * 4096, 4096, 1024, 1024, (long long)(OFF_W2T + 1ull * 8388608)},
  {16, 2ll * 1024 * 4096, 4096, 1024, 1024, (long long)(OFF_W2T + 2ull * 8388608)},
  {16, 3ll * 1024 * 4096, 4096, 1024, 1024, (long long)(OFF_W2T + 3ull * 8388608)},
  {17, 0, 1024, 1536, 1536, (long long)OFF_AQKV},
  {20, 0, 1024, 1024, 1024, (long long)OFF_AO_W},
  {21, 0, 1024, 672, 768, (long long)OFF_MIN},
  {24, 0, 384, 1536, 1536, (long long)OFF_MUQ},
  {25, 0, 256, 2048, 2048, (long long)OFF_MUKV},
  {26, 0, 1024, 1024, 1024, (long long)OFF_MO},
  {27, 0, 1024, 1536, 1536, (long long)OFF_SQKV},
  {29, 0, 1024, 1024, 1024, (long long)OFF_SO},
  {30, 0, 1024, 3072, 3072, (long long)OFF_NQKV},
  {32, 0, 1024, 1024, 1024, (long long)OFF_NO},
};

DI void transpose_tile(const float* __restrict__ src, u16* __restrict__ dst, int K, int N, int k0, int n0, char* smem) {
  float (*T)[65] = (float (*)[65])smem;
  const int tid = ltid();
  const int nl = tid & 63, kl0 = tid >> 6;
  __syncthreads();
  const int n = n0 + nl;
#pragma unroll 4
  for (int j = 0; j < 16; ++j) {
    const int k = kl0 + 4 * j;
    T[k][nl] = (n < N) ? src[(size_t)(k0 + k) * N + n] : 0.f;
  }
  __syncthreads();
  const int kp = tid & 31, nl0 = tid >> 5;
#pragma unroll
  for (int j = 0; j < 8; ++j) {
    const int nn = nl0 + 8 * j;
    *(unsigned*)&dst[(size_t)(n0 + nn) * K + k0 + 2 * kp] = pack2(T[2 * kp][nn], T[2 * kp + 1][nn]);
  }
}

DI void convert_f32_bf16(const float* __restrict__ src, u16* __restrict__ dst, size_t n) {
  const size_t n4 = n >> 2;
  const int tid_ = ltid();
  for (size_t i = (size_t)blockIdx.x * 256 + tid_; i < n4; i += (size_t)gridDim.x * 256) {
    const float4 v = ((const float4*)src)[i];
    uint2 o; o.x = pack2(v.x, v.y); o.y = pack2(v.z, v.w);
    ((uint2*)dst)[i] = o;
  }
}

DI void prepass(const Params& p, const Params& pk, long long z, char* smem) {
  int total = 0;
  for (int j = 0; j < 18; ++j) total += (int)((TJ[j][2] >> 6) * (TJ[j][4] >> 6));
  for (int t = blockIdx.x; t < total; t += gridDim.x) {
    int j = 0, tt = t;
    for (;;) { const int c = (int)((TJ[j][2] >> 6) * (TJ[j][4] >> 6)); if (tt < c) break; tt -= c; ++j; }
    const int K = (int)TJ[j][2], N = (int)TJ[j][3];
    const int nk = K >> 6;
    const int kt = tt % nk, nt = tt / nk;
    transpose_tile(pk.in[TJ[j][0]] + TJ[j][1] + z, (u16*)(p.ws + TJ[j][5]), K, N, kt * 64, nt * 64, smem);
  }
  convert_f32_bf16(p.in[2], (u16*)(p.ws + OFF_CK), 4096ull * 256);
  convert_f32_bf16(p.in[3], (u16*)(p.ws + OFF_CV), 4096ull * 256);
  convert_f32_bf16(p.in[4], (u16*)(p.ws + OFF_CKV) + 12288ull * 256, 4096ull * 256);
  convert_f32_bf16(p.in[5], (u16*)(p.ws + OFF_KPE) + 12288ull * 32, 4096ull * 32);
  {
    float* tab = (float*)(p.ws + OFF_ROPE);
    const int tid_ = ltid();
    for (int e = blockIdx.x * 256 + tid_; e < 3 * 64 * 32; e += gridDim.x * 256) {
      const int kind = e / 2048, pos = (e >> 5) & 63, i = e & 31;
      const int quarter = kind == 0 ? 32 : (kind == 1 ? 16 : 8);
      float c = 1.f, s = 0.f;
      if (i < quarter) {
        const float inv = exp2f(-(float)i / (float)quarter * 13.287712379549449f);
        const float ang = (float)pos * inv;
        c = cosf(ang); s = sinf(ang);
      }
      tab[2 * e] = c; tab[2 * e + 1] = s;
    }
  }
  {
    float* scond = (float*)smem;
    float* red = (float*)(smem + 36864);
    float* MOD = (float*)(p.ws + OFF_MOD);
    const int tid = ltid();
    bool ready = false;
    for (int it = blockIdx.x; it < 768; it += gridDim.x) {
      __syncthreads();
      if (!ready) {
        for (int e = tid; e < 9 * 1024; e += 256) {
          const float c = e < 8192 ? p.in[10][e] : p.in[11][e - 8192];
          scond[e] = c / (1.f + __expf(-c));
        }
        ready = true;
        __syncthreads();
      }
      const int l = it / 192, n0 = (it % 192) * 32;
      const int col = tid & 31, kg = tid >> 5;
      float acc[9];
#pragma unroll
      for (int c = 0; c < 9; ++c) acc[c] = 0.f;
      const float* wp = p.in[12] + (size_t)l * 1024 * 6144 + n0 + col;
#pragma unroll 8
      for (int i = 0; i < 128; ++i) {
        const int k = kg + 8 * i;
        const float wv = wp[(size_t)k * 6144];
#pragma unroll
        for (int c = 0; c < 9; ++c) acc[c] += scond[c * 1024 + k] * wv;
      }
#pragma unroll
      for (int c = 0; c < 9; ++c) red[(kg * 9 + c) * 32 + col] = acc[c];
      __syncthreads();
      for (int e = tid; e < 288; e += 256) {
        const int c = e >> 5, cc = e & 31;
        float s = p.in[13][l * 6144 + n0 + cc];
#pragma unroll
        for (int g = 0; g < 8; ++g) s += red[(g * 9 + c) * 32 + cc];
        MOD[(size_t)(l * 9 + c) * 6144 + n0 + cc] = s;
      }
    }
  }
}

DI void norm_phase(const Params& p, int l, int mode) {
  const int tid_ = ltid(); const int lane = tid_ & 63, w = tid_ >> 6;
  float* X = p.out;
  const float* MOD = (const float*)(p.ws + OFF_MOD);
  const float* FF = (const float*)(p.ws + OFF_QO);
  u16* H = (u16*)(p.ws + OFF_HAO);
  const float* ng = p.in[14];
  const bool x_in = (l == 0);
  const bool add = !(l == 0 && mode == 0);
  const int la = (mode == 1) ? l : l - 1;
  const int gate_w = (mode == 1) ? 2 : 5;
  const int gadd = (mode == 1) ? 1 : 3;
  const bool do_h = mode != 2;
  const int gh = (mode == 0) ? 0 : 2, scw = (mode == 0) ? 1 : 4, shw = (mode == 0) ? 0 : 3;
  for (int row = blockIdx.x * 4 + w; row < NTOK; row += gridDim.x * 4) {
    const int ci = row < NCTX ? 8 : ((row - NCTX) >> 10);
    const float* xs = x_in ? (row < NCTX ? p.in[0] + (size_t)row * 1024 : p.in[1] + (size_t)(row - NCTX) * 1024)
                           : X + (size_t)row * 1024;
    float4 x[4];
#pragma unroll
    for (int j = 0; j < 4; ++j) x[j] = *(const float4*)(xs + 4 * lane + 256 * j);
    if (add) {
      const float* fr = FF + (size_t)row * 1024;
      float4 f[4];
      float ss = 0.f;
#pragma unroll
      for (int j = 0; j < 4; ++j) {
        f[j] = *(const float4*)(fr + 4 * lane + 256 * j);
        ss += f[j].x * f[j].x + f[j].y * f[j].y + f[j].z * f[j].z + f[j].w * f[j].w;
      }
      ss = wave_sum(ss);
      const float rstd = rsqrtf(ss * (1.f / 1024.f) + 1e-6f);
      const float* ga = ng + (la * 4 + gadd) * 1024;
      const float* gt = MOD + (size_t)(la * 9 + ci) * 6144 + gate_w * 1024;
#pragma unroll
      for (int j = 0; j < 4; ++j) {
        const float4 g4 = *(const float4*)(ga + 4 * lane + 256 * j);
        const float4 t4 = *(const float4*)(gt + 4 * lane + 256 * j);
        x[j].x += t4.x * (f[j].x * rstd * g4.x);
        x[j].y += t4.y * (f[j].y * rstd * g4.y);
        x[j].z += t4.z * (f[j].z * rstd * g4.z);
        x[j].w += t4.w * (f[j].w * rstd * g4.w);
        *(float4*)(X + (size_t)row * 1024 + 4 * lane + 256 * j) = x[j];
      }
    }
    if (do_h) {
      float ss = 0.f;
#pragma unroll
      for (int j = 0; j < 4; ++j) ss += x[j].x * x[j].x + x[j].y * x[j].y + x[j].z * x[j].z + x[j].w * x[j].w;
      ss = wave_sum(ss);
      const float rstd = rsqrtf(ss * (1.f / 1024.f) + 1e-6f);
      const float* g = ng + (l * 4 + gh) * 1024;
      const float* sc = MOD + (size_t)(l * 9 + ci) * 6144 + scw * 1024;
      const float* sh = MOD + (size_t)(l * 9 + ci) * 6144 + shw * 1024;
#pragma unroll
      for (int j = 0; j < 4; ++j) {
        const float4 g4 = *(const float4*)(g + 4 * lane + 256 * j);
        const float4 c4 = *(const float4*)(sc + 4 * lane + 256 * j);
        const float4 s4 = *(const float4*)(sh + 4 * lane + 256 * j);
        const float h0 = x[j].x * rstd * g4.x * (1.f + c4.x) + s4.x;
        const float h1 = x[j].y * rstd * g4.y * (1.f + c4.y) + s4.y;
        const float h2 = x[j].z * rstd * g4.z * (1.f + c4.z) + s4.z;
        const float h3 = x[j].w * rstd * g4.w * (1.f + c4.w) + s4.w;
        uint2 o; o.x = pack2(h0, h1); o.y = pack2(h2, h3);
        *(uint2*)(H + (size_t)row * 1024 + 4 * lane + 256 * j) = o;
      }
    }
  }
}

enum { EPI_F32 = 0, EPI_BF16 = 1, EPI_RELU2 = 2, EPI_NAT = 3 };
struct GemmDesc { const u16* A; const u16* Bt; void* dst; int lda, ldb, ldc, M, N, K, epi; };

DI void gemm_tile(const GemmDesc& g, int m0, int n0, float* outp, char* smem) {
  constexpr int LS = 72;
  u16* As = (u16*)smem;
  u16* Bs = As + 2 * 128 * LS;
  const int tid = ltid(), lane = tid & 63, w = tid >> 6, r = lane & 31, h = lane >> 5;
  const int wm = w >> 1, wn = w & 1;
  const int lrow = tid >> 3, lcc = tid & 7;
  const u16* ag = g.A + (size_t)(m0 + lrow) * g.lda + lcc * 8;
  const u16* bg = g.Bt + (size_t)(n0 + lrow) * g.ldb + lcc * 8;
  uint4 ra0, ra1, ra2, ra3, rb0, rb1, rb2, rb3;
  f32x16 acc00, acc01, acc10, acc11;
#pragma unroll
  for (int i = 0; i < 16; ++i) { acc00[i] = 0.f; acc01[i] = 0.f; acc10[i] = 0.f; acc11[i] = 0.f; }
  const size_t sa = (size_t)32 * g.lda, sb = (size_t)32 * g.ldb;
#define GLOAD(off)                                                                                           \
  ra0 = *(const uint4*)(ag + (off)); ra1 = *(const uint4*)(ag + sa + (off)); ra2 = *(const uint4*)(ag + 2 * sa + (off)); \
  ra3 = *(const uint4*)(ag + 3 * sa + (off)); rb0 = *(const uint4*)(bg + (off)); rb1 = *(const uint4*)(bg + sb + (off)); \
  rb2 = *(const uint4*)(bg + 2 * sb + (off)); rb3 = *(const uint4*)(bg + 3 * sb + (off));
#define LSTORE(buf)                                                                     \
  *(uint4*)&As[(buf) * 128 * LS + (lrow) * LS + lcc * 8] = ra0;                          \
  *(uint4*)&As[(buf) * 128 * LS + (lrow + 32) * LS + lcc * 8] = ra1;                     \
  *(uint4*)&As[(buf) * 128 * LS + (lrow + 64) * LS + lcc * 8] = ra2;                     \
  *(uint4*)&As[(buf) * 128 * LS + (lrow + 96) * LS + lcc * 8] = ra3;                     \
  *(uint4*)&Bs[(buf) * 128 * LS + (lrow) * LS + lcc * 8] = rb0;                          \
  *(uint4*)&Bs[(buf) * 128 * LS + (lrow + 32) * LS + lcc * 8] = rb1;                     \
  *(uint4*)&Bs[(buf) * 128 * LS + (lrow + 64) * LS + lcc * 8] = rb2;                     \
  *(uint4*)&Bs[(buf) * 128 * LS + (lrow + 96) * LS + lcc * 8] = rb3;
  GLOAD(0)
  LSTORE(0)
  __syncthreads();
  const int KT = g.K >> 6;
  for (int kt = 0; kt < KT; ++kt) {
    const int cur = kt & 1;
    if (kt + 1 < KT) { GLOAD((kt + 1) * 64) }
    const u16* Ac = As + cur * 128 * LS + (64 * wm + r) * LS + 8 * h;
    const u16* Bc = Bs + cur * 128 * LS + (64 * wn + r) * LS + 8 * h;
#pragma unroll
    for (int kk = 0; kk < 4; ++kk) {
      const bf16x8 a0 = *(const bf16x8*)(Ac + 16 * kk);
      const bf16x8 a1 = *(const bf16x8*)(Ac + 32 * LS + 16 * kk);
      const bf16x8 b0 = *(const bf16x8*)(Bc + 16 * kk);
      const bf16x8 b1 = *(const bf16x8*)(Bc + 32 * LS + 16 * kk);
      acc00 = MFMA(a0, b0, acc00);
      acc01 = MFMA(a0, b1, acc01);
      acc10 = MFMA(a1, b0, acc10);
      acc11 = MFMA(a1, b1, acc11);
    }
    if (kt + 1 < KT) { LSTORE(cur ^ 1) }
    __syncthreads();
  }
#undef GLOAD
#undef LSTORE
  const int epi = g.epi;
#pragma unroll
  for (int mi = 0; mi < 2; ++mi)
#pragma unroll
    for (int ni = 0; ni < 2; ++ni) {
      const int col = n0 + 64 * wn + 32 * ni + r;
#pragma unroll
      for (int i = 0; i < 16; ++i) {
        const int row = m0 + 64 * wm + 32 * mi + crow(i, h);
        const float v = mi == 0 ? (ni == 0 ? acc00[i] : acc01[i]) : (ni == 0 ? acc10[i] : acc11[i]);
        if (epi == EPI_F32) {
          ((float*)g.dst)[(size_t)row * g.ldc + col] = v;
        } else if (epi == EPI_BF16) {
          ((u16*)g.dst)[(size_t)row * g.ldc + col] = f2bf(v);
        } else if (epi == EPI_RELU2) {
          const float t = v > 0.f ? v : 0.f;
          ((u16*)g.dst)[(size_t)row * g.ldc + col] = f2bf(t * t);
        } else {
          ((u16*)g.dst)[(size_t)row * g.ldc + col] = f2bf(v);
          if (row < NCTX && col >= 1024) {
            if (col < 2048) outp[O_L3K + (size_t)row * 1024 + (col - 1024)] = v;
            else outp[O_L3V + (size_t)row * 1024 + (col - 2048)] = v;
          }
        }
      }
    }
}

DI void gemm_phase(const Params& p, const GemmDesc& g0, const GemmDesc& g1, int ng, char* smem) {
  const int t0 = (g0.M >> 7) * (g0.N >> 7);
  const int t1 = ng > 1 ? (g1.M >> 7) * (g1.N >> 7) : 0;
  for (int t = blockIdx.x; t < t0 + t1; t += gridDim.x) {
    const bool first = t < t0;
    GemmDesc g;
    g.A = first ? g0.A : g1.A; g.Bt = first ? g0.Bt : g1.Bt; g.dst = first ? g0.dst : g1.dst;
    g.lda = first ? g0.lda : g1.lda; g.ldb = first ? g0.ldb : g1.ldb; g.ldc = first ? g0.ldc : g1.ldc;
    g.M = first ? g0.M : g1.M; g.N = first ? g0.N : g1.N; g.K = first ? g0.K : g1.K; g.epi = first ? g0.epi : g1.epi;
    const int tt = first ? t : t - t0;
    const int nt = g.N >> 7;
    gemm_tile(g, (tt / nt) * 128, (tt % nt) * 128, p.out, smem);
  }
}

DI void pp_attn(const Params& p) {
  const int tid_ = ltid(); const int lane = tid_ & 63, w = tid_ >> 6;
  const float* Z = (const float*)(p.ws + OFF_UZ);
  u16* QKV = (u16*)(p.ws + OFF_QO);
  const float* tab = (const float*)(p.ws + OFF_ROPE);
  const float* qn = p.in[18];
  const float* kn = p.in[19];
  for (int row = blockIdx.x * 4 + w; row < NTOK; row += gridDim.x * 4) {
    const bool lat = row >= NCTX;
    const int t = (row - NCTX) & 1023, pr = t >> 6, pc = t & 63;
    const float* z = Z + (size_t)row * 1536;
    u16* o = QKV + (size_t)row * 1536;
    const int i = lane & 31;
    const float c0 = tab[(pr * 32 + i) * 2], s0 = tab[(pr * 32 + i) * 2 + 1];
    const float c1 = tab[(pc * 32 + i) * 2], s1 = tab[(pc * 32 + i) * 2 + 1];
    const float sg = lane < 32 ? -1.f : 1.f;
    for (int hd = 0; hd < 10; ++hd) {
      const float v0 = z[hd * 128 + lane], v1 = z[hd * 128 + 64 + lane];
      const float ss = wave_sum(v0 * v0 + v1 * v1);
      const float rstd = rsqrtf(ss * (1.f / 128.f) + 1e-6f);
      const float* g = hd < 8 ? qn : kn;
      float y0 = v0 * rstd * g[lane], y1 = v1 * rstd * g[64 + lane];
      if (hd >= 8 && !lat) {
        p.out[O_L0K + (size_t)row * 256 + (hd - 8) * 128 + lane] = y0;
        p.out[O_L0K + (size_t)row * 256 + (hd - 8) * 128 + 64 + lane] = y1;
      }
      const float p0 = __shfl_xor(y0, 32, 64), p1 = __shfl_xor(y1, 32, 64);
      if (lat) {
        y0 = y0 * c0 + sg * p0 * s0;
        y1 = y1 * c1 + sg * p1 * s1;
      }
      o[hd * 128 + lane] = f2bf(y0);
      o[hd * 128 + 64 + lane] = f2bf(y1);
    }
#pragma unroll
    for (int j = 0; j < 4; ++j) {
      const float v = z[1280 + 64 * j + lane];
      o[1280 + 64 * j + lane] = f2bf(v);
      if (!lat) p.out[O_L0V + (size_t)row * 256 + 64 * j + lane] = v;
    }
  }
}

DI void pp_swa(const Params& p) {
  const int tid_ = ltid(); const int lane = tid_ & 63, w = tid_ >> 6;
  const float* Z = (const float*)(p.ws + OFF_UZ);
  u16* QKV = (u16*)(p.ws + OFF_QO);
  const float* tab = (const float*)(p.ws + OFF_ROPE) + 1 * 64 * 32 * 2;
  for (int row = blockIdx.x * 4 + w; row < NTOK; row += gridDim.x * 4) {
    const bool lat = row >= NCTX;
    const int t = (row - NCTX) & 1023, pr = t >> 6, pc = t & 63;
    const float* z = Z + (size_t)row * 1536;
    u16* o = QKV + (size_t)row * 1536;
    const int i = lane & 15, axis = lane >> 5, half = (lane >> 4) & 1;
    const int pos = axis ? pc : pr;
    const float c = tab[(pos * 32 + i) * 2], s = tab[(pos * 32 + i) * 2 + 1];
    const float sg = half ? 1.f : -1.f;
    for (int hd = 0; hd < 20; ++hd) {
      float v = z[hd * 64 + lane];
      if (hd >= 16 && !lat) p.out[O_L2K + (size_t)row * 256 + (hd - 16) * 64 + lane] = v;
      const float pv = __shfl_xor(v, 16, 64);
      if (lat) v = v * c + sg * pv * s;
      o[hd * 64 + lane] = f2bf(v);
    }
#pragma unroll
    for (int j = 0; j < 4; ++j) {
      const float v = z[1280 + 64 * j + lane];
      o[1280 + 64 * j + lane] = f2bf(v);
      if (!lat) p.out[O_L2V + (size_t)row * 256 + 64 * j + lane] = v;
    }
  }
}

DI void pp_mla1(const Params& p) {
  const int tid_ = ltid(); const int lane = tid_ & 63, w = tid_ >> 6;
  const float* Z = (const float*)(p.ws + OFF_UZ);
  u16* CQ = (u16*)(p.ws + OFF_CQ);
  u16* CKV = (u16*)(p.ws + OFF_CKV);
  u16* KPE = (u16*)(p.ws + OFF_KPE);
  const float* tab = (const float*)(p.ws + OFF_ROPE) + 2 * 64 * 32 * 2;
  const float* qn = p.in[22];
  const float* kvn = p.in[23];
  for (int row = blockIdx.x * 4 + w; row < NTOK; row += gridDim.x * 4) {
    const bool lat = row >= NCTX;
    const int t = (row - NCTX) & 1023, pr = t >> 6, pc = t & 63;
    const float* z = Z + (size_t)row * 768;
    float a[6];
    float ss = 0.f;
#pragma unroll
    for (int j = 0; j < 6; ++j) { a[j] = z[64 * j + lane]; ss += a[j] * a[j]; }
    ss = wave_sum(ss);
    float rstd = rsqrtf(ss * (1.f / 384.f) + 1e-6f);
#pragma unroll
    for (int j = 0; j < 6; ++j) CQ[(size_t)row * 384 + 64 * j + lane] = f2bf(a[j] * rstd * qn[64 * j + lane]);
    ss = 0.f;
#pragma unroll
    for (int j = 0; j < 4; ++j) { a[j] = z[384 + 64 * j + lane]; ss += a[j] * a[j]; }
    ss = wave_sum(ss);
    rstd = rsqrtf(ss * (1.f / 256.f) + 1e-6f);
#pragma unroll
    for (int j = 0; j < 4; ++j) {
      const float y = a[j] * rstd * kvn[64 * j + lane];
      CKV[(size_t)row * 256 + 64 * j + lane] = f2bf(y);
      if (!lat) p.out[O_L1CKV + (size_t)row * 256 + 64 * j + lane] = y;
    }
    const int e = lane & 31;
    float v = z[640 + e];
    const float pv = __shfl_xor(v, 8, 64);
    if (lat) {
      const int i = e & 7, axis = e >> 4, half = (e >> 3) & 1;
      const int pos = axis ? pc : pr;
      const float c = tab[(pos * 32 + i) * 2], s = tab[(pos * 32 + i) * 2 + 1];
      v = v * c + (half ? pv : -pv) * s;
    }
    if (lane < 32) {
      KPE[(size_t)row * 32 + e] = f2bf(v);
      if (!lat) p.out[O_L1KPE + (size_t)row * 32 + e] = v;
    }
  }
}

DI void pp_mla2(const Params& p) {
  const int tid_ = ltid(); const int lane = tid_ & 63, w = tid_ >> 6;
  const float* Z = (const float*)(p.ws + OFF_UZ);
  u16* Q = (u16*)(p.ws + OFF_QO);
  const float* tab = (const float*)(p.ws + OFF_ROPE) + 2 * 64 * 32 * 2;
  for (int row = blockIdx.x * 4 + w; row < NTOK; row += gridDim.x * 4) {
    const bool lat = row >= NCTX;
    const int t = (row - NCTX) & 1023, pr = t >> 6, pc = t & 63;
    const float* z = Z + (size_t)row * 1536;
    for (int j = 0; j < 24; ++j) {
      const int col = 64 * j + lane;
      float v = z[col];
      const float pv = __shfl_xor(v, 8, 64);
      const int d = col % 96;
      if (lat && d >= 64) {
        const int e = d - 64;
        const int i = e & 7, axis = e >> 4, half = (e >> 3) & 1;
        const int pos = axis ? pc : pr;
        const float c = tab[(pos * 32 + i) * 2], s = tab[(pos * 32 + i) * 2 + 1];
        v = v * c + (half ? pv : -pv) * s;
      }
      Q[(size_t)row * 1536 + col] = f2bf(v);
    }
  }
}

struct Seg { const u16* k1; const u16* k2; const u16* v; int ldk1, ldk2, ldv, n0, n1, mode; };

template <int HDQK, int HDV>
DI void attn_item(const u16* __restrict__ Qp, int ldq, const Seg& sA, const Seg& sB, int nseg, int qpos0,
                  float scale_l2, const float* __restrict__ rpb_h, bool has_sink, float sink_l2,
                  u16* __restrict__ Op, int ldo, char* smem) {
  constexpr int K1W = (HDQK == 96) ? 64 : HDQK;
  constexpr int KS = HDQK + 8, VS = HDV + 8;
  constexpr int KC = HDQK / 8, VC = HDV / 8;
  u16* Ks = (u16*)smem;
  u16* Vs = Ks + 64 * KS;
  float* rp = (float*)(Vs + 64 * VS);
  const int tid = ltid(), lane = tid & 63, w = tid >> 6, r = lane & 31, h = lane >> 5;
  const int q4 = (lane & 15) >> 2, p4 = lane & 3, dblk = (lane >> 4) & 1;

  __syncthreads();
  if (rpb_h) for (int e = tid; e < 465; e += 256) rp[e] = rpb_h[e];

  bf16x8 qf[HDQK / 16];
  {
    const u16* qrow = Qp + (size_t)(32 * w + r) * ldq + 8 * h;
#pragma unroll
    for (int kk = 0; kk < HDQK / 16; ++kk) qf[kk] = *(const bf16x8*)(qrow + 16 * kk);
  }
  f32x16 o[HDV / 32];
#pragma unroll
  for (int dt = 0; dt < HDV / 32; ++dt)
#pragma unroll
    for (int i = 0; i < 16; ++i) o[dt][i] = 0.f;
  float m = -1e30f, l = 0.f;
  const int qpos = qpos0 + 32 * w + r;
  const int qr = qpos >> 6, qc = qpos & 63;
  const int r0 = min(max(qr - 4, 0), 8), c0 = min(max(qc - 8, 0), 48);

  for (int sg = 0; sg < nseg; ++sg) {
    Seg s;
    s.k1 = sg == 0 ? sA.k1 : sB.k1; s.k2 = sg == 0 ? sA.k2 : sB.k2; s.v = sg == 0 ? sA.v : sB.v;
    s.ldk1 = sg == 0 ? sA.ldk1 : sB.ldk1; s.ldk2 = sg == 0 ? sA.ldk2 : sB.ldk2; s.ldv = sg == 0 ? sA.ldv : sB.ldv;
    s.n0 = sg == 0 ? sA.n0 : sB.n0; s.n1 = sg == 0 ? sA.n1 : sB.n1; s.mode = sg == 0 ? sA.mode : sB.mode;
    const int mode = s.mode;
    for (int n = s.n0; n < s.n1; n += 64) {
      __syncthreads();
      for (int c = tid; c < 64 * KC; c += 256) {
        const int row = c / KC, cc = c - row * KC;
        const u16* src = (cc * 8 < K1W) ? s.k1 + (size_t)(n + row) * s.ldk1 + cc * 8
                                        : s.k2 + (size_t)(n + row) * s.ldk2 + (cc * 8 - K1W);
        *(uint4*)&Ks[row * KS + cc * 8] = *(const uint4*)src;
      }
      for (int c = tid; c < 64 * VC; c += 256) {
        const int row = c / VC, cc = c - row * VC;
        *(uint4*)&Vs[row * VS + cc * 8] = *(const uint4*)(s.v + (size_t)(n + row) * s.ldv + cc * 8);
      }
      __syncthreads();
      f32x16 st[2];
#pragma unroll
      for (int kt = 0; kt < 2; ++kt) {
#pragma unroll
        for (int i = 0; i < 16; ++i) st[kt][i] = 0.f;
        const u16* kb = Ks + (32 * kt + r) * KS + 8 * h;
#pragma unroll
        for (int kk = 0; kk < HDQK / 16; ++kk) {
          const bf16x8 a = *(const bf16x8*)(kb + 16 * kk);
          st[kt] = MFMA(a, qf[kk], st[kt]);
        }
      }
      float mx = -1e30f;
      if (mode == 0) {
#pragma unroll
        for (int kt = 0; kt < 2; ++kt)
#pragma unroll
          for (int i = 0; i < 16; ++i) { const float v = st[kt][i] * scale_l2; st[kt][i] = v; mx = fmaxf(mx, v); }
      } else if (mode == 1) {
#pragma unroll
        for (int kt = 0; kt < 2; ++kt)
#pragma unroll
          for (int i = 0; i < 16; ++i) {
            const int kpos = n + 32 * kt + crow(i, h);
            const int d = qpos - kpos;
            float v = st[kt][i] * scale_l2;
            if (d > 128 || d < -128) v = -1e30f;
            st[kt][i] = v; mx = fmaxf(mx, v);
          }
      } else {
#pragma unroll
        for (int kt = 0; kt < 2; ++kt)
#pragma unroll
          for (int i = 0; i < 16; ++i) {
            const int kpos = n + 32 * kt + crow(i, h);
            const int kr = kpos >> 6, kc = kpos & 63;
            const bool ok = ((unsigned)(kr - r0) < 8u) && ((unsigned)(kc - c0) < 16u);
            const int idx = ok ? (kr - qr + 7) * 31 + (kc - qc + 15) : 0;
            const float b = rp[idx];
            float v = st[kt][i] * scale_l2 + b * LOG2E;
            if (!ok) v = -1e30f;
            st[kt][i] = v; mx = fmaxf(mx, v);
          }
      }
      mx = fmaxf(mx, __shfl_xor(mx, 32, 64));
      const float mn = fmaxf(m, mx);
      const float alpha = __builtin_amdgcn_exp2f(m - mn);
      m = mn;
      float rs = 0.f;
#pragma unroll
      for (int kt = 0; kt < 2; ++kt)
#pragma unroll
        for (int i = 0; i < 16; ++i) { const float pz = __builtin_amdgcn_exp2f(st[kt][i] - mn); st[kt][i] = pz; rs += pz; }
      rs += __shfl_xor(rs, 32, 64);
      l = l * alpha + rs;
#pragma unroll
      for (int dt = 0; dt < HDV / 32; ++dt)
#pragma unroll
        for (int i = 0; i < 16; ++i) o[dt][i] *= alpha;
#pragma unroll
      for (int kt = 0; kt < 2; ++kt)
#pragma unroll
        for (int s2 = 0; s2 < 2; ++s2) {
          unsigned pk[4];
#pragma unroll
          for (int j = 0; j < 4; ++j) pk[j] = pack2(st[kt][8 * s2 + 2 * j], st[kt][8 * s2 + 2 * j + 1]);
          bf16x8 pb;
          {
            typedef unsigned u32x4 __attribute__((ext_vector_type(4)));
            u32x4 t4 = {pk[0], pk[1], pk[2], pk[3]};
            pb = __builtin_bit_cast(bf16x8, t4);
          }
          const u16* vb = Vs + (32 * kt + 16 * s2 + 4 * h + q4) * VS + 16 * dblk + 4 * p4;
#pragma unroll
          for (int dt = 0; dt < HDV / 32; ++dt) {
            const s16x4 lo = __builtin_amdgcn_ds_read_tr16_b64_v4i16((LDS3 s16x4*)(vb + 32 * dt));
            const s16x4 hi = __builtin_amdgcn_ds_read_tr16_b64_v4i16((LDS3 s16x4*)(vb + 8 * VS + 32 * dt));
            const bf16x8 va = __builtin_shufflevector(lo, hi, 0, 1, 2, 3, 4, 5, 6, 7);
            o[dt] = MFMA(va, pb, o[dt]);
          }
        }
    }
  }
  if (has_sink) l += __builtin_amdgcn_exp2f(sink_l2 - m);
  const float inv = 1.f / l;
  u16* orow = Op + (size_t)(32 * w + r) * ldo + 4 * h;
#pragma unroll
  for (int dt = 0; dt < HDV / 32; ++dt)
#pragma unroll
    for (int g = 0; g < 4; ++g) {
      uint2 v;
      v.x = pack2(o[dt][4 * g] * inv, o[dt][4 * g + 1] * inv);
      v.y = pack2(o[dt][4 * g + 2] * inv, o[dt][4 * g + 3] * inv);
      *(uint2*)(orow + 32 * dt + 8 * g) = v;
    }
}

DI void attn_phase(const Params& p, int kind, char* smem) {
  const int Hq = kind == 0 ? 8 : 16;
  const int nlat = 8 * Hq * 8, nctx = 16 * Hq * 2;
  u16* AO = (u16*)(p.ws + OFF_HAO);
  const u16* QKV = (const u16*)(p.ws + OFF_QO);
  for (int item = blockIdx.x; item < nlat + nctx; item += gridDim.x) {
    const bool lat = item < nlat;
    int b, hq, qt;
    if (lat) { b = item / (Hq * 8); const int rem = item - b * Hq * 8; hq = rem >> 3; qt = rem & 7; }
    else { const int it = item - nlat; b = it / (Hq * 2); const int rem = it - b * Hq * 2; hq = rem >> 1; qt = rem & 1; }
    const int tok0 = lat ? NCTX + b * 1024 : b * 256;
    const int S = lat ? 1024 : 256;
    const int qrow0 = tok0 + qt * 128;
    Seg sc, ss;
    sc.k2 = nullptr; sc.ldk2 = 0; ss.k2 = nullptr; ss.ldk2 = 0;
    sc.n0 = 0; sc.n1 = 512; sc.mode = 0;
    ss.n0 = 0; ss.n1 = S; ss.mode = 0;
    const u16* Qp; int ldq; float sl2; const float* rpb = nullptr; bool has_sink = false; float sink_l2 = 0.f;
    u16* Op;
    if (kind == 0) {
      const int kvh = hq >> 2;
      ss.k1 = QKV + (size_t)tok0 * 1536 + 1024 + kvh * 128; ss.ldk1 = 1536;
      ss.v = QKV + (size_t)tok0 * 1536 + 1280 + kvh * 128; ss.ldv = 1536;
      sc.k1 = (const u16*)(p.ws + OFF_CK) + (size_t)b * 512 * 256 + kvh * 128; sc.ldk1 = 256;
      sc.v = (const u16*)(p.ws + OFF_CV) + (size_t)b * 512 * 256 + kvh * 128; sc.ldv = 256;
      sl2 = 0.08838834764831845f * LOG2E;
      Qp = QKV + (size_t)qrow0 * 1536 + hq * 128; ldq = 1536;
      Op = AO + (size_t)qrow0 * 1024 + hq * 128;
    } else if (kind == 1) {
      const u16* KV = (const u16*)(p.ws + OFF_KV);
      const u16* KPE = (const u16*)(p.ws + OFF_KPE);
      ss.k1 = KV + (size_t)tok0 * 2048 + hq * 128; ss.ldk1 = 2048;
      ss.k2 = KPE + (size_t)tok0 * 32; ss.ldk2 = 32;
      ss.v = KV + (size_t)tok0 * 2048 + hq * 128 + 64; ss.ldv = 2048;
      const size_t crow0 = 12288 + (size_t)b * 512;
      sc.k1 = KV + crow0 * 2048 + hq * 128; sc.ldk1 = 2048;
      sc.k2 = KPE + crow0 * 32; sc.ldk2 = 32;
      sc.v = KV + crow0 * 2048 + hq * 128 + 64; sc.ldv = 2048;
      sl2 = 0.10206207261596575f * LOG2E;
      Qp = QKV + (size_t)qrow0 * 1536 + hq * 96; ldq = 1536;
      Op = AO + (size_t)qrow0 * 1024 + hq * 64;
    } else if (kind == 2) {
      const int kvh = hq >> 2;
      ss.k1 = QKV + (size_t)tok0 * 1536 + 1024 + kvh * 64; ss.ldk1 = 1536;
      ss.v = QKV + (size_t)tok0 * 1536 + 1280 + kvh * 64; ss.ldv = 1536;
      sc.k1 = (const u16*)(p.ws + OFF_CK) + (size_t)b * 512 * 256 + kvh * 64; sc.ldk1 = 256;
      sc.v = (const u16*)(p.ws + OFF_CV) + (size_t)b * 512 * 256 + kvh * 64; sc.ldv = 256;
      sl2 = 0.125f * LOG2E;
      has_sink = true; sink_l2 = p.in[28][hq] * LOG2E;
      if (lat) { ss.n0 = max(0, qt * 128 - 128); ss.n1 = min(1024, qt * 128 + 256); ss.mode = 1; }
      Qp = QKV + (size_t)qrow0 * 1536 + hq * 64; ldq = 1536;
      Op = AO + (size_t)qrow0 * 1024 + hq * 64;
    } else {
      ss.k1 = QKV + (size_t)tok0 * 3072 + 1024 + hq * 64; ss.ldk1 = 3072;
      ss.v = QKV + (size_t)tok0 * 3072 + 2048 + hq * 64; ss.ldv = 3072;
      sc.k1 = (const u16*)(p.ws + OFF_C3K) + (size_t)b * 512 * 1024 + hq * 64; sc.ldk1 = 1024;
      sc.v = (const u16*)(p.ws + OFF_C3V) + (size_t)b * 512 * 1024 + hq * 64; sc.ldv = 1024;
      sl2 = 0.125f * LOG2E;
      if (lat) {
        const int r0a = min(max(2 * qt - 4, 0), 8), r0b = min(max(2 * qt - 3, 0), 8);
        ss.n0 = r0a * 64; ss.n1 = (r0b + 8) * 64; ss.mode = 2;
        rpb = p.in[31] + hq * 465;
      }
      Qp = QKV + (size_t)qrow0 * 3072 + hq * 64; ldq = 3072;
      Op = AO + (size_t)qrow0 * 1024 + hq * 64;
    }
    Seg s0;
    s0.k1 = lat ? sc.k1 : ss.k1; s0.k2 = lat ? sc.k2 : ss.k2; s0.v = lat ? sc.v : ss.v;
    s0.ldk1 = lat ? sc.ldk1 : ss.ldk1; s0.ldk2 = lat ? sc.ldk2 : ss.ldk2; s0.ldv = lat ? sc.ldv : ss.ldv;
    s0.n0 = lat ? sc.n0 : ss.n0; s0.n1 = lat ? sc.n1 : ss.n1; s0.mode = lat ? sc.mode : ss.mode;
    const int nseg = lat ? 2 : 1;
    if (kind == 0) attn_item<128, 128>(Qp, ldq, s0, ss, nseg, qt * 128, sl2, rpb, has_sink, sink_l2, Op, 1024, smem);
    else if (kind == 1) attn_item<96, 64>(Qp, ldq, s0, ss, nseg, qt * 128, sl2, rpb, has_sink, sink_l2, Op, 1024, smem);
    else attn_item<64, 64>(Qp, ldq, s0, ss, nseg, qt * 128, sl2, rpb, has_sink, sink_l2, Op, 1024, smem);
  }
}

__host__ __device__ inline bool phase_exists(int ph) {
  if (ph == 0 || ph == 41) return true;
  const int l = (ph - 1) / 10, s = (ph - 1) % 10;
  if ((s == 3 || s == 4) && l != 1) return false;
  if (s == 2 && l == 3) return false;
  return true;
}

DI void run_phase(const Params& p, const Params& pk, long long z, int ph, char* smem) {
  if (ph == 0) { prepass(p, pk, z, smem); return; }
  if (ph == 41) { norm_phase(p, 4, 2); return; }
  const int l = (ph - 1) / 10, s = (ph - 1) % 10;
  char* ws = p.ws;
  GemmDesc g0, g1;
  g1 = GemmDesc{nullptr, nullptr, nullptr, 0, 0, 0, 0, 0, 0, 0};
  switch (s) {
    case 0:
      norm_phase(p, l, 0);
      if (l == 2) {
        convert_f32_bf16(p.in[6], (u16*)(ws + OFF_CK), 4096ull * 256);
        convert_f32_bf16(p.in[7], (u16*)(ws + OFF_CV), 4096ull * 256);
      } else if (l == 3) {
        convert_f32_bf16(p.in[8], (u16*)(ws + OFF_C3K), 4096ull * 1024);
        convert_f32_bf16(p.in[9], (u16*)(ws + OFF_C3V), 4096ull * 1024);
      }
      break;
    case 1: {
      const u16* H = (const u16*)(ws + OFF_HAO);
      if (l == 0) g0 = GemmDesc{H, (const u16*)(ws + OFF_AQKV), ws + OFF_UZ, 1024, 1024, 1536, NTOK, 1536, 1024, EPI_F32};
      else if (l == 1) g0 = GemmDesc{H, (const u16*)(ws + OFF_MIN), ws + OFF_UZ, 1024, 1024, 768, NTOK, 768, 1024, EPI_F32};
      else if (l == 2) g0 = GemmDesc{H, (const u16*)(ws + OFF_SQKV), ws + OFF_UZ, 1024, 1024, 1536, NTOK, 1536, 1024, EPI_F32};
      else g0 = GemmDesc{H, (const u16*)(ws + OFF_NQKV), ws + OFF_QO, 1024, 1024, 3072, NTOK, 3072, 1024, EPI_NAT};
      gemm_phase(p, g0, g1, 1, smem);
    } break;
    case 2:
      if (l == 0) pp_attn(p); else if (l == 1) pp_mla1(p); else if (l == 2) pp_swa(p);
      break;
    case 3:
      g0 = GemmDesc{(const u16*)(ws + OFF_CQ), (const u16*)(ws + OFF_MUQ), ws + OFF_UZ, 384, 384, 1536, NTOK, 1536, 384, EPI_F32};
      g1 = GemmDesc{(const u16*)(ws + OFF_CKV), (const u16*)(ws + OFF_MUKV), ws + OFF_KV, 256, 256, 2048, 16384, 2048, 256, EPI_BF16};
      gemm_phase(p, g0, g1, 2, smem);
      break;
    case 4: pp_mla2(p); break;
    case 5: attn_phase(p, l, smem); break;
    case 6: {
      const size_t wo = l == 0 ? OFF_AO_W : (l == 1 ? OFF_MO : (l == 2 ? OFF_SO : OFF_NO));
      g0 = GemmDesc{(const u16*)(ws + OFF_HAO), (const u16*)(ws + wo), ws + OFF_QO, 1024, 1024, 1024, NTOK, 1024, 1024, EPI_F32};
      gemm_phase(p, g0, g1, 1, smem);
    } break;
    case 7: norm_phase(p, l, 1); break;
    case 8:
      g0 = GemmDesc{(const u16*)(ws + OFF_HAO), (const u16*)(ws + OFF_W1T + (size_t)l * 8388608), ws + OFF_UZ, 1024, 1024, 4096, NTOK, 4096, 1024, EPI_RELU2};
      gemm_phase(p, g0, g1, 1, smem);
      break;
    case 9:
      g0 = GemmDesc{(const u16*)(ws + OFF_UZ), (const u16*)(ws + OFF_W2T + (size_t)l * 8388608), ws + OFF_QO, 4096, 4096, 1024, NTOK, 1024, 4096, EPI_F32};
      gemm_phase(p, g0, g1, 1, smem);
      break;
  }
}

__global__ void __launch_bounds__(256, 2) mega(Params p) {
  __shared__ __attribute__((aligned(16))) char smem[73728];
  cg::grid_group grid = cg::this_grid();
  for (int ph = p.ph0; ph < p.ph1; ++ph) {
    if (!phase_exists(ph)) continue;
    long long z = 0;
    asm volatile("" : "+s"(z));
    Params q;
#pragma unroll
    for (int i = 0; i < 33; ++i) q.in[i] = p.in[i] + z;
    q.out = p.out + z;
    q.ws = p.ws + z;
    q.ph0 = p.ph0; q.ph1 = p.ph1;
    run_phase(q, p, z, ph, smem);
    if (ph + 1 < p.ph1) grid.sync();
  }
}

extern "C" void kernel_launch(void* const* d_in, const int* in_sizes, int n_in, void* d_out, int out_size,
                              void* d_ws, size_t ws_size, hipStream_t stream) {
  if (n_in < 33 || ws_size < WS_NEED) { fprintf(stderr, "bad args: n_in %d ws %zu need %zu\n", n_in, ws_size, (size_t)WS_NEED); return; }
  Params p{};
  for (int i = 0; i < 33; ++i) p.in[i] = (const float*)d_in[i];
  p.out = (float*)d_out;
  p.ws = (char*)d_ws;
#if N_LAUNCH_MODE == 1
  for (int ph = 0; ph < 42; ++ph) {
    if (!phase_exists(ph)) continue;
    p.ph0 = ph; p.ph1 = ph + 1;
    hipLaunchKernelGGL(mega, dim3(512), dim3(256), 0, stream, p);
  }
#else
  static int grid_blocks = 0;
  if (!grid_blocks) {
    int dev = 0, cus = 0, per_cu = 0;
    hipGetDevice(&dev);
    hipDeviceGetAttribute(&cus, hipDeviceAttributeMultiprocessorCount, dev);
    hipOccupancyMaxActiveBlocksPerMultiprocessor(&per_cu, mega, 256, 0);
    if (per_cu > 2) per_cu = 2;
    grid_blocks = cus * per_cu;
  }
  p.ph0 = 0; p.ph1 = 42;
  void* args[] = {&p};
  hipError_t e = hipLaunchCooperativeKernel((void*)mega, dim3(grid_blocks), dim3(256), args, 0, stream);
  if (e != hipSuccess) fprintf(stderr, "cooperative launch failed: %s (grid %d)\n", hipGetErrorString(e), grid_blocks);
#endif
}
```

```cpp
#include <hip/hip_runtime.h>
#include <hip/hip_cooperative_groups.h>
#include <cstdio>
namespace cg = cooperative_groups;

typedef unsigned short u16;
typedef short bf16x8 __attribute__((ext_vector_type(8)));
typedef short s16x4 __attribute__((ext_vector_type(4)));
typedef float f32x16 __attribute__((ext_vector_type(16)));
typedef float f32x2 __attribute__((ext_vector_type(2)));
typedef __bf16 bfx2 __attribute__((ext_vector_type(2)));
#define DI __device__ __forceinline__
#define MFMA(a, b, c) __builtin_amdgcn_mfma_f32_32x32x16_bf16((a), (b), (c), 0, 0, 0)
#define LDS3 __attribute__((address_space(3)))

#ifndef N_LAUNCH_MODE
#define N_LAUNCH_MODE 0
#endif

constexpr int NTOK = 12288, NCTX = 4096;
constexpr float LOG2E = 1.4426950408889634f;

constexpr size_t O_L0K = 12582912, O_L0V = 13631488, O_L1CKV = 14680064, O_L1KPE = 15728640,
                 O_L2K = 15859712, O_L2V = 16908288, O_L3K = 17956864, O_L3V = 22151168;

constexpr size_t OFF_W1T = 0;
constexpr size_t OFF_W2T = OFF_W1T + 4ull * 4096 * 1024 * 2;
constexpr size_t OFF_AQKV = OFF_W2T + 4ull * 4096 * 1024 * 2;
constexpr size_t OFF_AO_W = OFF_AQKV + 1536ull * 1024 * 2;
constexpr size_t OFF_MIN = OFF_AO_W + 1024ull * 1024 * 2;
constexpr size_t OFF_MUQ = OFF_MIN + 768ull * 1024 * 2;
constexpr size_t OFF_MUKV = OFF_MUQ + 1536ull * 384 * 2;
constexpr size_t OFF_MO = OFF_MUKV + 2048ull * 256 * 2;
constexpr size_t OFF_SQKV = OFF_MO + 1024ull * 1024 * 2;
constexpr size_t OFF_SO = OFF_SQKV + 1536ull * 1024 * 2;
constexpr size_t OFF_NQKV = OFF_SO + 1024ull * 1024 * 2;
constexpr size_t OFF_NO = OFF_NQKV + 3072ull * 1024 * 2;
constexpr size_t OFF_MOD = OFF_NO + 1024ull * 1024 * 2;
constexpr size_t OFF_ROPE = OFF_MOD + 4ull * 9 * 6144 * 4;
constexpr size_t OFF_HAO = OFF_ROPE + 3ull * 64 * 32 * 2 * 4;
constexpr size_t OFF_UZ = OFF_HAO + 12288ull * 1024 * 2;
constexpr size_t OFF_QO = OFF_UZ + 12288ull * 4096 * 2;
constexpr size_t OFF_CQ = OFF_QO + 12288ull * 3072 * 2;
constexpr size_t OFF_CKV = OFF_CQ + 12288ull * 384 * 2;
constexpr size_t OFF_KPE = OFF_CKV + 16384ull * 256 * 2;
constexpr size_t OFF_KV = OFF_KPE + 16384ull * 32 * 2;
constexpr size_t OFF_CK = OFF_KV;
constexpr size_t OFF_CV = OFF_KV + 2097152;
constexpr size_t OFF_C3K = OFF_KV + 4194304;
constexpr size_t OFF_C3V = OFF_C3K + 8388608;
constexpr size_t OFF_BAR = OFF_KV + 16384ull * 2048 * 2;
constexpr size_t WS_NEED = OFF_BAR + 16384;

struct Params {
  const float* in[33];
  float* out;
  char* ws;
  int ph0, ph1;
};

#define AS4 __attribute__((address_space(4)))
struct KA {
  const AS4 char* ka;
  DI const float* in(int i) const { return *(const float* const AS4*)(ka + 8 * i); }
  DI float* out() const { return *(float* const AS4*)(ka + 264); }
  DI char* ws() const { return *(char* const AS4*)(ka + 272); }
};

DI unsigned pack2(float a, float b) { f32x2 f = {a, b}; bfx2 v = __builtin_convertvector(f, bfx2); return __builtin_bit_cast(unsigned, v); }
DI u16 f2bf(float a) { return (u16)(pack2(a, a) & 0xffffu); }
DI float wave_sum(float v) {
#pragma unroll
  for (int o = 32; o; o >>= 1) v += __shfl_xor(v, o, 64);
  return v;
}
DI int ltid() { int t = threadIdx.x; asm volatile("" : "+v"(t)); return t; }
DI int crow(int i, int h) { return (i & 3) + 8 * (i >> 2) + 4 * h; }

__device__ const long long TJ[18][6] = {
  {15, 0ll * 1024 * 4096, 1024, 4096, 4096, (long long)(OFF_W1T + 0ull * 8388608)},
  {15, 1ll * 1024 * 4096, 1024, 4096, 4096, (long long)(OFF_W1T + 1ull * 8388608)},
  {15, 2ll * 1024 * 4096, 1024, 4096, 4096, (long long)(OFF_W1T + 2ull * 8388608)},
  {15, 3ll * 1024 * 4096, 1024, 4096, 4096, (long long)(OFF_W1T + 3ull * 8388608)},
  {16, 0ll * 1024 * 4096, 4096, 1024, 1024, (long long)(OFF_W2T + 0ull * 8388608)},
  {16, 1ll * 1024 * 4096, 4096, 1024, 1024, (long long)(OFF_W2T + 1ull * 8388608)},
  {16, 2ll * 1024 * 4096, 4096, 1024, 1024, (long long)(OFF_W2T + 2ull * 8388608)},
  {16, 3ll * 1024 * 4096, 4096, 1024, 1024, (long long)(OFF_W2T + 3ull * 8388608)},
  {17, 0, 1024, 1536, 1536, (long long)OFF_AQKV},
  {20, 0, 1024, 1024, 1024, (long long)OFF_AO_W},
  {21, 0, 1024, 672, 768, (long long)OFF_MIN},
  {24, 0, 384, 1536, 1536, (long long)OFF_MUQ},
  {25, 0, 256, 2048, 2048, (long long)OFF_MUKV},
  {26, 0, 1024, 1024, 1024, (long long)OFF_MO},
  {27, 0, 1024, 1536, 1536, (long long)OFF_SQKV},
  {29, 0, 1024, 1024, 1024, (long long)OFF_SO},
  {30, 0, 1024, 3072, 3072, (long long)OFF_NQKV},
  {32, 0, 1024, 1024, 1024, (long long)OFF_NO},
};

DI void transpose_tile(const float* __restrict__ src, u16* __restrict__ dst, int K, int N, int k0, int n0, char* smem) {
  float (*T)[65] = (float (*)[65])smem;
  const int tid = ltid();
  const int nl = tid & 63, kl0 = tid >> 6;
  __syncthreads();
  const int n = n0 + nl;
#pragma unroll 4
  for (int j = 0; j < 16; ++j) {
    const int k = kl0 + 4 * j;
    T[k][nl] = (n < N) ? src[(size_t)(k0 + k) * N + n] : 0.f;
  }
  __syncthreads();
  const int kp = tid & 31, nl0 = tid >> 5;
#pragma unroll
  for (int j = 0; j < 8; ++j) {
    const int nn = nl0 + 8 * j;
    *(unsigned*)&dst[(size_t)(n0 + nn) * K + k0 + 2 * kp] = pack2(T[2 * kp][nn], T[2 * kp + 1][nn]);
  }
}

DI void convert_f32_bf16(const float* __restrict__ src, u16* __restrict__ dst, size_t n) {
  const size_t n4 = n >> 2;
  const int tid_ = ltid();
  for (size_t i = (size_t)blockIdx.x * 256 + tid_; i < n4; i += (size_t)gridDim.x * 256) {
    const float4 v = ((const float4*)src)[i];
    uint2 o; o.x = pack2(v.x, v.y); o.y = pack2(v.z, v.w);
    ((uint2*)dst)[i] = o;
  }
}

DI void prepass(const KA& p, char* smem) {
  int total = 0;
  for (int j = 0; j < 18; ++j) total += (int)((TJ[j][2] >> 6) * (TJ[j][4] >> 6));
  for (int t = blockIdx.x; t < total; t += gridDim.x) {
    int j = 0, tt = t;
    for (;;) { const int c = (int)((TJ[j][2] >> 6) * (TJ[j][4] >> 6)); if (tt < c) break; tt -= c; ++j; }
    const int K = (int)TJ[j][2], N = (int)TJ[j][3];
    const int nk = K >> 6;
    const int kt = tt % nk, nt = tt / nk;
    transpose_tile(p.in((int)TJ[j][0]) + TJ[j][1], (u16*)(p.ws() + TJ[j][5]), K, N, kt * 64, nt * 64, smem);
  }
  convert_f32_bf16(p.in(2), (u16*)(p.ws() + OFF_CK), 4096ull * 256);
  convert_f32_bf16(p.in(3), (u16*)(p.ws() + OFF_CV), 4096ull * 256);
  convert_f32_bf16(p.in(4), (u16*)(p.ws() + OFF_CKV) + 12288ull * 256, 4096ull * 256);
  convert_f32_bf16(p.in(5), (u16*)(p.ws() + OFF_KPE) + 12288ull * 32, 4096ull * 32);
  {
    float* tab = (float*)(p.ws() + OFF_ROPE);
    const int tid_ = ltid();
    for (int e = blockIdx.x * 256 + tid_; e < 3 * 64 * 32; e += gridDim.x * 256) {
      const int kind = e / 2048, pos = (e >> 5) & 63, i = e & 31;
      const int quarter = kind == 0 ? 32 : (kind == 1 ? 16 : 8);
      float c = 1.f, s = 0.f;
      if (i < quarter) {
        const float inv = exp2f(-(float)i / (float)quarter * 13.287712379549449f);
        const float ang = (float)pos * inv;
        c = cosf(ang); s = sinf(ang);
      }
      tab[2 * e] = c; tab[2 * e + 1] = s;
    }
  }
  {
    float* scond = (float*)smem;
    float* red = (float*)(smem + 36864);
    float* MOD = (float*)(p.ws() + OFF_MOD);
    const int tid = ltid();
    bool ready = false;
    for (int it = blockIdx.x; it < 768; it += gridDim.x) {
      __syncthreads();
      if (!ready) {
        for (int e = tid; e < 9 * 1024; e += 256) {
          const float c = e < 8192 ? p.in(10)[e] : p.in(11)[e - 8192];
          scond[e] = c / (1.f + __expf(-c));
        }
        ready = true;
        __syncthreads();
      }
      const int l = it / 192, n0 = (it % 192) * 32;
      const int col = tid & 31, kg = tid >> 5;
      float acc[9];
#pragma unroll
      for (int c = 0; c < 9; ++c) acc[c] = 0.f;
      const float* wp = p.in(12) + (size_t)l * 1024 * 6144 + n0 + col;
#pragma unroll 8
      for (int i = 0; i < 128; ++i) {
        const int k = kg + 8 * i;
        const float wv = wp[(size_t)k * 6144];
#pragma unroll
        for (int c = 0; c < 9; ++c) acc[c] += scond[c * 1024 + k] * wv;
      }
#pragma unroll
      for (int c = 0; c < 9; ++c) red[(kg * 9 + c) * 32 + col] = acc[c];
      __syncthreads();
      for (int e = tid; e < 288; e += 256) {
        const int c = e >> 5, cc = e & 31;
        float s = p.in(13)[l * 6144 + n0 + cc];
#pragma unroll
        for (int g = 0; g < 8; ++g) s += red[(g * 9 + c) * 32 + cc];
        MOD[(size_t)(l * 9 + c) * 6144 + n0 + cc] = s;
      }
    }
  }
}

DI void norm_phase(const KA& p, int l, int mode) {
  const int tid_ = ltid(); const int lane = tid_ & 63, w = tid_ >> 6;
  float* X = p.out();
  const float* MOD = (const float*)(p.ws() + OFF_MOD);
  const float* FF = (const float*)(p.ws() + OFF_QO);
  u16* H = (u16*)(p.ws() + OFF_HAO);
  const float* ng = p.in(14);
  const bool x_in = (l == 0);
  const bool add = !(l == 0 && mode == 0);
  const int la = (mode == 1) ? l : l - 1;
  const int gate_w = (mode == 1) ? 2 : 5;
  const int gadd = (mode == 1) ? 1 : 3;
  const bool do_h = mode != 2;
  const int gh = (mode == 0) ? 0 : 2, scw = (mode == 0) ? 1 : 4, shw = (mode == 0) ? 0 : 3;
  for (int row = blockIdx.x * 4 + w; row < NTOK; row += gridDim.x * 4) {
    const int ci = row < NCTX ? 8 : ((row - NCTX) >> 10);
    const float* xs = x_in ? (row < NCTX ? p.in(0) + (size_t)row * 1024 : p.in(1) + (size_t)(row - NCTX) * 1024)
                           : X + (size_t)row * 1024;
    float4 x[4];
#pragma unroll
    for (int j = 0; j < 4; ++j) x[j] = *(const float4*)(xs + 4 * lane + 256 * j);
    if (add) {
      const float* fr = FF + (size_t)row * 1024;
      float4 f[4];
      float ss = 0.f;
#pragma unroll
      for (int j = 0; j < 4; ++j) {
        f[j] = *(const float4*)(fr + 4 * lane + 256 * j);
        ss += f[j].x * f[j].x + f[j].y * f[j].y + f[j].z * f[j].z + f[j].w * f[j].w;
      }
      ss = wave_sum(ss);
      const float rstd = rsqrtf(ss * (1.f / 1024.f) + 1e-6f);
      const float* ga = ng + (la * 4 + gadd) * 1024;
      const float* gt = MOD + (size_t)(la * 9 + ci) * 6144 + gate_w * 1024;
#pragma unroll
      for (int j = 0; j < 4; ++j) {
        const float4 g4 = *(const float4*)(ga + 4 * lane + 256 * j);
        const float4 t4 = *(const float4*)(gt + 4 * lane + 256 * j);
        x[j].x += t4.x * (f[j].x * rstd * g4.x);
        x[j].y += t4.y * (f[j].y * rstd * g4.y);
        x[j].z += t4.z * (f[j].z * rstd * g4.z);
        x[j].w += t4.w * (f[j].w * rstd * g4.w);
        *(float4*)(X + (size_t)row * 1024 + 4 * lane + 256 * j) = x[j];
      }
    }
    if (do_h) {
      float ss = 0.f;
#pragma unroll
      for (int j = 0; j < 4; ++j) ss += x[j].x * x[j].x + x[j].y * x[j].y + x[j].z * x[j].z + x[j].w * x[j].w;
      ss = wave_sum(ss);
      const float rstd = rsqrtf(ss * (1.f / 1024.f) + 1e-6f);
      const float* g = ng + (l * 4 + gh) * 1024;
      const float* sc = MOD + (size_t)(l * 9 + ci) * 6144 + scw * 1024;
      const float* sh = MOD + (size_t)(l * 9 + ci) * 6144 + shw * 1024;
#pragma unroll
      for (int j = 0; j < 4; ++j) {
        const float4 g4 = *(const float4*)(g + 4 * lane + 256 * j);
        const float4 c4 = *(const float4*)(sc + 4 * lane + 256 * j);
        const float4 s4 = *(const float4*)(sh + 4 * lane + 256 * j);
        const float h0 = x[j].x * rstd * g4.x * (1.f + c4.x) + s4.x;
        const float h1 = x[j].y * rstd * g4.y * (1.f + c4.y) + s4.y;
        const float h2 = x[j].z * rstd * g4.z * (1.f + c4.z) + s4.z;
        const float h3 = x[j].w * rstd * g4.w * (1.f + c4.w) + s4.w;
        uint2 o; o.x = pack2(h0, h1); o.y = pack2(h2, h3);
        *(uint2*)(H + (size_t)row * 1024 + 4 * lane + 256 * j) = o;
      }
    }
  }
}

enum { EPI_F32 = 0, EPI_BF16 = 1, EPI_RELU2 = 2, EPI_NAT = 3 };
struct GemmDesc { const u16* A; const u16* Bt; void* dst; int lda, ldb, ldc, M, N, K, epi; };

DI void gemm_tile(const GemmDesc& g, int m0, int n0, float* outp, char* smem) {
  constexpr int LS = 72;
  u16* As = (u16*)smem;
  u16* Bs = As + 2 * 128 * LS;
  const int tid = ltid(), lane = tid & 63, w = tid >> 6, r = lane & 31, h = lane >> 5;
  const int wm = w >> 1, wn = w & 1;
  const int lrow = tid >> 3, lcc = tid & 7;
  const u16* ag = g.A + (size_t)(m0 + lrow) * g.lda + lcc * 8;
  const u16* bg = g.Bt + (size_t)(n0 + lrow) * g.ldb + lcc * 8;
  uint4 ra0, ra1, ra2, ra3, rb0, rb1, rb2, rb3;
  f32x16 acc00, acc01, acc10, acc11;
#pragma unroll
  for (int i = 0; i < 16; ++i) { acc00[i] = 0.f; acc01[i] = 0.f; acc10[i] = 0.f; acc11[i] = 0.f; }
  const size_t sa = (size_t)32 * g.lda, sb = (size_t)32 * g.ldb;
#define GLOAD(off)                                                                                           \
  ra0 = *(const uint4*)(ag + (off)); ra1 = *(const uint4*)(ag + sa + (off)); ra2 = *(const uint4*)(ag + 2 * sa + (off)); \
  ra3 = *(const uint4*)(ag + 3 * sa + (off)); rb0 = *(const uint4*)(bg + (off)); rb1 = *(const uint4*)(bg + sb + (off)); \
  rb2 = *(const uint4*)(bg + 2 * sb + (off)); rb3 = *(const uint4*)(bg + 3 * sb + (off));
#define LSTORE(buf)                                                                     \
  *(uint4*)&As[(buf) * 128 * LS + (lrow) * LS + lcc * 8] = ra0;                          \
  *(uint4*)&As[(buf) * 128 * LS + (lrow + 32) * LS + lcc * 8] = ra1;                     \
  *(uint4*)&As[(buf) * 128 * LS + (lrow + 64) * LS + lcc * 8] = ra2;                     \
  *(uint4*)&As[(buf) * 128 * LS + (lrow + 96) * LS + lcc * 8] = ra3;                     \
  *(uint4*)&Bs[(buf) * 128 * LS + (lrow) * LS + lcc * 8] = rb0;                          \
  *(uint4*)&Bs[(buf) * 128 * LS + (lrow + 32) * LS + lcc * 8] = rb1;                     \
  *(uint4*)&Bs[(buf) * 128 * LS + (lrow + 64) * LS + lcc * 8] = rb2;                     \
  *(uint4*)&Bs[(buf) * 128 * LS + (lrow + 96) * LS + lcc * 8] = rb3;
  GLOAD(0)
  LSTORE(0)
  __syncthreads();
  const int KT = g.K >> 6;
  for (int kt = 0; kt < KT; ++kt) {
    const int cur = kt & 1;
    if (kt + 1 < KT) { GLOAD((kt + 1) * 64) }
    const u16* Ac = As + cur * 128 * LS + (64 * wm + r) * LS + 8 * h;
    const u16* Bc = Bs + cur * 128 * LS + (64 * wn + r) * LS + 8 * h;
#pragma unroll
    for (int kk = 0; kk < 4; ++kk) {
      const bf16x8 a0 = *(const bf16x8*)(Ac + 16 * kk);
      const bf16x8 a1 = *(const bf16x8*)(Ac + 32 * LS + 16 * kk);
      const bf16x8 b0 = *(const bf16x8*)(Bc + 16 * kk);
      const bf16x8 b1 = *(const bf16x8*)(Bc + 32 * LS + 16 * kk);
      acc00 = MFMA(a0, b0, acc00);
      acc01 = MFMA(a0, b1, acc01);
      acc10 = MFMA(a1, b0, acc10);
      acc11 = MFMA(a1, b1, acc11);
    }
    if (kt + 1 < KT) { LSTORE(cur ^ 1) }
    __syncthreads();
  }
#undef GLOAD
#undef LSTORE
  const int epi = g.epi;
#pragma unroll
  for (int mi = 0; mi < 2; ++mi)
#pragma unroll
    for (int ni = 0; ni < 2; ++ni) {
      const int col = n0 + 64 * wn + 32 * ni + r;
#pragma unroll
      for (int i = 0; i < 16; ++i) {
        const int row = m0 + 64 * wm + 32 * mi + crow(i, h);
        const float v = mi == 0 ? (ni == 0 ? acc00[i] : acc01[i]) : (ni == 0 ? acc10[i] : acc11[i]);
        if (epi == EPI_F32) {
          ((float*)g.dst)[(size_t)row * g.ldc + col] = v;
        } else if (epi == EPI_BF16) {
          ((u16*)g.dst)[(size_t)row * g.ldc + col] = f2bf(v);
        } else if (epi == EPI_RELU2) {
          const float t = v > 0.f ? v : 0.f;
          ((u16*)g.dst)[(size_t)row * g.ldc + col] = f2bf(t * t);
        } else {
          ((u16*)g.dst)[(size_t)row * g.ldc + col] = f2bf(v);
          if (row < NCTX && col >= 1024) {
            if (col < 2048) outp[O_L3K + (size_t)row * 1024 + (col - 1024)] = v;
            else outp[O_L3V + (size_t)row * 1024 + (col - 2048)] = v;
          }
        }
      }
    }
}

DI void gemm_phase(const KA& p, const GemmDesc& g0, const GemmDesc& g1, int ng, char* smem) {
  const int t0 = (g0.M >> 7) * (g0.N >> 7);
  const int t1 = ng > 1 ? (g1.M >> 7) * (g1.N >> 7) : 0;
  for (int t = blockIdx.x; t < t0 + t1; t += gridDim.x) {
    const bool first = t < t0;
    GemmDesc g;
    g.A = first ? g0.A : g1.A; g.Bt = first ? g0.Bt : g1.Bt; g.dst = first ? g0.dst : g1.dst;
    g.lda = first ? g0.lda : g1.lda; g.ldb = first ? g0.ldb : g1.ldb; g.ldc = first ? g0.ldc : g1.ldc;
    g.M = first ? g0.M : g1.M; g.N = first ? g0.N : g1.N; g.K = first ? g0.K : g1.K; g.epi = first ? g0.epi : g1.epi;
    const int tt = first ? t : t - t0;
    const int nt = g.N >> 7;
    gemm_tile(g, (tt / nt) * 128, (tt % nt) * 128, p.out(), smem);
  }
}

DI void pp_attn(const KA& p) {
  const int tid_ = ltid(); const int lane = tid_ & 63, w = tid_ >> 6;
  const float* Z = (const float*)(p.ws() + OFF_UZ);
  u16* QKV = (u16*)(p.ws() + OFF_QO);
  const float* tab = (const float*)(p.ws() + OFF_ROPE);
  const float* qn = p.in(18);
  const float* kn = p.in(19);
  for (int row = blockIdx.x * 4 + w; row < NTOK; row += gridDim.x * 4) {
    const bool lat = row >= NCTX;
    const int t = (row - NCTX) & 1023, pr = t >> 6, pc = t & 63;
    const float* z = Z + (size_t)row * 1536;
    u16* o = QKV + (size_t)row * 1536;
    const int i = lane & 31;
    const float c0 = tab[(pr * 32 + i) * 2], s0 = tab[(pr * 32 + i) * 2 + 1];
    const float c1 = tab[(pc * 32 + i) * 2], s1 = tab[(pc * 32 + i) * 2 + 1];
    const float sg = lane < 32 ? -1.f : 1.f;
    for (int hd = 0; hd < 10; ++hd) {
      const float v0 = z[hd * 128 + lane], v1 = z[hd * 128 + 64 + lane];
      const float ss = wave_sum(v0 * v0 + v1 * v1);
      const float rstd = rsqrtf(ss * (1.f / 128.f) + 1e-6f);
      const float* g = hd < 8 ? qn : kn;
      float y0 = v0 * rstd * g[lane], y1 = v1 * rstd * g[64 + lane];
      if (hd >= 8 && !lat) {
        p.out()[O_L0K + (size_t)row * 256 + (hd - 8) * 128 + lane] = y0;
        p.out()[O_L0K + (size_t)row * 256 + (hd - 8) * 128 + 64 + lane] = y1;
      }
      const float p0 = __shfl_xor(y0, 32, 64), p1 = __shfl_xor(y1, 32, 64);
      if (lat) {
        y0 = y0 * c0 + sg * p0 * s0;
        y1 = y1 * c1 + sg * p1 * s1;
      }
      o[hd * 128 + lane] = f2bf(y0);
      o[hd * 128 + 64 + lane] = f2bf(y1);
    }
#pragma unroll
    for (int j = 0; j < 4; ++j) {
      const float v = z[1280 + 64 * j + lane];
      o[1280 + 64 * j + lane] = f2bf(v);
      if (!lat) p.out()[O_L0V + (size_t)row * 256 + 64 * j + lane] = v;
    }
  }
}

DI void pp_swa(const KA& p) {
  const int tid_ = ltid(); const int lane = tid_ & 63, w = tid_ >> 6;
  const float* Z = (const float*)(p.ws() + OFF_UZ);
  u16* QKV = (u16*)(p.ws() + OFF_QO);
  const float* tab = (const float*)(p.ws() + OFF_ROPE) + 1 * 64 * 32 * 2;
  for (int row = blockIdx.x * 4 + w; row < NTOK; row += gridDim.x * 4) {
    const bool lat = row >= NCTX;
    const int t = (row - NCTX) & 1023, pr = t >> 6, pc = t & 63;
    const float* z = Z + (size_t)row * 1536;
    u16* o = QKV + (size_t)row * 1536;
    const int i = lane & 15, axis = lane >> 5, half = (lane >> 4) & 1;
    const int pos = axis ? pc : pr;
    const float c = tab[(pos * 32 + i) * 2], s = tab[(pos * 32 + i) * 2 + 1];
    const float sg = half ? 1.f : -1.f;
    for (int hd = 0; hd < 20; ++hd) {
      float v = z[hd * 64 + lane];
      if (hd >= 16 && !lat) p.out()[O_L2K + (size_t)row * 256 + (hd - 16) * 64 + lane] = v;
      const float pv = __shfl_xor(v, 16, 64);
      if (lat) v = v * c + sg * pv * s;
      o[hd * 64 + lane] = f2bf(v);
    }
#pragma unroll
    for (int j = 0; j < 4; ++j) {
      const float v = z[1280 + 64 * j + lane];
      o[1280 + 64 * j + lane] = f2bf(v);
      if (!lat) p.out()[O_L2V + (size_t)row * 256 + 64 * j + lane] = v;
    }
  }
}

DI void pp_mla1(const KA& p) {
  const int tid_ = ltid(); const int lane = tid_ & 63, w = tid_ >> 6;
  const float* Z = (const float*)(p.ws() + OFF_UZ);
  u16* CQ = (u16*)(p.ws() + OFF_CQ);
  u16* CKV = (u16*)(p.ws() + OFF_CKV);
  u16* KPE = (u16*)(p.ws() + OFF_KPE);
  const float* tab = (const float*)(p.ws() + OFF_ROPE) + 2 * 64 * 32 * 2;
  const float* qn = p.in(22);
  const float* kvn = p.in(23);
  for (int row = blockIdx.x * 4 + w; row < NTOK; row += gridDim.x * 4) {
    const bool lat = row >= NCTX;
    const int t = (row - NCTX) & 1023, pr = t >> 6, pc = t & 63;
    const float* z = Z + (size_t)row * 768;
    float a[6];
    float ss = 0.f;
#pragma unroll
    for (int j = 0; j < 6; ++j) { a[j] = z[64 * j + lane]; ss += a[j] * a[j]; }
    ss = wave_sum(ss);
    float rstd = rsqrtf(ss * (1.f / 384.f) + 1e-6f);
#pragma unroll
    for (int j = 0; j < 6; ++j) CQ[(size_t)row * 384 + 64 * j + lane] = f2bf(a[j] * rstd * qn[64 * j + lane]);
    ss = 0.f;
#pragma unroll
    for (int j = 0; j < 4; ++j) { a[j] = z[384 + 64 * j + lane]; ss += a[j] * a[j]; }
    ss = wave_sum(ss);
    rstd = rsqrtf(ss * (1.f / 256.f) + 1e-6f);
#pragma unroll
    for (int j = 0; j < 4; ++j) {
      const float y = a[j] * rstd * kvn[64 * j + lane];
      CKV[(size_t)row * 256 + 64 * j + lane] = f2bf(y);
      if (!lat) p.out()[O_L1CKV + (size_t)row * 256 + 64 * j + lane] = y;
    }
    const int e = lane & 31;
    float v = z[640 + e];
    const float pv = __shfl_xor(v, 8, 64);
    if (lat) {
      const int i = e & 7, axis = e >> 4, half = (e >> 3) & 1;
      const int pos = axis ? pc : pr;
      const float c = tab[(pos * 32 + i) * 2], s = tab[(pos * 32 + i) * 2 + 1];
      v = v * c + (half ? pv : -pv) * s;
    }
    if (lane < 32) {
      KPE[(size_t)row * 32 + e] = f2bf(v);
      if (!lat) p.out()[O_L1KPE + (size_t)row * 32 + e] = v;
    }
  }
}

DI void pp_mla2(const KA& p) {
  const int tid_ = ltid(); const int lane = tid_ & 63, w = tid_ >> 6;
  const float* Z = (const float*)(p.ws() + OFF_UZ);
  u16* Q = (u16*)(p.ws() + OFF_QO);
  const float* tab = (const float*)(p.ws() + OFF_ROPE) + 2 * 64 * 32 * 2;
  for (int row = blockIdx.x * 4 + w; row < NTOK; row += gridDim.x * 4) {
    const bool lat = row >= NCTX;
    const int t = (row - NCTX) & 1023, pr = t >> 6, pc = t & 63;
    const float* z = Z + (size_t)row * 1536;
    for (int j = 0; j < 24; ++j) {
      const int col = 64 * j + lane;
      float v = z[col];
      const float pv = __shfl_xor(v, 8, 64);
      const int d = col % 96;
      if (lat && d >= 64) {
        const int e = d - 64;
        const int i = e & 7, axis = e >> 4, half = (e >> 3) & 1;
        const int pos = axis ? pc : pr;
        const float c = tab[(pos * 32 + i) * 2], s = tab[(pos * 32 + i) * 2 + 1];
        v = v * c + (half ? pv : -pv) * s;
      }
      Q[(size_t)row * 1536 + col] = f2bf(v);
    }
  }
}

struct Seg { const u16* k1; const u16* k2; const u16* v; int ldk1, ldk2, ldv, n0, n1, mode; };

template <int HDQK, int HDV>
DI void attn_item(const u16* __restrict__ Qp, int ldq, const Seg& sA, const Seg& sB, int nseg, int qpos0,
                  float scale_l2, const float* __restrict__ rpb_h, bool has_sink, float sink_l2,
                  u16* __restrict__ Op, int ldo, char* smem) {
  constexpr int K1W = (HDQK == 96) ? 64 : HDQK;
  constexpr int KS = HDQK + 8, VS = HDV + 8;
  constexpr int KC = HDQK / 8, VC = HDV / 8;
  u16* Ks = (u16*)smem;
  u16* Vs = Ks + 64 * KS;
  float* rp = (float*)(Vs + 64 * VS);
  const int tid = ltid(), lane = tid & 63, w = tid >> 6, r = lane & 31, h = lane >> 5;
  const int q4 = (lane & 15) >> 2, p4 = lane & 3, dblk = (lane >> 4) & 1;

  __syncthreads();
  if (rpb_h) for (int e = tid; e < 465; e += 256) rp[e] = rpb_h[e];

  bf16x8 qf[HDQK / 16];
  {
    const u16* qrow = Qp + (size_t)(32 * w + r) * ldq + 8 * h;
#pragma unroll
    for (int kk = 0; kk < HDQK / 16; ++kk) qf[kk] = *(const bf16x8*)(qrow + 16 * kk);
  }
  f32x16 o[HDV / 32];
#pragma unroll
  for (int dt = 0; dt < HDV / 32; ++dt)
#pragma unroll
    for (int i = 0; i < 16; ++i) o[dt][i] = 0.f;
  float m = -1e30f, l = 0.f;
  const int qpos = qpos0 + 32 * w + r;
  const int qr = qpos >> 6, qc = qpos & 63;
  const int r0 = min(max(qr - 4, 0), 8), c0 = min(max(qc - 8, 0), 48);

  for (int sg = 0; sg < nseg; ++sg) {
    Seg s;
    s.k1 = sg == 0 ? sA.k1 : sB.k1; s.k2 = sg == 0 ? sA.k2 : sB.k2; s.v = sg == 0 ? sA.v : sB.v;
    s.ldk1 = sg == 0 ? sA.ldk1 : sB.ldk1; s.ldk2 = sg == 0 ? sA.ldk2 : sB.ldk2; s.ldv = sg == 0 ? sA.ldv : sB.ldv;
    s.n0 = sg == 0 ? sA.n0 : sB.n0; s.n1 = sg == 0 ? sA.n1 : sB.n1; s.mode = sg == 0 ? sA.mode : sB.mode;
    const int mode = s.mode;
    for (int n = s.n0; n < s.n1; n += 64) {
      __syncthreads();
      for (int c = tid; c < 64 * KC; c += 256) {
        const int row = c / KC, cc = c - row * KC;
        const u16* src = (cc * 8 < K1W) ? s.k1 + (size_t)(n + row) * s.ldk1 + cc * 8
                                        : s.k2 + (size_t)(n + row) * s.ldk2 + (cc * 8 - K1W);
        *(uint4*)&Ks[row * KS + cc * 8] = *(const uint4*)src;
      }
      for (int c = tid; c < 64 * VC; c += 256) {
        const int row = c / VC, cc = c - row * VC;
        *(uint4*)&Vs[row * VS + cc * 8] = *(const uint4*)(s.v + (size_t)(n + row) * s.ldv + cc * 8);
      }
      __syncthreads();
      f32x16 st[2];
#pragma unroll
      for (int kt = 0; kt < 2; ++kt) {
#pragma unroll
        for (int i = 0; i < 16; ++i) st[kt][i] = 0.f;
        const u16* kb = Ks + (32 * kt + r) * KS + 8 * h;
#pragma unroll
        for (int kk = 0; kk < HDQK / 16; ++kk) {
          const bf16x8 a = *(const bf16x8*)(kb + 16 * kk);
          st[kt] = MFMA(a, qf[kk], st[kt]);
        }
      }
      float mx = -1e30f;
      if (mode == 0) {
#pragma unroll
        for (int kt = 0; kt < 2; ++kt)
#pragma unroll
          for (int i = 0; i < 16; ++i) { const float v = st[kt][i] * scale_l2; st[kt][i] = v; mx = fmaxf(mx, v); }
      } else if (mode == 1) {
#pragma unroll
        for (int kt = 0; kt < 2; ++kt)
#pragma unroll
          for (int i = 0; i < 16; ++i) {
            const int kpos = n + 32 * kt + crow(i, h);
            const int d = qpos - kpos;
            float v = st[kt][i] * scale_l2;
            if (d > 128 || d < -128) v = -1e30f;
            st[kt][i] = v; mx = fmaxf(mx, v);
          }
      } else {
#pragma unroll
        for (int kt = 0; kt < 2; ++kt)
#pragma unroll
          for (int i = 0; i < 16; ++i) {
            const int kpos = n + 32 * kt + crow(i, h);
            const int kr = kpos >> 6, kc = kpos & 63;
            const bool ok = ((unsigned)(kr - r0) < 8u) && ((unsigned)(kc - c0) < 16u);
            const int idx = ok ? (kr - qr + 7) * 31 + (kc - qc + 15) : 0;
            const float b = rp[idx];
            float v = st[kt][i] * scale_l2 + b * LOG2E;
            if (!ok) v = -1e30f;
            st[kt][i] = v; mx = fmaxf(mx, v);
          }
      }
      mx = fmaxf(mx, __shfl_xor(mx, 32, 64));
      const float mn = fmaxf(m, mx);
      const float alpha = __builtin_amdgcn_exp2f(m - mn);
      m = mn;
      float rs = 0.f;
#pragma unroll
      for (int kt = 0; kt < 2; ++kt)
#pragma unroll
        for (int i = 0; i < 16; ++i) { const float pz = __builtin_amdgcn_exp2f(st[kt][i] - mn); st[kt][i] = pz; rs += pz; }
      rs += __shfl_xor(rs, 32, 64);
      l = l * alpha + rs;
#pragma unroll
      for (int dt = 0; dt < HDV / 32; ++dt)
#pragma unroll
        for (int i = 0; i < 16; ++i) o[dt][i] *= alpha;
#pragma unroll
      for (int kt = 0; kt < 2; ++kt)
#pragma unroll
        for (int s2 = 0; s2 < 2; ++s2) {
          unsigned pk[4];
#pragma unroll
          for (int j = 0; j < 4; ++j) pk[j] = pack2(st[kt][8 * s2 + 2 * j], st[kt][8 * s2 + 2 * j + 1]);
          bf16x8 pb;
          {
            typedef unsigned u32x4 __attribute__((ext_vector_type(4)));
            u32x4 t4 = {pk[0], pk[1], pk[2], pk[3]};
            pb = __builtin_bit_cast(bf16x8, t4);
          }
          const u16* vb = Vs + (32 * kt + 16 * s2 + 4 * h + q4) * VS + 16 * dblk + 4 * p4;
#pragma unroll
          for (int dt = 0; dt < HDV / 32; ++dt) {
            const s16x4 lo = __builtin_amdgcn_ds_read_tr16_b64_v4i16((LDS3 s16x4*)(vb + 32 * dt));
            const s16x4 hi = __builtin_amdgcn_ds_read_tr16_b64_v4i16((LDS3 s16x4*)(vb + 8 * VS + 32 * dt));
            const bf16x8 va = __builtin_shufflevector(lo, hi, 0, 1, 2, 3, 4, 5, 6, 7);
            o[dt] = MFMA(va, pb, o[dt]);
          }
        }
    }
  }
  if (has_sink) l += __builtin_amdgcn_exp2f(sink_l2 - m);
  const float inv = 1.f / l;
  u16* orow = Op + (size_t)(32 * w + r) * ldo + 4 * h;
#pragma unroll
  for (int dt = 0; dt < HDV / 32; ++dt)
#pragma unroll
    for (int g = 0; g < 4; ++g) {
      uint2 v;
      v.x = pack2(o[dt][4 * g] * inv, o[dt][4 * g + 1] * inv);
      v.y = pack2(o[dt][4 * g + 2] * inv, o[dt][4 * g + 3] * inv);
      *(uint2*)(orow + 32 * dt + 8 * g) = v;
    }
}

DI void attn_phase(const KA& p, int kind, char* smem) {
  const int Hq = kind == 0 ? 8 : 16;
  const int nlat = 8 * Hq * 8, nctx = 16 * Hq * 2;
  u16* AO = (u16*)(p.ws() + OFF_HAO);
  const u16* QKV = (const u16*)(p.ws() + OFF_QO);
  for (int item = blockIdx.x; item < nlat + nctx; item += gridDim.x) {
    const bool lat = item < nlat;
    int b, hq, qt;
    if (lat) { b = item / (Hq * 8); const int rem = item - b * Hq * 8; hq = rem >> 3; qt = rem & 7; }
    else { const int it = item - nlat; b = it / (Hq * 2); const int rem = it - b * Hq * 2; hq = rem >> 1; qt = rem & 1; }
    const int tok0 = lat ? NCTX + b * 1024 : b * 256;
    const int S = lat ? 1024 : 256;
    const int qrow0 = tok0 + qt * 128;
    Seg sc, ss;
    sc.k2 = nullptr; sc.ldk2 = 0; ss.k2 = nullptr; ss.ldk2 = 0;
    sc.n0 = 0; sc.n1 = 512; sc.mode = 0;
    ss.n0 = 0; ss.n1 = S; ss.mode = 0;
    const u16* Qp; int ldq; float sl2; const float* rpb = nullptr; bool has_sink = false; float sink_l2 = 0.f;
    u16* Op;
    if (kind == 0) {
      const int kvh = hq >> 2;
      ss.k1 = QKV + (size_t)tok0 * 1536 + 1024 + kvh * 128; ss.ldk1 = 1536;
      ss.v = QKV + (size_t)tok0 * 1536 + 1280 + kvh * 128; ss.ldv = 1536;
      sc.k1 = (const u16*)(p.ws() + OFF_CK) + (size_t)b * 512 * 256 + kvh * 128; sc.ldk1 = 256;
      sc.v = (const u16*)(p.ws() + OFF_CV) + (size_t)b * 512 * 256 + kvh * 128; sc.ldv = 256;
      sl2 = 0.08838834764831845f * LOG2E;
      Qp = QKV + (size_t)qrow0 * 1536 + hq * 128; ldq = 1536;
      Op = AO + (size_t)qrow0 * 1024 + hq * 128;
    } else if (kind == 1) {
      const u16* KV = (const u16*)(p.ws() + OFF_KV);
      const u16* KPE = (const u16*)(p.ws() + OFF_KPE);
      ss.k1 = KV + (size_t)tok0 * 2048 + hq * 128; ss.ldk1 = 2048;
      ss.k2 = KPE + (size_t)tok0 * 32; ss.ldk2 = 32;
      ss.v = KV + (size_t)tok0 * 2048 + hq * 128 + 64; ss.ldv = 2048;
      const size_t crow0 = 12288 + (size_t)b * 512;
      sc.k1 = KV + crow0 * 2048 + hq * 128; sc.ldk1 = 2048;
      sc.k2 = KPE + crow0 * 32; sc.ldk2 = 32;
      sc.v = KV + crow0 * 2048 + hq * 128 + 64; sc.ldv = 2048;
      sl2 = 0.10206207261596575f * LOG2E;
      Qp = QKV + (size_t)qrow0 * 1536 + hq * 96; ldq = 1536;
      Op = AO + (size_t)qrow0 * 1024 + hq * 64;
    } else if (kind == 2) {
      const int kvh = hq >> 2;
      ss.k1 = QKV + (size_t)tok0 * 1536 + 1024 + kvh * 64; ss.ldk1 = 1536;
      ss.v = QKV + (size_t)tok0 * 1536 + 1280 + kvh * 64; ss.ldv = 1536;
      sc.k1 = (const u16*)(p.ws() + OFF_CK) + (size_t)b * 512 * 256 + kvh * 64; sc.ldk1 = 256;
      sc.v = (const u16*)(p.ws() + OFF_CV) + (size_t)b * 512 * 256 + kvh * 64; sc.ldv = 256;
      sl2 = 0.125f * LOG2E;
      has_sink = true; sink_l2 = p.in(28)[hq] * LOG2E;
      if (lat) { ss.n0 = max(0, qt * 128 - 128); ss.n1 = min(1024, qt * 128 + 256); ss.mode = 1; }
      Qp = QKV + (size_t)qrow0 * 1536 + hq * 64; ldq = 1536;
      Op = AO + (size_t)qrow0 * 1024 + hq * 64;
    } else {
      ss.k1 = QKV + (size_t)tok0 * 3072 + 1024 + hq * 64; ss.ldk1 = 3072;
      ss.v = QKV + (size_t)tok0 * 3072 + 2048 + hq * 64; ss.ldv = 3072;
      sc.k1 = (const u16*)(p.ws() + OFF_C3K) + (size_t)b * 512 * 1024 + hq * 64; sc.ldk1 = 1024;
      sc.v = (const u16*)(p.ws() + OFF_C3V) + (size_t)b * 512 * 1024 + hq * 64; sc.ldv = 1024;
      sl2 = 0.125f * LOG2E;
      if (lat) {
        const int r0a = min(max(2 * qt - 4, 0), 8), r0b = min(max(2 * qt - 3, 0), 8);
        ss.n0 = r0a * 64; ss.n1 = (r0b + 8) * 64; ss.mode = 2;
        rpb = p.in(31) + hq * 465;
      }
      Qp = QKV + (size_t)qrow0 * 3072 + hq * 64; ldq = 3072;
      Op = AO + (size_t)qrow0 * 1024 + hq * 64;
    }
    Seg s0;
    s0.k1 = lat ? sc.k1 : ss.k1; s0.k2 = lat ? sc.k2 : ss.k2; s0.v = lat ? sc.v : ss.v;
    s0.ldk1 = lat ? sc.ldk1 : ss.ldk1; s0.ldk2 = lat ? sc.ldk2 : ss.ldk2; s0.ldv = lat ? sc.ldv : ss.ldv;
    s0.n0 = lat ? sc.n0 : ss.n0; s0.n1 = lat ? sc.n1 : ss.n1; s0.mode = lat ? sc.mode : ss.mode;
    const int nseg = lat ? 2 : 1;
    if (kind == 0) attn_item<128, 128>(Qp, ldq, s0, ss, nseg, qt * 128, sl2, rpb, has_sink, sink_l2, Op, 1024, smem);
    else if (kind == 1) attn_item<96, 64>(Qp, ldq, s0, ss, nseg, qt * 128, sl2, rpb, has_sink, sink_l2, Op, 1024, smem);
    else attn_item<64, 64>(Qp, ldq, s0, ss, nseg, qt * 128, sl2, rpb, has_sink, sink_l2, Op, 1024, smem);
  }
}

__host__ __device__ inline bool phase_exists(int ph) {
  if (ph == 0 || ph == 41) return true;
  const int l = (ph - 1) / 10, s = (ph - 1) % 10;
  if ((s == 3 || s == 4) && l != 1) return false;
  if (s == 2 && l == 3) return false;
  return true;
}

DI void run_phase(const KA& p, int ph, char* smem) {
  if (ph == 0) { prepass(p, smem); return; }
  if (ph == 41) { norm_phase(p, 4, 2); return; }
  const int l = (ph - 1) / 10, s = (ph - 1) % 10;
  char* ws = p.ws();
  GemmDesc g0, g1;
  g1 = GemmDesc{nullptr, nullptr, nullptr, 0, 0, 0, 0, 0, 0, 0};
  switch (s) {
    case 0:
      norm_phase(p, l, 0);
      if (l == 2) {
        convert_f32_bf16(p.in(6), (u16*)(ws + OFF_CK), 4096ull * 256);
        convert_f32_bf16(p.in(7), (u16*)(ws + OFF_CV), 4096ull * 256);
      } else if (l == 3) {
        convert_f32_bf16(p.in(8), (u16*)(ws + OFF_C3K), 4096ull * 1024);
        convert_f32_bf16(p.in(9), (u16*)(ws + OFF_C3V), 4096ull * 1024);
      }
      break;
    case 1: {
      const u16* H = (const u16*)(ws + OFF_HAO);
      if (l == 0) g0 = GemmDesc{H, (const u16*)(ws + OFF_AQKV), ws + OFF_UZ, 1024, 1024, 1536, NTOK, 1536, 1024, EPI_F32};
      else if (l == 1) g0 = GemmDesc{H, (const u16*)(ws + OFF_MIN), ws + OFF_UZ, 1024, 1024, 768, NTOK, 768, 1024, EPI_F32};
      else if (l == 2) g0 = GemmDesc{H, (const u16*)(ws + OFF_SQKV), ws + OFF_UZ, 1024, 1024, 1536, NTOK, 1536, 1024, EPI_F32};
      else g0 = GemmDesc{H, (const u16*)(ws + OFF_NQKV), ws + OFF_QO, 1024, 1024, 3072, NTOK, 3072, 1024, EPI_NAT};
      gemm_phase(p, g0, g1, 1, smem);
    } break;
    case 2:
      if (l == 0) pp_attn(p); else if (l == 1) pp_mla1(p); else if (l == 2) pp_swa(p);
      break;
    case 3:
      g0 = GemmDesc{(const u16*)(ws + OFF_CQ), (const u16*)(ws + OFF_MUQ), ws + OFF_UZ, 384, 384, 1536, NTOK, 1536, 384, EPI_F32};
      g1 = GemmDesc{(const u16*)(ws + OFF_CKV), (const u16*)(ws + OFF_MUKV), ws + OFF_KV, 256, 256, 2048, 16384, 2048, 256, EPI_BF16};
      gemm_phase(p, g0, g1, 2, smem);
      break;
    case 4: pp_mla2(p); break;
    case 5: attn_phase(p, l, smem); break;
    case 6: {
      const size_t wo = l == 0 ? OFF_AO_W : (l == 1 ? OFF_MO : (l == 2 ? OFF_SO : OFF_NO));
      g0 = GemmDesc{(const u16*)(ws + OFF_HAO), (const u16*)(ws + wo), ws + OFF_QO, 1024, 1024, 1024, NTOK, 1024, 1024, EPI_F32};
      gemm_phase(p, g0, g1, 1, smem);
    } break;
    case 7: norm_phase(p, l, 1); break;
    case 8:
      g0 = GemmDesc{(const u16*)(ws + OFF_HAO), (const u16*)(ws + OFF_W1T + (size_t)l * 8388608), ws + OFF_UZ, 1024, 1024, 4096, NTOK, 4096, 1024, EPI_RELU2};
      gemm_phase(p, g0, g1, 1, smem);
      break;
    case 9:
      g0 = GemmDesc{(const u16*)(ws + OFF_UZ), (const u16*)(ws + OFF_W2T + (size_t)l * 8388608), ws + OFF_QO, 4096, 4096, 1024, NTOK, 1024, 4096, EPI_F32};
      gemm_phase(p, g0, g1, 1, smem);
      break;
  }
}

#define XB_TMO      128
#define XB_XCNT(j)  (256  + 64 * (j))
#define XB_XSUB(j)  (1280 + 64 * (j))
#define XB_XGEN(j)  (2304 + 64 * (j))
#define XB_TOP      3328
#define XB_TOPGEN   3392
#define XCD_BAR_WORDS 3456
#define XB_SPIN_CAP (1u << 18)
#define LAS __attribute__((address_space(3)))

__device__ __forceinline__ unsigned xb_ld(unsigned* p)              { return __hip_atomic_load(p, __ATOMIC_RELAXED, __HIP_MEMORY_SCOPE_AGENT); }
__device__ __forceinline__ unsigned xb_add(unsigned* p, unsigned v) { return __hip_atomic_fetch_add(p, v, __ATOMIC_RELAXED, __HIP_MEMORY_SCOPE_AGENT); }
__device__ __forceinline__ unsigned xb_xcc_id() { return (unsigned)__builtin_amdgcn_s_getreg((3 << 11) | 20) & 0xFu; }
#define XB_SPIN(cond, bar) do { unsigned _sp = 0; while (cond) { __builtin_amdgcn_s_sleep(1); \
    if ((++_sp & 255u) == 0u) { if (xb_ld(&(bar)[XB_TMO])) break; if (_sp > XB_SPIN_CAP) { atomicAdd(&(bar)[XB_TMO], 1u); break; } } } } while (0)

struct XcdBarrier {
    unsigned* bar; unsigned x;
    volatile LAS unsigned* st;
};

__device__ __forceinline__ XcdBarrier xcd_barrier_post(unsigned* bar, volatile LAS unsigned* st) {
    XcdBarrier b; b.bar = bar; b.x = xb_xcc_id(); b.st = st;
    if (threadIdx.x == 0) (void)xb_add(&bar[XB_XCNT(b.x)], 1u);
    return b;
}
__device__ __forceinline__ void xcd_barrier_complete(unsigned* bar, unsigned x, unsigned& nloc, unsigned& nx) {
    const unsigned G = gridDim.x * gridDim.y * gridDim.z;
    unsigned sum, cnt, mine, sp = 0u;
    for (;;) {
        sum = 0u; cnt = 0u; mine = 0u;
#pragma unroll
        for (unsigned j = 0; j < 16; ++j) { const unsigned c = xb_ld(&bar[XB_XCNT(j)]); sum += c; cnt += (c > 0u) ? 1u : 0u; mine = (j == x) ? c : mine; }
        if (sum == G) break;
        __builtin_amdgcn_s_sleep(1);
        if ((++sp & 255u) == 0u) { if (xb_ld(&bar[XB_TMO])) break; if (sp > XB_SPIN_CAP) { atomicAdd(&bar[XB_TMO], 1u); break; } }
    }
    nloc = mine > 0u ? mine : 1u; nx = cnt > 0u ? cnt : 1u;
}

__device__ __forceinline__ void xcd_barrier(const XcdBarrier& b) {
    asm volatile("s_waitcnt vmcnt(0)" ::: "memory");
    __syncthreads();
    if (threadIdx.x == 0) {
        unsigned* bar = b.bar;
        __builtin_amdgcn_s_waitcnt(0);
        unsigned nloc = b.st[0], nx = b.st[1];
        if (nloc == 0u) { xcd_barrier_complete(bar, b.x, nloc, nx); b.st[0] = nloc; b.st[1] = nx; }
        const unsigned old = xb_add(&bar[XB_XSUB(b.x)], 1u);
        const unsigned gen = old / nloc;
        if (old + 1u == (gen + 1u) * nloc) {
            __builtin_amdgcn_fence(__ATOMIC_RELEASE, "agent");
            asm volatile("s_waitcnt vmcnt(0)" ::: "memory");
            const unsigned og = xb_add(&bar[XB_TOP], 1u);
            const unsigned tg = og / nx;
            if (og + 1u == (tg + 1u) * nx) xb_add(&bar[XB_TOPGEN], 1u);
            else XB_SPIN(xb_ld(&bar[XB_TOPGEN]) == tg, bar);
            __builtin_amdgcn_fence(__ATOMIC_ACQUIRE, "agent");
            xb_add(&bar[XB_XGEN(b.x)], 1u);
            asm volatile("s_waitcnt vmcnt(0)" ::: "memory");
        } else {
            XB_SPIN(xb_ld(&bar[XB_XGEN(b.x)]) == gen, bar);
            __builtin_amdgcn_fence(__ATOMIC_ACQUIRE, "agent");
            asm volatile("s_waitcnt vmcnt(0)" ::: "memory");
        }
    }
    __syncthreads();
}

__global__ void __launch_bounds__(256, 2) mega(Params p) {
  __shared__ __attribute__((aligned(16))) char smem[73728];
  __shared__ uint4 xb_words;
  const bool coop = (p.ph1 - p.ph0) > 1;
  XcdBarrier xb;
  if (coop) {
    if (threadIdx.x == 0) xb_words = make_uint4(0u, 0u, 0u, 0u);
    __syncthreads();
    xb = xcd_barrier_post((unsigned*)(p.ws + OFF_BAR), (volatile LAS unsigned*)&xb_words);
  }
  if (p.ph1 < 0) cg::this_grid().sync();
  for (int ph = p.ph0; ph < p.ph1; ++ph) {
    if (!phase_exists(ph)) continue;
    KA q;
    q.ka = (const AS4 char*)__builtin_amdgcn_kernarg_segment_ptr();
    asm volatile("" : "+s"(q.ka));
    run_phase(q, ph, smem);
    if (ph + 1 < p.ph1) xcd_barrier(xb);
  }
}

extern "C" void kernel_launch(void* const* d_in, const int* in_sizes, int n_in, void* d_out, int out_size,
                              void* d_ws, size_t ws_size, hipStream_t stream) {
  if (n_in < 33 || ws_size < WS_NEED) { fprintf(stderr, "bad args: n_in %d ws %zu need %zu\n", n_in, ws_size, (size_t)WS_NEED); return; }
  Params p{};
  for (int i = 0; i < 33; ++i) p.in[i] = (const float*)d_in[i];
  p.out = (float*)d_out;
  p.ws = (char*)d_ws;
#if N_LAUNCH_MODE == 1
  for (int ph = 0; ph < 42; ++ph) {
    if (!phase_exists(ph)) continue;
    p.ph0 = ph; p.ph1 = ph + 1;
    hipLaunchKernelGGL(mega, dim3(512), dim3(256), 0, stream, p);
  }
#else
  static int grid_blocks = 0;
  if (!grid_blocks) {
    int dev = 0, cus = 0, per_cu = 0;
    hipGetDevice(&dev);
    hipDeviceGetAttribute(&cus, hipDeviceAttributeMultiprocessorCount, dev);
    hipOccupancyMaxActiveBlocksPerMultiprocessor(&per_cu, mega, 256, 0);
    if (per_cu > 2) per_cu = 2;
    grid_blocks = cus * per_cu;
  }
  p.ph0 = 0; p.ph1 = 42;
  hipMemsetAsync((char*)d_ws + OFF_BAR, 0, XCD_BAR_WORDS * 4, stream);
  void* args[] = {&p};
  hipError_t e = hipLaunchCooperativeKernel((void*)mega, dim3(grid_blocks), dim3(256), args, 0, stream);
  if (e != hipSuccess) fprintf(stderr, "cooperative launch failed: %s (grid %d)\n", hipGetErrorString(e), grid_blocks);
#endif
}
```

```cpp
#include <hip/hip_runtime.h>
#include <hip/hip_cooperative_groups.h>
#include <cstdio>
namespace cg = cooperative_groups;

typedef unsigned short u16;
typedef short bf16x8 __attribute__((ext_vector_type(8)));
typedef short s16x4 __attribute__((ext_vector_type(4)));
typedef float f32x16 __attribute__((ext_vector_type(16)));
typedef float f32x2 __attribute__((ext_vector_type(2)));
typedef __bf16 bfx2 __attribute__((ext_vector_type(2)));
#define DI __device__ __forceinline__
#define MFMA(a, b, c) __builtin_amdgcn_mfma_f32_32x32x16_bf16((a), (b), (c), 0, 0, 0)
#define LDS3 __attribute__((address_space(3)))

#ifndef REP_GEMM
#define REP_GEMM 1
#endif
#ifndef REP_ATT
#define REP_ATT 1
#endif
#ifndef N_LAUNCH_MODE
#define N_LAUNCH_MODE 0
#endif

constexpr int NTOK = 12288, NCTX = 4096;
constexpr float LOG2E = 1.4426950408889634f;

constexpr size_t O_L0K = 12582912, O_L0V = 13631488, O_L1CKV = 14680064, O_L1KPE = 15728640,
                 O_L2K = 15859712, O_L2V = 16908288, O_L3K = 17956864, O_L3V = 22151168;

constexpr size_t OFF_W1T = 0;
constexpr size_t OFF_W2T = OFF_W1T + 4ull * 4096 * 1024 * 2;
constexpr size_t OFF_AQKV = OFF_W2T + 4ull * 4096 * 1024 * 2;
constexpr size_t OFF_AO_W = OFF_AQKV + 1536ull * 1024 * 2;
constexpr size_t OFF_MIN = OFF_AO_W + 1024ull * 1024 * 2;
constexpr size_t OFF_MUQ = OFF_MIN + 768ull * 1024 * 2;
constexpr size_t OFF_MUKV = OFF_MUQ + 1536ull * 384 * 2;
constexpr size_t OFF_MO = OFF_MUKV + 2048ull * 256 * 2;
constexpr size_t OFF_SQKV = OFF_MO + 1024ull * 1024 * 2;
constexpr size_t OFF_SO = OFF_SQKV + 1536ull * 1024 * 2;
constexpr size_t OFF_NQKV = OFF_SO + 1024ull * 1024 * 2;
constexpr size_t OFF_NO = OFF_NQKV + 3072ull * 1024 * 2;
constexpr size_t OFF_MOD = OFF_NO + 1024ull * 1024 * 2;
constexpr size_t OFF_ROPE = OFF_MOD + 4ull * 9 * 6144 * 4;
constexpr size_t OFF_HAO = OFF_ROPE + 3ull * 64 * 32 * 2 * 4;
constexpr size_t OFF_UZ = OFF_HAO + 12288ull * 1024 * 2;
constexpr size_t OFF_QO = OFF_UZ + 12288ull * 4096 * 2;
constexpr size_t OFF_CQ = OFF_QO + 12288ull * 3072 * 2;
constexpr size_t OFF_CKV = OFF_CQ + 12288ull * 384 * 2;
constexpr size_t OFF_KPE = OFF_CKV + 16384ull * 256 * 2;
constexpr size_t OFF_KV = OFF_KPE + 16384ull * 32 * 2;
constexpr size_t OFF_CK = OFF_KV;
constexpr size_t OFF_CV = OFF_KV + 2097152;
constexpr size_t OFF_C3K = OFF_KV + 4194304;
constexpr size_t OFF_C3V = OFF_C3K + 8388608;
constexpr size_t OFF_BAR = OFF_KV + 16384ull * 2048 * 2;
constexpr size_t WS_NEED = OFF_BAR + 16384;

struct Params {
  const float* in[33];
  float* out;
  char* ws;
  int ph0, ph1;
};

#define AS4 __attribute__((address_space(4)))
struct KA {
  const AS4 char* ka;
  DI const float* in(int i) const { return *(const float* const AS4*)(ka + 8 * i); }
  DI float* out() const { return *(float* const AS4*)(ka + 264); }
  DI char* ws() const { return *(char* const AS4*)(ka + 272); }
};

DI unsigned pack2(float a, float b) { f32x2 f = {a, b}; bfx2 v = __builtin_convertvector(f, bfx2); return __builtin_bit_cast(unsigned, v); }
DI u16 f2bf(float a) { return (u16)(pack2(a, a) & 0xffffu); }
DI float wave_sum(float v) {
#pragma unroll
  for (int o = 32; o; o >>= 1) v += __shfl_xor(v, o, 64);
  return v;
}
DI int ltid() { int t = threadIdx.x; asm volatile("" : "+v"(t)); return t; }
DI int crow(int i, int h) { return (i & 3) + 8 * (i >> 2) + 4 * h; }

__device__ const long long TJ[18][6] = {
  {15, 0ll * 1024 * 4096, 1024, 4096, 4096, (long long)(OFF_W1T + 0ull * 8388608)},
  {15, 1ll * 1024 * 4096, 1024, 4096, 4096, (long long)(OFF_W1T + 1ull * 8388608)},
  {15, 2ll * 1024 * 4096, 1024, 4096, 4096, (long long)(OFF_W1T + 2ull * 8388608)},
  {15, 3ll * 1024 * 4096, 1024, 4096, 4096, (long long)(OFF_W1T + 3ull * 8388608)},
  {16, 0ll * 1024 * 4096, 4096, 1024, 1024, (long long)(OFF_W2T + 0ull * 8388608)},
  {16, 1ll * 1024 * 4096, 4096, 1024, 1024, (long long)(OFF_W2T + 1ull * 8388608)},
  {16, 2ll * 1024 * 4096, 4096, 1024, 1024, (long long)(OFF_W2T + 2ull * 8388608)},
  {16, 3ll * 1024 * 4096, 4096, 1024, 1024, (long long)(OFF_W2T + 3ull * 8388608)},
  {17, 0, 1024, 1536, 1536, (long long)OFF_AQKV},
  {20, 0, 1024, 1024, 1024, (long long)OFF_AO_W},
  {21, 0, 1024, 672, 768, (long long)OFF_MIN},
  {24, 0, 384, 1536, 1536, (long long)OFF_MUQ},
  {25, 0, 256, 2048, 2048, (long long)OFF_MUKV},
  {26, 0, 1024, 1024, 1024, (long long)OFF_MO},
  {27, 0, 1024, 1536, 1536, (long long)OFF_SQKV},
  {29, 0, 1024, 1024, 1024, (long long)OFF_SO},
  {30, 0, 1024, 3072, 3072, (long long)OFF_NQKV},
  {32, 0, 1024, 1024, 1024, (long long)OFF_NO},
};

DI void transpose_tile(const float* __restrict__ src, u16* __restrict__ dst, int K, int N, int k0, int n0, char* smem) {
  float (*T)[65] = (float (*)[65])smem;
  const int tid = ltid();
  const int nl = tid & 63, kl0 = tid >> 6;
  __syncthreads();
  const int n = n0 + nl;
#pragma unroll 4
  for (int j = 0; j < 16; ++j) {
    const int k = kl0 + 4 * j;
    T[k][nl] = (n < N) ? src[(size_t)(k0 + k) * N + n] : 0.f;
  }
  __syncthreads();
  const int kp = tid & 31, nl0 = tid >> 5;
#pragma unroll
  for (int j = 0; j < 8; ++j) {
    const int nn = nl0 + 8 * j;
    *(unsigned*)&dst[(size_t)(n0 + nn) * K + k0 + 2 * kp] = pack2(T[2 * kp][nn], T[2 * kp + 1][nn]);
  }
}

DI void convert_f32_bf16(const float* __restrict__ src, u16* __restrict__ dst, size_t n) {
  const size_t n4 = n >> 2;
  const int tid_ = ltid();
  for (size_t i = (size_t)blockIdx.x * 256 + tid_; i < n4; i += (size_t)gridDim.x * 256) {
    const float4 v = ((const float4*)src)[i];
    uint2 o; o.x = pack2(v.x, v.y); o.y = pack2(v.z, v.w);
    ((uint2*)dst)[i] = o;
  }
}

DI void prepass(const KA& p, char* smem) {
  int total = 0;
  for (int j = 0; j < 18; ++j) total += (int)((TJ[j][2] >> 6) * (TJ[j][4] >> 6));
  for (int t = blockIdx.x; t < total; t += gridDim.x) {
    int j = 0, tt = t;
    for (;;) { const int c = (int)((TJ[j][2] >> 6) * (TJ[j][4] >> 6)); if (tt < c) break; tt -= c; ++j; }
    const int K = (int)TJ[j][2], N = (int)TJ[j][3];
    const int nk = K >> 6;
    const int kt = tt % nk, nt = tt / nk;
    transpose_tile(p.in((int)TJ[j][0]) + TJ[j][1], (u16*)(p.ws() + TJ[j][5]), K, N, kt * 64, nt * 64, smem);
  }
  convert_f32_bf16(p.in(2), (u16*)(p.ws() + OFF_CK), 4096ull * 256);
  convert_f32_bf16(p.in(3), (u16*)(p.ws() + OFF_CV), 4096ull * 256);
  convert_f32_bf16(p.in(4), (u16*)(p.ws() + OFF_CKV) + 12288ull * 256, 4096ull * 256);
  convert_f32_bf16(p.in(5), (u16*)(p.ws() + OFF_KPE) + 12288ull * 32, 4096ull * 32);
  {
    float* tab = (float*)(p.ws() + OFF_ROPE);
    const int tid_ = ltid();
    for (int e = blockIdx.x * 256 + tid_; e < 3 * 64 * 32; e += gridDim.x * 256) {
      const int kind = e / 2048, pos = (e >> 5) & 63, i = e & 31;
      const int quarter = kind == 0 ? 32 : (kind == 1 ? 16 : 8);
      float c = 1.f, s = 0.f;
      if (i < quarter) {
        const float inv = exp2f(-(float)i / (float)quarter * 13.287712379549449f);
        const float ang = (float)pos * inv;
        c = cosf(ang); s = sinf(ang);
      }
      tab[2 * e] = c; tab[2 * e + 1] = s;
    }
  }
  {
    float* scond = (float*)smem;
    float* red = (float*)(smem + 36864);
    float* MOD = (float*)(p.ws() + OFF_MOD);
    const int tid = ltid();
    bool ready = false;
    for (int it = blockIdx.x; it < 768; it += gridDim.x) {
      __syncthreads();
      if (!ready) {
        for (int e = tid; e < 9 * 1024; e += 256) {
          const float c = e < 8192 ? p.in(10)[e] : p.in(11)[e - 8192];
          scond[e] = c / (1.f + __expf(-c));
        }
        ready = true;
        __syncthreads();
      }
      const int l = it / 192, n0 = (it % 192) * 32;
      const int col = tid & 31, kg = tid >> 5;
      float acc[9];
#pragma unroll
      for (int c = 0; c < 9; ++c) acc[c] = 0.f;
      const float* wp = p.in(12) + (size_t)l * 1024 * 6144 + n0 + col;
#pragma unroll 8
      for (int i = 0; i < 128; ++i) {
        const int k = kg + 8 * i;
        const float wv = wp[(size_t)k * 6144];
#pragma unroll
        for (int c = 0; c < 9; ++c) acc[c] += scond[c * 1024 + k] * wv;
      }
#pragma unroll
      for (int c = 0; c < 9; ++c) red[(kg * 9 + c) * 32 + col] = acc[c];
      __syncthreads();
      for (int e = tid; e < 288; e += 256) {
        const int c = e >> 5, cc = e & 31;
        float s = p.in(13)[l * 6144 + n0 + cc];
#pragma unroll
        for (int g = 0; g < 8; ++g) s += red[(g * 9 + c) * 32 + cc];
        MOD[(size_t)(l * 9 + c) * 6144 + n0 + cc] = s;
      }
    }
  }
}

DI void norm_phase(const KA& p, int l, int mode) {
  const int tid_ = ltid(); const int lane = tid_ & 63, w = tid_ >> 6;
  float* X = p.out();
  const float* MOD = (const float*)(p.ws() + OFF_MOD);
  const float* FF = (const float*)(p.ws() + OFF_QO);
  u16* H = (u16*)(p.ws() + OFF_HAO);
  const float* ng = p.in(14);
  const bool x_in = (l == 0);
  const bool add = !(l == 0 && mode == 0);
  const int la = (mode == 1) ? l : l - 1;
  const int gate_w = (mode == 1) ? 2 : 5;
  const int gadd = (mode == 1) ? 1 : 3;
  const bool do_h = mode != 2;
  const int gh = (mode == 0) ? 0 : 2, scw = (mode == 0) ? 1 : 4, shw = (mode == 0) ? 0 : 3;
  for (int row = blockIdx.x * 4 + w; row < NTOK; row += gridDim.x * 4) {
    const int ci = row < NCTX ? 8 : ((row - NCTX) >> 10);
    const float* xs = x_in ? (row < NCTX ? p.in(0) + (size_t)row * 1024 : p.in(1) + (size_t)(row - NCTX) * 1024)
                           : X + (size_t)row * 1024;
    float4 x[4];
#pragma unroll
    for (int j = 0; j < 4; ++j) x[j] = *(const float4*)(xs + 4 * lane + 256 * j);
    if (add) {
      const float* fr = FF + (size_t)row * 1024;
      float4 f[4];
      float ss = 0.f;
#pragma unroll
      for (int j = 0; j < 4; ++j) {
        f[j] = *(const float4*)(fr + 4 * lane + 256 * j);
        ss += f[j].x * f[j].x + f[j].y * f[j].y + f[j].z * f[j].z + f[j].w * f[j].w;
      }
      ss = wave_sum(ss);
      const float rstd = rsqrtf(ss * (1.f / 1024.f) + 1e-6f);
      const float* ga = ng + (la * 4 + gadd) * 1024;
      const float* gt = MOD + (size_t)(la * 9 + ci) * 6144 + gate_w * 1024;
#pragma unroll
      for (int j = 0; j < 4; ++j) {
        const float4 g4 = *(const float4*)(ga + 4 * lane + 256 * j);
        const float4 t4 = *(const float4*)(gt + 4 * lane + 256 * j);
        x[j].x += t4.x * (f[j].x * rstd * g4.x);
        x[j].y += t4.y * (f[j].y * rstd * g4.y);
        x[j].z += t4.z * (f[j].z * rstd * g4.z);
        x[j].w += t4.w * (f[j].w * rstd * g4.w);
        *(float4*)(X + (size_t)row * 1024 + 4 * lane + 256 * j) = x[j];
      }
    }
    if (do_h) {
      float ss = 0.f;
#pragma unroll
      for (int j = 0; j < 4; ++j) ss += x[j].x * x[j].x + x[j].y * x[j].y + x[j].z * x[j].z + x[j].w * x[j].w;
      ss = wave_sum(ss);
      const float rstd = rsqrtf(ss * (1.f / 1024.f) + 1e-6f);
      const float* g = ng + (l * 4 + gh) * 1024;
      const float* sc = MOD + (size_t)(l * 9 + ci) * 6144 + scw * 1024;
      const float* sh = MOD + (size_t)(l * 9 + ci) * 6144 + shw * 1024;
#pragma unroll
      for (int j = 0; j < 4; ++j) {
        const float4 g4 = *(const float4*)(g + 4 * lane + 256 * j);
        const float4 c4 = *(const float4*)(sc + 4 * lane + 256 * j);
        const float4 s4 = *(const float4*)(sh + 4 * lane + 256 * j);
        const float h0 = x[j].x * rstd * g4.x * (1.f + c4.x) + s4.x;
        const float h1 = x[j].y * rstd * g4.y * (1.f + c4.y) + s4.y;
        const float h2 = x[j].z * rstd * g4.z * (1.f + c4.z) + s4.z;
        const float h3 = x[j].w * rstd * g4.w * (1.f + c4.w) + s4.w;
        uint2 o; o.x = pack2(h0, h1); o.y = pack2(h2, h3);
        *(uint2*)(H + (size_t)row * 1024 + 4 * lane + 256 * j) = o;
      }
    }
  }
}

enum { EPI_F32 = 0, EPI_BF16 = 1, EPI_RELU2 = 2, EPI_NAT = 3 };
struct GemmDesc { const u16* A; const u16* Bt; void* dst; int lda, ldb, ldc, M, N, K, epi; };

DI void gemm_tile(const GemmDesc& g, int m0, int n0, float* outp, char* smem) {
  constexpr int LS = 72;
  u16* As = (u16*)smem;
  u16* Bs = As + 2 * 128 * LS;
  const int tid = ltid(), lane = tid & 63, w = tid >> 6, r = lane & 31, h = lane >> 5;
  const int wm = w >> 1, wn = w & 1;
  const int lrow = tid >> 3, lcc = tid & 7;
  const u16* ag = g.A + (size_t)(m0 + lrow) * g.lda + lcc * 8;
  const u16* bg = g.Bt + (size_t)(n0 + lrow) * g.ldb + lcc * 8;
  uint4 pa0, pa1, pa2, pa3, pb0, pb1, pb2, pb3;
  uint4 qa0, qa1, qa2, qa3, qb0, qb1, qb2, qb3;
  f32x16 acc00, acc01, acc10, acc11;
#pragma unroll
  for (int i = 0; i < 16; ++i) { acc00[i] = 0.f; acc01[i] = 0.f; acc10[i] = 0.f; acc11[i] = 0.f; }
  const size_t sa = (size_t)32 * g.lda, sb = (size_t)32 * g.ldb;
#define GLOAD(R, off)                                                                                                   \
  R##a0 = *(const uint4*)(ag + (off)); R##a1 = *(const uint4*)(ag + sa + (off)); R##a2 = *(const uint4*)(ag + 2 * sa + (off)); \
  R##a3 = *(const uint4*)(ag + 3 * sa + (off)); R##b0 = *(const uint4*)(bg + (off)); R##b1 = *(const uint4*)(bg + sb + (off)); \
  R##b2 = *(const uint4*)(bg + 2 * sb + (off)); R##b3 = *(const uint4*)(bg + 3 * sb + (off));
#define LSTORE(R, buf)                                                                  \
  *(uint4*)&As[(buf) * 128 * LS + (lrow) * LS + lcc * 8] = R##a0;                        \
  *(uint4*)&As[(buf) * 128 * LS + (lrow + 32) * LS + lcc * 8] = R##a1;                   \
  *(uint4*)&As[(buf) * 128 * LS + (lrow + 64) * LS + lcc * 8] = R##a2;                   \
  *(uint4*)&As[(buf) * 128 * LS + (lrow + 96) * LS + lcc * 8] = R##a3;                   \
  *(uint4*)&Bs[(buf) * 128 * LS + (lrow) * LS + lcc * 8] = R##b0;                        \
  *(uint4*)&Bs[(buf) * 128 * LS + (lrow + 32) * LS + lcc * 8] = R##b1;                   \
  *(uint4*)&Bs[(buf) * 128 * LS + (lrow + 64) * LS + lcc * 8] = R##b2;                   \
  *(uint4*)&Bs[(buf) * 128 * LS + (lrow + 96) * LS + lcc * 8] = R##b3;
#define COMPUTE(buf)                                                                    \
  {                                                                                     \
    const u16* Ac = As + (buf) * 128 * LS + (64 * wm + r) * LS + 8 * h;                 \
    const u16* Bc = Bs + (buf) * 128 * LS + (64 * wn + r) * LS + 8 * h;                 \
    _Pragma("unroll") for (int kk = 0; kk < 4; ++kk) {                                  \
      const bf16x8 a0 = *(const bf16x8*)(Ac + 16 * kk);                                 \
      const bf16x8 a1 = *(const bf16x8*)(Ac + 32 * LS + 16 * kk);                       \
      const bf16x8 b0 = *(const bf16x8*)(Bc + 16 * kk);                                 \
      const bf16x8 b1 = *(const bf16x8*)(Bc + 32 * LS + 16 * kk);                       \
      acc00 = MFMA(a0, b0, acc00);                                                      \
      acc01 = MFMA(a0, b1, acc01);                                                      \
      acc10 = MFMA(a1, b0, acc10);                                                      \
      acc11 = MFMA(a1, b1, acc11);                                                      \
    }                                                                                   \
  }
  const int KT = g.K >> 6;
  GLOAD(p, 0)
  if (KT > 1) { GLOAD(q, 64) }
  LSTORE(p, 0)
  __syncthreads();
  for (int kt = 0; kt < KT; kt += 2) {
    if (kt + 2 < KT) { GLOAD(p, (kt + 2) * 64) }
    COMPUTE(0)
    if (kt + 1 < KT) { LSTORE(q, 1) }
    __syncthreads();
    if (kt + 1 >= KT) break;
    if (kt + 3 < KT) { GLOAD(q, (kt + 3) * 64) }
    COMPUTE(1)
    if (kt + 2 < KT) { LSTORE(p, 0) }
    __syncthreads();
  }
#undef GLOAD
#undef LSTORE
#undef COMPUTE
  const int epi = g.epi;
#pragma unroll
  for (int mi = 0; mi < 2; ++mi)
#pragma unroll
    for (int ni = 0; ni < 2; ++ni) {
      const int col = n0 + 64 * wn + 32 * ni + r;
#pragma unroll
      for (int i = 0; i < 16; ++i) {
        const int row = m0 + 64 * wm + 32 * mi + crow(i, h);
        const float v = mi == 0 ? (ni == 0 ? acc00[i] : acc01[i]) : (ni == 0 ? acc10[i] : acc11[i]);
        if (epi == EPI_F32) {
          ((float*)g.dst)[(size_t)row * g.ldc + col] = v;
        } else if (epi == EPI_BF16) {
          ((u16*)g.dst)[(size_t)row * g.ldc + col] = f2bf(v);
        } else if (epi == EPI_RELU2) {
          const float t = v > 0.f ? v : 0.f;
          ((u16*)g.dst)[(size_t)row * g.ldc + col] = f2bf(t * t);
        } else {
          ((u16*)g.dst)[(size_t)row * g.ldc + col] = f2bf(v);
          if (row < NCTX && col >= 1024) {
            if (col < 2048) outp[O_L3K + (size_t)row * 1024 + (col - 1024)] = v;
            else outp[O_L3V + (size_t)row * 1024 + (col - 2048)] = v;
          }
        }
      }
    }
}

DI void gemm_phase(const KA& p, const GemmDesc& g0, const GemmDesc& g1, int ng, char* smem) {
  const int nt0 = g0.N >> 7, mt0 = g0.M >> 7;
  if (ng == 1 && gridDim.x == 512 && (nt0 & 3) == 0 && (mt0 & 7) == 0) {
    const int x = blockIdx.x & 7, s = blockIdx.x >> 3, hf = s >> 5, si = s & 31, mi = si >> 2, ni = si & 3;
    const int ncn = nt0 >> 2, nchunks = (mt0 >> 3) * ncn;
    for (int rep = 0; rep < REP_GEMM; ++rep)
    for (int k = hf;; k += 2) {
      const int c = k * 8 + x;
      if (c >= nchunks) break;
      const int cm = c / ncn, cn = c - cm * ncn;
      gemm_tile(g0, (cm * 8 + mi) * 128, (cn * 4 + ni) * 128, p.out(), smem);
    }
    return;
  }
  const int t0 = mt0 * nt0;
  const int t1 = ng > 1 ? (g1.M >> 7) * (g1.N >> 7) : 0;
  for (int rep = 0; rep < REP_GEMM; ++rep)
  for (int t = blockIdx.x; t < t0 + t1; t += gridDim.x) {
    const bool first = t < t0;
    GemmDesc g;
    g.A = first ? g0.A : g1.A; g.Bt = first ? g0.Bt : g1.Bt; g.dst = first ? g0.dst : g1.dst;
    g.lda = first ? g0.lda : g1.lda; g.ldb = first ? g0.ldb : g1.ldb; g.ldc = first ? g0.ldc : g1.ldc;
    g.M = first ? g0.M : g1.M; g.N = first ? g0.N : g1.N; g.K = first ? g0.K : g1.K; g.epi = first ? g0.epi : g1.epi;
    const int tt = first ? t : t - t0;
    const int nt = g.N >> 7;
    gemm_tile(g, (tt / nt) * 128, (tt % nt) * 128, p.out(), smem);
  }
}

DI void pp_attn(const KA& p) {
  const int tid_ = ltid(); const int lane = tid_ & 63, w = tid_ >> 6;
  const float* Z = (const float*)(p.ws() + OFF_UZ);
  u16* QKV = (u16*)(p.ws() + OFF_QO);
  const float* tab = (const float*)(p.ws() + OFF_ROPE);
  const float* qn = p.in(18);
  const float* kn = p.in(19);
  for (int row = blockIdx.x * 4 + w; row < NTOK; row += gridDim.x * 4) {
    const bool lat = row >= NCTX;
    const int t = (row - NCTX) & 1023, pr = t >> 6, pc = t & 63;
    const float* z = Z + (size_t)row * 1536;
    u16* o = QKV + (size_t)row * 1536;
    const int i = lane & 31;
    const float c0 = tab[(pr * 32 + i) * 2], s0 = tab[(pr * 32 + i) * 2 + 1];
    const float c1 = tab[(pc * 32 + i) * 2], s1 = tab[(pc * 32 + i) * 2 + 1];
    const float sg = lane < 32 ? -1.f : 1.f;
    for (int hd = 0; hd < 10; ++hd) {
      const float v0 = z[hd * 128 + lane], v1 = z[hd * 128 + 64 + lane];
      const float ss = wave_sum(v0 * v0 + v1 * v1);
      const float rstd = rsqrtf(ss * (1.f / 128.f) + 1e-6f);
      const float* g = hd < 8 ? qn : kn;
      float y0 = v0 * rstd * g[lane], y1 = v1 * rstd * g[64 + lane];
      if (hd >= 8 && !lat) {
        p.out()[O_L0K + (size_t)row * 256 + (hd - 8) * 128 + lane] = y0;
        p.out()[O_L0K + (size_t)row * 256 + (hd - 8) * 128 + 64 + lane] = y1;
      }
      const float p0 = __shfl_xor(y0, 32, 64), p1 = __shfl_xor(y1, 32, 64);
      if (lat) {
        y0 = y0 * c0 + sg * p0 * s0;
        y1 = y1 * c1 + sg * p1 * s1;
      }
      o[hd * 128 + lane] = f2bf(y0);
      o[hd * 128 + 64 + lane] = f2bf(y1);
    }
#pragma unroll
    for (int j = 0; j < 4; ++j) {
      const float v = z[1280 + 64 * j + lane];
      o[1280 + 64 * j + lane] = f2bf(v);
      if (!lat) p.out()[O_L0V + (size_t)row * 256 + 64 * j + lane] = v;
    }
  }
}

DI void pp_swa(const KA& p) {
  const int tid_ = ltid(); const int lane = tid_ & 63, w = tid_ >> 6;
  const float* Z = (const float*)(p.ws() + OFF_UZ);
  u16* QKV = (u16*)(p.ws() + OFF_QO);
  const float* tab = (const float*)(p.ws() + OFF_ROPE) + 1 * 64 * 32 * 2;
  for (int row = blockIdx.x * 4 + w; row < NTOK; row += gridDim.x * 4) {
    const bool lat = row >= NCTX;
    const int t = (row - NCTX) & 1023, pr = t >> 6, pc = t & 63;
    const float* z = Z + (size_t)row * 1536;
    u16* o = QKV + (size_t)row * 1536;
    const int i = lane & 15, axis = lane >> 5, half = (lane >> 4) & 1;
    const int pos = axis ? pc : pr;
    const float c = tab[(pos * 32 + i) * 2], s = tab[(pos * 32 + i) * 2 + 1];
    const float sg = half ? 1.f : -1.f;
    for (int hd = 0; hd < 20; ++hd) {
      float v = z[hd * 64 + lane];
      if (hd >= 16 && !lat) p.out()[O_L2K + (size_t)row * 256 + (hd - 16) * 64 + lane] = v;
      const float pv = __shfl_xor(v, 16, 64);
      if (lat) v = v * c + sg * pv * s;
      o[hd * 64 + lane] = f2bf(v);
    }
#pragma unroll
    for (int j = 0; j < 4; ++j) {
      const float v = z[1280 + 64 * j + lane];
      o[1280 + 64 * j + lane] = f2bf(v);
      if (!lat) p.out()[O_L2V + (size_t)row * 256 + 64 * j + lane] = v;
    }
  }
}

DI void pp_mla1(const KA& p) {
  const int tid_ = ltid(); const int lane = tid_ & 63, w = tid_ >> 6;
  const float* Z = (const float*)(p.ws() + OFF_UZ);
  u16* CQ = (u16*)(p.ws() + OFF_CQ);
  u16* CKV = (u16*)(p.ws() + OFF_CKV);
  u16* KPE = (u16*)(p.ws() + OFF_KPE);
  const float* tab = (const float*)(p.ws() + OFF_ROPE) + 2 * 64 * 32 * 2;
  const float* qn = p.in(22);
  const float* kvn = p.in(23);
  for (int row = blockIdx.x * 4 + w; row < NTOK; row += gridDim.x * 4) {
    const bool lat = row >= NCTX;
    const int t = (row - NCTX) & 1023, pr = t >> 6, pc = t & 63;
    const float* z = Z + (size_t)row * 768;
    float a[6];
    float ss = 0.f;
#pragma unroll
    for (int j = 0; j < 6; ++j) { a[j] = z[64 * j + lane]; ss += a[j] * a[j]; }
    ss = wave_sum(ss);
    float rstd = rsqrtf(ss * (1.f / 384.f) + 1e-6f);
#pragma unroll
    for (int j = 0; j < 6; ++j) CQ[(size_t)row * 384 + 64 * j + lane] = f2bf(a[j] * rstd * qn[64 * j + lane]);
    ss = 0.f;
#pragma unroll
    for (int j = 0; j < 4; ++j) { a[j] = z[384 + 64 * j + lane]; ss += a[j] * a[j]; }
    ss = wave_sum(ss);
    rstd = rsqrtf(ss * (1.f / 256.f) + 1e-6f);
#pragma unroll
    for (int j = 0; j < 4; ++j) {
      const float y = a[j] * rstd * kvn[64 * j + lane];
      CKV[(size_t)row * 256 + 64 * j + lane] = f2bf(y);
      if (!lat) p.out()[O_L1CKV + (size_t)row * 256 + 64 * j + lane] = y;
    }
    const int e = lane & 31;
    float v = z[640 + e];
    const float pv = __shfl_xor(v, 8, 64);
    if (lat) {
      const int i = e & 7, axis = e >> 4, half = (e >> 3) & 1;
      const int pos = axis ? pc : pr;
      const float c = tab[(pos * 32 + i) * 2], s = tab[(pos * 32 + i) * 2 + 1];
      v = v * c + (half ? pv : -pv) * s;
    }
    if (lane < 32) {
      KPE[(size_t)row * 32 + e] = f2bf(v);
      if (!lat) p.out()[O_L1KPE + (size_t)row * 32 + e] = v;
    }
  }
}

DI void pp_mla2(const KA& p) {
  const int tid_ = ltid(); const int lane = tid_ & 63, w = tid_ >> 6;
  const float* Z = (const float*)(p.ws() + OFF_UZ);
  u16* Q = (u16*)(p.ws() + OFF_QO);
  const float* tab = (const float*)(p.ws() + OFF_ROPE) + 2 * 64 * 32 * 2;
  for (int row = blockIdx.x * 4 + w; row < NTOK; row += gridDim.x * 4) {
    const bool lat = row >= NCTX;
    const int t = (row - NCTX) & 1023, pr = t >> 6, pc = t & 63;
    const float* z = Z + (size_t)row * 1536;
    for (int j = 0; j < 24; ++j) {
      const int col = 64 * j + lane;
      float v = z[col];
      const float pv = __shfl_xor(v, 8, 64);
      const int d = col % 96;
      if (lat && d >= 64) {
        const int e = d - 64;
        const int i = e & 7, axis = e >> 4, half = (e >> 3) & 1;
        const int pos = axis ? pc : pr;
        const float c = tab[(pos * 32 + i) * 2], s = tab[(pos * 32 + i) * 2 + 1];
        v = v * c + (half ? pv : -pv) * s;
      }
      Q[(size_t)row * 1536 + col] = f2bf(v);
    }
  }
}

struct Seg { const u16* k1; const u16* k2; const u16* v; int ldk1, ldk2, ldv, n0, n1, mode; };

template <int HDQK, int HDV>
DI void attn_item(const u16* __restrict__ Qp, int ldq, const Seg& sA, const Seg& sB, int nseg, int qpos0,
                  float scale_l2, const float* __restrict__ rpb_h, bool has_sink, float sink_l2,
                  u16* __restrict__ Op, int ldo, char* smem) {
  constexpr int K1W = (HDQK == 96) ? 64 : HDQK;
  constexpr int KS = HDQK + 8, VS = HDV + 8;
  constexpr int KC = HDQK / 8, VC = HDV / 8;
  u16* Ks = (u16*)smem;
  u16* Vs = Ks + 64 * KS;
  float* rp = (float*)(Vs + 64 * VS);
  const int tid = ltid(), lane = tid & 63, w = tid >> 6, r = lane & 31, h = lane >> 5;
  const int q4 = (lane & 15) >> 2, p4 = lane & 3, dblk = (lane >> 4) & 1;

  __syncthreads();
  if (rpb_h) for (int e = tid; e < 465; e += 256) rp[e] = rpb_h[e];

  bf16x8 qf[HDQK / 16];
  {
    const u16* qrow = Qp + (size_t)(32 * w + r) * ldq + 8 * h;
#pragma unroll
    for (int kk = 0; kk < HDQK / 16; ++kk) qf[kk] = *(const bf16x8*)(qrow + 16 * kk);
  }
  f32x16 o[HDV / 32];
#pragma unroll
  for (int dt = 0; dt < HDV / 32; ++dt)
#pragma unroll
    for (int i = 0; i < 16; ++i) o[dt][i] = 0.f;
  float m = -1e30f, l = 0.f;
  const int qpos = qpos0 + 32 * w + r;
  const int qr = qpos >> 6, qc = qpos & 63;
  const int r0 = min(max(qr - 4, 0), 8), c0 = min(max(qc - 8, 0), 48);

  for (int sg = 0; sg < nseg; ++sg) {
    Seg s;
    s.k1 = sg == 0 ? sA.k1 : sB.k1; s.k2 = sg == 0 ? sA.k2 : sB.k2; s.v = sg == 0 ? sA.v : sB.v;
    s.ldk1 = sg == 0 ? sA.ldk1 : sB.ldk1; s.ldk2 = sg == 0 ? sA.ldk2 : sB.ldk2; s.ldv = sg == 0 ? sA.ldv : sB.ldv;
    s.n0 = sg == 0 ? sA.n0 : sB.n0; s.n1 = sg == 0 ? sA.n1 : sB.n1; s.mode = sg == 0 ? sA.mode : sB.mode;
    const int mode = s.mode;
    for (int n = s.n0; n < s.n1; n += 64) {
      __syncthreads();
      for (int c = tid; c < 64 * KC; c += 256) {
        const int row = c / KC, cc = c - row * KC;
        const u16* src = (cc * 8 < K1W) ? s.k1 + (size_t)(n + row) * s.ldk1 + cc * 8
                                        : s.k2 + (size_t)(n + row) * s.ldk2 + (cc * 8 - K1W);
        *(uint4*)&Ks[row * KS + cc * 8] = *(const uint4*)src;
      }
      for (int c = tid; c < 64 * VC; c += 256) {
        const int row = c / VC, cc = c - row * VC;
        *(uint4*)&Vs[row * VS + cc * 8] = *(const uint4*)(s.v + (size_t)(n + row) * s.ldv + cc * 8);
      }
      __syncthreads();
      f32x16 st[2];
#pragma unroll
      for (int kt = 0; kt < 2; ++kt) {
#pragma unroll
        for (int i = 0; i < 16; ++i) st[kt][i] = 0.f;
        const u16* kb = Ks + (32 * kt + r) * KS + 8 * h;
#pragma unroll
        for (int kk = 0; kk < HDQK / 16; ++kk) {
          const bf16x8 a = *(const bf16x8*)(kb + 16 * kk);
          st[kt] = MFMA(a, qf[kk], st[kt]);
        }
      }
      float mx = -1e30f;
      if (mode == 0) {
#pragma unroll
        for (int kt = 0; kt < 2; ++kt)
#pragma unroll
          for (int i = 0; i < 16; ++i) { const float v = st[kt][i] * scale_l2; st[kt][i] = v; mx = fmaxf(mx, v); }
      } else if (mode == 1) {
#pragma unroll
        for (int kt = 0; kt < 2; ++kt)
#pragma unroll
          for (int i = 0; i < 16; ++i) {
            const int kpos = n + 32 * kt + crow(i, h);
            const int d = qpos - kpos;
            float v = st[kt][i] * scale_l2;
            if (d > 128 || d < -128) v = -1e30f;
            st[kt][i] = v; mx = fmaxf(mx, v);
          }
      } else {
#pragma unroll
        for (int kt = 0; kt < 2; ++kt)
#pragma unroll
          for (int i = 0; i < 16; ++i) {
            const int kpos = n + 32 * kt + crow(i, h);
            const int kr = kpos >> 6, kc = kpos & 63;
            const bool ok = ((unsigned)(kr - r0) < 8u) && ((unsigned)(kc - c0) < 16u);
            const int idx = ok ? (kr - qr + 7) * 31 + (kc - qc + 15) : 0;
            const float b = rp[idx];
            float v = st[kt][i] * scale_l2 + b * LOG2E;
            if (!ok) v = -1e30f;
            st[kt][i] = v; mx = fmaxf(mx, v);
          }
      }
      mx = fmaxf(mx, __shfl_xor(mx, 32, 64));
      const float mn = fmaxf(m, mx);
      const float alpha = __builtin_amdgcn_exp2f(m - mn);
      m = mn;
      float rs = 0.f;
#pragma unroll
      for (int kt = 0; kt < 2; ++kt)
#pragma unroll
        for (int i = 0; i < 16; ++i) { const float pz = __builtin_amdgcn_exp2f(st[kt][i] - mn); st[kt][i] = pz; rs += pz; }
      rs += __shfl_xor(rs, 32, 64);
      l = l * alpha + rs;
#pragma unroll
      for (int dt = 0; dt < HDV / 32; ++dt)
#pragma unroll
        for (int i = 0; i < 16; ++i) o[dt][i] *= alpha;
#pragma unroll
      for (int kt = 0; kt < 2; ++kt)
#pragma unroll
        for (int s2 = 0; s2 < 2; ++s2) {
          unsigned pk[4];
#pragma unroll
          for (int j = 0; j < 4; ++j) pk[j] = pack2(st[kt][8 * s2 + 2 * j], st[kt][8 * s2 + 2 * j + 1]);
          bf16x8 pb;
          {
            typedef unsigned u32x4 __attribute__((ext_vector_type(4)));
            u32x4 t4 = {pk[0], pk[1], pk[2], pk[3]};
            pb = __builtin_bit_cast(bf16x8, t4);
          }
          const u16* vb = Vs + (32 * kt + 16 * s2 + 4 * h + q4) * VS + 16 * dblk + 4 * p4;
#pragma unroll
          for (int dt = 0; dt < HDV / 32; ++dt) {
            const s16x4 lo = __builtin_amdgcn_ds_read_tr16_b64_v4i16((LDS3 s16x4*)(vb + 32 * dt));
            const s16x4 hi = __builtin_amdgcn_ds_read_tr16_b64_v4i16((LDS3 s16x4*)(vb + 8 * VS + 32 * dt));
            const bf16x8 va = __builtin_shufflevector(lo, hi, 0, 1, 2, 3, 4, 5, 6, 7);
            o[dt] = MFMA(va, pb, o[dt]);
          }
        }
    }
  }
  if (has_sink) l += __builtin_amdgcn_exp2f(sink_l2 - m);
  const float inv = 1.f / l;
  u16* orow = Op + (size_t)(32 * w + r) * ldo + 4 * h;
#pragma unroll
  for (int dt = 0; dt < HDV / 32; ++dt)
#pragma unroll
    for (int g = 0; g < 4; ++g) {
      uint2 v;
      v.x = pack2(o[dt][4 * g] * inv, o[dt][4 * g + 1] * inv);
      v.y = pack2(o[dt][4 * g + 2] * inv, o[dt][4 * g + 3] * inv);
      *(uint2*)(orow + 32 * dt + 8 * g) = v;
    }
}

DI void attn_phase(const KA& p, int kind, char* smem) {
  const int Hq = kind == 0 ? 8 : 16;
  const int nlat = 8 * Hq * 8, nctx = 16 * Hq * 2;
  u16* AO = (u16*)(p.ws() + OFF_HAO);
  const u16* QKV = (const u16*)(p.ws() + OFF_QO);
  for (int rep = 0; rep < REP_ATT; ++rep)
  for (int item = blockIdx.x; item < nlat + nctx; item += gridDim.x) {
    const bool lat = item < nlat;
    int b, hq, qt;
    if (lat) { b = item / (Hq * 8); const int rem = item - b * Hq * 8; hq = rem >> 3; qt = rem & 7; }
    else { const int it = item - nlat; b = it / (Hq * 2); const int rem = it - b * Hq * 2; hq = rem >> 1; qt = rem & 1; }
    const int tok0 = lat ? NCTX + b * 1024 : b * 256;
    const int S = lat ? 1024 : 256;
    const int qrow0 = tok0 + qt * 128;
    Seg sc, ss;
    sc.k2 = nullptr; sc.ldk2 = 0; ss.k2 = nullptr; ss.ldk2 = 0;
    sc.n0 = 0; sc.n1 = 512; sc.mode = 0;
    ss.n0 = 0; ss.n1 = S; ss.mode = 0;
    const u16* Qp; int ldq; float sl2; const float* rpb = nullptr; bool has_sink = false; float sink_l2 = 0.f;
    u16* Op;
    if (kind == 0) {
      const int kvh = hq >> 2;
      ss.k1 = QKV + (size_t)tok0 * 1536 + 1024 + kvh * 128; ss.ldk1 = 1536;
      ss.v = QKV + (size_t)tok0 * 1536 + 1280 + kvh * 128; ss.ldv = 1536;
      sc.k1 = (const u16*)(p.ws() + OFF_CK) + (size_t)b * 512 * 256 + kvh * 128; sc.ldk1 = 256;
      sc.v = (const u16*)(p.ws() + OFF_CV) + (size_t)b * 512 * 256 + kvh * 128; sc.ldv = 256;
      sl2 = 0.08838834764831845f * LOG2E;
      Qp = QKV + (size_t)qrow0 * 1536 + hq * 128; ldq = 1536;
      Op = AO + (size_t)qrow0 * 1024 + hq * 128;
    } else if (kind == 1) {
      const u16* KV = (const u16*)(p.ws() + OFF_KV);
      const u16* KPE = (const u16*)(p.ws() + OFF_KPE);
      ss.k1 = KV + (size_t)tok0 * 2048 + hq * 128; ss.ldk1 = 2048;
      ss.k2 = KPE + (size_t)tok0 * 32; ss.ldk2 = 32;
      ss.v = KV + (size_t)tok0 * 2048 + hq * 128 + 64; ss.ldv = 2048;
      const size_t crow0 = 12288 + (size_t)b * 512;
      sc.k1 = KV + crow0 * 2048 + hq * 128; sc.ldk1 = 2048;
      sc.k2 = KPE + crow0 * 32; sc.ldk2 = 32;
      sc.v = KV + crow0 * 2048 + hq * 128 + 64; sc.ldv = 2048;
      sl2 = 0.10206207261596575f * LOG2E;
      Qp = QKV + (size_t)qrow0 * 1536 + hq * 96; ldq = 1536;
      Op = AO + (size_t)qrow0 * 1024 + hq * 64;
    } else if (kind == 2) {
      const int kvh = hq >> 2;
      ss.k1 = QKV + (size_t)tok0 * 1536 + 1024 + kvh * 64; ss.ldk1 = 1536;
      ss.v = QKV + (size_t)tok0 * 1536 + 1280 + kvh * 64; ss.ldv = 1536;
      sc.k1 = (const u16*)(p.ws() + OFF_CK) + (size_t)b * 512 * 256 + kvh * 64; sc.ldk1 = 256;
      sc.v = (const u16*)(p.ws() + OFF_CV) + (size_t)b * 512 * 256 + kvh * 64; sc.ldv = 256;
      sl2 = 0.125f * LOG2E;
      has_sink = true; sink_l2 = p.in(28)[hq] * LOG2E;
      if (lat) { ss.n0 = max(0, qt * 128 - 128); ss.n1 = min(1024, qt * 128 + 256); ss.mode = 1; }
      Qp = QKV + (size_t)qrow0 * 1536 + hq * 64; ldq = 1536;
      Op = AO + (size_t)qrow0 * 1024 + hq * 64;
    } else {
      ss.k1 = QKV + (size_t)tok0 * 3072 + 1024 + hq * 64; ss.ldk1 = 3072;
      ss.v = QKV + (size_t)tok0 * 3072 + 2048 + hq * 64; ss.ldv = 3072;
      sc.k1 = (const u16*)(p.ws() + OFF_C3K) + (size_t)b * 512 * 1024 + hq * 64; sc.ldk1 = 1024;
      sc.v = (const u16*)(p.ws() + OFF_C3V) + (size_t)b * 512 * 1024 + hq * 64; sc.ldv = 1024;
      sl2 = 0.125f * LOG2E;
      if (lat) {
        const int r0a = min(max(2 * qt - 4, 0), 8), r0b = min(max(2 * qt - 3, 0), 8);
        ss.n0 = r0a * 64; ss.n1 = (r0b + 8) * 64; ss.mode = 2;
        rpb = p.in(31) + hq * 465;
      }
      Qp = QKV + (size_t)qrow0 * 3072 + hq * 64; ldq = 3072;
      Op = AO + (size_t)qrow0 * 1024 + hq * 64;
    }
    Seg s0;
    s0.k1 = lat ? sc.k1 : ss.k1; s0.k2 = lat ? sc.k2 : ss.k2; s0.v = lat ? sc.v : ss.v;
    s0.ldk1 = lat ? sc.ldk1 : ss.ldk1; s0.ldk2 = lat ? sc.ldk2 : ss.ldk2; s0.ldv = lat ? sc.ldv : ss.ldv;
    s0.n0 = lat ? sc.n0 : ss.n0; s0.n1 = lat ? sc.n1 : ss.n1; s0.mode = lat ? sc.mode : ss.mode;
    const int nseg = lat ? 2 : 1;
    if (kind == 0) attn_item<128, 128>(Qp, ldq, s0, ss, nseg, qt * 128, sl2, rpb, has_sink, sink_l2, Op, 1024, smem);
    else if (kind == 1) attn_item<96, 64>(Qp, ldq, s0, ss, nseg, qt * 128, sl2, rpb, has_sink, sink_l2, Op, 1024, smem);
    else attn_item<64, 64>(Qp, ldq, s0, ss, nseg, qt * 128, sl2, rpb, has_sink, sink_l2, Op, 1024, smem);
  }
}

__host__ __device__ inline bool phase_exists(int ph) {
  if (ph == 0 || ph == 41) return true;
  const int l = (ph - 1) / 10, s = (ph - 1) % 10;
  if ((s == 3 || s == 4) && l != 1) return false;
  if (s == 2 && l == 3) return false;
  return true;
}

DI void run_phase(const KA& p, int ph, char* smem) {
  if (ph == 0) { prepass(p, smem); return; }
  if (ph == 41) { norm_phase(p, 4, 2); return; }
  const int l = (ph - 1) / 10, s = (ph - 1) % 10;
  char* ws = p.ws();
  GemmDesc g0, g1;
  g1 = GemmDesc{nullptr, nullptr, nullptr, 0, 0, 0, 0, 0, 0, 0};
  switch (s) {
    case 0:
      norm_phase(p, l, 0);
      if (l == 2) {
        convert_f32_bf16(p.in(6), (u16*)(ws + OFF_CK), 4096ull * 256);
        convert_f32_bf16(p.in(7), (u16*)(ws + OFF_CV), 4096ull * 256);
      } else if (l == 3) {
        convert_f32_bf16(p.in(8), (u16*)(ws + OFF_C3K), 4096ull * 1024);
        convert_f32_bf16(p.in(9), (u16*)(ws + OFF_C3V), 4096ull * 1024);
      }
      break;
    case 1: {
      const u16* H = (const u16*)(ws + OFF_HAO);
      if (l == 0) g0 = GemmDesc{H, (const u16*)(ws + OFF_AQKV), ws + OFF_UZ, 1024, 1024, 1536, NTOK, 1536, 1024, EPI_F32};
      else if (l == 1) g0 = GemmDesc{H, (const u16*)(ws + OFF_MIN), ws + OFF_UZ, 1024, 1024, 768, NTOK, 768, 1024, EPI_F32};
      else if (l == 2) g0 = GemmDesc{H, (const u16*)(ws + OFF_SQKV), ws + OFF_UZ, 1024, 1024, 1536, NTOK, 1536, 1024, EPI_F32};
      else g0 = GemmDesc{H, (const u16*)(ws + OFF_NQKV), ws + OFF_QO, 1024, 1024, 3072, NTOK, 3072, 1024, EPI_NAT};
      gemm_phase(p, g0, g1, 1, smem);
    } break;
    case 2:
      if (l == 0) pp_attn(p); else if (l == 1) pp_mla1(p); else if (l == 2) pp_swa(p);
      break;
    case 3:
      g0 = GemmDesc{(const u16*)(ws + OFF_CQ), (const u16*)(ws + OFF_MUQ), ws + OFF_UZ, 384, 384, 1536, NTOK, 1536, 384, EPI_F32};
      g1 = GemmDesc{(const u16*)(ws + OFF_CKV), (const u16*)(ws + OFF_MUKV), ws + OFF_KV, 256, 256, 2048, 16384, 2048, 256, EPI_BF16};
      gemm_phase(p, g0, g1, 2, smem);
      break;
    case 4: pp_mla2(p); break;
    case 5: attn_phase(p, l, smem); break;
    case 6: {
      const size_t wo = l == 0 ? OFF_AO_W : (l == 1 ? OFF_MO : (l == 2 ? OFF_SO : OFF_NO));
      g0 = GemmDesc{(const u16*)(ws + OFF_HAO), (const u16*)(ws + wo), ws + OFF_QO, 1024, 1024, 1024, NTOK, 1024, 1024, EPI_F32};
      gemm_phase(p, g0, g1, 1, smem);
    } break;
    case 7: norm_phase(p, l, 1); break;
    case 8:
      g0 = GemmDesc{(const u16*)(ws + OFF_HAO), (const u16*)(ws + OFF_W1T + (size_t)l * 8388608), ws + OFF_UZ, 1024, 1024, 4096, NTOK, 4096, 1024, EPI_RELU2};
      gemm_phase(p, g0, g1, 1, smem);
      break;
    case 9:
      g0 = GemmDesc{(const u16*)(ws + OFF_UZ), (const u16*)(ws + OFF_W2T + (size_t)l * 8388608), ws + OFF_QO, 4096, 4096, 1024, NTOK, 1024, 4096, EPI_F32};
      gemm_phase(p, g0, g1, 1, smem);
      break;
  }
}

#define XB_TMO      128
#define XB_XCNT(j)  (256  + 64 * (j))
#define XB_XSUB(j)  (1280 + 64 * (j))
#define XB_XGEN(j)  (2304 + 64 * (j))
#define XB_TOP      3328
#define XB_TOPGEN   3392
#define XCD_BAR_WORDS 3456
#define XB_SPIN_CAP (1u << 18)
#define LAS __attribute__((address_space(3)))

__device__ __forceinline__ unsigned xb_ld(unsigned* p)              { return __hip_atomic_load(p, __ATOMIC_RELAXED, __HIP_MEMORY_SCOPE_AGENT); }
__device__ __forceinline__ unsigned xb_add(unsigned* p, unsigned v) { return __hip_atomic_fetch_add(p, v, __ATOMIC_RELAXED, __HIP_MEMORY_SCOPE_AGENT); }
__device__ __forceinline__ unsigned xb_xcc_id() { return (unsigned)__builtin_amdgcn_s_getreg((3 << 11) | 20) & 0xFu; }
#define XB_SPIN(cond, bar) do { unsigned _sp = 0; while (cond) { __builtin_amdgcn_s_sleep(1); \
    if ((++_sp & 255u) == 0u) { if (xb_ld(&(bar)[XB_TMO])) break; if (_sp > XB_SPIN_CAP) { atomicAdd(&(bar)[XB_TMO], 1u); break; } } } } while (0)

struct XcdBarrier {
    unsigned* bar; unsigned x;
    volatile LAS unsigned* st;
};

__device__ __forceinline__ XcdBarrier xcd_barrier_post(unsigned* bar, volatile LAS unsigned* st) {
    XcdBarrier b; b.bar = bar; b.x = xb_xcc_id(); b.st = st;
    if (threadIdx.x == 0) (void)xb_add(&bar[XB_XCNT(b.x)], 1u);
    return b;
}
__device__ __forceinline__ void xcd_barrier_complete(unsigned* bar, unsigned x, unsigned& nloc, unsigned& nx) {
    const unsigned G = gridDim.x * gridDim.y * gridDim.z;
    unsigned sum, cnt, mine, sp = 0u;
    for (;;) {
        sum = 0u; cnt = 0u; mine = 0u;
#pragma unroll
        for (unsigned j = 0; j < 16; ++j) { const unsigned c = xb_ld(&bar[XB_XCNT(j)]); sum += c; cnt += (c > 0u) ? 1u : 0u; mine = (j == x) ? c : mine; }
        if (sum == G) break;
        __builtin_amdgcn_s_sleep(1);
        if ((++sp & 255u) == 0u) { if (xb_ld(&bar[XB_TMO])) break; if (sp > XB_SPIN_CAP) { atomicAdd(&bar[XB_TMO], 1u); break; } }
    }
    nloc = mine > 0u ? mine : 1u; nx = cnt > 0u ? cnt : 1u;
}

__device__ __forceinline__ void xcd_barrier(const XcdBarrier& b) {
    asm volatile("s_waitcnt vmcnt(0)" ::: "memory");
    __syncthreads();
    if (threadIdx.x == 0) {
        unsigned* bar = b.bar;
        __builtin_amdgcn_s_waitcnt(0);
        unsigned nloc = b.st[0], nx = b.st[1];
        if (nloc == 0u) { xcd_barrier_complete(bar, b.x, nloc, nx); b.st[0] = nloc; b.st[1] = nx; }
        const unsigned old = xb_add(&bar[XB_XSUB(b.x)], 1u);
        const unsigned gen = old / nloc;
        if (old + 1u == (gen + 1u) * nloc) {
            __builtin_amdgcn_fence(__ATOMIC_RELEASE, "agent");
            asm volatile("s_waitcnt vmcnt(0)" ::: "memory");
            const unsigned og = xb_add(&bar[XB_TOP], 1u);
            const unsigned tg = og / nx;
            if (og + 1u == (tg + 1u) * nx) xb_add(&bar[XB_TOPGEN], 1u);
            else XB_SPIN(xb_ld(&bar[XB_TOPGEN]) == tg, bar);
            __builtin_amdgcn_fence(__ATOMIC_ACQUIRE, "agent");
            xb_add(&bar[XB_XGEN(b.x)], 1u);
            asm volatile("s_waitcnt vmcnt(0)" ::: "memory");
        } else {
            XB_SPIN(xb_ld(&bar[XB_XGEN(b.x)]) == gen, bar);
            __builtin_amdgcn_fence(__ATOMIC_ACQUIRE, "agent");
            asm volatile("s_waitcnt vmcnt(0)" ::: "memory");
        }
    }
    __syncthreads();
}

__global__ void __launch_bounds__(256, 2) mega(Params p) {
  __shared__ __attribute__((aligned(16))) char smem[73728];
  __shared__ uint4 xb_words;
  const bool coop = (p.ph1 - p.ph0) > 1;
  XcdBarrier xb;
  if (coop) {
    if (threadIdx.x == 0) xb_words = make_uint4(0u, 0u, 0u, 0u);
    __syncthreads();
    xb = xcd_barrier_post((unsigned*)(p.ws + OFF_BAR), (volatile LAS unsigned*)&xb_words);
  }
  if (p.ph1 < 0) cg::this_grid().sync();
  for (int ph = p.ph0; ph < p.ph1; ++ph) {
    if (!phase_exists(ph)) continue;
    KA q;
    q.ka = (const AS4 char*)__builtin_amdgcn_kernarg_segment_ptr();
    asm volatile("" : "+s"(q.ka));
    run_phase(q, ph, smem);
    if (ph + 1 < p.ph1) xcd_barrier(xb);
  }
}

extern "C" void kernel_launch(void* const* d_in, const int* in_sizes, int n_in, void* d_out, int out_size,
                              void* d_ws, size_t ws_size, hipStream_t stream) {
  if (n_in < 33 || ws_size < WS_NEED) { fprintf(stderr, "bad args: n_in %d ws %zu need %zu\n", n_in, ws_size, (size_t)WS_NEED); return; }
  Params p{};
  for (int i = 0; i < 33; ++i) p.in[i] = (const float*)d_in[i];
  p.out = (float*)d_out;
  p.ws = (char*)d_ws;
#if N_LAUNCH_MODE == 1
  for (int ph = 0; ph < 42; ++ph) {
    if (!phase_exists(ph)) continue;
    p.ph0 = ph; p.ph1 = ph + 1;
    hipLaunchKernelGGL(mega, dim3(512), dim3(256), 0, stream, p);
  }
#else
  static int grid_blocks = 0;
  if (!grid_blocks) {
    int dev = 0, cus = 0, per_cu = 0;
    hipGetDevice(&dev);
    hipDeviceGetAttribute(&cus, hipDeviceAttributeMultiprocessorCount, dev);
    hipOccupancyMaxActiveBlocksPerMultiprocessor(&per_cu, mega, 256, 0);
    if (per_cu > 2) per_cu = 2;
    grid_blocks = cus * per_cu;
  }
  p.ph0 = 0; p.ph1 = 42;
  hipMemsetAsync((char*)d_ws + OFF_BAR, 0, XCD_BAR_WORDS * 4, stream);
  void* args[] = {&p};
  hipError_t e = hipLaunchCooperativeKernel((void*)mega, dim3(grid_blocks), dim3(256), args, 0, stream);
  if (e != hipSuccess) fprintf(stderr, "cooperative launch failed: %s (grid %d)\n", hipGetErrorString(e), grid_blocks);
#endif
}
```

```cpp
#include <hip/hip_runtime.h>
#include <hip/hip_cooperative_groups.h>
#include <cstdio>
namespace cg = cooperative_groups;

typedef unsigned short u16;
typedef short bf16x8 __attribute__((ext_vector_type(8)));
typedef short s16x4 __attribute__((ext_vector_type(4)));
typedef float f32x16 __attribute__((ext_vector_type(16)));
typedef float f32x2 __attribute__((ext_vector_type(2)));
typedef __bf16 bfx2 __attribute__((ext_vector_type(2)));
#define DI __device__ __forceinline__
#define MFMA(a, b, c) __builtin_amdgcn_mfma_f32_32x32x16_bf16((a), (b), (c), 0, 0, 0)
#define LDS3 __attribute__((address_space(3)))

#ifndef REP_GEMM
#define REP_GEMM 1
#endif
#ifndef REP_ATT
#define REP_ATT 1
#endif
#ifndef N_LAUNCH_MODE
#define N_LAUNCH_MODE 0
#endif

constexpr int NTOK = 12288, NCTX = 4096;
constexpr int NTHR = 512, NWAVE = 8;
constexpr float LOG2E = 1.4426950408889634f;

constexpr size_t O_L0K = 12582912, O_L0V = 13631488, O_L1CKV = 14680064, O_L1KPE = 15728640,
                 O_L2K = 15859712, O_L2V = 16908288, O_L3K = 17956864, O_L3V = 22151168;

constexpr size_t OFF_W1T = 0;
constexpr size_t OFF_W2T = OFF_W1T + 4ull * 4096 * 1024 * 2;
constexpr size_t OFF_AQKV = OFF_W2T + 4ull * 4096 * 1024 * 2;
constexpr size_t OFF_AO_W = OFF_AQKV + 1536ull * 1024 * 2;
constexpr size_t OFF_MIN = OFF_AO_W + 1024ull * 1024 * 2;
constexpr size_t OFF_MUQ = OFF_MIN + 768ull * 1024 * 2;
constexpr size_t OFF_MUKV = OFF_MUQ + 1536ull * 384 * 2;
constexpr size_t OFF_MO = OFF_MUKV + 2048ull * 256 * 2;
constexpr size_t OFF_SQKV = OFF_MO + 1024ull * 1024 * 2;
constexpr size_t OFF_SO = OFF_SQKV + 1536ull * 1024 * 2;
constexpr size_t OFF_NQKV = OFF_SO + 1024ull * 1024 * 2;
constexpr size_t OFF_NO = OFF_NQKV + 3072ull * 1024 * 2;
constexpr size_t OFF_MOD = OFF_NO + 1024ull * 1024 * 2;
constexpr size_t OFF_ROPE = OFF_MOD + 4ull * 9 * 6144 * 4;
constexpr size_t OFF_HAO = OFF_ROPE + 3ull * 64 * 32 * 2 * 4;
constexpr size_t OFF_UZ = OFF_HAO + 12288ull * 1024 * 2;
constexpr size_t OFF_QO = OFF_UZ + 12288ull * 4096 * 2;
constexpr size_t OFF_CQ = OFF_QO + 12288ull * 3072 * 2;
constexpr size_t OFF_CKV = OFF_CQ + 12288ull * 384 * 2;
constexpr size_t OFF_KPE = OFF_CKV + 16384ull * 256 * 2;
constexpr size_t OFF_KV = OFF_KPE + 16384ull * 32 * 2;
constexpr size_t OFF_CK = OFF_KV;
constexpr size_t OFF_CV = OFF_KV + 2097152;
constexpr size_t OFF_C3K = OFF_KV + 4194304;
constexpr size_t OFF_C3V = OFF_C3K + 8388608;
constexpr size_t OFF_BAR = OFF_KV + 16384ull * 2048 * 2;
constexpr size_t WS_NEED = OFF_BAR + 16384;

struct Params {
  const float* in[33];
  float* out;
  char* ws;
  int ph0, ph1;
};

#define AS4 __attribute__((address_space(4)))
struct KA {
  const AS4 char* ka;
  DI const float* in(int i) const { return *(const float* const AS4*)(ka + 8 * i); }
  DI float* out() const { return *(float* const AS4*)(ka + 264); }
  DI char* ws() const { return *(char* const AS4*)(ka + 272); }
};

DI unsigned pack2(float a, float b) { f32x2 f = {a, b}; bfx2 v = __builtin_convertvector(f, bfx2); return __builtin_bit_cast(unsigned, v); }
DI u16 f2bf(float a) { return (u16)(pack2(a, a) & 0xffffu); }
DI float wave_sum(float v) {
#pragma unroll
  for (int o = 32; o; o >>= 1) v += __shfl_xor(v, o, 64);
  return v;
}
DI int ltid() { int t = threadIdx.x; asm volatile("" : "+v"(t)); return t; }
DI int crow(int i, int h) { return (i & 3) + 8 * (i >> 2) + 4 * h; }

__device__ const long long TJ[18][6] = {
  {15, 0ll * 1024 * 4096, 1024, 4096, 4096, (long long)(OFF_W1T + 0ull * 8388608)},
  {15, 1ll * 1024 * 4096, 1024, 4096, 4096, (long long)(OFF_W1T + 1ull * 8388608)},
  {15, 2ll * 1024 * 4096, 1024, 4096, 4096, (long long)(OFF_W1T + 2ull * 8388608)},
  {15, 3ll * 1024 * 4096, 1024, 4096, 4096, (long long)(OFF_W1T + 3ull * 8388608)},
  {16, 0ll * 1024 * 4096, 4096, 1024, 1024, (long long)(OFF_W2T + 0ull * 8388608)},
  {16, 1ll * 1024 * 4096, 4096, 1024, 1024, (long long)(OFF_W2T + 1ull * 8388608)},
  {16, 2ll * 1024 * 4096, 4096, 1024, 1024, (long long)(OFF_W2T + 2ull * 8388608)},
  {16, 3ll * 1024 * 4096, 4096, 1024, 1024, (long long)(OFF_W2T + 3ull * 8388608)},
  {17, 0, 1024, 1536, 1536, (long long)OFF_AQKV},
  {20, 0, 1024, 1024, 1024, (long long)OFF_AO_W},
  {21, 0, 1024, 672, 768, (long long)OFF_MIN},
  {24, 0, 384, 1536, 1536, (long long)OFF_MUQ},
  {25, 0, 256, 2048, 2048, (long long)OFF_MUKV},
  {26, 0, 1024, 1024, 1024, (long long)OFF_MO},
  {27, 0, 1024, 1536, 1536, (long long)OFF_SQKV},
  {29, 0, 1024, 1024, 1024, (long long)OFF_SO},
  {30, 0, 1024, 3072, 3072, (long long)OFF_NQKV},
  {32, 0, 1024, 1024, 1024, (long long)OFF_NO},
};

DI void transpose_tile(const float* __restrict__ src, u16* __restrict__ dst, int K, int N, int k0, int n0, char* smem) {
  float (*T)[65] = (float (*)[65])smem;
  const int tid = ltid();
  const int nl = tid & 63, kl0 = tid >> 6;
  __syncthreads();
  const int n = n0 + nl;
#pragma unroll 4
  for (int j = 0; j < 8; ++j) {
    const int k = kl0 + 8 * j;
    T[k][nl] = (n < N) ? src[(size_t)(k0 + k) * N + n] : 0.f;
  }
  __syncthreads();
  const int kp = tid & 31, nl0 = tid >> 5;
#pragma unroll
  for (int j = 0; j < 4; ++j) {
    const int nn = nl0 + 16 * j;
    *(unsigned*)&dst[(size_t)(n0 + nn) * K + k0 + 2 * kp] = pack2(T[2 * kp][nn], T[2 * kp + 1][nn]);
  }
}

DI void convert_f32_bf16(const float* __restrict__ src, u16* __restrict__ dst, size_t n) {
  const size_t n4 = n >> 2;
  const int tid_ = ltid();
  for (size_t i = (size_t)blockIdx.x * NTHR + tid_; i < n4; i += (size_t)gridDim.x * NTHR) {
    const float4 v = ((const float4*)src)[i];
    uint2 o; o.x = pack2(v.x, v.y); o.y = pack2(v.z, v.w);
    ((uint2*)dst)[i] = o;
  }
}

DI void prepass(const KA& p, char* smem) {
  int total = 0;
  for (int j = 0; j < 18; ++j) total += (int)((TJ[j][2] >> 6) * (TJ[j][4] >> 6));
  for (int t = blockIdx.x; t < total; t += gridDim.x) {
    int j = 0, tt = t;
    for (;;) { const int c = (int)((TJ[j][2] >> 6) * (TJ[j][4] >> 6)); if (tt < c) break; tt -= c; ++j; }
    const int K = (int)TJ[j][2], N = (int)TJ[j][3];
    const int nk = K >> 6;
    const int kt = tt % nk, nt = tt / nk;
    transpose_tile(p.in((int)TJ[j][0]) + TJ[j][1], (u16*)(p.ws() + TJ[j][5]), K, N, kt * 64, nt * 64, smem);
  }
  convert_f32_bf16(p.in(2), (u16*)(p.ws() + OFF_CK), 4096ull * 256);
  convert_f32_bf16(p.in(3), (u16*)(p.ws() + OFF_CV), 4096ull * 256);
  convert_f32_bf16(p.in(4), (u16*)(p.ws() + OFF_CKV) + 12288ull * 256, 4096ull * 256);
  convert_f32_bf16(p.in(5), (u16*)(p.ws() + OFF_KPE) + 12288ull * 32, 4096ull * 32);
  {
    float* tab = (float*)(p.ws() + OFF_ROPE);
    const int tid_ = ltid();
    for (int e = blockIdx.x * NTHR + tid_; e < 3 * 64 * 32; e += gridDim.x * NTHR) {
      const int kind = e / 2048, pos = (e >> 5) & 63, i = e & 31;
      const int quarter = kind == 0 ? 32 : (kind == 1 ? 16 : 8);
      float c = 1.f, s = 0.f;
      if (i < quarter) {
        const float inv = exp2f(-(float)i / (float)quarter * 13.287712379549449f);
        const float ang = (float)pos * inv;
        c = cosf(ang); s = sinf(ang);
      }
      tab[2 * e] = c; tab[2 * e + 1] = s;
    }
  }
  {
    float* scond = (float*)smem;
    float* red = (float*)(smem + 36864);
    float* MOD = (float*)(p.ws() + OFF_MOD);
    const int tid = ltid();
    bool ready = false;
    for (int it = blockIdx.x; it < 768; it += gridDim.x) {
      __syncthreads();
      if (!ready) {
        for (int e = tid; e < 9 * 1024; e += NTHR) {
          const float c = e < 8192 ? p.in(10)[e] : p.in(11)[e - 8192];
          scond[e] = c / (1.f + __expf(-c));
        }
        ready = true;
        __syncthreads();
      }
      const int l = it / 192, n0 = (it % 192) * 32;
      const int col = tid & 31, kg = tid >> 5;
      float acc[9];
#pragma unroll
      for (int c = 0; c < 9; ++c) acc[c] = 0.f;
      const float* wp = p.in(12) + (size_t)l * 1024 * 6144 + n0 + col;
#pragma unroll 8
      for (int i = 0; i < 64; ++i) {
        const int k = kg + 16 * i;
        const float wv = wp[(size_t)k * 6144];
#pragma unroll
        for (int c = 0; c < 9; ++c) acc[c] += scond[c * 1024 + k] * wv;
      }
#pragma unroll
      for (int c = 0; c < 9; ++c) red[(kg * 9 + c) * 32 + col] = acc[c];
      __syncthreads();
      for (int e = tid; e < 288; e += NTHR) {
        const int c = e >> 5, cc = e & 31;
        float s = p.in(13)[l * 6144 + n0 + cc];
#pragma unroll
        for (int g = 0; g < 16; ++g) s += red[(g * 9 + c) * 32 + cc];
        MOD[(size_t)(l * 9 + c) * 6144 + n0 + cc] = s;
      }
    }
  }
}

DI void norm_phase(const KA& p, int l, int mode) {
  const int tid_ = ltid(); const int lane = tid_ & 63, w = tid_ >> 6;
  float* X = p.out();
  const float* MOD = (const float*)(p.ws() + OFF_MOD);
  const float* FF = (const float*)(p.ws() + OFF_QO);
  u16* H = (u16*)(p.ws() + OFF_HAO);
  const float* ng = p.in(14);
  const bool x_in = (l == 0);
  const bool add = !(l == 0 && mode == 0);
  const int la = (mode == 1) ? l : l - 1;
  const int gate_w = (mode == 1) ? 2 : 5;
  const int gadd = (mode == 1) ? 1 : 3;
  const bool do_h = mode != 2;
  const int gh = (mode == 0) ? 0 : 2, scw = (mode == 0) ? 1 : 4, shw = (mode == 0) ? 0 : 3;
  for (int row = blockIdx.x * NWAVE + w; row < NTOK; row += gridDim.x * NWAVE) {
    const int ci = row < NCTX ? 8 : ((row - NCTX) >> 10);
    const float* xs = x_in ? (row < NCTX ? p.in(0) + (size_t)row * 1024 : p.in(1) + (size_t)(row - NCTX) * 1024)
                           : X + (size_t)row * 1024;
    float4 x[4];
#pragma unroll
    for (int j = 0; j < 4; ++j) x[j] = *(const float4*)(xs + 4 * lane + 256 * j);
    if (add) {
      const float* fr = FF + (size_t)row * 1024;
      float4 f[4];
      float ss = 0.f;
#pragma unroll
      for (int j = 0; j < 4; ++j) {
        f[j] = *(const float4*)(fr + 4 * lane + 256 * j);
        ss += f[j].x * f[j].x + f[j].y * f[j].y + f[j].z * f[j].z + f[j].w * f[j].w;
      }
      ss = wave_sum(ss);
      const float rstd = rsqrtf(ss * (1.f / 1024.f) + 1e-6f);
      const float* ga = ng + (la * 4 + gadd) * 1024;
      const float* gt = MOD + (size_t)(la * 9 + ci) * 6144 + gate_w * 1024;
#pragma unroll
      for (int j = 0; j < 4; ++j) {
        const float4 g4 = *(const float4*)(ga + 4 * lane + 256 * j);
        const float4 t4 = *(const float4*)(gt + 4 * lane + 256 * j);
        x[j].x += t4.x * (f[j].x * rstd * g4.x);
        x[j].y += t4.y * (f[j].y * rstd * g4.y);
        x[j].z += t4.z * (f[j].z * rstd * g4.z);
        x[j].w += t4.w * (f[j].w * rstd * g4.w);
        *(float4*)(X + (size_t)row * 1024 + 4 * lane + 256 * j) = x[j];
      }
    }
    if (do_h) {
      float ss = 0.f;
#pragma unroll
      for (int j = 0; j < 4; ++j) ss += x[j].x * x[j].x + x[j].y * x[j].y + x[j].z * x[j].z + x[j].w * x[j].w;
      ss = wave_sum(ss);
      const float rstd = rsqrtf(ss * (1.f / 1024.f) + 1e-6f);
      const float* g = ng + (l * 4 + gh) * 1024;
      const float* sc = MOD + (size_t)(l * 9 + ci) * 6144 + scw * 1024;
      const float* sh = MOD + (size_t)(l * 9 + ci) * 6144 + shw * 1024;
#pragma unroll
      for (int j = 0; j < 4; ++j) {
        const float4 g4 = *(const float4*)(g + 4 * lane + 256 * j);
        const float4 c4 = *(const float4*)(sc + 4 * lane + 256 * j);
        const float4 s4 = *(const float4*)(sh + 4 * lane + 256 * j);
        const float h0 = x[j].x * rstd * g4.x * (1.f + c4.x) + s4.x;
        const float h1 = x[j].y * rstd * g4.y * (1.f + c4.y) + s4.y;
        const float h2 = x[j].z * rstd * g4.z * (1.f + c4.z) + s4.z;
        const float h3 = x[j].w * rstd * g4.w * (1.f + c4.w) + s4.w;
        uint2 o; o.x = pack2(h0, h1); o.y = pack2(h2, h3);
        *(uint2*)(H + (size_t)row * 1024 + 4 * lane + 256 * j) = o;
      }
    }
  }
}

enum { EPI_F32 = 0, EPI_BF16 = 1, EPI_RELU2 = 2, EPI_NAT = 3 };
struct GemmDesc { const u16* A; const u16* Bt; void* dst; int lda, ldb, ldc, M, N, K, epi; };

DI void gemm_tile(const GemmDesc& g, int m0, int n0, float* outp, char* smem) {
  constexpr int LS = 72;
  constexpr int BM = 192, BN = 256;
  u16* As = (u16*)smem;
  u16* Bs = As + 2 * BM * LS;
  const int tid = ltid(), lane = tid & 63, w = tid >> 6, r = lane & 31, h = lane >> 5;
  const int wm = w >> 2, wn = w & 3;
  const int lrow = tid >> 3, lcc = tid & 7;
  const int Mlast = g.M - 1;
  const u16* ag0 = g.A + (size_t)min(m0 + lrow, Mlast) * g.lda + lcc * 8;
  const u16* ag1 = g.A + (size_t)min(m0 + lrow + 64, Mlast) * g.lda + lcc * 8;
  const u16* ag2 = g.A + (size_t)min(m0 + lrow + 128, Mlast) * g.lda + lcc * 8;
  const u16* bg = g.Bt + (size_t)(n0 + lrow) * g.ldb + lcc * 8;
  const size_t sb = (size_t)64 * g.ldb;
  uint4 pa0, pa1, pa2, pb0, pb1, pb2, pb3;
  uint4 qa0, qa1, qa2, qb0, qb1, qb2, qb3;
  f32x16 acc00, acc01, acc10, acc11, acc20, acc21;
#pragma unroll
  for (int i = 0; i < 16; ++i) { acc00[i] = 0.f; acc01[i] = 0.f; acc10[i] = 0.f; acc11[i] = 0.f; acc20[i] = 0.f; acc21[i] = 0.f; }
#define GLOAD(R, off)                                                                                              \
  R##a0 = *(const uint4*)(ag0 + (off)); R##a1 = *(const uint4*)(ag1 + (off)); R##a2 = *(const uint4*)(ag2 + (off)); \
  R##b0 = *(const uint4*)(bg + (off)); R##b1 = *(const uint4*)(bg + sb + (off));                                   \
  R##b2 = *(const uint4*)(bg + 2 * sb + (off)); R##b3 = *(const uint4*)(bg + 3 * sb + (off));
#define LSTORE(R, buf)                                                                  \
  *(uint4*)&As[(buf) * BM * LS + (lrow) * LS + lcc * 8] = R##a0;                         \
  *(uint4*)&As[(buf) * BM * LS + (lrow + 64) * LS + lcc * 8] = R##a1;                    \
  *(uint4*)&As[(buf) * BM * LS + (lrow + 128) * LS + lcc * 8] = R##a2;                   \
  *(uint4*)&Bs[(buf) * BN * LS + (lrow) * LS + lcc * 8] = R##b0;                         \
  *(uint4*)&Bs[(buf) * BN * LS + (lrow + 64) * LS + lcc * 8] = R##b1;                    \
  *(uint4*)&Bs[(buf) * BN * LS + (lrow + 128) * LS + lcc * 8] = R##b2;                   \
  *(uint4*)&Bs[(buf) * BN * LS + (lrow + 192) * LS + lcc * 8] = R##b3;
#define COMPUTE(buf)                                                                    \
  {                                                                                     \
    const u16* Ac = As + (buf) * BM * LS + (96 * wm + r) * LS + 8 * h;                  \
    const u16* Bc = Bs + (buf) * BN * LS + (64 * wn + r) * LS + 8 * h;                  \
    _Pragma("unroll") for (int kk = 0; kk < 4; ++kk) {                                  \
      const bf16x8 a0 = *(const bf16x8*)(Ac + 16 * kk);                                 \
      const bf16x8 a1 = *(const bf16x8*)(Ac + 32 * LS + 16 * kk);                       \
      const bf16x8 a2 = *(const bf16x8*)(Ac + 64 * LS + 16 * kk);                       \
      const bf16x8 b0 = *(const bf16x8*)(Bc + 16 * kk);                                 \
      const bf16x8 b1 = *(const bf16x8*)(Bc + 32 * LS + 16 * kk);                       \
      acc00 = MFMA(a0, b0, acc00);                                                      \
      acc01 = MFMA(a0, b1, acc01);                                                      \
      acc10 = MFMA(a1, b0, acc10);                                                      \
      acc11 = MFMA(a1, b1, acc11);                                                      \
      acc20 = MFMA(a2, b0, acc20);                                                      \
      acc21 = MFMA(a2, b1, acc21);                                                      \
    }                                                                                   \
  }
  const int KT = g.K >> 6;
  GLOAD(p, 0)
  GLOAD(q, 64)
  LSTORE(p, 0)
  __syncthreads();
  for (int kt = 0; kt < KT; kt += 2) {
    if (kt + 2 < KT) { GLOAD(p, (kt + 2) * 64) }
    COMPUTE(0)
    LSTORE(q, 1)
    __syncthreads();
    if (kt + 3 < KT) { GLOAD(q, (kt + 3) * 64) }
    COMPUTE(1)
    if (kt + 2 < KT) { LSTORE(p, 0) }
    __syncthreads();
  }
#undef GLOAD
#undef LSTORE
#undef COMPUTE
  const int epi = g.epi;
#define EPI_LOOP(BODY)                                                                                         \
  _Pragma("unroll") for (int mi = 0; mi < 3; ++mi)                                                             \
  _Pragma("unroll") for (int ni = 0; ni < 2; ++ni) {                                                           \
    const int col = n0 + 64 * wn + 32 * ni + r;                                                                \
    _Pragma("unroll") for (int i = 0; i < 16; ++i) {                                                           \
      const int row = m0 + 96 * wm + 32 * mi + crow(i, h);                                                     \
      const float v = mi == 0 ? (ni == 0 ? acc00[i] : acc01[i]) : (mi == 1 ? (ni == 0 ? acc10[i] : acc11[i]) : (ni == 0 ? acc20[i] : acc21[i])); \
      BODY                                                                                                     \
    }                                                                                                          \
  }
  if (epi == EPI_F32) {
    float* dst = (float*)g.dst;
    EPI_LOOP(dst[(size_t)row * g.ldc + col] = v;)
  } else if (epi == EPI_RELU2) {
    u16* dst = (u16*)g.dst;
    EPI_LOOP(const float t = v > 0.f ? v : 0.f; dst[(size_t)row * g.ldc + col] = f2bf(t * t);)
  } else if (epi == EPI_BF16) {
    u16* dst = (u16*)g.dst;
    EPI_LOOP(if (row <= Mlast) dst[(size_t)row * g.ldc + col] = f2bf(v);)
  } else {
    u16* dst = (u16*)g.dst;
    EPI_LOOP(dst[(size_t)row * g.ldc + col] = f2bf(v);
             if (row < NCTX && col >= 1024) outp[(col < 2048 ? O_L3K - 1024 : O_L3V - 2048) + (size_t)row * 1024 + col] = v;)
  }
#undef EPI_LOOP
}

DI void gemm_phase(const KA& p, const GemmDesc& g0, const GemmDesc& g1, int ng, char* smem) {
  const int nt0 = g0.N >> 8, mt0 = (g0.M + 191) / 192;
  const int CN = (nt0 & 3) == 0 ? 4 : ((nt0 & 1) == 0 ? 2 : 1), CM = 32 / CN;
  if (ng == 1 && gridDim.x == 256 && (mt0 % CM) == 0) {
    const int x = blockIdx.x & 7, s = blockIdx.x >> 3, mi = s / CN, ni = s - mi * CN;
    const int ncn = nt0 / CN, nchunks = (mt0 / CM) * ncn;
    for (int rep = 0; rep < REP_GEMM; ++rep)
    for (int c = x; c < nchunks; c += 8) {
      const int cm = c / ncn, cn = c - cm * ncn;
      gemm_tile(g0, (cm * CM + mi) * 192, (cn * CN + ni) * 256, p.out(), smem);
    }
    return;
  }
  const int t0 = mt0 * nt0;
  const int t1 = ng > 1 ? ((g1.M + 191) / 192) * (g1.N >> 8) : 0;
  for (int rep = 0; rep < REP_GEMM; ++rep)
  for (int t = blockIdx.x; t < t0 + t1; t += gridDim.x) {
    const bool first = t < t0;
    GemmDesc g;
    g.A = first ? g0.A : g1.A; g.Bt = first ? g0.Bt : g1.Bt; g.dst = first ? g0.dst : g1.dst;
    g.lda = first ? g0.lda : g1.lda; g.ldb = first ? g0.ldb : g1.ldb; g.ldc = first ? g0.ldc : g1.ldc;
    g.M = first ? g0.M : g1.M; g.N = first ? g0.N : g1.N; g.K = first ? g0.K : g1.K; g.epi = first ? g0.epi : g1.epi;
    const int tt = first ? t : t - t0;
    const int nt = g.N >> 8;
    gemm_tile(g, (tt / nt) * 192, (tt % nt) * 256, p.out(), smem);
  }
}

DI void pp_attn(const KA& p) {
  const int tid_ = ltid(); const int lane = tid_ & 63, w = tid_ >> 6;
  const float* Z = (const float*)(p.ws() + OFF_UZ);
  u16* QKV = (u16*)(p.ws() + OFF_QO);
  const float* tab = (const float*)(p.ws() + OFF_ROPE);
  const float* qn = p.in(18);
  const float* kn = p.in(19);
  for (int row = blockIdx.x * NWAVE + w; row < NTOK; row += gridDim.x * NWAVE) {
    const bool lat = row >= NCTX;
    const int t = (row - NCTX) & 1023, pr = t >> 6, pc = t & 63;
    const float* z = Z + (size_t)row * 1536;
    u16* o = QKV + (size_t)row * 1536;
    const int i = lane & 31;
    const float c0 = tab[(pr * 32 + i) * 2], s0 = tab[(pr * 32 + i) * 2 + 1];
    const float c1 = tab[(pc * 32 + i) * 2], s1 = tab[(pc * 32 + i) * 2 + 1];
    const float sg = lane < 32 ? -1.f : 1.f;
    for (int hd = 0; hd < 10; ++hd) {
      const float v0 = z[hd * 128 + lane], v1 = z[hd * 128 + 64 + lane];
      const float ss = wave_sum(v0 * v0 + v1 * v1);
      const float rstd = rsqrtf(ss * (1.f / 128.f) + 1e-6f);
      const float* g = hd < 8 ? qn : kn;
      float y0 = v0 * rstd * g[lane], y1 = v1 * rstd * g[64 + lane];
      if (hd >= 8 && !lat) {
        p.out()[O_L0K + (size_t)row * 256 + (hd - 8) * 128 + lane] = y0;
        p.out()[O_L0K + (size_t)row * 256 + (hd - 8) * 128 + 64 + lane] = y1;
      }
      const float p0 = __shfl_xor(y0, 32, 64), p1 = __shfl_xor(y1, 32, 64);
      if (lat) {
        y0 = y0 * c0 + sg * p0 * s0;
        y1 = y1 * c1 + sg * p1 * s1;
      }
      o[hd * 128 + lane] = f2bf(y0);
      o[hd * 128 + 64 + lane] = f2bf(y1);
    }
#pragma unroll
    for (int j = 0; j < 4; ++j) {
      const float v = z[1280 + 64 * j + lane];
      o[1280 + 64 * j + lane] = f2bf(v);
      if (!lat) p.out()[O_L0V + (size_t)row * 256 + 64 * j + lane] = v;
    }
  }
}

DI void pp_swa(const KA& p) {
  const int tid_ = ltid(); const int lane = tid_ & 63, w = tid_ >> 6;
  const float* Z = (const float*)(p.ws() + OFF_UZ);
  u16* QKV = (u16*)(p.ws() + OFF_QO);
  const float* tab = (const float*)(p.ws() + OFF_ROPE) + 1 * 64 * 32 * 2;
  for (int row = blockIdx.x * NWAVE + w; row < NTOK; row += gridDim.x * NWAVE) {
    const bool lat = row >= NCTX;
    const int t = (row - NCTX) & 1023, pr = t >> 6, pc = t & 63;
    const float* z = Z + (size_t)row * 1536;
    u16* o = QKV + (size_t)row * 1536;
    const int i = lane & 15, axis = lane >> 5, half = (lane >> 4) & 1;
    const int pos = axis ? pc : pr;
    const float c = tab[(pos * 32 + i) * 2], s = tab[(pos * 32 + i) * 2 + 1];
    const float sg = half ? 1.f : -1.f;
    for (int hd = 0; hd < 20; ++hd) {
      float v = z[hd * 64 + lane];
      if (hd >= 16 && !lat) p.out()[O_L2K + (size_t)row * 256 + (hd - 16) * 64 + lane] = v;
      const float pv = __shfl_xor(v, 16, 64);
      if (lat) v = v * c + sg * pv * s;
      o[hd * 64 + lane] = f2bf(v);
    }
#pragma unroll
    for (int j = 0; j < 4; ++j) {
      const float v = z[1280 + 64 * j + lane];
      o[1280 + 64 * j + lane] = f2bf(v);
      if (!lat) p.out()[O_L2V + (size_t)row * 256 + 64 * j + lane] = v;
    }
  }
}

DI void pp_mla1(const KA& p) {
  const int tid_ = ltid(); const int lane = tid_ & 63, w = tid_ >> 6;
  const float* Z = (const float*)(p.ws() + OFF_UZ);
  u16* CQ = (u16*)(p.ws() + OFF_CQ);
  u16* CKV = (u16*)(p.ws() + OFF_CKV);
  u16* KPE = (u16*)(p.ws() + OFF_KPE);
  const float* tab = (const float*)(p.ws() + OFF_ROPE) + 2 * 64 * 32 * 2;
  const float* qn = p.in(22);
  const float* kvn = p.in(23);
  for (int row = blockIdx.x * NWAVE + w; row < NTOK; row += gridDim.x * NWAVE) {
    const bool lat = row >= NCTX;
    const int t = (row - NCTX) & 1023, pr = t >> 6, pc = t & 63;
    const float* z = Z + (size_t)row * 768;
    float a[6];
    float ss = 0.f;
#pragma unroll
    for (int j = 0; j < 6; ++j) { a[j] = z[64 * j + lane]; ss += a[j] * a[j]; }
    ss = wave_sum(ss);
    float rstd = rsqrtf(ss * (1.f / 384.f) + 1e-6f);
#pragma unroll
    for (int j = 0; j < 6; ++j) CQ[(size_t)row * 384 + 64 * j + lane] = f2bf(a[j] * rstd * qn[64 * j + lane]);
    ss = 0.f;
#pragma unroll
    for (int j = 0; j < 4; ++j) { a[j] = z[384 + 64 * j + lane]; ss += a[j] * a[j]; }
    ss = wave_sum(ss);
    rstd = rsqrtf(ss * (1.f / 256.f) + 1e-6f);
#pragma unroll
    for (int j = 0; j < 4; ++j) {
      const float y = a[j] * rstd * kvn[64 * j + lane];
      CKV[(size_t)row * 256 + 64 * j + lane] = f2bf(y);
      if (!lat) p.out()[O_L1CKV + (size_t)row * 256 + 64 * j + lane] = y;
    }
    const int e = lane & 31;
    float v = z[640 + e];
    const float pv = __shfl_xor(v, 8, 64);
    if (lat) {
      const int i = e & 7, axis = e >> 4, half = (e >> 3) & 1;
      const int pos = axis ? pc : pr;
      const float c = tab[(pos * 32 + i) * 2], s = tab[(pos * 32 + i) * 2 + 1];
      v = v * c + (half ? pv : -pv) * s;
    }
    if (lane < 32) {
      KPE[(size_t)row * 32 + e] = f2bf(v);
      if (!lat) p.out()[O_L1KPE + (size_t)row * 32 + e] = v;
    }
  }
}

DI void pp_mla2(const KA& p) {
  const int tid_ = ltid(); const int lane = tid_ & 63, w = tid_ >> 6;
  const float* Z = (const float*)(p.ws() + OFF_UZ);
  u16* Q = (u16*)(p.ws() + OFF_QO);
  const float* tab = (const float*)(p.ws() + OFF_ROPE) + 2 * 64 * 32 * 2;
  for (int row = blockIdx.x * NWAVE + w; row < NTOK; row += gridDim.x * NWAVE) {
    const bool lat = row >= NCTX;
    const int t = (row - NCTX) & 1023, pr = t >> 6, pc = t & 63;
    const float* z = Z + (size_t)row * 1536;
    for (int j = 0; j < 24; ++j) {
      const int col = 64 * j + lane;
      float v = z[col];
      const float pv = __shfl_xor(v, 8, 64);
      const int d = col % 96;
      if (lat && d >= 64) {
        const int e = d - 64;
        const int i = e & 7, axis = e >> 4, half = (e >> 3) & 1;
        const int pos = axis ? pc : pr;
        const float c = tab[(pos * 32 + i) * 2], s = tab[(pos * 32 + i) * 2 + 1];
        v = v * c + (half ? pv : -pv) * s;
      }
      Q[(size_t)row * 1536 + col] = f2bf(v);
    }
  }
}

struct Seg { const u16* k1; const u16* k2; const u16* v; int ldk1, ldk2, ldv, n0, n1, mode; };

template <int HDQK, int HDV>
DI void attn_item(const u16* __restrict__ Qp, int ldq, const Seg& sA, const Seg& sB, int nseg, int qpos0,
                  float scale_l2, const float* __restrict__ rpb_h, bool has_sink, float sink_l2,
                  u16* __restrict__ Op, int ldo, char* smem) {
  constexpr int K1W = (HDQK == 96) ? 64 : HDQK;
  constexpr int KS = HDQK + 8, VS = HDV + 8;
  constexpr int KC = HDQK / 8, VC = HDV / 8;
  u16* Ks = (u16*)smem;
  u16* Vs = Ks + 64 * KS;
  float* rp = (float*)(Vs + 64 * VS);
  const int tid = ltid(), lane = tid & 63, w = tid >> 6, r = lane & 31, h = lane >> 5;
  const int q4 = (lane & 15) >> 2, p4 = lane & 3, dblk = (lane >> 4) & 1;

  __syncthreads();
  if (rpb_h) for (int e = tid; e < 465; e += NTHR) rp[e] = rpb_h[e];

  bf16x8 qf[HDQK / 16];
  {
    const u16* qrow = Qp + (size_t)(32 * w + r) * ldq + 8 * h;
#pragma unroll
    for (int kk = 0; kk < HDQK / 16; ++kk) qf[kk] = *(const bf16x8*)(qrow + 16 * kk);
  }
  f32x16 o[HDV / 32];
#pragma unroll
  for (int dt = 0; dt < HDV / 32; ++dt)
#pragma unroll
    for (int i = 0; i < 16; ++i) o[dt][i] = 0.f;
  float m = -1e30f, l = 0.f;
  const int qpos = qpos0 + 32 * w + r;
  const int qr = qpos >> 6, qc = qpos & 63;
  const int r0 = min(max(qr - 4, 0), 8), c0 = min(max(qc - 8, 0), 48);

  for (int sg = 0; sg < nseg; ++sg) {
    Seg s;
    s.k1 = sg == 0 ? sA.k1 : sB.k1; s.k2 = sg == 0 ? sA.k2 : sB.k2; s.v = sg == 0 ? sA.v : sB.v;
    s.ldk1 = sg == 0 ? sA.ldk1 : sB.ldk1; s.ldk2 = sg == 0 ? sA.ldk2 : sB.ldk2; s.ldv = sg == 0 ? sA.ldv : sB.ldv;
    s.n0 = sg == 0 ? sA.n0 : sB.n0; s.n1 = sg == 0 ? sA.n1 : sB.n1; s.mode = sg == 0 ? sA.mode : sB.mode;
    const int mode = s.mode;
    for (int n = s.n0; n < s.n1; n += 64) {
      __syncthreads();
      for (int c = tid; c < 64 * KC; c += NTHR) {
        const int row = c / KC, cc = c - row * KC;
        const u16* src = (cc * 8 < K1W) ? s.k1 + (size_t)(n + row) * s.ldk1 + cc * 8
                                        : s.k2 + (size_t)(n + row) * s.ldk2 + (cc * 8 - K1W);
        *(uint4*)&Ks[row * KS + cc * 8] = *(const uint4*)src;
      }
      for (int c = tid; c < 64 * VC; c += NTHR) {
        const int row = c / VC, cc = c - row * VC;
        *(uint4*)&Vs[row * VS + cc * 8] = *(const uint4*)(s.v + (size_t)(n + row) * s.ldv + cc * 8);
      }
      __syncthreads();
      const int qw = qpos0 + 32 * w;
      bool skip = false;
      if (mode == 1) skip = (n > qw + 31 + 128) || (n + 63 < qw - 128);
      else if (mode == 2) { const int r0w = min(max((qw >> 6) - 4, 0), 8); const int kr = n >> 6; skip = (kr < r0w) || (kr >= r0w + 8); }
      if (skip) continue;
      f32x16 st[2];
#pragma unroll
      for (int kt = 0; kt < 2; ++kt) {
#pragma unroll
        for (int i = 0; i < 16; ++i) st[kt][i] = 0.f;
        const u16* kb = Ks + (32 * kt + r) * KS + 8 * h;
#pragma unroll
        for (int kk = 0; kk < HDQK / 16; ++kk) {
          const bf16x8 a = *(const bf16x8*)(kb + 16 * kk);
          st[kt] = MFMA(a, qf[kk], st[kt]);
        }
      }
      float mx = -1e30f;
      if (mode == 0) {
#pragma unroll
        for (int kt = 0; kt < 2; ++kt)
#pragma unroll
          for (int i = 0; i < 16; ++i) { const float v = st[kt][i] * scale_l2; st[kt][i] = v; mx = fmaxf(mx, v); }
      } else if (mode == 1) {
#pragma unroll
        for (int kt = 0; kt < 2; ++kt)
#pragma unroll
          for (int i = 0; i < 16; ++i) {
            const int kpos = n + 32 * kt + crow(i, h);
            const int d = qpos - kpos;
            float v = st[kt][i] * scale_l2;
            if (d > 128 || d < -128) v = -1e30f;
            st[kt][i] = v; mx = fmaxf(mx, v);
          }
      } else {
#pragma unroll
        for (int kt = 0; kt < 2; ++kt)
#pragma unroll
          for (int i = 0; i < 16; ++i) {
            const int kpos = n + 32 * kt + crow(i, h);
            const int kr = kpos >> 6, kc = kpos & 63;
            const bool ok = ((unsigned)(kr - r0) < 8u) && ((unsigned)(kc - c0) < 16u);
            const int idx = ok ? (kr - qr + 7) * 31 + (kc - qc + 15) : 0;
            const float b = rp[idx];
            float v = st[kt][i] * scale_l2 + b * LOG2E;
            if (!ok) v = -1e30f;
            st[kt][i] = v; mx = fmaxf(mx, v);
          }
      }
      mx = fmaxf(mx, __shfl_xor(mx, 32, 64));
      const float mn = fmaxf(m, mx);
      const float alpha = __builtin_amdgcn_exp2f(m - mn);
      m = mn;
      float rs = 0.f;
#pragma unroll
      for (int kt = 0; kt < 2; ++kt)
#pragma unroll
        for (int i = 0; i < 16; ++i) { const float pz = __builtin_amdgcn_exp2f(st[kt][i] - mn); st[kt][i] = pz; rs += pz; }
      rs += __shfl_xor(rs, 32, 64);
      l = l * alpha + rs;
#pragma unroll
      for (int dt = 0; dt < HDV / 32; ++dt)
#pragma unroll
        for (int i = 0; i < 16; ++i) o[dt][i] *= alpha;
#pragma unroll
      for (int kt = 0; kt < 2; ++kt)
#pragma unroll
        for (int s2 = 0; s2 < 2; ++s2) {
          unsigned pk[4];
#pragma unroll
          for (int j = 0; j < 4; ++j) pk[j] = pack2(st[kt][8 * s2 + 2 * j], st[kt][8 * s2 + 2 * j + 1]);
          bf16x8 pb;
          {
            typedef unsigned u32x4 __attribute__((ext_vector_type(4)));
            u32x4 t4 = {pk[0], pk[1], pk[2], pk[3]};
            pb = __builtin_bit_cast(bf16x8, t4);
          }
          const u16* vb = Vs + (32 * kt + 16 * s2 + 4 * h + q4) * VS + 16 * dblk + 4 * p4;
#pragma unroll
          for (int dt = 0; dt < HDV / 32; ++dt) {
            const s16x4 lo = __builtin_amdgcn_ds_read_tr16_b64_v4i16((LDS3 s16x4*)(vb + 32 * dt));
            const s16x4 hi = __builtin_amdgcn_ds_read_tr16_b64_v4i16((LDS3 s16x4*)(vb + 8 * VS + 32 * dt));
            const bf16x8 va = __builtin_shufflevector(lo, hi, 0, 1, 2, 3, 4, 5, 6, 7);
            o[dt] = MFMA(va, pb, o[dt]);
          }
        }
    }
  }
  if (has_sink) l += __builtin_amdgcn_exp2f(sink_l2 - m);
  const float inv = 1.f / l;
  u16* orow = Op + (size_t)(32 * w + r) * ldo + 4 * h;
#pragma unroll
  for (int dt = 0; dt < HDV / 32; ++dt)
#pragma unroll
    for (int g = 0; g < 4; ++g) {
      uint2 v;
      v.x = pack2(o[dt][4 * g] * inv, o[dt][4 * g + 1] * inv);
      v.y = pack2(o[dt][4 * g + 2] * inv, o[dt][4 * g + 3] * inv);
      *(uint2*)(orow + 32 * dt + 8 * g) = v;
    }
}

DI void attn_phase(const KA& p, int kind, char* smem) {
  const int Hq = kind == 0 ? 8 : 16;
  const int nlat = 8 * Hq * 4, nctx = 16 * Hq;
  u16* AO = (u16*)(p.ws() + OFF_HAO);
  const u16* QKV = (const u16*)(p.ws() + OFF_QO);
  for (int rep = 0; rep < REP_ATT; ++rep)
  for (int item = blockIdx.x; item < nlat + nctx; item += gridDim.x) {
    const bool lat = item < nlat;
    int b, hq, qt;
    if (lat) { b = item / (Hq * 4); const int rem = item - b * Hq * 4; hq = rem >> 2; qt = rem & 3; }
    else { const int it = item - nlat; b = it / Hq; hq = it - b * Hq; qt = 0; }
    const int tok0 = lat ? NCTX + b * 1024 : b * 256;
    const int S = lat ? 1024 : 256;
    const int qrow0 = tok0 + qt * 256;
    Seg sc, ss;
    sc.k2 = nullptr; sc.ldk2 = 0; ss.k2 = nullptr; ss.ldk2 = 0;
    sc.n0 = 0; sc.n1 = 512; sc.mode = 0;
    ss.n0 = 0; ss.n1 = S; ss.mode = 0;
    const u16* Qp; int ldq; float sl2; const float* rpb = nullptr; bool has_sink = false; float sink_l2 = 0.f;
    u16* Op;
    if (kind == 0) {
      const int kvh = hq >> 2;
      ss.k1 = QKV + (size_t)tok0 * 1536 + 1024 + kvh * 128; ss.ldk1 = 1536;
      ss.v = QKV + (size_t)tok0 * 1536 + 1280 + kvh * 128; ss.ldv = 1536;
      sc.k1 = (const u16*)(p.ws() + OFF_CK) + (size_t)b * 512 * 256 + kvh * 128; sc.ldk1 = 256;
      sc.v = (const u16*)(p.ws() + OFF_CV) + (size_t)b * 512 * 256 + kvh * 128; sc.ldv = 256;
      sl2 = 0.08838834764831845f * LOG2E;
      Qp = QKV + (size_t)qrow0 * 1536 + hq * 128; ldq = 1536;
      Op = AO + (size_t)qrow0 * 1024 + hq * 128;
    } else if (kind == 1) {
      const u16* KV = (const u16*)(p.ws() + OFF_KV);
      const u16* KPE = (const u16*)(p.ws() + OFF_KPE);
      ss.k1 = KV + (size_t)tok0 * 2048 + hq * 128; ss.ldk1 = 2048;
      ss.k2 = KPE + (size_t)tok0 * 32; ss.ldk2 = 32;
      ss.v = KV + (size_t)tok0 * 2048 + hq * 128 + 64; ss.ldv = 2048;
      const size_t crow0 = 12288 + (size_t)b * 512;
      sc.k1 = KV + crow0 * 2048 + hq * 128; sc.ldk1 = 2048;
      sc.k2 = KPE + crow0 * 32; sc.ldk2 = 32;
      sc.v = KV + crow0 * 2048 + hq * 128 + 64; sc.ldv = 2048;
      sl2 = 0.10206207261596575f * LOG2E;
      Qp = QKV + (size_t)qrow0 * 1536 + hq * 96; ldq = 1536;
      Op = AO + (size_t)qrow0 * 1024 + hq * 64;
    } else if (kind == 2) {
      const int kvh = hq >> 2;
      ss.k1 = QKV + (size_t)tok0 * 1536 + 1024 + kvh * 64; ss.ldk1 = 1536;
      ss.v = QKV + (size_t)tok0 * 1536 + 1280 + kvh * 64; ss.ldv = 1536;
      sc.k1 = (const u16*)(p.ws() + OFF_CK) + (size_t)b * 512 * 256 + kvh * 64; sc.ldk1 = 256;
      sc.v = (const u16*)(p.ws() + OFF_CV) + (size_t)b * 512 * 256 + kvh * 64; sc.ldv = 256;
      sl2 = 0.125f * LOG2E;
      has_sink = true; sink_l2 = p.in(28)[hq] * LOG2E;
      if (lat) { ss.n0 = max(0, qt * 256 - 128); ss.n1 = min(1024, qt * 256 + 384); ss.mode = 1; }
      Qp = QKV + (size_t)qrow0 * 1536 + hq * 64; ldq = 1536;
      Op = AO + (size_t)qrow0 * 1024 + hq * 64;
    } else {
      ss.k1 = QKV + (size_t)tok0 * 3072 + 1024 + hq * 64; ss.ldk1 = 3072;
      ss.v = QKV + (size_t)tok0 * 3072 + 2048 + hq * 64; ss.ldv = 3072;
      sc.k1 = (const u16*)(p.ws() + OFF_C3K) + (size_t)b * 512 * 1024 + hq * 64; sc.ldk1 = 1024;
      sc.v = (const u16*)(p.ws() + OFF_C3V) + (size_t)b * 512 * 1024 + hq * 64; sc.ldv = 1024;
      sl2 = 0.125f * LOG2E;
      if (lat) {
        const int r0a = min(max(4 * qt - 4, 0), 8), r0b = min(max(4 * qt - 1, 0), 8);
        ss.n0 = r0a * 64; ss.n1 = (r0b + 8) * 64; ss.mode = 2;
        rpb = p.in(31) + hq * 465;
      }
      Qp = QKV + (size_t)qrow0 * 3072 + hq * 64; ldq = 3072;
      Op = AO + (size_t)qrow0 * 1024 + hq * 64;
    }
    Seg s0;
    s0.k1 = lat ? sc.k1 : ss.k1; s0.k2 = lat ? sc.k2 : ss.k2; s0.v = lat ? sc.v : ss.v;
    s0.ldk1 = lat ? sc.ldk1 : ss.ldk1; s0.ldk2 = lat ? sc.ldk2 : ss.ldk2; s0.ldv = lat ? sc.ldv : ss.ldv;
    s0.n0 = lat ? sc.n0 : ss.n0; s0.n1 = lat ? sc.n1 : ss.n1; s0.mode = lat ? sc.mode : ss.mode;
    const int nseg = lat ? 2 : 1;
    if (kind == 0) attn_item<128, 128>(Qp, ldq, s0, ss, nseg, qt * 256, sl2, rpb, has_sink, sink_l2, Op, 1024, smem);
    else if (kind == 1) attn_item<96, 64>(Qp, ldq, s0, ss, nseg, qt * 256, sl2, rpb, has_sink, sink_l2, Op, 1024, smem);
    else attn_item<64, 64>(Qp, ldq, s0, ss, nseg, qt * 256, sl2, rpb, has_sink, sink_l2, Op, 1024, smem);
  }
}

__host__ __device__ inline bool phase_exists(int ph) {
  if (ph == 0 || ph == 41) return true;
  const int l = (ph - 1) / 10, s = (ph - 1) % 10;
  if ((s == 3 || s == 4) && l != 1) return false;
  if (s == 2 && l == 3) return false;
  return true;
}

DI void run_phase(const KA& p, int ph, char* smem) {
  if (ph == 0) { prepass(p, smem); return; }
  if (ph == 41) { norm_phase(p, 4, 2); return; }
  const int l = (ph - 1) / 10, s = (ph - 1) % 10;
  char* ws = p.ws();
  GemmDesc g0, g1;
  g0 = GemmDesc{nullptr, nullptr, nullptr, 0, 0, 0, 0, 0, 0, 0};
  g1 = g0;
  int ng = 0;
  switch (s) {
    case 0:
      norm_phase(p, l, 0);
      if (l == 2) {
        convert_f32_bf16(p.in(6), (u16*)(ws + OFF_CK), 4096ull * 256);
        convert_f32_bf16(p.in(7), (u16*)(ws + OFF_CV), 4096ull * 256);
      } else if (l == 3) {
        convert_f32_bf16(p.in(8), (u16*)(ws + OFF_C3K), 4096ull * 1024);
        convert_f32_bf16(p.in(9), (u16*)(ws + OFF_C3V), 4096ull * 1024);
      }
      break;
    case 1: {
      const u16* H = (const u16*)(ws + OFF_HAO);
      if (l == 0) g0 = GemmDesc{H, (const u16*)(ws + OFF_AQKV), ws + OFF_UZ, 1024, 1024, 1536, NTOK, 1536, 1024, EPI_F32};
      else if (l == 1) g0 = GemmDesc{H, (const u16*)(ws + OFF_MIN), ws + OFF_UZ, 1024, 1024, 768, NTOK, 768, 1024, EPI_F32};
      else if (l == 2) g0 = GemmDesc{H, (const u16*)(ws + OFF_SQKV), ws + OFF_UZ, 1024, 1024, 1536, NTOK, 1536, 1024, EPI_F32};
      else g0 = GemmDesc{H, (const u16*)(ws + OFF_NQKV), ws + OFF_QO, 1024, 1024, 3072, NTOK, 3072, 1024, EPI_NAT};
      ng = 1;
    } break;
    case 2:
      if (l == 0) pp_attn(p); else if (l == 1) pp_mla1(p); else if (l == 2) pp_swa(p);
      break;
    case 3:
      g0 = GemmDesc{(const u16*)(ws + OFF_CQ), (const u16*)(ws + OFF_MUQ), ws + OFF_UZ, 384, 384, 1536, NTOK, 1536, 384, EPI_F32};
      g1 = GemmDesc{(const u16*)(ws + OFF_CKV), (const u16*)(ws + OFF_MUKV), ws + OFF_KV, 256, 256, 2048, 16384, 2048, 256, EPI_BF16};
      ng = 2;
      break;
    case 4: pp_mla2(p); break;
    case 5: attn_phase(p, l, smem); break;
    case 6: {
      const size_t wo = l == 0 ? OFF_AO_W : (l == 1 ? OFF_MO : (l == 2 ? OFF_SO : OFF_NO));
      g0 = GemmDesc{(const u16*)(ws + OFF_HAO), (const u16*)(ws + wo), ws + OFF_QO, 1024, 1024, 1024, NTOK, 1024, 1024, EPI_F32};
      ng = 1;
    } break;
    case 7: norm_phase(p, l, 1); break;
    case 8:
      g0 = GemmDesc{(const u16*)(ws + OFF_HAO), (const u16*)(ws + OFF_W1T + (size_t)l * 8388608), ws + OFF_UZ, 1024, 1024, 4096, NTOK, 4096, 1024, EPI_RELU2};
      ng = 1;
      break;
    case 9:
      g0 = GemmDesc{(const u16*)(ws + OFF_UZ), (const u16*)(ws + OFF_W2T + (size_t)l * 8388608), ws + OFF_QO, 4096, 4096, 1024, NTOK, 1024, 4096, EPI_F32};
      ng = 1;
      break;
  }
  if (ng > 0) gemm_phase(p, g0, g1, ng, smem);
}

#define XB_TMO      128
#define XB_XCNT(j)  (256  + 64 * (j))
#define XB_XSUB(j)  (1280 + 64 * (j))
#define XB_XGEN(j)  (2304 + 64 * (j))
#define XB_TOP      3328
#define XB_TOPGEN   3392
#define XCD_BAR_WORDS 3456
#define XB_SPIN_CAP (1u << 18)
#define LAS __attribute__((address_space(3)))

__device__ __forceinline__ unsigned xb_ld(unsigned* p)              { return __hip_atomic_load(p, __ATOMIC_RELAXED, __HIP_MEMORY_SCOPE_AGENT); }
__device__ __forceinline__ unsigned xb_add(unsigned* p, unsigned v) { return __hip_atomic_fetch_add(p, v, __ATOMIC_RELAXED, __HIP_MEMORY_SCOPE_AGENT); }
__device__ __forceinline__ unsigned xb_xcc_id() { return (unsigned)__builtin_amdgcn_s_getreg((3 << 11) | 20) & 0xFu; }
#define XB_SPIN(cond, bar) do { unsigned _sp = 0; while (cond) { __builtin_amdgcn_s_sleep(1); \
    if ((++_sp & 255u) == 0u) { if (xb_ld(&(bar)[XB_TMO])) break; if (_sp > XB_SPIN_CAP) { atomicAdd(&(bar)[XB_TMO], 1u); break; } } } } while (0)

struct XcdBarrier {
    unsigned* bar; unsigned x;
    volatile LAS unsigned* st;
};

__device__ __forceinline__ XcdBarrier xcd_barrier_post(unsigned* bar, volatile LAS unsigned* st) {
    XcdBarrier b; b.bar = bar; b.x = xb_xcc_id(); b.st = st;
    if (threadIdx.x == 0) (void)xb_add(&bar[XB_XCNT(b.x)], 1u);
    return b;
}
__device__ __forceinline__ void xcd_barrier_complete(unsigned* bar, unsigned x, unsigned& nloc, unsigned& nx) {
    const unsigned G = gridDim.x * gridDim.y * gridDim.z;
    unsigned sum, cnt, mine, sp = 0u;
    for (;;) {
        sum = 0u; cnt = 0u; mine = 0u;
#pragma unroll
        for (unsigned j = 0; j < 16; ++j) { const unsigned c = xb_ld(&bar[XB_XCNT(j)]); sum += c; cnt += (c > 0u) ? 1u : 0u; mine = (j == x) ? c : mine; }
        if (sum == G) break;
        __builtin_amdgcn_s_sleep(1);
        if ((++sp & 255u) == 0u) { if (xb_ld(&bar[XB_TMO])) break; if (sp > XB_SPIN_CAP) { atomicAdd(&bar[XB_TMO], 1u); break; } }
    }
    nloc = mine > 0u ? mine : 1u; nx = cnt > 0u ? cnt : 1u;
}

__device__ __forceinline__ void xcd_barrier(const XcdBarrier& b) {
    asm volatile("s_waitcnt vmcnt(0)" ::: "memory");
    __syncthreads();
    if (threadIdx.x == 0) {
        unsigned* bar = b.bar;
        __builtin_amdgcn_s_waitcnt(0);
        unsigned nloc = b.st[0], nx = b.st[1];
        if (nloc == 0u) { xcd_barrier_complete(bar, b.x, nloc, nx); b.st[0] = nloc; b.st[1] = nx; }
        const unsigned old = xb_add(&bar[XB_XSUB(b.x)], 1u);
        const unsigned gen = old / nloc;
        if (old + 1u == (gen + 1u) * nloc) {
            __builtin_amdgcn_fence(__ATOMIC_RELEASE, "agent");
            asm volatile("s_waitcnt vmcnt(0)" ::: "memory");
            const unsigned og = xb_add(&bar[XB_TOP], 1u);
            const unsigned tg = og / nx;
            if (og + 1u == (tg + 1u) * nx) xb_add(&bar[XB_TOPGEN], 1u);
            else XB_SPIN(xb_ld(&bar[XB_TOPGEN]) == tg, bar);
            __builtin_amdgcn_fence(__ATOMIC_ACQUIRE, "agent");
            xb_add(&bar[XB_XGEN(b.x)], 1u);
            asm volatile("s_waitcnt vmcnt(0)" ::: "memory");
        } else {
            XB_SPIN(xb_ld(&bar[XB_XGEN(b.x)]) == gen, bar);
            __builtin_amdgcn_fence(__ATOMIC_ACQUIRE, "agent");
            asm volatile("s_waitcnt vmcnt(0)" ::: "memory");
        }
    }
    __syncthreads();
}

__global__ void __launch_bounds__(512, 2) mega(Params p) {
  __shared__ __attribute__((aligned(16))) char smem[129024];
  __shared__ uint4 xb_words;
  const bool coop = (p.ph1 - p.ph0) > 1;
  XcdBarrier xb;
  if (coop) {
    if (threadIdx.x == 0) xb_words = make_uint4(0u, 0u, 0u, 0u);
    __syncthreads();
    xb = xcd_barrier_post((unsigned*)(p.ws + OFF_BAR), (volatile LAS unsigned*)&xb_words);
  }
  if (p.ph1 < 0) cg::this_grid().sync();
  for (int ph = p.ph0; ph < p.ph1; ++ph) {
    if (!phase_exists(ph)) continue;
    KA q;
    q.ka = (const AS4 char*)__builtin_amdgcn_kernarg_segment_ptr();
    asm volatile("" : "+s"(q.ka));
    run_phase(q, ph, smem);
    if (ph + 1 < p.ph1) xcd_barrier(xb);
  }
}

extern "C" void kernel_launch(void* const* d_in, const int* in_sizes, int n_in, void* d_out, int out_size,
                              void* d_ws, size_t ws_size, hipStream_t stream) {
  if (n_in < 33 || ws_size < WS_NEED) { fprintf(stderr, "bad args: n_in %d ws %zu need %zu\n", n_in, ws_size, (size_t)WS_NEED); return; }
  Params p{};
  for (int i = 0; i < 33; ++i) p.in[i] = (const float*)d_in[i];
  p.out = (float*)d_out;
  p.ws = (char*)d_ws;
#if N_LAUNCH_MODE == 1
  for (int ph = 0; ph < 42; ++ph) {
    if (!phase_exists(ph)) continue;
    p.ph0 = ph; p.ph1 = ph + 1;
    hipLaunchKernelGGL(mega, dim3(256), dim3(NTHR), 0, stream, p);
  }
#else
  static int grid_blocks = 0;
  if (!grid_blocks) {
    int dev = 0, cus = 0, per_cu = 0;
    hipGetDevice(&dev);
    hipDeviceGetAttribute(&cus, hipDeviceAttributeMultiprocessorCount, dev);
    hipOccupancyMaxActiveBlocksPerMultiprocessor(&per_cu, mega, NTHR, 0);
    if (per_cu > 1) per_cu = 1;
    grid_blocks = cus * per_cu;
  }
  p.ph0 = 0; p.ph1 = 42;
  hipMemsetAsync((char*)d_ws + OFF_BAR, 0, XCD_BAR_WORDS * 4, stream);
  void* args[] = {&p};
  hipError_t e = hipLaunchCooperativeKernel((void*)mega, dim3(grid_blocks), dim3(NTHR), args, 0, stream);
  if (e != hipSuccess) fprintf(stderr, "cooperative launch failed: %s (grid %d)\n", hipGetErrorString(e), grid_blocks);
#endif
}
```

```cpp
#include <hip/hip_runtime.h>
#include <hip/hip_cooperative_groups.h>
#include <cstdio>
namespace cg = cooperative_groups;

typedef unsigned short u16;
typedef short bf16x8 __attribute__((ext_vector_type(8)));
typedef short s16x4 __attribute__((ext_vector_type(4)));
typedef float f32x16 __attribute__((ext_vector_type(16)));
typedef float f32x2 __attribute__((ext_vector_type(2)));
typedef __bf16 bfx2 __attribute__((ext_vector_type(2)));
#define DI __device__ __forceinline__
#define MFMA(a, b, c) __builtin_amdgcn_mfma_f32_32x32x16_bf16((a), (b), (c), 0, 0, 0)
#define LDS3 __attribute__((address_space(3)))

#ifndef REP_GEMM
#define REP_GEMM 1
#endif
#ifndef REP_ATT
#define REP_ATT 1
#endif
#ifndef N_LAUNCH_MODE
#define N_LAUNCH_MODE 0
#endif

constexpr int NTOK = 12288, NCTX = 4096;
constexpr int NTHR = 512, NWAVE = 8;
constexpr float LOG2E = 1.4426950408889634f;

constexpr size_t O_L0K = 12582912, O_L0V = 13631488, O_L1CKV = 14680064, O_L1KPE = 15728640,
                 O_L2K = 15859712, O_L2V = 16908288, O_L3K = 17956864, O_L3V = 22151168;

constexpr size_t OFF_W1T = 0;
constexpr size_t OFF_W2T = OFF_W1T + 4ull * 4096 * 1024 * 2;
constexpr size_t OFF_AQKV = OFF_W2T + 4ull * 4096 * 1024 * 2;
constexpr size_t OFF_AO_W = OFF_AQKV + 1536ull * 1024 * 2;
constexpr size_t OFF_MIN = OFF_AO_W + 1024ull * 1024 * 2;
constexpr size_t OFF_MUQ = OFF_MIN + 768ull * 1024 * 2;
constexpr size_t OFF_MUKV = OFF_MUQ + 1536ull * 384 * 2;
constexpr size_t OFF_MO = OFF_MUKV + 2048ull * 256 * 2;
constexpr size_t OFF_SQKV = OFF_MO + 1024ull * 1024 * 2;
constexpr size_t OFF_SO = OFF_SQKV + 1536ull * 1024 * 2;
constexpr size_t OFF_NQKV = OFF_SO + 1024ull * 1024 * 2;
constexpr size_t OFF_NO = OFF_NQKV + 3072ull * 1024 * 2;
constexpr size_t OFF_MOD = OFF_NO + 1024ull * 1024 * 2;
constexpr size_t OFF_ROPE = OFF_MOD + 4ull * 9 * 6144 * 4;
constexpr size_t OFF_HAO = OFF_ROPE + 3ull * 64 * 32 * 2 * 4;
constexpr size_t OFF_UZ = OFF_HAO + 12288ull * 1024 * 2;
constexpr size_t OFF_QO = OFF_UZ + 12288ull * 4096 * 2;
constexpr size_t OFF_CQ = OFF_QO + 12288ull * 3072 * 2;
constexpr size_t OFF_CKV = OFF_CQ + 12288ull * 384 * 2;
constexpr size_t OFF_KPE = OFF_CKV + 16384ull * 256 * 2;
constexpr size_t OFF_KV = OFF_KPE + 16384ull * 32 * 2;
constexpr size_t OFF_CK = OFF_KV;
constexpr size_t OFF_CV = OFF_KV + 2097152;
constexpr size_t OFF_C3K = OFF_KV + 4194304;
constexpr size_t OFF_C3V = OFF_C3K + 8388608;
constexpr size_t OFF_BAR = OFF_KV + 16384ull * 2048 * 2;
constexpr size_t WS_NEED = OFF_BAR + 16384;

struct Params {
  const float* in[33];
  float* out;
  char* ws;
  int ph0, ph1;
};

#define AS4 __attribute__((address_space(4)))
struct KA {
  const AS4 char* ka;
  DI const float* in(int i) const { return *(const float* const AS4*)(ka + 8 * i); }
  DI float* out() const { return *(float* const AS4*)(ka + 264); }
  DI char* ws() const { return *(char* const AS4*)(ka + 272); }
};

DI unsigned pack2(float a, float b) { f32x2 f = {a, b}; bfx2 v = __builtin_convertvector(f, bfx2); return __builtin_bit_cast(unsigned, v); }
DI u16 f2bf(float a) { return (u16)(pack2(a, a) & 0xffffu); }
DI float wave_sum(float v) {
#pragma unroll
  for (int o = 32; o; o >>= 1) v += __shfl_xor(v, o, 64);
  return v;
}
DI int ltid() { int t = threadIdx.x; asm volatile("" : "+v"(t)); return t; }
DI int crow(int i, int h) { return (i & 3) + 8 * (i >> 2) + 4 * h; }

__device__ const long long TJ[18][6] = {
  {15, 0ll * 1024 * 4096, 1024, 4096, 4096, (long long)(OFF_W1T + 0ull * 8388608)},
  {15, 1ll * 1024 * 4096, 1024, 4096, 4096, (long long)(OFF_W1T + 1ull * 8388608)},
  {15, 2ll * 1024 * 4096, 1024, 4096, 4096, (long long)(OFF_W1T + 2ull * 8388608)},
  {15, 3ll * 1024 * 4096, 1024, 4096, 4096, (long long)(OFF_W1T + 3ull * 8388608)},
  {16, 0ll * 1024 * 4096, 4096, 1024, 1024, (long long)(OFF_W2T + 0ull * 8388608)},
  {16, 1ll * 1024 * 4096, 4096, 1024, 1024, (long long)(OFF_W2T + 1ull * 8388608)},
  {16, 2ll * 1024 * 4096, 4096, 1024, 1024, (long long)(OFF_W2T + 2ull * 8388608)},
  {16, 3ll * 1024 * 4096, 4096, 1024, 1024, (long long)(OFF_W2T + 3ull * 8388608)},
  {17, 0, 1024, 1536, 1536, (long long)OFF_AQKV},
  {20, 0, 1024, 1024, 1024, (long long)OFF_AO_W},
  {21, 0, 1024, 672, 768, (long long)OFF_MIN},
  {24, 0, 384, 1536, 1536, (long long)OFF_MUQ},
  {25, 0, 256, 2048, 2048, (long long)OFF_MUKV},
  {26, 0, 1024, 1024, 1024, (long long)OFF_MO},
  {27, 0, 1024, 1536, 1536, (long long)OFF_SQKV},
  {29, 0, 1024, 1024, 1024, (long long)OFF_SO},
  {30, 0, 1024, 3072, 3072, (long long)OFF_NQKV},
  {32, 0, 1024, 1024, 1024, (long long)OFF_NO},
};

DI void transpose_tile(const float* __restrict__ src, u16* __restrict__ dst, int K, int N, int k0, int n0, char* smem) {
  float (*T)[65] = (float (*)[65])smem;
  const int tid = ltid();
  const int nl = tid & 63, kl0 = tid >> 6;
  __syncthreads();
  const int n = n0 + nl;
#pragma unroll 4
  for (int j = 0; j < 8; ++j) {
    const int k = kl0 + 8 * j;
    T[k][nl] = (n < N) ? src[(size_t)(k0 + k) * N + n] : 0.f;
  }
  __syncthreads();
  const int kp = tid & 31, nl0 = tid >> 5;
#pragma unroll
  for (int j = 0; j < 4; ++j) {
    const int nn = nl0 + 16 * j;
    *(unsigned*)&dst[(size_t)(n0 + nn) * K + k0 + 2 * kp] = pack2(T[2 * kp][nn], T[2 * kp + 1][nn]);
  }
}

DI void convert_f32_bf16(const float* __restrict__ src, u16* __restrict__ dst, size_t n) {
  const size_t n4 = n >> 2;
  const int tid_ = ltid();
  for (size_t i = (size_t)blockIdx.x * NTHR + tid_; i < n4; i += (size_t)gridDim.x * NTHR) {
    const float4 v = ((const float4*)src)[i];
    uint2 o; o.x = pack2(v.x, v.y); o.y = pack2(v.z, v.w);
    ((uint2*)dst)[i] = o;
  }
}

DI void prepass(const KA& p, char* smem) {
  int total = 0;
  for (int j = 0; j < 18; ++j) total += (int)((TJ[j][2] >> 6) * (TJ[j][4] >> 6));
  for (int t = blockIdx.x; t < total; t += gridDim.x) {
    int j = 0, tt = t;
    for (;;) { const int c = (int)((TJ[j][2] >> 6) * (TJ[j][4] >> 6)); if (tt < c) break; tt -= c; ++j; }
    const int K = (int)TJ[j][2], N = (int)TJ[j][3];
    const int nk = K >> 6;
    const int kt = tt % nk, nt = tt / nk;
    transpose_tile(p.in((int)TJ[j][0]) + TJ[j][1], (u16*)(p.ws() + TJ[j][5]), K, N, kt * 64, nt * 64, smem);
  }
  convert_f32_bf16(p.in(2), (u16*)(p.ws() + OFF_CK), 4096ull * 256);
  convert_f32_bf16(p.in(3), (u16*)(p.ws() + OFF_CV), 4096ull * 256);
  convert_f32_bf16(p.in(4), (u16*)(p.ws() + OFF_CKV) + 12288ull * 256, 4096ull * 256);
  convert_f32_bf16(p.in(5), (u16*)(p.ws() + OFF_KPE) + 12288ull * 32, 4096ull * 32);
  {
    float* tab = (float*)(p.ws() + OFF_ROPE);
    const int tid_ = ltid();
    for (int e = blockIdx.x * NTHR + tid_; e < 3 * 64 * 32; e += gridDim.x * NTHR) {
      const int kind = e / 2048, pos = (e >> 5) & 63, i = e & 31;
      const int quarter = kind == 0 ? 32 : (kind == 1 ? 16 : 8);
      float c = 1.f, s = 0.f;
      if (i < quarter) {
        const float inv = exp2f(-(float)i / (float)quarter * 13.287712379549449f);
        const float ang = (float)pos * inv;
        c = cosf(ang); s = sinf(ang);
      }
      tab[2 * e] = c; tab[2 * e + 1] = s;
    }
  }
  {
    float* scond = (float*)smem;
    float* red = (float*)(smem + 36864);
    float* MOD = (float*)(p.ws() + OFF_MOD);
    const int tid = ltid();
    bool ready = false;
    for (int it = blockIdx.x; it < 768; it += gridDim.x) {
      __syncthreads();
      if (!ready) {
        for (int e = tid; e < 9 * 1024; e += NTHR) {
          const float c = e < 8192 ? p.in(10)[e] : p.in(11)[e - 8192];
          scond[e] = c / (1.f + __expf(-c));
        }
        ready = true;
        __syncthreads();
      }
      const int l = it / 192, n0 = (it % 192) * 32;
      const int col = tid & 31, kg = tid >> 5;
      float acc[9];
#pragma unroll
      for (int c = 0; c < 9; ++c) acc[c] = 0.f;
      const float* wp = p.in(12) + (size_t)l * 1024 * 6144 + n0 + col;
#pragma unroll 8
      for (int i = 0; i < 64; ++i) {
        const int k = kg + 16 * i;
        const float wv = wp[(size_t)k * 6144];
#pragma unroll
        for (int c = 0; c < 9; ++c) acc[c] += scond[c * 1024 + k] * wv;
      }
#pragma unroll
      for (int c = 0; c < 9; ++c) red[(kg * 9 + c) * 32 + col] = acc[c];
      __syncthreads();
      for (int e = tid; e < 288; e += NTHR) {
        const int c = e >> 5, cc = e & 31;
        float s = p.in(13)[l * 6144 + n0 + cc];
#pragma unroll
        for (int g = 0; g < 16; ++g) s += red[(g * 9 + c) * 32 + cc];
        MOD[(size_t)(l * 9 + c) * 6144 + n0 + cc] = s;
      }
    }
  }
}

DI void norm_phase(const KA& p, int l, int mode) {
  const int tid_ = ltid(); const int lane = tid_ & 63, w = tid_ >> 6;
  float* X = p.out();
  const float* MOD = (const float*)(p.ws() + OFF_MOD);
  const float* FF = (const float*)(p.ws() + OFF_QO);
  u16* H = (u16*)(p.ws() + OFF_HAO);
  const float* ng = p.in(14);
  const bool x_in = (l == 0);
  const bool add = !(l == 0 && mode == 0);
  const int la = (mode == 1) ? l : l - 1;
  const int gate_w = (mode == 1) ? 2 : 5;
  const int gadd = (mode == 1) ? 1 : 3;
  const bool do_h = mode != 2;
  const int gh = (mode == 0) ? 0 : 2, scw = (mode == 0) ? 1 : 4, shw = (mode == 0) ? 0 : 3;
  for (int row = blockIdx.x * NWAVE + w; row < NTOK; row += gridDim.x * NWAVE) {
    const int ci = row < NCTX ? 8 : ((row - NCTX) >> 10);
    const float* xs = x_in ? (row < NCTX ? p.in(0) + (size_t)row * 1024 : p.in(1) + (size_t)(row - NCTX) * 1024)
                           : X + (size_t)row * 1024;
    float4 x[4];
#pragma unroll
    for (int j = 0; j < 4; ++j) x[j] = *(const float4*)(xs + 4 * lane + 256 * j);
    if (add) {
      const float* fr = FF + (size_t)row * 1024;
      float4 f[4];
      float ss = 0.f;
#pragma unroll
      for (int j = 0; j < 4; ++j) {
        f[j] = *(const float4*)(fr + 4 * lane + 256 * j);
        ss += f[j].x * f[j].x + f[j].y * f[j].y + f[j].z * f[j].z + f[j].w * f[j].w;
      }
      ss = wave_sum(ss);
      const float rstd = rsqrtf(ss * (1.f / 1024.f) + 1e-6f);
      const float* ga = ng + (la * 4 + gadd) * 1024;
      const float* gt = MOD + (size_t)(la * 9 + ci) * 6144 + gate_w * 1024;
#pragma unroll
      for (int j = 0; j < 4; ++j) {
        const float4 g4 = *(const float4*)(ga + 4 * lane + 256 * j);
        const float4 t4 = *(const float4*)(gt + 4 * lane + 256 * j);
        x[j].x += t4.x * (f[j].x * rstd * g4.x);
        x[j].y += t4.y * (f[j].y * rstd * g4.y);
        x[j].z += t4.z * (f[j].z * rstd * g4.z);
        x[j].w += t4.w * (f[j].w * rstd * g4.w);
        *(float4*)(X + (size_t)row * 1024 + 4 * lane + 256 * j) = x[j];
      }
    }
    if (do_h) {
      float ss = 0.f;
#pragma unroll
      for (int j = 0; j < 4; ++j) ss += x[j].x * x[j].x + x[j].y * x[j].y + x[j].z * x[j].z + x[j].w * x[j].w;
      ss = wave_sum(ss);
      const float rstd = rsqrtf(ss * (1.f / 1024.f) + 1e-6f);
      const float* g = ng + (l * 4 + gh) * 1024;
      const float* sc = MOD + (size_t)(l * 9 + ci) * 6144 + scw * 1024;
      const float* sh = MOD + (size_t)(l * 9 + ci) * 6144 + shw * 1024;
#pragma unroll
      for (int j = 0; j < 4; ++j) {
        const float4 g4 = *(const float4*)(g + 4 * lane + 256 * j);
        const float4 c4 = *(const float4*)(sc + 4 * lane + 256 * j);
        const float4 s4 = *(const float4*)(sh + 4 * lane + 256 * j);
        const float h0 = x[j].x * rstd * g4.x * (1.f + c4.x) + s4.x;
        const float h1 = x[j].y * rstd * g4.y * (1.f + c4.y) + s4.y;
        const float h2 = x[j].z * rstd * g4.z * (1.f + c4.z) + s4.z;
        const float h3 = x[j].w * rstd * g4.w * (1.f + c4.w) + s4.w;
        uint2 o; o.x = pack2(h0, h1); o.y = pack2(h2, h3);
        *(uint2*)(H + (size_t)row * 1024 + 4 * lane + 256 * j) = o;
      }
    }
  }
}

enum { EPI_F32 = 0, EPI_BF16 = 1, EPI_RELU2 = 2, EPI_NAT = 3 };
struct GemmDesc { const u16* A; const u16* Bt; void* dst; int lda, ldb, ldc, M, N, K, epi; };

DI void gemm_tile(const GemmDesc& g, int m0, int n0, float* outp, char* smem) {
  constexpr int LS = 72;
  constexpr int BM = 192, BN = 256;
  u16* As = (u16*)smem;
  u16* Bs = As + 2 * BM * LS;
  const int tid = ltid(), lane = tid & 63, w = tid >> 6, r = lane & 31, h = lane >> 5;
  const int wm = w >> 2, wn = w & 3;
  const int lrow = tid >> 3, lcc = tid & 7;
  const int Mlast = g.M - 1;
  const u16* ag0 = g.A + (size_t)min(m0 + lrow, Mlast) * g.lda + lcc * 8;
  const u16* ag1 = g.A + (size_t)min(m0 + lrow + 64, Mlast) * g.lda + lcc * 8;
  const u16* ag2 = g.A + (size_t)min(m0 + lrow + 128, Mlast) * g.lda + lcc * 8;
  const u16* bg = g.Bt + (size_t)(n0 + lrow) * g.ldb + lcc * 8;
  const size_t sb = (size_t)64 * g.ldb;
  uint4 pa0, pa1, pa2, pb0, pb1, pb2, pb3;
  uint4 qa0, qa1, qa2, qb0, qb1, qb2, qb3;
  f32x16 acc00, acc01, acc10, acc11, acc20, acc21;
#pragma unroll
  for (int i = 0; i < 16; ++i) { acc00[i] = 0.f; acc01[i] = 0.f; acc10[i] = 0.f; acc11[i] = 0.f; acc20[i] = 0.f; acc21[i] = 0.f; }
#define GLOAD(R, off)                                                                                              \
  R##a0 = *(const uint4*)(ag0 + (off)); R##a1 = *(const uint4*)(ag1 + (off)); R##a2 = *(const uint4*)(ag2 + (off)); \
  R##b0 = *(const uint4*)(bg + (off)); R##b1 = *(const uint4*)(bg + sb + (off));                                   \
  R##b2 = *(const uint4*)(bg + 2 * sb + (off)); R##b3 = *(const uint4*)(bg + 3 * sb + (off));
#define LSTORE(R, buf)                                                                  \
  *(uint4*)&As[(buf) * BM * LS + (lrow) * LS + lcc * 8] = R##a0;                         \
  *(uint4*)&As[(buf) * BM * LS + (lrow + 64) * LS + lcc * 8] = R##a1;                    \
  *(uint4*)&As[(buf) * BM * LS + (lrow + 128) * LS + lcc * 8] = R##a2;                   \
  *(uint4*)&Bs[(buf) * BN * LS + (lrow) * LS + lcc * 8] = R##b0;                         \
  *(uint4*)&Bs[(buf) * BN * LS + (lrow + 64) * LS + lcc * 8] = R##b1;                    \
  *(uint4*)&Bs[(buf) * BN * LS + (lrow + 128) * LS + lcc * 8] = R##b2;                   \
  *(uint4*)&Bs[(buf) * BN * LS + (lrow + 192) * LS + lcc * 8] = R##b3;
#define COMPUTE(buf)                                                                    \
  {                                                                                     \
    const u16* Ac = As + (buf) * BM * LS + (96 * wm + r) * LS + 8 * h;                  \
    const u16* Bc = Bs + (buf) * BN * LS + (64 * wn + r) * LS + 8 * h;                  \
    _Pragma("unroll") for (int kk = 0; kk < 4; ++kk) {                                  \
      const bf16x8 a0 = *(const bf16x8*)(Ac + 16 * kk);                                 \
      const bf16x8 a1 = *(const bf16x8*)(Ac + 32 * LS + 16 * kk);                       \
      const bf16x8 a2 = *(const bf16x8*)(Ac + 64 * LS + 16 * kk);                       \
      const bf16x8 b0 = *(const bf16x8*)(Bc + 16 * kk);                                 \
      const bf16x8 b1 = *(const bf16x8*)(Bc + 32 * LS + 16 * kk);                       \
      acc00 = MFMA(a0, b0, acc00);                                                      \
      acc01 = MFMA(a0, b1, acc01);                                                      \
      acc10 = MFMA(a1, b0, acc10);                                                      \
      acc11 = MFMA(a1, b1, acc11);                                                      \
      acc20 = MFMA(a2, b0, acc20);                                                      \
      acc21 = MFMA(a2, b1, acc21);                                                      \
    }                                                                                   \
  }
  const int KT = g.K >> 6;
  GLOAD(p, 0)
  GLOAD(q, 64)
  LSTORE(p, 0)
  __syncthreads();
  for (int kt = 0; kt < KT; kt += 2) {
    if (kt + 2 < KT) { GLOAD(p, (kt + 2) * 64) }
    COMPUTE(0)
    LSTORE(q, 1)
    __syncthreads();
    if (kt + 3 < KT) { GLOAD(q, (kt + 3) * 64) }
    COMPUTE(1)
    if (kt + 2 < KT) { LSTORE(p, 0) }
    __syncthreads();
  }
#undef GLOAD
#undef LSTORE
#undef COMPUTE
  const int epi = g.epi;
#define EPI_LOOP(BODY)                                                                                         \
  _Pragma("unroll") for (int mi = 0; mi < 3; ++mi)                                                             \
  _Pragma("unroll") for (int ni = 0; ni < 2; ++ni) {                                                           \
    const int col = n0 + 64 * wn + 32 * ni + r;                                                                \
    _Pragma("unroll") for (int i = 0; i < 16; ++i) {                                                           \
      const int row = m0 + 96 * wm + 32 * mi + crow(i, h);                                                     \
      const float v = mi == 0 ? (ni == 0 ? acc00[i] : acc01[i]) : (mi == 1 ? (ni == 0 ? acc10[i] : acc11[i]) : (ni == 0 ? acc20[i] : acc21[i])); \
      BODY                                                                                                     \
    }                                                                                                          \
  }
  if (epi == EPI_F32) {
    float* dst = (float*)g.dst;
    EPI_LOOP(dst[(size_t)row * g.ldc + col] = v;)
  } else if (epi == EPI_RELU2) {
    u16* dst = (u16*)g.dst;
    EPI_LOOP(const float t = v > 0.f ? v : 0.f; dst[(size_t)row * g.ldc + col] = f2bf(t * t);)
  } else if (epi == EPI_BF16) {
    u16* dst = (u16*)g.dst;
    EPI_LOOP(if (row <= Mlast) dst[(size_t)row * g.ldc + col] = f2bf(v);)
  } else {
    u16* dst = (u16*)g.dst;
    EPI_LOOP(dst[(size_t)row * g.ldc + col] = f2bf(v);
             if (row < NCTX && col >= 1024) outp[(col < 2048 ? O_L3K - 1024 : O_L3V - 2048) + (size_t)row * 1024 + col] = v;)
  }
#undef EPI_LOOP
}

DI void gemm_phase(const KA& p, const GemmDesc& g0, const GemmDesc& g1, int ng, char* smem) {
  const int nt0 = g0.N >> 8, mt0 = (g0.M + 191) / 192;
  const int CN = (nt0 & 3) == 0 ? 4 : ((nt0 & 1) == 0 ? 2 : 1), CM = 32 / CN;
  if (ng == 1 && gridDim.x == 256 && (mt0 % CM) == 0) {
    const int x = blockIdx.x & 7, s = blockIdx.x >> 3, mi = s / CN, ni = s - mi * CN;
    const int ncn = nt0 / CN, nchunks = (mt0 / CM) * ncn;
    for (int rep = 0; rep < REP_GEMM; ++rep)
    for (int c = x; c < nchunks; c += 8) {
      const int cm = c / ncn, cn = c - cm * ncn;
      gemm_tile(g0, (cm * CM + mi) * 192, (cn * CN + ni) * 256, p.out(), smem);
    }
    return;
  }
  const int t0 = mt0 * nt0;
  const int t1 = ng > 1 ? ((g1.M + 191) / 192) * (g1.N >> 8) : 0;
  for (int rep = 0; rep < REP_GEMM; ++rep)
  for (int t = blockIdx.x; t < t0 + t1; t += gridDim.x) {
    const bool first = t < t0;
    GemmDesc g;
    g.A = first ? g0.A : g1.A; g.Bt = first ? g0.Bt : g1.Bt; g.dst = first ? g0.dst : g1.dst;
    g.lda = first ? g0.lda : g1.lda; g.ldb = first ? g0.ldb : g1.ldb; g.ldc = first ? g0.ldc : g1.ldc;
    g.M = first ? g0.M : g1.M; g.N = first ? g0.N : g1.N; g.K = first ? g0.K : g1.K; g.epi = first ? g0.epi : g1.epi;
    const int tt = first ? t : t - t0;
    const int nt = g.N >> 8;
    gemm_tile(g, (tt / nt) * 192, (tt % nt) * 256, p.out(), smem);
  }
}

DI void pp_attn(const KA& p) {
  const int tid_ = ltid(); const int lane = tid_ & 63, w = tid_ >> 6;
  const float* Z = (const float*)(p.ws() + OFF_UZ);
  u16* QKV = (u16*)(p.ws() + OFF_QO);
  const float* tab = (const float*)(p.ws() + OFF_ROPE);
  const float* qn = p.in(18);
  const float* kn = p.in(19);
  for (int row = blockIdx.x * NWAVE + w; row < NTOK; row += gridDim.x * NWAVE) {
    const bool lat = row >= NCTX;
    const int t = (row - NCTX) & 1023, pr = t >> 6, pc = t & 63;
    const float* z = Z + (size_t)row * 1536;
    u16* o = QKV + (size_t)row * 1536;
    const int i = lane & 31;
    const float c0 = tab[(pr * 32 + i) * 2], s0 = tab[(pr * 32 + i) * 2 + 1];
    const float c1 = tab[(pc * 32 + i) * 2], s1 = tab[(pc * 32 + i) * 2 + 1];
    const float sg = lane < 32 ? -1.f : 1.f;
    for (int hd = 0; hd < 10; ++hd) {
      const float v0 = z[hd * 128 + lane], v1 = z[hd * 128 + 64 + lane];
      const float ss = wave_sum(v0 * v0 + v1 * v1);
      const float rstd = rsqrtf(ss * (1.f / 128.f) + 1e-6f);
      const float* g = hd < 8 ? qn : kn;
      float y0 = v0 * rstd * g[lane], y1 = v1 * rstd * g[64 + lane];
      if (hd >= 8 && !lat) {
        p.out()[O_L0K + (size_t)row * 256 + (hd - 8) * 128 + lane] = y0;
        p.out()[O_L0K + (size_t)row * 256 + (hd - 8) * 128 + 64 + lane] = y1;
      }
      const float p0 = __shfl_xor(y0, 32, 64), p1 = __shfl_xor(y1, 32, 64);
      if (lat) {
        y0 = y0 * c0 + sg * p0 * s0;
        y1 = y1 * c1 + sg * p1 * s1;
      }
      o[hd * 128 + lane] = f2bf(y0);
      o[hd * 128 + 64 + lane] = f2bf(y1);
    }
#pragma unroll
    for (int j = 0; j < 4; ++j) {
      const float v = z[1280 + 64 * j + lane];
      o[1280 + 64 * j + lane] = f2bf(v);
      if (!lat) p.out()[O_L0V + (size_t)row * 256 + 64 * j + lane] = v;
    }
  }
}

DI void pp_swa(const KA& p) {
  const int tid_ = ltid(); const int lane = tid_ & 63, w = tid_ >> 6;
  const float* Z = (const float*)(p.ws() + OFF_UZ);
  u16* QKV = (u16*)(p.ws() + OFF_QO);
  const float* tab = (const float*)(p.ws() + OFF_ROPE) + 1 * 64 * 32 * 2;
  for (int row = blockIdx.x * NWAVE + w; row < NTOK; row += gridDim.x * NWAVE) {
    const bool lat = row >= NCTX;
    const int t = (row - NCTX) & 1023, pr = t >> 6, pc = t & 63;
    const float* z = Z + (size_t)row * 1536;
    u16* o = QKV + (size_t)row * 1536;
    const int i = lane & 15, axis = lane >> 5, half = (lane >> 4) & 1;
    const int pos = axis ? pc : pr;
    const float c = tab[(pos * 32 + i) * 2], s = tab[(pos * 32 + i) * 2 + 1];
    const float sg = half ? 1.f : -1.f;
    for (int hd = 0; hd < 20; ++hd) {
      float v = z[hd * 64 + lane];
      if (hd >= 16 && !lat) p.out()[O_L2K + (size_t)row * 256 + (hd - 16) * 64 + lane] = v;
      const float pv = __shfl_xor(v, 16, 64);
      if (lat) v = v * c + sg * pv * s;
      o[hd * 64 + lane] = f2bf(v);
    }
#pragma unroll
    for (int j = 0; j < 4; ++j) {
      const float v = z[1280 + 64 * j + lane];
      o[1280 + 64 * j + lane] = f2bf(v);
      if (!lat) p.out()[O_L2V + (size_t)row * 256 + 64 * j + lane] = v;
    }
  }
}

DI void pp_mla1(const KA& p) {
  const int tid_ = ltid(); const int lane = tid_ & 63, w = tid_ >> 6;
  const float* Z = (const float*)(p.ws() + OFF_UZ);
  u16* CQ = (u16*)(p.ws() + OFF_CQ);
  u16* CKV = (u16*)(p.ws() + OFF_CKV);
  u16* KPE = (u16*)(p.ws() + OFF_KPE);
  const float* tab = (const float*)(p.ws() + OFF_ROPE) + 2 * 64 * 32 * 2;
  const float* qn = p.in(22);
  const float* kvn = p.in(23);
  for (int row = blockIdx.x * NWAVE + w; row < NTOK; row += gridDim.x * NWAVE) {
    const bool lat = row >= NCTX;
    const int t = (row - NCTX) & 1023, pr = t >> 6, pc = t & 63;
    const float* z = Z + (size_t)row * 768;
    float a[6];
    float ss = 0.f;
#pragma unroll
    for (int j = 0; j < 6; ++j) { a[j] = z[64 * j + lane]; ss += a[j] * a[j]; }
    ss = wave_sum(ss);
    float rstd = rsqrtf(ss * (1.f / 384.f) + 1e-6f);
#pragma unroll
    for (int j = 0; j < 6; ++j) CQ[(size_t)row * 384 + 64 * j + lane] = f2bf(a[j] * rstd * qn[64 * j + lane]);
    ss = 0.f;
#pragma unroll
    for (int j = 0; j < 4; ++j) { a[j] = z[384 + 64 * j + lane]; ss += a[j] * a[j]; }
    ss = wave_sum(ss);
    rstd = rsqrtf(ss * (1.f / 256.f) + 1e-6f);
#pragma unroll
    for (int j = 0; j < 4; ++j) {
      const float y = a[j] * rstd * kvn[64 * j + lane];
      CKV[(size_t)row * 256 + 64 * j + lane] = f2bf(y);
      if (!lat) p.out()[O_L1CKV + (size_t)row * 256 + 64 * j + lane] = y;
    }
    const int e = lane & 31;
    float v = z[640 + e];
    const float pv = __shfl_xor(v, 8, 64);
    if (lat) {
      const int i = e & 7, axis = e >> 4, half = (e >> 3) & 1;
      const int pos = axis ? pc : pr;
      const float c = tab[(pos * 32 + i) * 2], s = tab[(pos * 32 + i) * 2 + 1];
      v = v * c + (half ? pv : -pv) * s;
    }
    if (lane < 32) {
      KPE[(size_t)row * 32 + e] = f2bf(v);
      if (!lat) p.out()[O_L1KPE + (size_t)row * 32 + e] = v;
    }
  }
}

DI void pp_mla2(const KA& p) {
  const int tid_ = ltid(); const int lane = tid_ & 63, w = tid_ >> 6;
  const float* Z = (const float*)(p.ws() + OFF_UZ);
  u16* Q = (u16*)(p.ws() + OFF_QO);
  const float* tab = (const float*)(p.ws() + OFF_ROPE) + 2 * 64 * 32 * 2;
  for (int row = blockIdx.x * NWAVE + w; row < NTOK; row += gridDim.x * NWAVE) {
    const bool lat = row >= NCTX;
    const int t = (row - NCTX) & 1023, pr = t >> 6, pc = t & 63;
    const float* z = Z + (size_t)row * 1536;
    for (int j = 0; j < 24; ++j) {
      const int col = 64 * j + lane;
      float v = z[col];
      const float pv = __shfl_xor(v, 8, 64);
      const int d = col % 96;
      if (lat && d >= 64) {
        const int e = d - 64;
        const int i = e & 7, axis = e >> 4, half = (e >> 3) & 1;
        const int pos = axis ? pc : pr;
        const float c = tab[(pos * 32 + i) * 2], s = tab[(pos * 32 + i) * 2 + 1];
        v = v * c + (half ? pv : -pv) * s;
      }
      Q[(size_t)row * 1536 + col] = f2bf(v);
    }
  }
}

struct Seg { const u16* k1; const u16* k2; const u16* v; int ldk1, ldk2, ldv, n0, n1, mode; };

template <int HDQK, int HDV>
DI void attn_item(const u16* __restrict__ Qp, int ldq, const Seg& sA, const Seg& sB, int nseg, int qpos0,
                  float scale_l2, const float* __restrict__ rpb_h, bool has_sink, float sink_l2,
                  u16* __restrict__ Op, int ldo, char* smem) {
  constexpr int K1W = (HDQK == 96) ? 64 : HDQK;
  constexpr int KS = HDQK + 8, VS = HDV + 8;
  constexpr int KC = HDQK / 8, VC = HDV / 8;
  u16* Ks = (u16*)smem;
  u16* Vs = Ks + 64 * KS;
  float* rp = (float*)(Vs + 64 * VS);
  const int tid = ltid(), lane = tid & 63, w = tid >> 6, r = lane & 31, h = lane >> 5;
  const int q4 = (lane & 15) >> 2, p4 = lane & 3, dblk = (lane >> 4) & 1;

  __syncthreads();
  if (rpb_h) for (int e = tid; e < 465; e += NTHR) rp[e] = rpb_h[e];

  bf16x8 qf[HDQK / 16];
  {
    const u16* qrow = Qp + (size_t)(32 * w + r) * ldq + 8 * h;
#pragma unroll
    for (int kk = 0; kk < HDQK / 16; ++kk) qf[kk] = *(const bf16x8*)(qrow + 16 * kk);
  }
  f32x16 o[HDV / 32];
#pragma unroll
  for (int dt = 0; dt < HDV / 32; ++dt)
#pragma unroll
    for (int i = 0; i < 16; ++i) o[dt][i] = 0.f;
  float m = -1e30f, l = 0.f;
  const int qpos = qpos0 + 32 * w + r;
  const int qr = qpos >> 6, qc = qpos & 63;
  const int r0 = min(max(qr - 4, 0), 8), c0 = min(max(qc - 8, 0), 48);

  constexpr int KI = (64 * KC + NTHR - 1) / NTHR, VI = (64 * VC + NTHR - 1) / NTHR;
  const int TA = (sA.n1 - sA.n0) >> 6;
  const int T = TA + (nseg > 1 ? ((sB.n1 - sB.n0) >> 6) : 0);
  uint4 kreg0 = make_uint4(0, 0, 0, 0), kreg1 = kreg0, vreg0 = kreg0, vreg1 = kreg0;
#define ATT_KADDR(i, p1, p2, l1, l2, nn)                                                               \
  const int kc_##i = tid + NTHR * i; const int krow_##i = kc_##i / KC, kcc_##i = kc_##i - krow_##i * KC; \
  const u16* ksrc_##i = (kcc_##i * 8 < K1W) ? p1 + (size_t)(nn + krow_##i) * l1 + kcc_##i * 8          \
                                            : p2 + (size_t)(nn + krow_##i) * l2 + (kcc_##i * 8 - K1W);
#define ATT_FETCH(t)                                                                                   \
  {                                                                                                    \
    const bool fa = (t) < TA;                                                                          \
    const u16* fk1 = fa ? sA.k1 : sB.k1; const u16* fk2 = fa ? sA.k2 : sB.k2; const u16* fv = fa ? sA.v : sB.v; \
    const int fl1 = fa ? sA.ldk1 : sB.ldk1, fl2 = fa ? sA.ldk2 : sB.ldk2, flv = fa ? sA.ldv : sB.ldv;   \
    const int fn = fa ? sA.n0 + 64 * (t) : sB.n0 + 64 * ((t) - TA);                                    \
    { ATT_KADDR(0, fk1, fk2, fl1, fl2, fn) kreg0 = *(const uint4*)ksrc_0; }                            \
    if (KI > 1) { ATT_KADDR(1, fk1, fk2, fl1, fl2, fn) if (64 * KC % NTHR == 0 || kc_1 < 64 * KC) kreg1 = *(const uint4*)ksrc_1; } \
    { const int c = tid; const int row = c / VC, cc = c - row * VC; vreg0 = *(const uint4*)(fv + (size_t)(fn + row) * flv + cc * 8); } \
    if (VI > 1) { const int c = tid + NTHR; const int row = c / VC, cc = c - row * VC; vreg1 = *(const uint4*)(fv + (size_t)(fn + row) * flv + cc * 8); } \
  }
  ATT_FETCH(0)
  for (int t = 0; t < T; ++t) {
    {
      const bool ca = t < TA;
      const int mode = ca ? sA.mode : sB.mode;
      const int n = ca ? sA.n0 + 64 * t : sB.n0 + 64 * (t - TA);
      __syncthreads();
      { const int c = tid; const int row = c / KC, cc = c - row * KC; *(uint4*)&Ks[row * KS + cc * 8] = kreg0; }
      if (KI > 1) { const int c = tid + NTHR; if (64 * KC % NTHR == 0 || c < 64 * KC) { const int row = c / KC, cc = c - row * KC; *(uint4*)&Ks[row * KS + cc * 8] = kreg1; } }
      { const int c = tid; const int row = c / VC, cc = c - row * VC; *(uint4*)&Vs[row * VS + cc * 8] = vreg0; }
      if (VI > 1) { const int c = tid + NTHR; const int row = c / VC, cc = c - row * VC; *(uint4*)&Vs[row * VS + cc * 8] = vreg1; }
      __syncthreads();
      if (t + 1 < T) ATT_FETCH(t + 1)
      const int qw = qpos0 + 32 * w;
      bool skip = false;
      if (mode == 1) skip = (n > qw + 31 + 128) || (n + 63 < qw - 128);
      else if (mode == 2) { const int r0w = min(max((qw >> 6) - 4, 0), 8); const int kr = n >> 6; skip = (kr < r0w) || (kr >= r0w + 8); }
      if (skip) continue;
      f32x16 st[2];
#pragma unroll
      for (int kt = 0; kt < 2; ++kt) {
#pragma unroll
        for (int i = 0; i < 16; ++i) st[kt][i] = 0.f;
        const u16* kb = Ks + (32 * kt + r) * KS + 8 * h;
#pragma unroll
        for (int kk = 0; kk < HDQK / 16; ++kk) {
          const bf16x8 a = *(const bf16x8*)(kb + 16 * kk);
          st[kt] = MFMA(a, qf[kk], st[kt]);
        }
      }
      float mx = -1e30f;
      if (mode == 0) {
#pragma unroll
        for (int kt = 0; kt < 2; ++kt)
#pragma unroll
          for (int i = 0; i < 16; ++i) { const float v = st[kt][i] * scale_l2; st[kt][i] = v; mx = fmaxf(mx, v); }
      } else if (mode == 1) {
#pragma unroll
        for (int kt = 0; kt < 2; ++kt)
#pragma unroll
          for (int i = 0; i < 16; ++i) {
            const int kpos = n + 32 * kt + crow(i, h);
            const int d = qpos - kpos;
            float v = st[kt][i] * scale_l2;
            if (d > 128 || d < -128) v = -1e30f;
            st[kt][i] = v; mx = fmaxf(mx, v);
          }
      } else {
#pragma unroll
        for (int kt = 0; kt < 2; ++kt)
#pragma unroll
          for (int i = 0; i < 16; ++i) {
            const int kpos = n + 32 * kt + crow(i, h);
            const int kr = kpos >> 6, kc = kpos & 63;
            const bool ok = ((unsigned)(kr - r0) < 8u) && ((unsigned)(kc - c0) < 16u);
            const int idx = ok ? (kr - qr + 7) * 31 + (kc - qc + 15) : 0;
            const float b = rp[idx];
            float v = st[kt][i] * scale_l2 + b * LOG2E;
            if (!ok) v = -1e30f;
            st[kt][i] = v; mx = fmaxf(mx, v);
          }
      }
      mx = fmaxf(mx, __shfl_xor(mx, 32, 64));
      const float mn = fmaxf(m, mx);
      const float alpha = __builtin_amdgcn_exp2f(m - mn);
      m = mn;
      float rs = 0.f;
#pragma unroll
      for (int kt = 0; kt < 2; ++kt)
#pragma unroll
        for (int i = 0; i < 16; ++i) { const float pz = __builtin_amdgcn_exp2f(st[kt][i] - mn); st[kt][i] = pz; rs += pz; }
      rs += __shfl_xor(rs, 32, 64);
      l = l * alpha + rs;
#pragma unroll
      for (int dt = 0; dt < HDV / 32; ++dt)
#pragma unroll
        for (int i = 0; i < 16; ++i) o[dt][i] *= alpha;
#pragma unroll
      for (int kt = 0; kt < 2; ++kt)
#pragma unroll
        for (int s2 = 0; s2 < 2; ++s2) {
          unsigned pk[4];
#pragma unroll
          for (int j = 0; j < 4; ++j) pk[j] = pack2(st[kt][8 * s2 + 2 * j], st[kt][8 * s2 + 2 * j + 1]);
          bf16x8 pb;
          {
            typedef unsigned u32x4 __attribute__((ext_vector_type(4)));
            u32x4 t4 = {pk[0], pk[1], pk[2], pk[3]};
            pb = __builtin_bit_cast(bf16x8, t4);
          }
          const u16* vb = Vs + (32 * kt + 16 * s2 + 4 * h + q4) * VS + 16 * dblk + 4 * p4;
#pragma unroll
          for (int dt = 0; dt < HDV / 32; ++dt) {
            const s16x4 lo = __builtin_amdgcn_ds_read_tr16_b64_v4i16((LDS3 s16x4*)(vb + 32 * dt));
            const s16x4 hi = __builtin_amdgcn_ds_read_tr16_b64_v4i16((LDS3 s16x4*)(vb + 8 * VS + 32 * dt));
            const bf16x8 va = __builtin_shufflevector(lo, hi, 0, 1, 2, 3, 4, 5, 6, 7);
            o[dt] = MFMA(va, pb, o[dt]);
          }
        }
    }
  }
#undef ATT_FETCH
#undef ATT_KADDR
  if (has_sink) l += __builtin_amdgcn_exp2f(sink_l2 - m);
  const float inv = 1.f / l;
  u16* orow = Op + (size_t)(32 * w + r) * ldo + 4 * h;
#pragma unroll
  for (int dt = 0; dt < HDV / 32; ++dt)
#pragma unroll
    for (int g = 0; g < 4; ++g) {
      uint2 v;
      v.x = pack2(o[dt][4 * g] * inv, o[dt][4 * g + 1] * inv);
      v.y = pack2(o[dt][4 * g + 2] * inv, o[dt][4 * g + 3] * inv);
      *(uint2*)(orow + 32 * dt + 8 * g) = v;
    }
}

DI void attn_phase(const KA& p, int kind, char* smem) {
  const int Hq = kind == 0 ? 8 : 16;
  const int nlat = 8 * Hq * 4, nctx = 16 * Hq;
  u16* AO = (u16*)(p.ws() + OFF_HAO);
  const u16* QKV = (const u16*)(p.ws() + OFF_QO);
  for (int rep = 0; rep < REP_ATT; ++rep)
  for (int item = blockIdx.x; item < nlat + nctx; item += gridDim.x) {
    const bool lat = item < nlat;
    int b, hq, qt;
    if (lat) { b = item / (Hq * 4); const int rem = item - b * Hq * 4; hq = rem >> 2; qt = rem & 3; }
    else { const int it = item - nlat; b = it / Hq; hq = it - b * Hq; qt = 0; }
    const int tok0 = lat ? NCTX + b * 1024 : b * 256;
    const int S = lat ? 1024 : 256;
    const int qrow0 = tok0 + qt * 256;
    Seg sc, ss;
    sc.k2 = nullptr; sc.ldk2 = 0; ss.k2 = nullptr; ss.ldk2 = 0;
    sc.n0 = 0; sc.n1 = 512; sc.mode = 0;
    ss.n0 = 0; ss.n1 = S; ss.mode = 0;
    const u16* Qp; int ldq; float sl2; const float* rpb = nullptr; bool has_sink = false; float sink_l2 = 0.f;
    u16* Op;
    if (kind == 0) {
      const int kvh = hq >> 2;
      ss.k1 = QKV + (size_t)tok0 * 1536 + 1024 + kvh * 128; ss.ldk1 = 1536;
      ss.v = QKV + (size_t)tok0 * 1536 + 1280 + kvh * 128; ss.ldv = 1536;
      sc.k1 = (const u16*)(p.ws() + OFF_CK) + (size_t)b * 512 * 256 + kvh * 128; sc.ldk1 = 256;
      sc.v = (const u16*)(p.ws() + OFF_CV) + (size_t)b * 512 * 256 + kvh * 128; sc.ldv = 256;
      sl2 = 0.08838834764831845f * LOG2E;
      Qp = QKV + (size_t)qrow0 * 1536 + hq * 128; ldq = 1536;
      Op = AO + (size_t)qrow0 * 1024 + hq * 128;
    } else if (kind == 1) {
      const u16* KV = (const u16*)(p.ws() + OFF_KV);
      const u16* KPE = (const u16*)(p.ws() + OFF_KPE);
      ss.k1 = KV + (size_t)tok0 * 2048 + hq * 128; ss.ldk1 = 2048;
      ss.k2 = KPE + (size_t)tok0 * 32; ss.ldk2 = 32;
      ss.v = KV + (size_t)tok0 * 2048 + hq * 128 + 64; ss.ldv = 2048;
      const size_t crow0 = 12288 + (size_t)b * 512;
      sc.k1 = KV + crow0 * 2048 + hq * 128; sc.ldk1 = 2048;
      sc.k2 = KPE + crow0 * 32; sc.ldk2 = 32;
      sc.v = KV + crow0 * 2048 + hq * 128 + 64; sc.ldv = 2048;
      sl2 = 0.10206207261596575f * LOG2E;
      Qp = QKV + (size_t)qrow0 * 1536 + hq * 96; ldq = 1536;
      Op = AO + (size_t)qrow0 * 1024 + hq * 64;
    } else if (kind == 2) {
      const int kvh = hq >> 2;
      ss.k1 = QKV + (size_t)tok0 * 1536 + 1024 + kvh * 64; ss.ldk1 = 1536;
      ss.v = QKV + (size_t)tok0 * 1536 + 1280 + kvh * 64; ss.ldv = 1536;
      sc.k1 = (const u16*)(p.ws() + OFF_CK) + (size_t)b * 512 * 256 + kvh * 64; sc.ldk1 = 256;
      sc.v = (const u16*)(p.ws() + OFF_CV) + (size_t)b * 512 * 256 + kvh * 64; sc.ldv = 256;
      sl2 = 0.125f * LOG2E;
      has_sink = true; sink_l2 = p.in(28)[hq] * LOG2E;
      if (lat) { ss.n0 = max(0, qt * 256 - 128); ss.n1 = min(1024, qt * 256 + 384); ss.mode = 1; }
      Qp = QKV + (size_t)qrow0 * 1536 + hq * 64; ldq = 1536;
      Op = AO + (size_t)qrow0 * 1024 + hq * 64;
    } else {
      ss.k1 = QKV + (size_t)tok0 * 3072 + 1024 + hq * 64; ss.ldk1 = 3072;
      ss.v = QKV + (size_t)tok0 * 3072 + 2048 + hq * 64; ss.ldv = 3072;
      sc.k1 = (const u16*)(p.ws() + OFF_C3K) + (size_t)b * 512 * 1024 + hq * 64; sc.ldk1 = 1024;
      sc.v = (const u16*)(p.ws() + OFF_C3V) + (size_t)b * 512 * 1024 + hq * 64; sc.ldv = 1024;
      sl2 = 0.125f * LOG2E;
      if (lat) {
        const int r0a = min(max(4 * qt - 4, 0), 8), r0b = min(max(4 * qt - 1, 0), 8);
        ss.n0 = r0a * 64; ss.n1 = (r0b + 8) * 64; ss.mode = 2;
        rpb = p.in(31) + hq * 465;
      }
      Qp = QKV + (size_t)qrow0 * 3072 + hq * 64; ldq = 3072;
      Op = AO + (size_t)qrow0 * 1024 + hq * 64;
    }
    Seg s0;
    s0.k1 = lat ? sc.k1 : ss.k1; s0.k2 = lat ? sc.k2 : ss.k2; s0.v = lat ? sc.v : ss.v;
    s0.ldk1 = lat ? sc.ldk1 : ss.ldk1; s0.ldk2 = lat ? sc.ldk2 : ss.ldk2; s0.ldv = lat ? sc.ldv : ss.ldv;
    s0.n0 = lat ? sc.n0 : ss.n0; s0.n1 = lat ? sc.n1 : ss.n1; s0.mode = lat ? sc.mode : ss.mode;
    const int nseg = lat ? 2 : 1;
    if (kind == 0) attn_item<128, 128>(Qp, ldq, s0, ss, nseg, qt * 256, sl2, rpb, has_sink, sink_l2, Op, 1024, smem);
    else if (kind == 1) attn_item<96, 64>(Qp, ldq, s0, ss, nseg, qt * 256, sl2, rpb, has_sink, sink_l2, Op, 1024, smem);
    else attn_item<64, 64>(Qp, ldq, s0, ss, nseg, qt * 256, sl2, rpb, has_sink, sink_l2, Op, 1024, smem);
  }
}

__host__ __device__ inline bool phase_exists(int ph) {
  if (ph == 0 || ph == 41) return true;
  const int l = (ph - 1) / 10, s = (ph - 1) % 10;
  if ((s == 3 || s == 4) && l != 1) return false;
  if (s == 2 && l == 3) return false;
  return true;
}

DI void run_phase(const KA& p, int ph, char* smem) {
  if (ph == 0) { prepass(p, smem); return; }
  if (ph == 41) { norm_phase(p, 4, 2); return; }
  const int l = (ph - 1) / 10, s = (ph - 1) % 10;
  char* ws = p.ws();
  GemmDesc g0, g1;
  g0 = GemmDesc{nullptr, nullptr, nullptr, 0, 0, 0, 0, 0, 0, 0};
  g1 = g0;
  int ng = 0;
  switch (s) {
    case 0:
      norm_phase(p, l, 0);
      if (l == 2) {
        convert_f32_bf16(p.in(6), (u16*)(ws + OFF_CK), 4096ull * 256);
        convert_f32_bf16(p.in(7), (u16*)(ws + OFF_CV), 4096ull * 256);
      } else if (l == 3) {
        convert_f32_bf16(p.in(8), (u16*)(ws + OFF_C3K), 4096ull * 1024);
        convert_f32_bf16(p.in(9), (u16*)(ws + OFF_C3V), 4096ull * 1024);
      }
      break;
    case 1: {
      const u16* H = (const u16*)(ws + OFF_HAO);
      if (l == 0) g0 = GemmDesc{H, (const u16*)(ws + OFF_AQKV), ws + OFF_UZ, 1024, 1024, 1536, NTOK, 1536, 1024, EPI_F32};
      else if (l == 1) g0 = GemmDesc{H, (const u16*)(ws + OFF_MIN), ws + OFF_UZ, 1024, 1024, 768, NTOK, 768, 1024, EPI_F32};
      else if (l == 2) g0 = GemmDesc{H, (const u16*)(ws + OFF_SQKV), ws + OFF_UZ, 1024, 1024, 1536, NTOK, 1536, 1024, EPI_F32};
      else g0 = GemmDesc{H, (const u16*)(ws + OFF_NQKV), ws + OFF_QO, 1024, 1024, 3072, NTOK, 3072, 1024, EPI_NAT};
      ng = 1;
    } break;
    case 2:
      if (l == 0) pp_attn(p); else if (l == 1) pp_mla1(p); else if (l == 2) pp_swa(p);
      break;
    case 3:
      g0 = GemmDesc{(const u16*)(ws + OFF_CQ), (const u16*)(ws + OFF_MUQ), ws + OFF_UZ, 384, 384, 1536, NTOK, 1536, 384, EPI_F32};
      g1 = GemmDesc{(const u16*)(ws + OFF_CKV), (const u16*)(ws + OFF_MUKV), ws + OFF_KV, 256, 256, 2048, 16384, 2048, 256, EPI_BF16};
      ng = 2;
      break;
    case 4: pp_mla2(p); break;
    case 5: attn_phase(p, l, smem); break;
    case 6: {
      const size_t wo = l == 0 ? OFF_AO_W : (l == 1 ? OFF_MO : (l == 2 ? OFF_SO : OFF_NO));
      g0 = GemmDesc{(const u16*)(ws + OFF_HAO), (const u16*)(ws + wo), ws + OFF_QO, 1024, 1024, 1024, NTOK, 1024, 1024, EPI_F32};
      ng = 1;
    } break;
    case 7: norm_phase(p, l, 1); break;
    case 8:
      g0 = GemmDesc{(const u16*)(ws + OFF_HAO), (const u16*)(ws + OFF_W1T + (size_t)l * 8388608), ws + OFF_UZ, 1024, 1024, 4096, NTOK, 4096, 1024, EPI_RELU2};
      ng = 1;
      break;
    case 9:
      g0 = GemmDesc{(const u16*)(ws + OFF_UZ), (const u16*)(ws + OFF_W2T + (size_t)l * 8388608), ws + OFF_QO, 4096, 4096, 1024, NTOK, 1024, 4096, EPI_F32};
      ng = 1;
      break;
  }
  if (ng > 0) gemm_phase(p, g0, g1, ng, smem);
}

#define XB_TMO      128
#define XB_XCNT(j)  (256  + 64 * (j))
#define XB_XSUB(j)  (1280 + 64 * (j))
#define XB_XGEN(j)  (2304 + 64 * (j))
#define XB_TOP      3328
#define XB_TOPGEN   3392
#define XCD_BAR_WORDS 3456
#define XB_SPIN_CAP (1u << 18)
#define LAS __attribute__((address_space(3)))

__device__ __forceinline__ unsigned xb_ld(unsigned* p)              { return __hip_atomic_load(p, __ATOMIC_RELAXED, __HIP_MEMORY_SCOPE_AGENT); }
__device__ __forceinline__ unsigned xb_add(unsigned* p, unsigned v) { return __hip_atomic_fetch_add(p, v, __ATOMIC_RELAXED, __HIP_MEMORY_SCOPE_AGENT); }
__device__ __forceinline__ unsigned xb_xcc_id() { return (unsigned)__builtin_amdgcn_s_getreg((3 << 11) | 20) & 0xFu; }
#define XB_SPIN(cond, bar) do { unsigned _sp = 0; while (cond) { __builtin_amdgcn_s_sleep(1); \
    if ((++_sp & 255u) == 0u) { if (xb_ld(&(bar)[XB_TMO])) break; if (_sp > XB_SPIN_CAP) { atomicAdd(&(bar)[XB_TMO], 1u); break; } } } } while (0)

struct XcdBarrier {
    unsigned* bar; unsigned x;
    volatile LAS unsigned* st;
};

__device__ __forceinline__ XcdBarrier xcd_barrier_post(unsigned* bar, volatile LAS unsigned* st) {
    XcdBarrier b; b.bar = bar; b.x = xb_xcc_id(); b.st = st;
    if (threadIdx.x == 0) (void)xb_add(&bar[XB_XCNT(b.x)], 1u);
    return b;
}
__device__ __forceinline__ void xcd_barrier_complete(unsigned* bar, unsigned x, unsigned& nloc, unsigned& nx) {
    const unsigned G = gridDim.x * gridDim.y * gridDim.z;
    unsigned sum, cnt, mine, sp = 0u;
    for (;;) {
        sum = 0u; cnt = 0u; mine = 0u;
#pragma unroll
        for (unsigned j = 0; j < 16; ++j) { const unsigned c = xb_ld(&bar[XB_XCNT(j)]); sum += c; cnt += (c > 0u) ? 1u : 0u; mine = (j == x) ? c : mine; }
        if (sum == G) break;
        __builtin_amdgcn_s_sleep(1);
        if ((++sp & 255u) == 0u) { if (xb_ld(&bar[XB_TMO])) break; if (sp > XB_SPIN_CAP) { atomicAdd(&bar[XB_TMO], 1u); break; } }
    }
    nloc = mine > 0u ? mine : 1u; nx = cnt > 0u ? cnt : 1u;
}

__device__ __forceinline__ void xcd_barrier(const XcdBarrier& b) {
    asm volatile("s_waitcnt vmcnt(0)" ::: "memory");
    __syncthreads();
    if (threadIdx.x == 0) {
        unsigned* bar = b.bar;
        __builtin_amdgcn_s_waitcnt(0);
        unsigned nloc = b.st[0], nx = b.st[1];
        if (nloc == 0u) { xcd_barrier_complete(bar, b.x, nloc, nx); b.st[0] = nloc; b.st[1] = nx; }
        const unsigned old = xb_add(&bar[XB_XSUB(b.x)], 1u);
        const unsigned gen = old / nloc;
        if (old + 1u == (gen + 1u) * nloc) {
            __builtin_amdgcn_fence(__ATOMIC_RELEASE, "agent");
            asm volatile("s_waitcnt vmcnt(0)" ::: "memory");
            const unsigned og = xb_add(&bar[XB_TOP], 1u);
            const unsigned tg = og / nx;
            if (og + 1u == (tg + 1u) * nx) xb_add(&bar[XB_TOPGEN], 1u);
            else XB_SPIN(xb_ld(&bar[XB_TOPGEN]) == tg, bar);
            __builtin_amdgcn_fence(__ATOMIC_ACQUIRE, "agent");
            xb_add(&bar[XB_XGEN(b.x)], 1u);
            asm volatile("s_waitcnt vmcnt(0)" ::: "memory");
        } else {
            XB_SPIN(xb_ld(&bar[XB_XGEN(b.x)]) == gen, bar);
            __builtin_amdgcn_fence(__ATOMIC_ACQUIRE, "agent");
            asm volatile("s_waitcnt vmcnt(0)" ::: "memory");
        }
    }
    __syncthreads();
}

__global__ void __launch_bounds__(512, 2) mega(Params p) {
  __shared__ __attribute__((aligned(16))) char smem[129024];
  __shared__ uint4 xb_words;
  const bool coop = (p.ph1 - p.ph0) > 1;
  XcdBarrier xb;
  if (coop) {
    if (threadIdx.x == 0) xb_words = make_uint4(0u, 0u, 0u, 0u);
    __syncthreads();
    xb = xcd_barrier_post((unsigned*)(p.ws + OFF_BAR), (volatile LAS unsigned*)&xb_words);
  }
  if (p.ph1 < 0) cg::this_grid().sync();
  for (int ph = p.ph0; ph < p.ph1; ++ph) {
    if (!phase_exists(ph)) continue;
    KA q;
    q.ka = (const AS4 char*)__builtin_amdgcn_kernarg_segment_ptr();
    asm volatile("" : "+s"(q.ka));
    run_phase(q, ph, smem);
    if (ph + 1 < p.ph1) xcd_barrier(xb);
  }
}

extern "C" void kernel_launch(void* const* d_in, const int* in_sizes, int n_in, void* d_out, int out_size,
                              void* d_ws, size_t ws_size, hipStream_t stream) {
  if (n_in < 33 || ws_size < WS_NEED) { fprintf(stderr, "bad args: n_in %d ws %zu need %zu\n", n_in, ws_size, (size_t)WS_NEED); return; }
  Params p{};
  for (int i = 0; i < 33; ++i) p.in[i] = (const float*)d_in[i];
  p.out = (float*)d_out;
  p.ws = (char*)d_ws;
#if N_LAUNCH_MODE == 1
  for (int ph = 0; ph < 42; ++ph) {
    if (!phase_exists(ph)) continue;
    p.ph0 = ph; p.ph1 = ph + 1;
    hipLaunchKernelGGL(mega, dim3(256), dim3(NTHR), 0, stream, p);
  }
#else
  static int grid_blocks = 0;
  if (!grid_blocks) {
    int dev = 0, cus = 0, per_cu = 0;
    hipGetDevice(&dev);
    hipDeviceGetAttribute(&cus, hipDeviceAttributeMultiprocessorCount, dev);
    hipOccupancyMaxActiveBlocksPerMultiprocessor(&per_cu, mega, NTHR, 0);
    if (per_cu > 1) per_cu = 1;
    grid_blocks = cus * per_cu;
  }
  p.ph0 = 0; p.ph1 = 42;
  hipMemsetAsync((char*)d_ws + OFF_BAR, 0, XCD_BAR_WORDS * 4, stream);
  void* args[] = {&p};
  hipError_t e = hipLaunchCooperativeKernel((void*)mega, dim3(grid_blocks), dim3(NTHR), args, 0, stream);
  if (e != hipSuccess) fprintf(stderr, "cooperative launch failed: %s (grid %d)\n", hipGetErrorString(e), grid_blocks);
#endif
}
```

```cpp
#include <hip/hip_runtime.h>
#include <hip/hip_cooperative_groups.h>
#include <cstdio>
namespace cg = cooperative_groups;

typedef unsigned short u16;
typedef short bf16x8 __attribute__((ext_vector_type(8)));
typedef short s16x4 __attribute__((ext_vector_type(4)));
typedef float f32x16 __attribute__((ext_vector_type(16)));
typedef float f32x2 __attribute__((ext_vector_type(2)));
typedef __bf16 bfx2 __attribute__((ext_vector_type(2)));
#define DI __device__ __forceinline__
#define MFMA(a, b, c) __builtin_amdgcn_mfma_f32_32x32x16_bf16((a), (b), (c), 0, 0, 0)
#define LDS3 __attribute__((address_space(3)))

#ifndef REP_GEMM
#define REP_GEMM 1
#endif
#ifndef REP_ATT
#define REP_ATT 1
#endif
#ifndef N_LAUNCH_MODE
#define N_LAUNCH_MODE 0
#endif

constexpr int NTOK = 12288, NCTX = 4096;
constexpr int NTHR = 512, NWAVE = 8;
constexpr float LOG2E = 1.4426950408889634f;

constexpr size_t O_L0K = 12582912, O_L0V = 13631488, O_L1CKV = 14680064, O_L1KPE = 15728640,
                 O_L2K = 15859712, O_L2V = 16908288, O_L3K = 17956864, O_L3V = 22151168;

constexpr int P1024 = 1088, P4096 = 4160, P384 = 448, P256 = 320;
constexpr size_t W1T_SZ = 4096ull * P1024 * 2, W2T_SZ = 1024ull * P4096 * 2;
constexpr size_t OFF_W1T = 0;
constexpr size_t OFF_W2T = OFF_W1T + 4 * W1T_SZ;
constexpr size_t OFF_AQKV = OFF_W2T + 4 * W2T_SZ;
constexpr size_t OFF_AO_W = OFF_AQKV + 1536ull * P1024 * 2;
constexpr size_t OFF_MIN = OFF_AO_W + 1024ull * P1024 * 2;
constexpr size_t OFF_MUQ = OFF_MIN + 768ull * P1024 * 2;
constexpr size_t OFF_MUKV = OFF_MUQ + 1536ull * P384 * 2;
constexpr size_t OFF_MO = OFF_MUKV + 2048ull * P256 * 2;
constexpr size_t OFF_SQKV = OFF_MO + 1024ull * P1024 * 2;
constexpr size_t OFF_SO = OFF_SQKV + 1536ull * P1024 * 2;
constexpr size_t OFF_NQKV = OFF_SO + 1024ull * P1024 * 2;
constexpr size_t OFF_NO = OFF_NQKV + 3072ull * P1024 * 2;
constexpr size_t OFF_MOD = OFF_NO + 1024ull * P1024 * 2;
constexpr size_t OFF_ROPE = OFF_MOD + 4ull * 9 * 6144 * 4;
constexpr size_t OFF_HAO = OFF_ROPE + 3ull * 64 * 32 * 2 * 4;
constexpr size_t OFF_UZ = OFF_HAO + 12288ull * P1024 * 2;
constexpr size_t OFF_QO = OFF_UZ + 12288ull * P4096 * 2;
constexpr size_t OFF_CQ = OFF_QO + 12288ull * 3072 * 2;
constexpr size_t OFF_CKV = OFF_CQ + 12288ull * P384 * 2;
constexpr size_t OFF_KPE = OFF_CKV + 16384ull * P256 * 2;
constexpr size_t OFF_KV = OFF_KPE + 16384ull * 32 * 2;
constexpr size_t OFF_CK = OFF_KV;
constexpr size_t OFF_CV = OFF_KV + 2097152;
constexpr size_t OFF_C3K = OFF_KV + 4194304;
constexpr size_t OFF_C3V = OFF_C3K + 8388608;
constexpr size_t OFF_BAR = OFF_KV + 16384ull * 2048 * 2;
constexpr size_t WS_NEED = OFF_BAR + 16384;

struct Params {
  const float* in[33];
  float* out;
  char* ws;
  int ph0, ph1;
};

#define AS4 __attribute__((address_space(4)))
struct KA {
  const AS4 char* ka;
  DI const float* in(int i) const { return *(const float* const AS4*)(ka + 8 * i); }
  DI float* out() const { return *(float* const AS4*)(ka + 264); }
  DI char* ws() const { return *(char* const AS4*)(ka + 272); }
};

DI unsigned pack2(float a, float b) { f32x2 f = {a, b}; bfx2 v = __builtin_convertvector(f, bfx2); return __builtin_bit_cast(unsigned, v); }
DI u16 f2bf(float a) { return (u16)(pack2(a, a) & 0xffffu); }
DI float wave_sum(float v) {
#pragma unroll
  for (int o = 32; o; o >>= 1) v += __shfl_xor(v, o, 64);
  return v;
}
DI int ltid() { int t = threadIdx.x; asm volatile("" : "+v"(t)); return t; }
DI int crow(int i, int h) { return (i & 3) + 8 * (i >> 2) + 4 * h; }

__device__ const long long TJ[18][6] = {
  {15, 0ll * 1024 * 4096, 1024, 4096, 4096, (long long)(OFF_W1T + 0ull * W1T_SZ)},
  {15, 1ll * 1024 * 4096, 1024, 4096, 4096, (long long)(OFF_W1T + 1ull * W1T_SZ)},
  {15, 2ll * 1024 * 4096, 1024, 4096, 4096, (long long)(OFF_W1T + 2ull * W1T_SZ)},
  {15, 3ll * 1024 * 4096, 1024, 4096, 4096, (long long)(OFF_W1T + 3ull * W1T_SZ)},
  {16, 0ll * 1024 * 4096, 4096, 1024, 1024, (long long)(OFF_W2T + 0ull * W2T_SZ)},
  {16, 1ll * 1024 * 4096, 4096, 1024, 1024, (long long)(OFF_W2T + 1ull * W2T_SZ)},
  {16, 2ll * 1024 * 4096, 4096, 1024, 1024, (long long)(OFF_W2T + 2ull * W2T_SZ)},
  {16, 3ll * 1024 * 4096, 4096, 1024, 1024, (long long)(OFF_W2T + 3ull * W2T_SZ)},
  {17, 0, 1024, 1536, 1536, (long long)OFF_AQKV},
  {20, 0, 1024, 1024, 1024, (long long)OFF_AO_W},
  {21, 0, 1024, 672, 768, (long long)OFF_MIN},
  {24, 0, 384, 1536, 1536, (long long)OFF_MUQ},
  {25, 0, 256, 2048, 2048, (long long)OFF_MUKV},
  {26, 0, 1024, 1024, 1024, (long long)OFF_MO},
  {27, 0, 1024, 1536, 1536, (long long)OFF_SQKV},
  {29, 0, 1024, 1024, 1024, (long long)OFF_SO},
  {30, 0, 1024, 3072, 3072, (long long)OFF_NQKV},
  {32, 0, 1024, 1024, 1024, (long long)OFF_NO},
};

DI void transpose_tile(const float* __restrict__ src, u16* __restrict__ dst, int K, int N, int k0, int n0, char* smem) {
  float (*T)[65] = (float (*)[65])smem;
  const int tid = ltid();
  const int nl = tid & 63, kl0 = tid >> 6;
  __syncthreads();
  const int n = n0 + nl;
#pragma unroll 4
  for (int j = 0; j < 8; ++j) {
    const int k = kl0 + 8 * j;
    T[k][nl] = (n < N) ? src[(size_t)(k0 + k) * N + n] : 0.f;
  }
  __syncthreads();
  const int kp = tid & 31, nl0 = tid >> 5;
#pragma unroll
  for (int j = 0; j < 4; ++j) {
    const int nn = nl0 + 16 * j;
    *(unsigned*)&dst[(size_t)(n0 + nn) * (K + 64) + k0 + 2 * kp] = pack2(T[2 * kp][nn], T[2 * kp + 1][nn]);
  }
}

DI void convert_f32_bf16(const float* __restrict__ src, u16* __restrict__ dst, size_t n) {
  const size_t n4 = n >> 2;
  const int tid_ = ltid();
  for (size_t i = (size_t)blockIdx.x * NTHR + tid_; i < n4; i += (size_t)gridDim.x * NTHR) {
    const float4 v = ((const float4*)src)[i];
    uint2 o; o.x = pack2(v.x, v.y); o.y = pack2(v.z, v.w);
    ((uint2*)dst)[i] = o;
  }
}

DI void convert_rows256(const float* __restrict__ src, u16* __restrict__ dst, int rows, int dpitch) {
  const int tid_ = ltid();
  for (int i = blockIdx.x * NTHR + tid_; i < rows * 64; i += gridDim.x * NTHR) {
    const int r = i >> 6, c4 = i & 63;
    const float4 v = ((const float4*)src)[i];
    uint2 o; o.x = pack2(v.x, v.y); o.y = pack2(v.z, v.w);
    *(uint2*)(dst + (size_t)r * dpitch + 4 * c4) = o;
  }
}

DI void prepass(const KA& p, char* smem) {
  int total = 0;
  for (int j = 0; j < 18; ++j) total += (int)((TJ[j][2] >> 6) * (TJ[j][4] >> 6));
  for (int t = blockIdx.x; t < total; t += gridDim.x) {
    int j = 0, tt = t;
    for (;;) { const int c = (int)((TJ[j][2] >> 6) * (TJ[j][4] >> 6)); if (tt < c) break; tt -= c; ++j; }
    const int K = (int)TJ[j][2], N = (int)TJ[j][3];
    const int nk = K >> 6;
    const int kt = tt % nk, nt = tt / nk;
    transpose_tile(p.in((int)TJ[j][0]) + TJ[j][1], (u16*)(p.ws() + TJ[j][5]), K, N, kt * 64, nt * 64, smem);
  }
  convert_f32_bf16(p.in(2), (u16*)(p.ws() + OFF_CK), 4096ull * 256);
  convert_f32_bf16(p.in(3), (u16*)(p.ws() + OFF_CV), 4096ull * 256);
  convert_rows256(p.in(4), (u16*)(p.ws() + OFF_CKV) + 12288ull * P256, 4096, P256);
  convert_f32_bf16(p.in(5), (u16*)(p.ws() + OFF_KPE) + 12288ull * 32, 4096ull * 32);
  {
    float* tab = (float*)(p.ws() + OFF_ROPE);
    const int tid_ = ltid();
    for (int e = blockIdx.x * NTHR + tid_; e < 3 * 64 * 32; e += gridDim.x * NTHR) {
      const int kind = e / 2048, pos = (e >> 5) & 63, i = e & 31;
      const int quarter = kind == 0 ? 32 : (kind == 1 ? 16 : 8);
      float c = 1.f, s = 0.f;
      if (i < quarter) {
        const float inv = exp2f(-(float)i / (float)quarter * 13.287712379549449f);
        const float ang = (float)pos * inv;
        c = cosf(ang); s = sinf(ang);
      }
      tab[2 * e] = c; tab[2 * e + 1] = s;
    }
  }
  {
    float* scond = (float*)smem;
    float* red = (float*)(smem + 36864);
    float* MOD = (float*)(p.ws() + OFF_MOD);
    const int tid = ltid();
    bool ready = false;
    for (int it = blockIdx.x; it < 768; it += gridDim.x) {
      __syncthreads();
      if (!ready) {
        for (int e = tid; e < 9 * 1024; e += NTHR) {
          const float c = e < 8192 ? p.in(10)[e] : p.in(11)[e - 8192];
          scond[e] = c / (1.f + __expf(-c));
        }
        ready = true;
        __syncthreads();
      }
      const int l = it / 192, n0 = (it % 192) * 32;
      const int col = tid & 31, kg = tid >> 5;
      float acc[9];
#pragma unroll
      for (int c = 0; c < 9; ++c) acc[c] = 0.f;
      const float* wp = p.in(12) + (size_t)l * 1024 * 6144 + n0 + col;
#pragma unroll 8
      for (int i = 0; i < 64; ++i) {
        const int k = kg + 16 * i;
        const float wv = wp[(size_t)k * 6144];
#pragma unroll
        for (int c = 0; c < 9; ++c) acc[c] += scond[c * 1024 + k] * wv;
      }
#pragma unroll
      for (int c = 0; c < 9; ++c) red[(kg * 9 + c) * 32 + col] = acc[c];
      __syncthreads();
      for (int e = tid; e < 288; e += NTHR) {
        const int c = e >> 5, cc = e & 31;
        float s = p.in(13)[l * 6144 + n0 + cc];
#pragma unroll
        for (int g = 0; g < 16; ++g) s += red[(g * 9 + c) * 32 + cc];
        MOD[(size_t)(l * 9 + c) * 6144 + n0 + cc] = s;
      }
    }
  }
}

DI void norm_phase(const KA& p, int l, int mode) {
  const int tid_ = ltid(); const int lane = tid_ & 63, w = tid_ >> 6;
  float* X = p.out();
  const float* MOD = (const float*)(p.ws() + OFF_MOD);
  const float* FF = (const float*)(p.ws() + OFF_QO);
  u16* H = (u16*)(p.ws() + OFF_HAO);
  const float* ng = p.in(14);
  const bool x_in = (l == 0);
  const bool add = !(l == 0 && mode == 0);
  const int la = (mode == 1) ? l : l - 1;
  const int gate_w = (mode == 1) ? 2 : 5;
  const int gadd = (mode == 1) ? 1 : 3;
  const bool do_h = mode != 2;
  const int gh = (mode == 0) ? 0 : 2, scw = (mode == 0) ? 1 : 4, shw = (mode == 0) ? 0 : 3;
  for (int row = blockIdx.x * NWAVE + w; row < NTOK; row += gridDim.x * NWAVE) {
    const int ci = row < NCTX ? 8 : ((row - NCTX) >> 10);
    const float* xs = x_in ? (row < NCTX ? p.in(0) + (size_t)row * 1024 : p.in(1) + (size_t)(row - NCTX) * 1024)
                           : X + (size_t)row * 1024;
    float4 x[4];
#pragma unroll
    for (int j = 0; j < 4; ++j) x[j] = *(const float4*)(xs + 4 * lane + 256 * j);
    if (add) {
      const float* fr = FF + (size_t)row * 1024;
      float4 f[4];
      float ss = 0.f;
#pragma unroll
      for (int j = 0; j < 4; ++j) {
        f[j] = *(const float4*)(fr + 4 * lane + 256 * j);
        ss += f[j].x * f[j].x + f[j].y * f[j].y + f[j].z * f[j].z + f[j].w * f[j].w;
      }
      ss = wave_sum(ss);
      const float rstd = rsqrtf(ss * (1.f / 1024.f) + 1e-6f);
      const float* ga = ng + (la * 4 + gadd) * 1024;
      const float* gt = MOD + (size_t)(la * 9 + ci) * 6144 + gate_w * 1024;
#pragma unroll
      for (int j = 0; j < 4; ++j) {
        const float4 g4 = *(const float4*)(ga + 4 * lane + 256 * j);
        const float4 t4 = *(const float4*)(gt + 4 * lane + 256 * j);
        x[j].x += t4.x * (f[j].x * rstd * g4.x);
        x[j].y += t4.y * (f[j].y * rstd * g4.y);
        x[j].z += t4.z * (f[j].z * rstd * g4.z);
        x[j].w += t4.w * (f[j].w * rstd * g4.w);
        *(float4*)(X + (size_t)row * 1024 + 4 * lane + 256 * j) = x[j];
      }
    }
    if (do_h) {
      float ss = 0.f;
#pragma unroll
      for (int j = 0; j < 4; ++j) ss += x[j].x * x[j].x + x[j].y * x[j].y + x[j].z * x[j].z + x[j].w * x[j].w;
      ss = wave_sum(ss);
      const float rstd = rsqrtf(ss * (1.f / 1024.f) + 1e-6f);
      const float* g = ng + (l * 4 + gh) * 1024;
      const float* sc = MOD + (size_t)(l * 9 + ci) * 6144 + scw * 1024;
      const float* sh = MOD + (size_t)(l * 9 + ci) * 6144 + shw * 1024;
#pragma unroll
      for (int j = 0; j < 4; ++j) {
        const float4 g4 = *(const float4*)(g + 4 * lane + 256 * j);
        const float4 c4 = *(const float4*)(sc + 4 * lane + 256 * j);
        const float4 s4 = *(const float4*)(sh + 4 * lane + 256 * j);
        const float h0 = x[j].x * rstd * g4.x * (1.f + c4.x) + s4.x;
        const float h1 = x[j].y * rstd * g4.y * (1.f + c4.y) + s4.y;
        const float h2 = x[j].z * rstd * g4.z * (1.f + c4.z) + s4.z;
        const float h3 = x[j].w * rstd * g4.w * (1.f + c4.w) + s4.w;
        uint2 o; o.x = pack2(h0, h1); o.y = pack2(h2, h3);
        *(uint2*)(H + (size_t)row * P1024 + 4 * lane + 256 * j) = o;
      }
    }
  }
}

enum { EPI_F32 = 0, EPI_BF16 = 1, EPI_RELU2 = 2, EPI_NAT = 3 };
struct GemmDesc { const u16* A; const u16* Bt; void* dst; int lda, ldb, ldc, M, N, K, epi; };

DI void gemm_tile(const GemmDesc& g, int m0, int n0, float* outp, char* smem) {
  constexpr int LS = 72;
  constexpr int BM = 192, BN = 256;
  u16* As = (u16*)smem;
  u16* Bs = As + 2 * BM * LS;
  const int tid = ltid(), lane = tid & 63, w = tid >> 6, r = lane & 31, h = lane >> 5;
  const int wm = w >> 2, wn = w & 3;
  const int lrow = tid >> 3, lcc = tid & 7;
  const int Mlast = g.M - 1;
  const char* Ab = (const char*)g.A;
  const char* Bb = (const char*)g.Bt;
  const unsigned ao0 = (unsigned)(min(m0 + lrow, Mlast) * g.lda + lcc * 8) * 2u;
  const unsigned ao1 = (unsigned)(min(m0 + lrow + 64, Mlast) * g.lda + lcc * 8) * 2u;
  const unsigned ao2 = (unsigned)(min(m0 + lrow + 128, Mlast) * g.lda + lcc * 8) * 2u;
  const unsigned bo0 = (unsigned)((n0 + lrow) * g.ldb + lcc * 8) * 2u;
  const unsigned bst = (unsigned)(64 * g.ldb) * 2u;
  uint4 pa0, pa1, pa2, pb0, pb1, pb2, pb3;
  f32x16 acc00, acc01, acc10, acc11, acc20, acc21;
#pragma unroll
  for (int i = 0; i < 16; ++i) { acc00[i] = 0.f; acc01[i] = 0.f; acc10[i] = 0.f; acc11[i] = 0.f; acc20[i] = 0.f; acc21[i] = 0.f; }
#define GLOAD(R, kt_)                                                                                  \
  {                                                                                                    \
    const char* ak = Ab + (size_t)(kt_) * 128; const char* bk = Bb + (size_t)(kt_) * 128;              \
    R##a0 = *(const uint4*)(ak + ao0); R##a1 = *(const uint4*)(ak + ao1); R##a2 = *(const uint4*)(ak + ao2); \
    R##b0 = *(const uint4*)(bk + bo0); R##b1 = *(const uint4*)(bk + bo0 + bst);                        \
    R##b2 = *(const uint4*)(bk + bo0 + 2 * bst); R##b3 = *(const uint4*)(bk + bo0 + 3 * bst);          \
  }
#define LSTORE(R, buf)                                                                  \
  *(uint4*)&As[(buf) * BM * LS + (lrow) * LS + lcc * 8] = R##a0;                         \
  *(uint4*)&As[(buf) * BM * LS + (lrow + 64) * LS + lcc * 8] = R##a1;                    \
  *(uint4*)&As[(buf) * BM * LS + (lrow + 128) * LS + lcc * 8] = R##a2;                   \
  *(uint4*)&Bs[(buf) * BN * LS + (lrow) * LS + lcc * 8] = R##b0;                         \
  *(uint4*)&Bs[(buf) * BN * LS + (lrow + 64) * LS + lcc * 8] = R##b1;                    \
  *(uint4*)&Bs[(buf) * BN * LS + (lrow + 128) * LS + lcc * 8] = R##b2;                   \
  *(uint4*)&Bs[(buf) * BN * LS + (lrow + 192) * LS + lcc * 8] = R##b3;
#define FRAGS(X, kk)                                                                    \
  X##a0 = *(const bf16x8*)(Ac + 16 * (kk));                                             \
  X##a1 = *(const bf16x8*)(Ac + 32 * LS + 16 * (kk));                                   \
  X##a2 = *(const bf16x8*)(Ac + 64 * LS + 16 * (kk));                                   \
  X##b0 = *(const bf16x8*)(Bc + 16 * (kk));                                             \
  X##b1 = *(const bf16x8*)(Bc + 32 * LS + 16 * (kk));
#define MMAS(X)                                                                         \
  acc00 = MFMA(X##a0, X##b0, acc00); acc01 = MFMA(X##a0, X##b1, acc01);                 \
  acc10 = MFMA(X##a1, X##b0, acc10); acc11 = MFMA(X##a1, X##b1, acc11);                 \
  acc20 = MFMA(X##a2, X##b0, acc20); acc21 = MFMA(X##a2, X##b1, acc21);
#define COMPUTE(buf)                                                                    \
  {                                                                                     \
    const u16* Ac = As + (buf) * BM * LS + (96 * wm + r) * LS + 8 * h;                  \
    const u16* Bc = Bs + (buf) * BN * LS + (64 * wn + r) * LS + 8 * h;                  \
    bf16x8 xa0, xa1, xa2, xb0, xb1, ya0, ya1, ya2, yb0, yb1;                            \
    FRAGS(x, 0) __builtin_amdgcn_sched_barrier(0);                                      \
    FRAGS(y, 1) __builtin_amdgcn_sched_barrier(0); MMAS(x) __builtin_amdgcn_sched_barrier(0); \
    FRAGS(x, 2) __builtin_amdgcn_sched_barrier(0); MMAS(y) __builtin_amdgcn_sched_barrier(0); \
    FRAGS(y, 3) __builtin_amdgcn_sched_barrier(0); MMAS(x) __builtin_amdgcn_sched_barrier(0); \
    MMAS(y)                                                                             \
  }
  const int KT = g.K >> 6;
  GLOAD(p, 0)
  LSTORE(p, 0)
  __syncthreads();
  for (int kt = 0; kt < KT; kt += 2) {
    GLOAD(p, min(kt + 1, KT - 1))
    __builtin_amdgcn_sched_barrier(0);
    COMPUTE(0)
    LSTORE(p, 1)
    __syncthreads();
    GLOAD(p, min(kt + 2, KT - 1))
    __builtin_amdgcn_sched_barrier(0);
    COMPUTE(1)
    LSTORE(p, 0)
    __syncthreads();
  }
#undef GLOAD
#undef LSTORE
#undef FRAGS
#undef MMAS
#undef COMPUTE
  const int epi = g.epi;
#define EPI_LOOP(BODY)                                                                                         \
  _Pragma("unroll") for (int mi = 0; mi < 3; ++mi)                                                             \
  _Pragma("unroll") for (int ni = 0; ni < 2; ++ni) {                                                           \
    const int col = n0 + 64 * wn + 32 * ni + r;                                                                \
    _Pragma("unroll") for (int i = 0; i < 16; ++i) {                                                           \
      const int row = m0 + 96 * wm + 32 * mi + crow(i, h);                                                     \
      const float v = mi == 0 ? (ni == 0 ? acc00[i] : acc01[i]) : (mi == 1 ? (ni == 0 ? acc10[i] : acc11[i]) : (ni == 0 ? acc20[i] : acc21[i])); \
      BODY                                                                                                     \
    }                                                                                                          \
  }
  if (epi == EPI_F32) {
    float* dst = (float*)g.dst;
    EPI_LOOP(dst[(size_t)row * g.ldc + col] = v;)
  } else if (epi == EPI_RELU2) {
    u16* dst = (u16*)g.dst;
    EPI_LOOP(const float t = v > 0.f ? v : 0.f; dst[(size_t)row * g.ldc + col] = f2bf(t * t);)
  } else if (epi == EPI_BF16) {
    u16* dst = (u16*)g.dst;
    EPI_LOOP(if (row <= Mlast) dst[(size_t)row * g.ldc + col] = f2bf(v);)
  } else {
    u16* dst = (u16*)g.dst;
    EPI_LOOP(dst[(size_t)row * g.ldc + col] = f2bf(v);
             if (row < NCTX && col >= 1024) outp[(col < 2048 ? O_L3K - 1024 : O_L3V - 2048) + (size_t)row * 1024 + col] = v;)
  }
#undef EPI_LOOP
}

DI void gemm_phase(const KA& p, const GemmDesc& g0, const GemmDesc& g1, int ng, char* smem) {
  const int nt0 = g0.N >> 8, mt0 = (g0.M + 191) / 192;
  const int CN = (nt0 & 3) == 0 ? 4 : ((nt0 & 1) == 0 ? 2 : 1), CM = 32 / CN;
  if (ng == 1 && gridDim.x == 256 && (mt0 % CM) == 0) {
    const int x = blockIdx.x & 7, s = blockIdx.x >> 3, mi = s / CN, ni = s - mi * CN;
    const int ncn = nt0 / CN, nchunks = (mt0 / CM) * ncn;
    for (int rep = 0; rep < REP_GEMM; ++rep)
    for (int c = x; c < nchunks; c += 8) {
      const int cm = c / ncn, cn = c - cm * ncn;
      gemm_tile(g0, (cm * CM + mi) * 192, (cn * CN + ni) * 256, p.out(), smem);
    }
    return;
  }
  const int t0 = mt0 * nt0;
  const int t1 = ng > 1 ? ((g1.M + 191) / 192) * (g1.N >> 8) : 0;
  for (int rep = 0; rep < REP_GEMM; ++rep)
  for (int t = blockIdx.x; t < t0 + t1; t += gridDim.x) {
    const bool first = t < t0;
    GemmDesc g;
    g.A = first ? g0.A : g1.A; g.Bt = first ? g0.Bt : g1.Bt; g.dst = first ? g0.dst : g1.dst;
    g.lda = first ? g0.lda : g1.lda; g.ldb = first ? g0.ldb : g1.ldb; g.ldc = first ? g0.ldc : g1.ldc;
    g.M = first ? g0.M : g1.M; g.N = first ? g0.N : g1.N; g.K = first ? g0.K : g1.K; g.epi = first ? g0.epi : g1.epi;
    const int tt = first ? t : t - t0;
    const int nt = g.N >> 8;
    gemm_tile(g, (tt / nt) * 192, (tt % nt) * 256, p.out(), smem);
  }
}

DI void pp_attn(const KA& p) {
  const int tid_ = ltid(); const int lane = tid_ & 63, w = tid_ >> 6;
  const float* Z = (const float*)(p.ws() + OFF_UZ);
  u16* QKV = (u16*)(p.ws() + OFF_QO);
  const float* tab = (const float*)(p.ws() + OFF_ROPE);
  const float* qn = p.in(18);
  const float* kn = p.in(19);
  for (int row = blockIdx.x * NWAVE + w; row < NTOK; row += gridDim.x * NWAVE) {
    const bool lat = row >= NCTX;
    const int t = (row - NCTX) & 1023, pr = t >> 6, pc = t & 63;
    const float* z = Z + (size_t)row * 1536;
    u16* o = QKV + (size_t)row * 1536;
    const int i = lane & 31;
    const float c0 = tab[(pr * 32 + i) * 2], s0 = tab[(pr * 32 + i) * 2 + 1];
    const float c1 = tab[(pc * 32 + i) * 2], s1 = tab[(pc * 32 + i) * 2 + 1];
    const float sg = lane < 32 ? -1.f : 1.f;
    for (int hd = 0; hd < 10; ++hd) {
      const float v0 = z[hd * 128 + lane], v1 = z[hd * 128 + 64 + lane];
      const float ss = wave_sum(v0 * v0 + v1 * v1);
      const float rstd = rsqrtf(ss * (1.f / 128.f) + 1e-6f);
      const float* g = hd < 8 ? qn : kn;
      float y0 = v0 * rstd * g[lane], y1 = v1 * rstd * g[64 + lane];
      if (hd >= 8 && !lat) {
        p.out()[O_L0K + (size_t)row * 256 + (hd - 8) * 128 + lane] = y0;
        p.out()[O_L0K + (size_t)row * 256 + (hd - 8) * 128 + 64 + lane] = y1;
      }
      const float p0 = __shfl_xor(y0, 32, 64), p1 = __shfl_xor(y1, 32, 64);
      if (lat) {
        y0 = y0 * c0 + sg * p0 * s0;
        y1 = y1 * c1 + sg * p1 * s1;
      }
      o[hd * 128 + lane] = f2bf(y0);
      o[hd * 128 + 64 + lane] = f2bf(y1);
    }
#pragma unroll
    for (int j = 0; j < 4; ++j) {
      const float v = z[1280 + 64 * j + lane];
      o[1280 + 64 * j + lane] = f2bf(v);
      if (!lat) p.out()[O_L0V + (size_t)row * 256 + 64 * j + lane] = v;
    }
  }
}

DI void pp_swa(const KA& p) {
  const int tid_ = ltid(); const int lane = tid_ & 63, w = tid_ >> 6;
  const float* Z = (const float*)(p.ws() + OFF_UZ);
  u16* QKV = (u16*)(p.ws() + OFF_QO);
  const float* tab = (const float*)(p.ws() + OFF_ROPE) + 1 * 64 * 32 * 2;
  for (int row = blockIdx.x * NWAVE + w; row < NTOK; row += gridDim.x * NWAVE) {
    const bool lat = row >= NCTX;
    const int t = (row - NCTX) & 1023, pr = t >> 6, pc = t & 63;
    const float* z = Z + (size_t)row * 1536;
    u16* o = QKV + (size_t)row * 1536;
    const int i = lane & 15, axis = lane >> 5, half = (lane >> 4) & 1;
    const int pos = axis ? pc : pr;
    const float c = tab[(pos * 32 + i) * 2], s = tab[(pos * 32 + i) * 2 + 1];
    const float sg = half ? 1.f : -1.f;
    for (int hd = 0; hd < 20; ++hd) {
      float v = z[hd * 64 + lane];
      if (hd >= 16 && !lat) p.out()[O_L2K + (size_t)row * 256 + (hd - 16) * 64 + lane] = v;
      const float pv = __shfl_xor(v, 16, 64);
      if (lat) v = v * c + sg * pv * s;
      o[hd * 64 + lane] = f2bf(v);
    }
#pragma unroll
    for (int j = 0; j < 4; ++j) {
      const float v = z[1280 + 64 * j + lane];
      o[1280 + 64 * j + lane] = f2bf(v);
      if (!lat) p.out()[O_L2V + (size_t)row * 256 + 64 * j + lane] = v;
    }
  }
}

DI void pp_mla1(const KA& p) {
  const int tid_ = ltid(); const int lane = tid_ & 63, w = tid_ >> 6;
  const float* Z = (const float*)(p.ws() + OFF_UZ);
  u16* CQ = (u16*)(p.ws() + OFF_CQ);
  u16* CKV = (u16*)(p.ws() + OFF_CKV);
  u16* KPE = (u16*)(p.ws() + OFF_KPE);
  const float* tab = (const float*)(p.ws() + OFF_ROPE) + 2 * 64 * 32 * 2;
  const float* qn = p.in(22);
  const float* kvn = p.in(23);
  for (int row = blockIdx.x * NWAVE + w; row < NTOK; row += gridDim.x * NWAVE) {
    const bool lat = row >= NCTX;
    const int t = (row - NCTX) & 1023, pr = t >> 6, pc = t & 63;
    const float* z = Z + (size_t)row * 768;
    float a[6];
    float ss = 0.f;
#pragma unroll
    for (int j = 0; j < 6; ++j) { a[j] = z[64 * j + lane]; ss += a[j] * a[j]; }
    ss = wave_sum(ss);
    float rstd = rsqrtf(ss * (1.f / 384.f) + 1e-6f);
#pragma unroll
    for (int j = 0; j < 6; ++j) CQ[(size_t)row * P384 + 64 * j + lane] = f2bf(a[j] * rstd * qn[64 * j + lane]);
    ss = 0.f;
#pragma unroll
    for (int j = 0; j < 4; ++j) { a[j] = z[384 + 64 * j + lane]; ss += a[j] * a[j]; }
    ss = wave_sum(ss);
    rstd = rsqrtf(ss * (1.f / 256.f) + 1e-6f);
#pragma unroll
    for (int j = 0; j < 4; ++j) {
      const float y = a[j] * rstd * kvn[64 * j + lane];
      CKV[(size_t)row * P256 + 64 * j + lane] = f2bf(y);
      if (!lat) p.out()[O_L1CKV + (size_t)row * 256 + 64 * j + lane] = y;
    }
    const int e = lane & 31;
    float v = z[640 + e];
    const float pv = __shfl_xor(v, 8, 64);
    if (lat) {
      const int i = e & 7, axis = e >> 4, half = (e >> 3) & 1;
      const int pos = axis ? pc : pr;
      const float c = tab[(pos * 32 + i) * 2], s = tab[(pos * 32 + i) * 2 + 1];
      v = v * c + (half ? pv : -pv) * s;
    }
    if (lane < 32) {
      KPE[(size_t)row * 32 + e] = f2bf(v);
      if (!lat) p.out()[O_L1KPE + (size_t)row * 32 + e] = v;
    }
  }
}

DI void pp_mla2(const KA& p) {
  const int tid_ = ltid(); const int lane = tid_ & 63, w = tid_ >> 6;
  const float* Z = (const float*)(p.ws() + OFF_UZ);
  u16* Q = (u16*)(p.ws() + OFF_QO);
  const float* tab = (const float*)(p.ws() + OFF_ROPE) + 2 * 64 * 32 * 2;
  for (int row = blockIdx.x * NWAVE + w; row < NTOK; row += gridDim.x * NWAVE) {
    const bool lat = row >= NCTX;
    const int t = (row - NCTX) & 1023, pr = t >> 6, pc = t & 63;
    const float* z = Z + (size_t)row * 1536;
    for (int j = 0; j < 24; ++j) {
      const int col = 64 * j + lane;
      float v = z[col];
      const float pv = __shfl_xor(v, 8, 64);
      const int d = col % 96;
      if (lat && d >= 64) {
        const int e = d - 64;
        const int i = e & 7, axis = e >> 4, half = (e >> 3) & 1;
        const int pos = axis ? pc : pr;
        const float c = tab[(pos * 32 + i) * 2], s = tab[(pos * 32 + i) * 2 + 1];
        v = v * c + (half ? pv : -pv) * s;
      }
      Q[(size_t)row * 1536 + col] = f2bf(v);
    }
  }
}

struct Seg { const u16* k1; const u16* k2; const u16* v; int ldk1, ldk2, ldv, n0, n1, mode; };

template <int HDQK, int HDV>
DI void attn_item(const u16* __restrict__ Qp, int ldq, const Seg& sA, const Seg& sB, int nseg, int qpos0,
                  float scale_l2, const float* __restrict__ rpb_h, bool has_sink, float sink_l2,
                  u16* __restrict__ Op, int ldo, char* smem) {
  constexpr int K1W = (HDQK == 96) ? 64 : HDQK;
  constexpr int KS = HDQK + 8, VS = HDV + 8;
  constexpr int KC = HDQK / 8, VC = HDV / 8;
  u16* Ks = (u16*)smem;
  u16* Vs = Ks + 64 * KS;
  float* rp = (float*)(Vs + 64 * VS);
  const int tid = ltid(), lane = tid & 63, w = tid >> 6, r = lane & 31, h = lane >> 5;
  const int q4 = (lane & 15) >> 2, p4 = lane & 3, dblk = (lane >> 4) & 1;

  __syncthreads();
  if (rpb_h) for (int e = tid; e < 465; e += NTHR) rp[e] = rpb_h[e];

  bf16x8 qf[HDQK / 16];
  {
    const u16* qrow = Qp + (size_t)(32 * w + r) * ldq + 8 * h;
#pragma unroll
    for (int kk = 0; kk < HDQK / 16; ++kk) qf[kk] = *(const bf16x8*)(qrow + 16 * kk);
  }
  f32x16 o[HDV / 32];
#pragma unroll
  for (int dt = 0; dt < HDV / 32; ++dt)
#pragma unroll
    for (int i = 0; i < 16; ++i) o[dt][i] = 0.f;
  float m = -1e30f, l = 0.f;
  const int qpos = qpos0 + 32 * w + r;
  const int qr = qpos >> 6, qc = qpos & 63;
  const int r0 = min(max(qr - 4, 0), 8), c0 = min(max(qc - 8, 0), 48);

  constexpr int KI = (64 * KC + NTHR - 1) / NTHR, VI = (64 * VC + NTHR - 1) / NTHR;
  const int TA = (sA.n1 - sA.n0) >> 6;
  const int T = TA + (nseg > 1 ? ((sB.n1 - sB.n0) >> 6) : 0);
  uint4 kreg0 = make_uint4(0, 0, 0, 0), kreg1 = kreg0, vreg0 = kreg0, vreg1 = kreg0;
#define ATT_KADDR(i, p1, p2, l1, l2, nn)                                                               \
  const int kc_##i = tid + NTHR * i; const int krow_##i = kc_##i / KC, kcc_##i = kc_##i - krow_##i * KC; \
  const u16* ksrc_##i = (kcc_##i * 8 < K1W) ? p1 + (size_t)(nn + krow_##i) * l1 + kcc_##i * 8          \
                                            : p2 + (size_t)(nn + krow_##i) * l2 + (kcc_##i * 8 - K1W);
#define ATT_FETCH(t)                                                                                   \
  {                                                                                                    \
    const bool fa = (t) < TA;                                                                          \
    const u16* fk1 = fa ? sA.k1 : sB.k1; const u16* fk2 = fa ? sA.k2 : sB.k2; const u16* fv = fa ? sA.v : sB.v; \
    const int fl1 = fa ? sA.ldk1 : sB.ldk1, fl2 = fa ? sA.ldk2 : sB.ldk2, flv = fa ? sA.ldv : sB.ldv;   \
    const int fn = fa ? sA.n0 + 64 * (t) : sB.n0 + 64 * ((t) - TA);                                    \
    { ATT_KADDR(0, fk1, fk2, fl1, fl2, fn) kreg0 = *(const uint4*)ksrc_0; }                            \
    if (KI > 1) { ATT_KADDR(1, fk1, fk2, fl1, fl2, fn) if (64 * KC % NTHR == 0 || kc_1 < 64 * KC) kreg1 = *(const uint4*)ksrc_1; } \
    { const int c = tid; const int row = c / VC, cc = c - row * VC; vreg0 = *(const uint4*)(fv + (size_t)(fn + row) * flv + cc * 8); } \
    if (VI > 1) { const int c = tid + NTHR; const int row = c / VC, cc = c - row * VC; vreg1 = *(const uint4*)(fv + (size_t)(fn + row) * flv + cc * 8); } \
  }
  ATT_FETCH(0)
  for (int t = 0; t < T; ++t) {
    {
      const bool ca = t < TA;
      const int mode = ca ? sA.mode : sB.mode;
      const int n = ca ? sA.n0 + 64 * t : sB.n0 + 64 * (t - TA);
      __syncthreads();
      { const int c = tid; const int row = c / KC, cc = c - row * KC; *(uint4*)&Ks[row * KS + cc * 8] = kreg0; }
      if (KI > 1) { const int c = tid + NTHR; if (64 * KC % NTHR == 0 || c < 64 * KC) { const int row = c / KC, cc = c - row * KC; *(uint4*)&Ks[row * KS + cc * 8] = kreg1; } }
      { const int c = tid; const int row = c / VC, cc = c - row * VC; *(uint4*)&Vs[row * VS + cc * 8] = vreg0; }
      if (VI > 1) { const int c = tid + NTHR; const int row = c / VC, cc = c - row * VC; *(uint4*)&Vs[row * VS + cc * 8] = vreg1; }
      __syncthreads();
      if (t + 1 < T) ATT_FETCH(t + 1)
      const int qw = qpos0 + 32 * w;
      bool skip = false;
      if (mode == 1) skip = (n > qw + 31 + 128) || (n + 63 < qw - 128);
      else if (mode == 2) { const int r0w = min(max((qw >> 6) - 4, 0), 8); const int kr = n >> 6; skip = (kr < r0w) || (kr >= r0w + 8); }
      if (skip) continue;
      f32x16 st[2];
#pragma unroll
      for (int kt = 0; kt < 2; ++kt) {
#pragma unroll
        for (int i = 0; i < 16; ++i) st[kt][i] = 0.f;
        const u16* kb = Ks + (32 * kt + r) * KS + 8 * h;
#pragma unroll
        for (int kk = 0; kk < HDQK / 16; ++kk) {
          const bf16x8 a = *(const bf16x8*)(kb + 16 * kk);
          st[kt] = MFMA(a, qf[kk], st[kt]);
        }
      }
      float mx = -1e30f;
      if (mode == 0) {
#pragma unroll
        for (int kt = 0; kt < 2; ++kt)
#pragma unroll
          for (int i = 0; i < 16; ++i) { const float v = st[kt][i] * scale_l2; st[kt][i] = v; mx = fmaxf(mx, v); }
      } else if (mode == 1) {
#pragma unroll
        for (int kt = 0; kt < 2; ++kt)
#pragma unroll
          for (int i = 0; i < 16; ++i) {
            const int kpos = n + 32 * kt + crow(i, h);
            const int d = qpos - kpos;
            float v = st[kt][i] * scale_l2;
            if (d > 128 || d < -128) v = -1e30f;
            st[kt][i] = v; mx = fmaxf(mx, v);
          }
      } else {
#pragma unroll
        for (int kt = 0; kt < 2; ++kt)
#pragma unroll
          for (int i = 0; i < 16; ++i) {
            const int kpos = n + 32 * kt + crow(i, h);
            const int kr = kpos >> 6, kc = kpos & 63;
            const bool ok = ((unsigned)(kr - r0) < 8u) && ((unsigned)(kc - c0) < 16u);
            const int idx = ok ? (kr - qr + 7) * 31 + (kc - qc + 15) : 0;
            const float b = rp[idx];
            float v = st[kt][i] * scale_l2 + b * LOG2E;
            if (!ok) v = -1e30f;
            st[kt][i] = v; mx = fmaxf(mx, v);
          }
      }
      mx = fmaxf(mx, __shfl_xor(mx, 32, 64));
      const float mn = fmaxf(m, mx);
      const float alpha = __builtin_amdgcn_exp2f(m - mn);
      m = mn;
      float rs = 0.f;
#pragma unroll
      for (int kt = 0; kt < 2; ++kt)
#pragma unroll
        for (int i = 0; i < 16; ++i) { const float pz = __builtin_amdgcn_exp2f(st[kt][i] - mn); st[kt][i] = pz; rs += pz; }
      rs += __shfl_xor(rs, 32, 64);
      l = l * alpha + rs;
#pragma unroll
      for (int dt = 0; dt < HDV / 32; ++dt)
#pragma unroll
        for (int i = 0; i < 16; ++i) o[dt][i] *= alpha;
#pragma unroll
      for (int kt = 0; kt < 2; ++kt)
#pragma unroll
        for (int s2 = 0; s2 < 2; ++s2) {
          unsigned pk[4];
#pragma unroll
          for (int j = 0; j < 4; ++j) pk[j] = pack2(st[kt][8 * s2 + 2 * j], st[kt][8 * s2 + 2 * j + 1]);
          bf16x8 pb;
          {
            typedef unsigned u32x4 __attribute__((ext_vector_type(4)));
            u32x4 t4 = {pk[0], pk[1], pk[2], pk[3]};
            pb = __builtin_bit_cast(bf16x8, t4);
          }
          const u16* vb = Vs + (32 * kt + 16 * s2 + 4 * h + q4) * VS + 16 * dblk + 4 * p4;
#pragma unroll
          for (int dt = 0; dt < HDV / 32; ++dt) {
            const s16x4 lo = __builtin_amdgcn_ds_read_tr16_b64_v4i16((LDS3 s16x4*)(vb + 32 * dt));
            const s16x4 hi = __builtin_amdgcn_ds_read_tr16_b64_v4i16((LDS3 s16x4*)(vb + 8 * VS + 32 * dt));
            const bf16x8 va = __builtin_shufflevector(lo, hi, 0, 1, 2, 3, 4, 5, 6, 7);
            o[dt] = MFMA(va, pb, o[dt]);
          }
        }
    }
  }
#undef ATT_FETCH
#undef ATT_KADDR
  if (has_sink) l += __builtin_amdgcn_exp2f(sink_l2 - m);
  const float inv = 1.f / l;
  u16* orow = Op + (size_t)(32 * w + r) * ldo + 4 * h;
#pragma unroll
  for (int dt = 0; dt < HDV / 32; ++dt)
#pragma unroll
    for (int g = 0; g < 4; ++g) {
      uint2 v;
      v.x = pack2(o[dt][4 * g] * inv, o[dt][4 * g + 1] * inv);
      v.y = pack2(o[dt][4 * g + 2] * inv, o[dt][4 * g + 3] * inv);
      *(uint2*)(orow + 32 * dt + 8 * g) = v;
    }
}

DI void attn_phase(const KA& p, int kind, char* smem) {
  const int Hq = kind == 0 ? 8 : 16;
  const int nlat = 8 * Hq * 4, nctx = 16 * Hq;
  u16* AO = (u16*)(p.ws() + OFF_HAO);
  const u16* QKV = (const u16*)(p.ws() + OFF_QO);
  for (int rep = 0; rep < REP_ATT; ++rep)
  for (int item = blockIdx.x; item < nlat + nctx; item += gridDim.x) {
    const bool lat = item < nlat;
    int b, hq, qt;
    if (lat) { b = item / (Hq * 4); const int rem = item - b * Hq * 4; hq = rem >> 2; qt = rem & 3; }
    else { const int it = item - nlat; b = it / Hq; hq = it - b * Hq; qt = 0; }
    const int tok0 = lat ? NCTX + b * 1024 : b * 256;
    const int S = lat ? 1024 : 256;
    const int qrow0 = tok0 + qt * 256;
    Seg sc, ss;
    sc.k2 = nullptr; sc.ldk2 = 0; ss.k2 = nullptr; ss.ldk2 = 0;
    sc.n0 = 0; sc.n1 = 512; sc.mode = 0;
    ss.n0 = 0; ss.n1 = S; ss.mode = 0;
    const u16* Qp; int ldq; float sl2; const float* rpb = nullptr; bool has_sink = false; float sink_l2 = 0.f;
    u16* Op;
    if (kind == 0) {
      const int kvh = hq >> 2;
      ss.k1 = QKV + (size_t)tok0 * 1536 + 1024 + kvh * 128; ss.ldk1 = 1536;
      ss.v = QKV + (size_t)tok0 * 1536 + 1280 + kvh * 128; ss.ldv = 1536;
      sc.k1 = (const u16*)(p.ws() + OFF_CK) + (size_t)b * 512 * 256 + kvh * 128; sc.ldk1 = 256;
      sc.v = (const u16*)(p.ws() + OFF_CV) + (size_t)b * 512 * 256 + kvh * 128; sc.ldv = 256;
      sl2 = 0.08838834764831845f * LOG2E;
      Qp = QKV + (size_t)qrow0 * 1536 + hq * 128; ldq = 1536;
      Op = AO + (size_t)qrow0 * P1024 + hq * 128;
    } else if (kind == 1) {
      const u16* KV = (const u16*)(p.ws() + OFF_KV);
      const u16* KPE = (const u16*)(p.ws() + OFF_KPE);
      ss.k1 = KV + (size_t)tok0 * 2048 + hq * 128; ss.ldk1 = 2048;
      ss.k2 = KPE + (size_t)tok0 * 32; ss.ldk2 = 32;
      ss.v = KV + (size_t)tok0 * 2048 + hq * 128 + 64; ss.ldv = 2048;
      const size_t crow0 = 12288 + (size_t)b * 512;
      sc.k1 = KV + crow0 * 2048 + hq * 128; sc.ldk1 = 2048;
      sc.k2 = KPE + crow0 * 32; sc.ldk2 = 32;
      sc.v = KV + crow0 * 2048 + hq * 128 + 64; sc.ldv = 2048;
      sl2 = 0.10206207261596575f * LOG2E;
      Qp = QKV + (size_t)qrow0 * 1536 + hq * 96; ldq = 1536;
      Op = AO + (size_t)qrow0 * P1024 + hq * 64;
    } else if (kind == 2) {
      const int kvh = hq >> 2;
      ss.k1 = QKV + (size_t)tok0 * 1536 + 1024 + kvh * 64; ss.ldk1 = 1536;
      ss.v = QKV + (size_t)tok0 * 1536 + 1280 + kvh * 64; ss.ldv = 1536;
      sc.k1 = (const u16*)(p.ws() + OFF_CK) + (size_t)b * 512 * 256 + kvh * 64; sc.ldk1 = 256;
      sc.v = (const u16*)(p.ws() + OFF_CV) + (size_t)b * 512 * 256 + kvh * 64; sc.ldv = 256;
      sl2 = 0.125f * LOG2E;
      has_sink = true; sink_l2 = p.in(28)[hq] * LOG2E;
      if (lat) { ss.n0 = max(0, qt * 256 - 128); ss.n1 = min(1024, qt * 256 + 384); ss.mode = 1; }
      Qp = QKV + (size_t)qrow0 * 1536 + hq * 64; ldq = 1536;
      Op = AO + (size_t)qrow0 * P1024 + hq * 64;
    } else {
      ss.k1 = QKV + (size_t)tok0 * 3072 + 1024 + hq * 64; ss.ldk1 = 3072;
      ss.v = QKV + (size_t)tok0 * 3072 + 2048 + hq * 64; ss.ldv = 3072;
      sc.k1 = (const u16*)(p.ws() + OFF_C3K) + (size_t)b * 512 * 1024 + hq * 64; sc.ldk1 = 1024;
      sc.v = (const u16*)(p.ws() + OFF_C3V) + (size_t)b * 512 * 1024 + hq * 64; sc.ldv = 1024;
      sl2 = 0.125f * LOG2E;
      if (lat) {
        const int r0a = min(max(4 * qt - 4, 0), 8), r0b = min(max(4 * qt - 1, 0), 8);
        ss.n0 = r0a * 64; ss.n1 = (r0b + 8) * 64; ss.mode = 2;
        rpb = p.in(31) + hq * 465;
      }
      Qp = QKV + (size_t)qrow0 * 3072 + hq * 64; ldq = 3072;
      Op = AO + (size_t)qrow0 * P1024 + hq * 64;
    }
    Seg s0;
    s0.k1 = lat ? sc.k1 : ss.k1; s0.k2 = lat ? sc.k2 : ss.k2; s0.v = lat ? sc.v : ss.v;
    s0.ldk1 = lat ? sc.ldk1 : ss.ldk1; s0.ldk2 = lat ? sc.ldk2 : ss.ldk2; s0.ldv = lat ? sc.ldv : ss.ldv;
    s0.n0 = lat ? sc.n0 : ss.n0; s0.n1 = lat ? sc.n1 : ss.n1; s0.mode = lat ? sc.mode : ss.mode;
    const int nseg = lat ? 2 : 1;
    if (kind == 0) attn_item<128, 128>(Qp, ldq, s0, ss, nseg, qt * 256, sl2, rpb, has_sink, sink_l2, Op, P1024, smem);
    else if (kind == 1) attn_item<96, 64>(Qp, ldq, s0, ss, nseg, qt * 256, sl2, rpb, has_sink, sink_l2, Op, P1024, smem);
    else attn_item<64, 64>(Qp, ldq, s0, ss, nseg, qt * 256, sl2, rpb, has_sink, sink_l2, Op, P1024, smem);
  }
}

__host__ __device__ inline bool phase_exists(int ph) {
  if (ph == 0 || ph == 41) return true;
  const int l = (ph - 1) / 10, s = (ph - 1) % 10;
  if ((s == 3 || s == 4) && l != 1) return false;
  if (s == 2 && l == 3) return false;
  return true;
}

DI void run_phase(const KA& p, int ph, char* smem) {
  if (ph == 0) { prepass(p, smem); return; }
  if (ph == 41) { norm_phase(p, 4, 2); return; }
  const int l = (ph - 1) / 10, s = (ph - 1) % 10;
  char* ws = p.ws();
  GemmDesc g0, g1;
  g0 = GemmDesc{nullptr, nullptr, nullptr, 0, 0, 0, 0, 0, 0, 0};
  g1 = g0;
  int ng = 0;
  switch (s) {
    case 0:
      norm_phase(p, l, 0);
      if (l == 2) {
        convert_f32_bf16(p.in(6), (u16*)(ws + OFF_CK), 4096ull * 256);
        convert_f32_bf16(p.in(7), (u16*)(ws + OFF_CV), 4096ull * 256);
      } else if (l == 3) {
        convert_f32_bf16(p.in(8), (u16*)(ws + OFF_C3K), 4096ull * 1024);
        convert_f32_bf16(p.in(9), (u16*)(ws + OFF_C3V), 4096ull * 1024);
      }
      break;
    case 1: {
      const u16* H = (const u16*)(ws + OFF_HAO);
      if (l == 0) g0 = GemmDesc{H, (const u16*)(ws + OFF_AQKV), ws + OFF_UZ, P1024, P1024, 1536, NTOK, 1536, 1024, EPI_F32};
      else if (l == 1) g0 = GemmDesc{H, (const u16*)(ws + OFF_MIN), ws + OFF_UZ, P1024, P1024, 768, NTOK, 768, 1024, EPI_F32};
      else if (l == 2) g0 = GemmDesc{H, (const u16*)(ws + OFF_SQKV), ws + OFF_UZ, P1024, P1024, 1536, NTOK, 1536, 1024, EPI_F32};
      else g0 = GemmDesc{H, (const u16*)(ws + OFF_NQKV), ws + OFF_QO, P1024, P1024, 3072, NTOK, 3072, 1024, EPI_NAT};
      ng = 1;
    } break;
    case 2:
      if (l == 0) pp_attn(p); else if (l == 1) pp_mla1(p); else if (l == 2) pp_swa(p);
      break;
    case 3:
      g0 = GemmDesc{(const u16*)(ws + OFF_CQ), (const u16*)(ws + OFF_MUQ), ws + OFF_UZ, P384, P384, 1536, NTOK, 1536, 384, EPI_F32};
      g1 = GemmDesc{(const u16*)(ws + OFF_CKV), (const u16*)(ws + OFF_MUKV), ws + OFF_KV, P256, P256, 2048, 16384, 2048, 256, EPI_BF16};
      ng = 2;
      break;
    case 4: pp_mla2(p); break;
    case 5: attn_phase(p, l, smem); break;
    case 6: {
      const size_t wo = l == 0 ? OFF_AO_W : (l == 1 ? OFF_MO : (l == 2 ? OFF_SO : OFF_NO));
      g0 = GemmDesc{(const u16*)(ws + OFF_HAO), (const u16*)(ws + wo), ws + OFF_QO, P1024, P1024, 1024, NTOK, 1024, 1024, EPI_F32};
      ng = 1;
    } break;
    case 7: norm_phase(p, l, 1); break;
    case 8:
      g0 = GemmDesc{(const u16*)(ws + OFF_HAO), (const u16*)(ws + OFF_W1T + (size_t)l * W1T_SZ), ws + OFF_UZ, P1024, P1024, P4096, NTOK, 4096, 1024, EPI_RELU2};
      ng = 1;
      break;
    case 9:
      g0 = GemmDesc{(const u16*)(ws + OFF_UZ), (const u16*)(ws + OFF_W2T + (size_t)l * W2T_SZ), ws + OFF_QO, P4096, P4096, 1024, NTOK, 1024, 4096, EPI_F32};
      ng = 1;
      break;
  }
  if (ng > 0) gemm_phase(p, g0, g1, ng, smem);
}

#define XB_TMO      128
#define XB_XCNT(j)  (256  + 64 * (j))
#define XB_XSUB(j)  (1280 + 64 * (j))
#define XB_XGEN(j)  (2304 + 64 * (j))
#define XB_TOP      3328
#define XB_TOPGEN   3392
#define XCD_BAR_WORDS 3456
#define XB_SPIN_CAP (1u << 18)
#define LAS __attribute__((address_space(3)))

__device__ __forceinline__ unsigned xb_ld(unsigned* p)              { return __hip_atomic_load(p, __ATOMIC_RELAXED, __HIP_MEMORY_SCOPE_AGENT); }
__device__ __forceinline__ unsigned xb_add(unsigned* p, unsigned v) { return __hip_atomic_fetch_add(p, v, __ATOMIC_RELAXED, __HIP_MEMORY_SCOPE_AGENT); }
__device__ __forceinline__ unsigned xb_xcc_id() { return (unsigned)__builtin_amdgcn_s_getreg((3 << 11) | 20) & 0xFu; }
#define XB_SPIN(cond, bar) do { unsigned _sp = 0; while (cond) { __builtin_amdgcn_s_sleep(1); \
    if ((++_sp & 255u) == 0u) { if (xb_ld(&(bar)[XB_TMO])) break; if (_sp > XB_SPIN_CAP) { atomicAdd(&(bar)[XB_TMO], 1u); break; } } } } while (0)

struct XcdBarrier {
    unsigned* bar; unsigned x;
    volatile LAS unsigned* st;
};

__device__ __forceinline__ XcdBarrier xcd_barrier_post(unsigned* bar, volatile LAS unsigned* st) {
    XcdBarrier b; b.bar = bar; b.x = xb_xcc_id(); b.st = st;
    if (threadIdx.x == 0) (void)xb_add(&bar[XB_XCNT(b.x)], 1u);
    return b;
}
__device__ __forceinline__ void xcd_barrier_complete(unsigned* bar, unsigned x, unsigned& nloc, unsigned& nx) {
    const unsigned G = gridDim.x * gridDim.y * gridDim.z;
    unsigned sum, cnt, mine, sp = 0u;
    for (;;) {
        sum = 0u; cnt = 0u; mine = 0u;
#pragma unroll
        for (unsigned j = 0; j < 16; ++j) { const unsigned c = xb_ld(&bar[XB_XCNT(j)]); sum += c; cnt += (c > 0u) ? 1u : 0u; mine = (j == x) ? c : mine; }
        if (sum == G) break;
        __builtin_amdgcn_s_sleep(1);
        if ((++sp & 255u) == 0u) { if (xb_ld(&bar[XB_TMO])) break; if (sp > XB_SPIN_CAP) { atomicAdd(&bar[XB_TMO], 1u); break; } }
    }
    nloc = mine > 0u ? mine : 1u; nx = cnt > 0u ? cnt : 1u;
}

__device__ __forceinline__ void xcd_barrier(const XcdBarrier& b) {
    asm volatile("s_waitcnt vmcnt(0)" ::: "memory");
    __syncthreads();
    if (threadIdx.x == 0) {
        unsigned* bar = b.bar;
        __builtin_amdgcn_s_waitcnt(0);
        unsigned nloc = b.st[0], nx = b.st[1];
        if (nloc == 0u) { xcd_barrier_complete(bar, b.x, nloc, nx); b.st[0] = nloc; b.st[1] = nx; }
        const unsigned old = xb_add(&bar[XB_XSUB(b.x)], 1u);
        const unsigned gen = old / nloc;
        if (old + 1u == (gen + 1u) * nloc) {
            __builtin_amdgcn_fence(__ATOMIC_RELEASE, "agent");
            asm volatile("s_waitcnt vmcnt(0)" ::: "memory");
            const unsigned og = xb_add(&bar[XB_TOP], 1u);
            const unsigned tg = og / nx;
            if (og + 1u == (tg + 1u) * nx) xb_add(&bar[XB_TOPGEN], 1u);
            else XB_SPIN(xb_ld(&bar[XB_TOPGEN]) == tg, bar);
            __builtin_amdgcn_fence(__ATOMIC_ACQUIRE, "agent");
            xb_add(&bar[XB_XGEN(b.x)], 1u);
            asm volatile("s_waitcnt vmcnt(0)" ::: "memory");
        } else {
            XB_SPIN(xb_ld(&bar[XB_XGEN(b.x)]) == gen, bar);
            __builtin_amdgcn_fence(__ATOMIC_ACQUIRE, "agent");
            asm volatile("s_waitcnt vmcnt(0)" ::: "memory");
        }
    }
    __syncthreads();
}

__global__ void __launch_bounds__(512, 2) mega(Params p) {
  __shared__ __attribute__((aligned(16))) char smem[129024];
  __shared__ uint4 xb_words;
  const bool coop = (p.ph1 - p.ph0) > 1;
  XcdBarrier xb;
  if (coop) {
    if (threadIdx.x == 0) xb_words = make_uint4(0u, 0u, 0u, 0u);
    __syncthreads();
    xb = xcd_barrier_post((unsigned*)(p.ws + OFF_BAR), (volatile LAS unsigned*)&xb_words);
  }
  if (p.ph1 < 0) cg::this_grid().sync();
  for (int ph = p.ph0; ph < p.ph1; ++ph) {
    if (!phase_exists(ph)) continue;
    KA q;
    q.ka = (const AS4 char*)__builtin_amdgcn_kernarg_segment_ptr();
    asm volatile("" : "+s"(q.ka));
    run_phase(q, ph, smem);
    if (ph + 1 < p.ph1) xcd_barrier(xb);
  }
}

extern "C" void kernel_launch(void* const* d_in, const int* in_sizes, int n_in, void* d_out, int out_size,
                              void* d_ws, size_t ws_size, hipStream_t stream) {
  if (n_in < 33 || ws_size < WS_NEED) { fprintf(stderr, "bad args: n_in %d ws %zu need %zu\n", n_in, ws_size, (size_t)WS_NEED); return; }
  Params p{};
  for (int i = 0; i < 33; ++i) p.in[i] = (const float*)d_in[i];
  p.out = (float*)d_out;
  p.ws = (char*)d_ws;
#if N_LAUNCH_MODE == 1
  for (int ph = 0; ph < 42; ++ph) {
    if (!phase_exists(ph)) continue;
    p.ph0 = ph; p.ph1 = ph + 1;
    hipLaunchKernelGGL(mega, dim3(256), dim3(NTHR), 0, stream, p);
  }
#else
  static int grid_blocks = 0;
  if (!grid_blocks) {
    int dev = 0, cus = 0, per_cu = 0;
    hipGetDevice(&dev);
    hipDeviceGetAttribute(&cus, hipDeviceAttributeMultiprocessorCount, dev);
    hipOccupancyMaxActiveBlocksPerMultiprocessor(&per_cu, mega, NTHR, 0);
    if (per_cu > 1) per_cu = 1;
    grid_blocks = cus * per_cu;
  }
  p.ph0 = 0; p.ph1 = 42;
  hipMemsetAsync((char*)d_ws + OFF_BAR, 0, XCD_BAR_WORDS * 4, stream);
  void* args[] = {&p};
  hipError_t e = hipLaunchCooperativeKernel((void*)mega, dim3(grid_blocks), dim3(NTHR), args, 0, stream);
  if (e != hipSuccess) fprintf(stderr, "cooperative launch failed: %s (grid %d)\n", hipGetErrorString(e), grid_blocks);
#endif
}
```

```cpp
#include <hip/hip_runtime.h>
#include <hip/hip_cooperative_groups.h>
#include <cstdio>
namespace cg = cooperative_groups;

typedef unsigned short u16;
typedef short bf16x8 __attribute__((ext_vector_type(8)));
typedef short s16x4 __attribute__((ext_vector_type(4)));
typedef float f32x16 __attribute__((ext_vector_type(16)));
typedef float f32x2 __attribute__((ext_vector_type(2)));
typedef __bf16 bfx2 __attribute__((ext_vector_type(2)));
#define DI __device__ __forceinline__
#define MFMA(a, b, c) __builtin_amdgcn_mfma_f32_32x32x16_bf16((a), (b), (c), 0, 0, 0)
#define LDS3 __attribute__((address_space(3)))

#ifndef REP_GEMM
#define REP_GEMM 1
#endif
#ifndef REP_ATT
#define REP_ATT 1
#endif
#ifndef N_LAUNCH_MODE
#define N_LAUNCH_MODE 0
#endif

constexpr int NTOK = 12288, NCTX = 4096;
constexpr int NTHR = 512, NWAVE = 8;
constexpr float LOG2E = 1.4426950408889634f;

constexpr size_t O_L0K = 12582912, O_L0V = 13631488, O_L1CKV = 14680064, O_L1KPE = 15728640,
                 O_L2K = 15859712, O_L2V = 16908288, O_L3K = 17956864, O_L3V = 22151168;

constexpr int P1024 = 1088, P4096 = 4160, P384 = 448, P256 = 320;
constexpr size_t W1T_SZ = 4096ull * P1024 * 2, W2T_SZ = 1024ull * P4096 * 2;
constexpr size_t OFF_W1T = 0;
constexpr size_t OFF_W2T = OFF_W1T + 4 * W1T_SZ;
constexpr size_t OFF_AQKV = OFF_W2T + 4 * W2T_SZ;
constexpr size_t OFF_AO_W = OFF_AQKV + 1536ull * P1024 * 2;
constexpr size_t OFF_MIN = OFF_AO_W + 1024ull * P1024 * 2;
constexpr size_t OFF_MUQ = OFF_MIN + 768ull * P1024 * 2;
constexpr size_t OFF_MUKV = OFF_MUQ + 1536ull * P384 * 2;
constexpr size_t OFF_MO = OFF_MUKV + 2048ull * P256 * 2;
constexpr size_t OFF_SQKV = OFF_MO + 1024ull * P1024 * 2;
constexpr size_t OFF_SO = OFF_SQKV + 1536ull * P1024 * 2;
constexpr size_t OFF_NQKV = OFF_SO + 1024ull * P1024 * 2;
constexpr size_t OFF_NO = OFF_NQKV + 3072ull * P1024 * 2;
constexpr size_t OFF_MOD = OFF_NO + 1024ull * P1024 * 2;
constexpr size_t OFF_ROPE = OFF_MOD + 4ull * 9 * 6144 * 4;
constexpr size_t OFF_HAO = OFF_ROPE + 3ull * 64 * 32 * 2 * 4;
constexpr size_t OFF_UZ = OFF_HAO + 12288ull * P1024 * 2;
constexpr size_t OFF_QO = OFF_UZ + 12288ull * P4096 * 2;
constexpr size_t OFF_CQ = OFF_QO + 12288ull * 3072 * 2;
constexpr size_t OFF_CKV = OFF_CQ + 12288ull * P384 * 2;
constexpr size_t OFF_KPE = OFF_CKV + 16384ull * P256 * 2;
constexpr size_t OFF_KV = OFF_KPE + 16384ull * 32 * 2;
constexpr size_t OFF_CK = OFF_KV;
constexpr size_t OFF_CV = OFF_KV + 2097152;
constexpr size_t OFF_C3K = OFF_KV + 4194304;
constexpr size_t OFF_C3V = OFF_C3K + 8388608;
constexpr size_t OFF_BAR = OFF_KV + 16384ull * 2048 * 2;
constexpr size_t WS_NEED = OFF_BAR + 16384;

struct Params {
  const float* in[33];
  float* out;
  char* ws;
  int ph0, ph1;
};

#define AS4 __attribute__((address_space(4)))
struct KA {
  const AS4 char* ka;
  DI const float* in(int i) const { return *(const float* const AS4*)(ka + 8 * i); }
  DI float* out() const { return *(float* const AS4*)(ka + 264); }
  DI char* ws() const { return *(char* const AS4*)(ka + 272); }
};

DI unsigned pack2(float a, float b) { f32x2 f = {a, b}; bfx2 v = __builtin_convertvector(f, bfx2); return __builtin_bit_cast(unsigned, v); }
DI u16 f2bf(float a) { return (u16)(pack2(a, a) & 0xffffu); }
DI float wave_sum(float v) {
#pragma unroll
  for (int o = 32; o; o >>= 1) v += __shfl_xor(v, o, 64);
  return v;
}
DI int ltid() { int t = threadIdx.x; asm volatile("" : "+v"(t)); return t; }
DI int crow(int i, int h) { return (i & 3) + 8 * (i >> 2) + 4 * h; }

__device__ const long long TJ[18][6] = {
  {15, 0ll * 1024 * 4096, 1024, 4096, 4096, (long long)(OFF_W1T + 0ull * W1T_SZ)},
  {15, 1ll * 1024 * 4096, 1024, 4096, 4096, (long long)(OFF_W1T + 1ull * W1T_SZ)},
  {15, 2ll * 1024 * 4096, 1024, 4096, 4096, (long long)(OFF_W1T + 2ull * W1T_SZ)},
  {15, 3ll * 1024 * 4096, 1024, 4096, 4096, (long long)(OFF_W1T + 3ull * W1T_SZ)},
  {16, 0ll * 1024 * 4096, 4096, 1024, 1024, (long long)(OFF_W2T + 0ull * W2T_SZ)},
  {16, 1ll * 1024 * 4096, 4096, 1024, 1024, (long long)(OFF_W2T + 1ull * W2T_SZ)},
  {16, 2ll * 1024 * 4096, 4096, 1024, 1024, (long long)(OFF_W2T + 2ull * W2T_SZ)},
  {16, 3ll * 1024 * 4096, 4096, 1024, 1024, (long long)(OFF_W2T + 3ull * W2T_SZ)},
  {17, 0, 1024, 1536, 1536, (long long)OFF_AQKV},
  {20, 0, 1024, 1024, 1024, (long long)OFF_AO_W},
  {21, 0, 1024, 672, 768, (long long)OFF_MIN},
  {24, 0, 384, 1536, 1536, (long long)OFF_MUQ},
  {25, 0, 256, 2048, 2048, (long long)OFF_MUKV},
  {26, 0, 1024, 1024, 1024, (long long)OFF_MO},
  {27, 0, 1024, 1536, 1536, (long long)OFF_SQKV},
  {29, 0, 1024, 1024, 1024, (long long)OFF_SO},
  {30, 0, 1024, 3072, 3072, (long long)OFF_NQKV},
  {32, 0, 1024, 1024, 1024, (long long)OFF_NO},
};

DI void transpose_tile(const float* __restrict__ src, u16* __restrict__ dst, int K, int N, int k0, int n0, char* smem) {
  float (*T)[65] = (float (*)[65])smem;
  const int tid = ltid();
  const int nl = tid & 63, kl0 = tid >> 6;
  __syncthreads();
  const int n = n0 + nl;
#pragma unroll 4
  for (int j = 0; j < 8; ++j) {
    const int k = kl0 + 8 * j;
    T[k][nl] = (n < N) ? src[(size_t)(k0 + k) * N + n] : 0.f;
  }
  __syncthreads();
  const int kp = tid & 31, nl0 = tid >> 5;
#pragma unroll
  for (int j = 0; j < 4; ++j) {
    const int nn = nl0 + 16 * j;
    *(unsigned*)&dst[(size_t)(n0 + nn) * (K + 64) + k0 + 2 * kp] = pack2(T[2 * kp][nn], T[2 * kp + 1][nn]);
  }
}

DI void convert_f32_bf16(const float* __restrict__ src, u16* __restrict__ dst, size_t n) {
  const size_t n4 = n >> 2;
  const int tid_ = ltid();
  for (size_t i = (size_t)blockIdx.x * NTHR + tid_; i < n4; i += (size_t)gridDim.x * NTHR) {
    const float4 v = ((const float4*)src)[i];
    uint2 o; o.x = pack2(v.x, v.y); o.y = pack2(v.z, v.w);
    ((uint2*)dst)[i] = o;
  }
}

DI void convert_rows256(const float* __restrict__ src, u16* __restrict__ dst, int rows, int dpitch) {
  const int tid_ = ltid();
  for (int i = blockIdx.x * NTHR + tid_; i < rows * 64; i += gridDim.x * NTHR) {
    const int r = i >> 6, c4 = i & 63;
    const float4 v = ((const float4*)src)[i];
    uint2 o; o.x = pack2(v.x, v.y); o.y = pack2(v.z, v.w);
    *(uint2*)(dst + (size_t)r * dpitch + 4 * c4) = o;
  }
}

DI void prepass(const KA& p, char* smem) {
  int total = 0;
  for (int j = 0; j < 18; ++j) total += (int)((TJ[j][2] >> 6) * (TJ[j][4] >> 6));
  for (int t = blockIdx.x; t < total; t += gridDim.x) {
    int j = 0, tt = t;
    for (;;) { const int c = (int)((TJ[j][2] >> 6) * (TJ[j][4] >> 6)); if (tt < c) break; tt -= c; ++j; }
    const int K = (int)TJ[j][2], N = (int)TJ[j][3];
    const int nk = K >> 6;
    const int kt = tt % nk, nt = tt / nk;
    transpose_tile(p.in((int)TJ[j][0]) + TJ[j][1], (u16*)(p.ws() + TJ[j][5]), K, N, kt * 64, nt * 64, smem);
  }
  convert_f32_bf16(p.in(2), (u16*)(p.ws() + OFF_CK), 4096ull * 256);
  convert_f32_bf16(p.in(3), (u16*)(p.ws() + OFF_CV), 4096ull * 256);
  convert_rows256(p.in(4), (u16*)(p.ws() + OFF_CKV) + 12288ull * P256, 4096, P256);
  convert_f32_bf16(p.in(5), (u16*)(p.ws() + OFF_KPE) + 12288ull * 32, 4096ull * 32);
  {
    float* tab = (float*)(p.ws() + OFF_ROPE);
    const int tid_ = ltid();
    for (int e = blockIdx.x * NTHR + tid_; e < 3 * 64 * 32; e += gridDim.x * NTHR) {
      const int kind = e / 2048, pos = (e >> 5) & 63, i = e & 31;
      const int quarter = kind == 0 ? 32 : (kind == 1 ? 16 : 8);
      float c = 1.f, s = 0.f;
      if (i < quarter) {
        const float inv = exp2f(-(float)i / (float)quarter * 13.287712379549449f);
        const float ang = (float)pos * inv;
        c = cosf(ang); s = sinf(ang);
      }
      tab[2 * e] = c; tab[2 * e + 1] = s;
    }
  }
  {
    float* scond = (float*)smem;
    float* red = (float*)(smem + 36864);
    float* MOD = (float*)(p.ws() + OFF_MOD);
    const int tid = ltid();
    bool ready = false;
    for (int it = blockIdx.x; it < 768; it += gridDim.x) {
      __syncthreads();
      if (!ready) {
        for (int e = tid; e < 9 * 1024; e += NTHR) {
          const float c = e < 8192 ? p.in(10)[e] : p.in(11)[e - 8192];
          scond[e] = c / (1.f + __expf(-c));
        }
        ready = true;
        __syncthreads();
      }
      const int l = it / 192, n0 = (it % 192) * 32;
      const int col = tid & 31, kg = tid >> 5;
      float acc[9];
#pragma unroll
      for (int c = 0; c < 9; ++c) acc[c] = 0.f;
      const float* wp = p.in(12) + (size_t)l * 1024 * 6144 + n0 + col;
#pragma unroll 8
      for (int i = 0; i < 64; ++i) {
        const int k = kg + 16 * i;
        const float wv = wp[(size_t)k * 6144];
#pragma unroll
        for (int c = 0; c < 9; ++c) acc[c] += scond[c * 1024 + k] * wv;
      }
#pragma unroll
      for (int c = 0; c < 9; ++c) red[(kg * 9 + c) * 32 + col] = acc[c];
      __syncthreads();
      for (int e = tid; e < 288; e += NTHR) {
        const int c = e >> 5, cc = e & 31;
        float s = p.in(13)[l * 6144 + n0 + cc];
#pragma unroll
        for (int g = 0; g < 16; ++g) s += red[(g * 9 + c) * 32 + cc];
        MOD[(size_t)(l * 9 + c) * 6144 + n0 + cc] = s;
      }
    }
  }
}

DI float bf2f(unsigned v16) { return __uint_as_float(v16 << 16); }

DI void norm_phase(const KA& p, int l, int mode) {
  const int tid_ = ltid(); const int lane = tid_ & 63, w = tid_ >> 6;
  float* X = p.out();
  const float* MOD = (const float*)(p.ws() + OFF_MOD);
  const u16* FF = (const u16*)(p.ws() + OFF_QO);
  u16* H = (u16*)(p.ws() + OFF_HAO);
  const float* ng = p.in(14);
  const float* xp0 = p.in(0);
  const float* xp1 = p.in(1);
  const bool x_in = (l == 0);
  const bool add = !(l == 0 && mode == 0);
  const int la = (mode == 1) ? l : l - 1;
  const int gate_w = (mode == 1) ? 2 : 5;
  const int gadd = (mode == 1) ? 1 : 3;
  const bool do_h = mode != 2;
  const int gh = (mode == 0) ? 0 : 2, scw = (mode == 0) ? 1 : 4, shw = (mode == 0) ? 0 : 3;
  const int stride = gridDim.x * NWAVE;
  const int lh = do_h ? l : 0;
  int row = blockIdx.x * NWAVE + w;
  float4 nx0, nx1, nx2, nx3;
  uint2 nf0 = make_uint2(0, 0), nf1 = nf0, nf2 = nf0, nf3 = nf0;
#define NLOAD(rw)                                                                                          \
  {                                                                                                        \
    const int rr = min((rw), NTOK - 1);                                                                    \
    const float* xs = x_in ? (rr < NCTX ? xp0 + (size_t)rr * 1024 : xp1 + (size_t)(rr - NCTX) * 1024)      \
                           : X + (size_t)rr * 1024;                                                        \
    nx0 = *(const float4*)(xs + 4 * lane); nx1 = *(const float4*)(xs + 4 * lane + 256);                    \
    nx2 = *(const float4*)(xs + 4 * lane + 512); nx3 = *(const float4*)(xs + 4 * lane + 768);              \
    if (add) {                                                                                             \
      const u16* fr = FF + (size_t)rr * 1024 + 4 * lane;                                                   \
      nf0 = *(const uint2*)(fr); nf1 = *(const uint2*)(fr + 256); nf2 = *(const uint2*)(fr + 512); nf3 = *(const uint2*)(fr + 768); \
    }                                                                                                      \
  }
  NLOAD(row)
  for (; row < NTOK; row += stride) {
    const int ci = row < NCTX ? 8 : ((row - NCTX) >> 10);
    float4 x[4] = {nx0, nx1, nx2, nx3};
    const uint2 fb[4] = {nf0, nf1, nf2, nf3};
    const float* ga = ng + (la * 4 + gadd) * 1024 + 4 * lane;
    const float* gt = MOD + (size_t)(la * 9 + ci) * 6144 + gate_w * 1024 + 4 * lane;
    const float* gp = ng + (lh * 4 + gh) * 1024 + 4 * lane;
    const float* sc = MOD + (size_t)(lh * 9 + ci) * 6144 + scw * 1024 + 4 * lane;
    const float* sh = MOD + (size_t)(lh * 9 + ci) * 6144 + shw * 1024 + 4 * lane;
    float4 ga4[4], gt4[4], g4[4], c4[4], s4[4];
#pragma unroll
    for (int j = 0; j < 4; ++j) {
      if (add) { ga4[j] = *(const float4*)(ga + 256 * j); gt4[j] = *(const float4*)(gt + 256 * j); }
      if (do_h) { g4[j] = *(const float4*)(gp + 256 * j); c4[j] = *(const float4*)(sc + 256 * j); s4[j] = *(const float4*)(sh + 256 * j); }
    }
    NLOAD(row + stride)
    if (add) {
      float f[16];
      float ss = 0.f;
#pragma unroll
      for (int j = 0; j < 4; ++j) {
        f[4 * j] = bf2f(fb[j].x & 0xffffu); f[4 * j + 1] = bf2f(fb[j].x >> 16);
        f[4 * j + 2] = bf2f(fb[j].y & 0xffffu); f[4 * j + 3] = bf2f(fb[j].y >> 16);
        ss += f[4 * j] * f[4 * j] + f[4 * j + 1] * f[4 * j + 1] + f[4 * j + 2] * f[4 * j + 2] + f[4 * j + 3] * f[4 * j + 3];
      }
      ss = wave_sum(ss);
      const float rstd = rsqrtf(ss * (1.f / 1024.f) + 1e-6f);
#pragma unroll
      for (int j = 0; j < 4; ++j) {
        x[j].x += gt4[j].x * (f[4 * j] * rstd * ga4[j].x);
        x[j].y += gt4[j].y * (f[4 * j + 1] * rstd * ga4[j].y);
        x[j].z += gt4[j].z * (f[4 * j + 2] * rstd * ga4[j].z);
        x[j].w += gt4[j].w * (f[4 * j + 3] * rstd * ga4[j].w);
        *(float4*)(X + (size_t)row * 1024 + 4 * lane + 256 * j) = x[j];
      }
    }
    if (do_h) {
      float ss = 0.f;
#pragma unroll
      for (int j = 0; j < 4; ++j) ss += x[j].x * x[j].x + x[j].y * x[j].y + x[j].z * x[j].z + x[j].w * x[j].w;
      ss = wave_sum(ss);
      const float rstd = rsqrtf(ss * (1.f / 1024.f) + 1e-6f);
#pragma unroll
      for (int j = 0; j < 4; ++j) {
        const float h0 = x[j].x * rstd * g4[j].x * (1.f + c4[j].x) + s4[j].x;
        const float h1 = x[j].y * rstd * g4[j].y * (1.f + c4[j].y) + s4[j].y;
        const float h2 = x[j].z * rstd * g4[j].z * (1.f + c4[j].z) + s4[j].z;
        const float h3 = x[j].w * rstd * g4[j].w * (1.f + c4[j].w) + s4[j].w;
        uint2 o; o.x = pack2(h0, h1); o.y = pack2(h2, h3);
        *(uint2*)(H + (size_t)row * P1024 + 4 * lane + 256 * j) = o;
      }
    }
  }
#undef NLOAD
}

enum { EPI_F32 = 0, EPI_BF16 = 1, EPI_RELU2 = 2, EPI_NAT = 3 };
struct GemmDesc { const u16* A; const u16* Bt; void* dst; int lda, ldb, ldc, M, N, K, epi; };

DI void gemm_tile(const GemmDesc& g, int m0, int n0, float* outp, char* smem) {
  constexpr int LS = 72;
  constexpr int BM = 192, BN = 256;
  u16* As = (u16*)smem;
  u16* Bs = As + 2 * BM * LS;
  const int tid = ltid(), lane = tid & 63, w = tid >> 6, r = lane & 31, h = lane >> 5;
  const int wm = w >> 2, wn = w & 3;
  const int lrow = tid >> 3, lcc = tid & 7;
  const int Mlast = g.M - 1;
  const char* Ab = (const char*)g.A;
  const char* Bb = (const char*)g.Bt;
  const unsigned ao0 = (unsigned)(min(m0 + lrow, Mlast) * g.lda + lcc * 8) * 2u;
  const unsigned ao1 = (unsigned)(min(m0 + lrow + 64, Mlast) * g.lda + lcc * 8) * 2u;
  const unsigned ao2 = (unsigned)(min(m0 + lrow + 128, Mlast) * g.lda + lcc * 8) * 2u;
  const unsigned bo0 = (unsigned)((n0 + lrow) * g.ldb + lcc * 8) * 2u;
  const unsigned bst = (unsigned)(64 * g.ldb) * 2u;
  uint4 pa0, pa1, pa2, pb0, pb1, pb2, pb3;
  f32x16 acc00, acc01, acc10, acc11, acc20, acc21;
#pragma unroll
  for (int i = 0; i < 16; ++i) { acc00[i] = 0.f; acc01[i] = 0.f; acc10[i] = 0.f; acc11[i] = 0.f; acc20[i] = 0.f; acc21[i] = 0.f; }
#define GLOAD(R, kt_)                                                                                  \
  {                                                                                                    \
    const char* ak = Ab + (size_t)(kt_) * 128; const char* bk = Bb + (size_t)(kt_) * 128;              \
    R##a0 = *(const uint4*)(ak + ao0); R##a1 = *(const uint4*)(ak + ao1); R##a2 = *(const uint4*)(ak + ao2); \
    R##b0 = *(const uint4*)(bk + bo0); R##b1 = *(const uint4*)(bk + bo0 + bst);                        \
    R##b2 = *(const uint4*)(bk + bo0 + 2 * bst); R##b3 = *(const uint4*)(bk + bo0 + 3 * bst);          \
  }
#define LSTORE(R, buf)                                                                  \
  *(uint4*)&As[(buf) * BM * LS + (lrow) * LS + lcc * 8] = R##a0;                         \
  *(uint4*)&As[(buf) * BM * LS + (lrow + 64) * LS + lcc * 8] = R##a1;                    \
  *(uint4*)&As[(buf) * BM * LS + (lrow + 128) * LS + lcc * 8] = R##a2;                   \
  *(uint4*)&Bs[(buf) * BN * LS + (lrow) * LS + lcc * 8] = R##b0;                         \
  *(uint4*)&Bs[(buf) * BN * LS + (lrow + 64) * LS + lcc * 8] = R##b1;                    \
  *(uint4*)&Bs[(buf) * BN * LS + (lrow + 128) * LS + lcc * 8] = R##b2;                   \
  *(uint4*)&Bs[(buf) * BN * LS + (lrow + 192) * LS + lcc * 8] = R##b3;
#define FRAGS(X, kk)                                                                    \
  X##a0 = *(const bf16x8*)(Ac + 16 * (kk));                                             \
  X##a1 = *(const bf16x8*)(Ac + 32 * LS + 16 * (kk));                                   \
  X##a2 = *(const bf16x8*)(Ac + 64 * LS + 16 * (kk));                                   \
  X##b0 = *(const bf16x8*)(Bc + 16 * (kk));                                             \
  X##b1 = *(const bf16x8*)(Bc + 32 * LS + 16 * (kk));
#define MMAS(X)                                                                         \
  acc00 = MFMA(X##a0, X##b0, acc00); acc01 = MFMA(X##a0, X##b1, acc01);                 \
  acc10 = MFMA(X##a1, X##b0, acc10); acc11 = MFMA(X##a1, X##b1, acc11);                 \
  acc20 = MFMA(X##a2, X##b0, acc20); acc21 = MFMA(X##a2, X##b1, acc21);
#define COMPUTE(buf)                                                                    \
  {                                                                                     \
    const u16* Ac = As + (buf) * BM * LS + (96 * wm + r) * LS + 8 * h;                  \
    const u16* Bc = Bs + (buf) * BN * LS + (64 * wn + r) * LS + 8 * h;                  \
    bf16x8 xa0, xa1, xa2, xb0, xb1, ya0, ya1, ya2, yb0, yb1;                            \
    FRAGS(x, 0) __builtin_amdgcn_sched_barrier(0);                                      \
    FRAGS(y, 1) __builtin_amdgcn_sched_barrier(0); MMAS(x) __builtin_amdgcn_sched_barrier(0); \
    FRAGS(x, 2) __builtin_amdgcn_sched_barrier(0); MMAS(y) __builtin_amdgcn_sched_barrier(0); \
    FRAGS(y, 3) __builtin_amdgcn_sched_barrier(0); MMAS(x) __builtin_amdgcn_sched_barrier(0); \
    MMAS(y)                                                                             \
  }
  const int KT = g.K >> 6;
  GLOAD(p, 0)
  LSTORE(p, 0)
  __syncthreads();
  for (int kt = 0; kt < KT; kt += 2) {
    GLOAD(p, min(kt + 1, KT - 1))
    __builtin_amdgcn_sched_barrier(0);
    COMPUTE(0)
    LSTORE(p, 1)
    __syncthreads();
    GLOAD(p, min(kt + 2, KT - 1))
    __builtin_amdgcn_sched_barrier(0);
    COMPUTE(1)
    LSTORE(p, 0)
    __syncthreads();
  }
#undef GLOAD
#undef LSTORE
#undef FRAGS
#undef MMAS
#undef COMPUTE
  const int epi = g.epi;
#define EPI_LOOP(BODY)                                                                                         \
  _Pragma("unroll") for (int mi = 0; mi < 3; ++mi)                                                             \
  _Pragma("unroll") for (int ni = 0; ni < 2; ++ni) {                                                           \
    const int col = n0 + 64 * wn + 32 * ni + r;                                                                \
    _Pragma("unroll") for (int i = 0; i < 16; ++i) {                                                           \
      const int row = m0 + 96 * wm + 32 * mi + crow(i, h);                                                     \
      const float v = mi == 0 ? (ni == 0 ? acc00[i] : acc01[i]) : (mi == 1 ? (ni == 0 ? acc10[i] : acc11[i]) : (ni == 0 ? acc20[i] : acc21[i])); \
      BODY                                                                                                     \
    }                                                                                                          \
  }
  if (epi == EPI_F32) {
    float* dst = (float*)g.dst;
    EPI_LOOP(dst[(size_t)row * g.ldc + col] = v;)
  } else if (epi == EPI_RELU2) {
    u16* dst = (u16*)g.dst;
    EPI_LOOP(const float t = v > 0.f ? v : 0.f; dst[(size_t)row * g.ldc + col] = f2bf(t * t);)
  } else if (epi == EPI_BF16) {
    u16* dst = (u16*)g.dst;
    EPI_LOOP(if (row <= Mlast) dst[(size_t)row * g.ldc + col] = f2bf(v);)
  } else {
    u16* dst = (u16*)g.dst;
    EPI_LOOP(dst[(size_t)row * g.ldc + col] = f2bf(v);
             if (row < NCTX && col >= 1024) outp[(col < 2048 ? O_L3K - 1024 : O_L3V - 2048) + (size_t)row * 1024 + col] = v;)
  }
#undef EPI_LOOP
}

DI void gemm_phase(const KA& p, const GemmDesc& g0, const GemmDesc& g1, int ng, char* smem) {
  const int nt0 = g0.N >> 8, mt0 = (g0.M + 191) / 192;
  const int CN = (nt0 & 3) == 0 ? 4 : ((nt0 & 1) == 0 ? 2 : 1), CM = 32 / CN;
  if (ng == 1 && gridDim.x == 256 && (mt0 % CM) == 0) {
    const int x = blockIdx.x & 7, s = blockIdx.x >> 3, mi = s / CN, ni = s - mi * CN;
    const int ncn = nt0 / CN, nchunks = (mt0 / CM) * ncn;
    for (int rep = 0; rep < REP_GEMM; ++rep)
    for (int c = x; c < nchunks; c += 8) {
      const int cm = c / ncn, cn = c - cm * ncn;
      gemm_tile(g0, (cm * CM + mi) * 192, (cn * CN + ni) * 256, p.out(), smem);
    }
    return;
  }
  const int t0 = mt0 * nt0;
  const int t1 = ng > 1 ? ((g1.M + 191) / 192) * (g1.N >> 8) : 0;
  for (int rep = 0; rep < REP_GEMM; ++rep)
  for (int t = blockIdx.x; t < t0 + t1; t += gridDim.x) {
    const bool first = t < t0;
    GemmDesc g;
    g.A = first ? g0.A : g1.A; g.Bt = first ? g0.Bt : g1.Bt; g.dst = first ? g0.dst : g1.dst;
    g.lda = first ? g0.lda : g1.lda; g.ldb = first ? g0.ldb : g1.ldb; g.ldc = first ? g0.ldc : g1.ldc;
    g.M = first ? g0.M : g1.M; g.N = first ? g0.N : g1.N; g.K = first ? g0.K : g1.K; g.epi = first ? g0.epi : g1.epi;
    const int tt = first ? t : t - t0;
    const int nt = g.N >> 8;
    gemm_tile(g, (tt / nt) * 192, (tt % nt) * 256, p.out(), smem);
  }
}

DI void pp_attn(const KA& p) {
  const int tid_ = ltid(); const int lane = tid_ & 63, w = tid_ >> 6;
  const float* Z = (const float*)(p.ws() + OFF_UZ);
  u16* QKV = (u16*)(p.ws() + OFF_QO);
  const float* tab = (const float*)(p.ws() + OFF_ROPE);
  const float* qn = p.in(18);
  const float* kn = p.in(19);
  for (int row = blockIdx.x * NWAVE + w; row < NTOK; row += gridDim.x * NWAVE) {
    const bool lat = row >= NCTX;
    const int t = (row - NCTX) & 1023, pr = t >> 6, pc = t & 63;
    const float* z = Z + (size_t)row * 1536;
    u16* o = QKV + (size_t)row * 1536;
    const int i = lane & 31;
    const float c0 = tab[(pr * 32 + i) * 2], s0 = tab[(pr * 32 + i) * 2 + 1];
    const float c1 = tab[(pc * 32 + i) * 2], s1 = tab[(pc * 32 + i) * 2 + 1];
    const float sg = lane < 32 ? -1.f : 1.f;
    for (int hd = 0; hd < 10; ++hd) {
      const float v0 = z[hd * 128 + lane], v1 = z[hd * 128 + 64 + lane];
      const float ss = wave_sum(v0 * v0 + v1 * v1);
      const float rstd = rsqrtf(ss * (1.f / 128.f) + 1e-6f);
      const float* g = hd < 8 ? qn : kn;
      float y0 = v0 * rstd * g[lane], y1 = v1 * rstd * g[64 + lane];
      if (hd >= 8 && !lat) {
        p.out()[O_L0K + (size_t)row * 256 + (hd - 8) * 128 + lane] = y0;
        p.out()[O_L0K + (size_t)row * 256 + (hd - 8) * 128 + 64 + lane] = y1;
      }
      const float p0 = __shfl_xor(y0, 32, 64), p1 = __shfl_xor(y1, 32, 64);
      if (lat) {
        y0 = y0 * c0 + sg * p0 * s0;
        y1 = y1 * c1 + sg * p1 * s1;
      }
      o[hd * 128 + lane] = f2bf(y0);
      o[hd * 128 + 64 + lane] = f2bf(y1);
    }
#pragma unroll
    for (int j = 0; j < 4; ++j) {
      const float v = z[1280 + 64 * j + lane];
      o[1280 + 64 * j + lane] = f2bf(v);
      if (!lat) p.out()[O_L0V + (size_t)row * 256 + 64 * j + lane] = v;
    }
  }
}

DI void pp_swa(const KA& p) {
  const int tid_ = ltid(); const int lane = tid_ & 63, w = tid_ >> 6;
  const float* Z = (const float*)(p.ws() + OFF_UZ);
  u16* QKV = (u16*)(p.ws() + OFF_QO);
  const float* tab = (const float*)(p.ws() + OFF_ROPE) + 1 * 64 * 32 * 2;
  for (int row = blockIdx.x * NWAVE + w; row < NTOK; row += gridDim.x * NWAVE) {
    const bool lat = row >= NCTX;
    const int t = (row - NCTX) & 1023, pr = t >> 6, pc = t & 63;
    const float* z = Z + (size_t)row * 1536;
    u16* o = QKV + (size_t)row * 1536;
    const int i = lane & 15, axis = lane >> 5, half = (lane >> 4) & 1;
    const int pos = axis ? pc : pr;
    const float c = tab[(pos * 32 + i) * 2], s = tab[(pos * 32 + i) * 2 + 1];
    const float sg = half ? 1.f : -1.f;
    for (int hd = 0; hd < 20; ++hd) {
      float v = z[hd * 64 + lane];
      if (hd >= 16 && !lat) p.out()[O_L2K + (size_t)row * 256 + (hd - 16) * 64 + lane] = v;
      const float pv = __shfl_xor(v, 16, 64);
      if (lat) v = v * c + sg * pv * s;
      o[hd * 64 + lane] = f2bf(v);
    }
#pragma unroll
    for (int j = 0; j < 4; ++j) {
      const float v = z[1280 + 64 * j + lane];
      o[1280 + 64 * j + lane] = f2bf(v);
      if (!lat) p.out()[O_L2V + (size_t)row * 256 + 64 * j + lane] = v;
    }
  }
}

DI void pp_mla1(const KA& p) {
  const int tid_ = ltid(); const int lane = tid_ & 63, w = tid_ >> 6;
  const float* Z = (const float*)(p.ws() + OFF_UZ);
  u16* CQ = (u16*)(p.ws() + OFF_CQ);
  u16* CKV = (u16*)(p.ws() + OFF_CKV);
  u16* KPE = (u16*)(p.ws() + OFF_KPE);
  const float* tab = (const float*)(p.ws() + OFF_ROPE) + 2 * 64 * 32 * 2;
  const float* qn = p.in(22);
  const float* kvn = p.in(23);
  for (int row = blockIdx.x * NWAVE + w; row < NTOK; row += gridDim.x * NWAVE) {
    const bool lat = row >= NCTX;
    const int t = (row - NCTX) & 1023, pr = t >> 6, pc = t & 63;
    const float* z = Z + (size_t)row * 768;
    float a[6];
    float ss = 0.f;
#pragma unroll
    for (int j = 0; j < 6; ++j) { a[j] = z[64 * j + lane]; ss += a[j] * a[j]; }
    ss = wave_sum(ss);
    float rstd = rsqrtf(ss * (1.f / 384.f) + 1e-6f);
#pragma unroll
    for (int j = 0; j < 6; ++j) CQ[(size_t)row * P384 + 64 * j + lane] = f2bf(a[j] * rstd * qn[64 * j + lane]);
    ss = 0.f;
#pragma unroll
    for (int j = 0; j < 4; ++j) { a[j] = z[384 + 64 * j + lane]; ss += a[j] * a[j]; }
    ss = wave_sum(ss);
    rstd = rsqrtf(ss * (1.f / 256.f) + 1e-6f);
#pragma unroll
    for (int j = 0; j < 4; ++j) {
      const float y = a[j] * rstd * kvn[64 * j + lane];
      CKV[(size_t)row * P256 + 64 * j + lane] = f2bf(y);
      if (!lat) p.out()[O_L1CKV + (size_t)row * 256 + 64 * j + lane] = y;
    }
    const int e = lane & 31;
    float v = z[640 + e];
    const float pv = __shfl_xor(v, 8, 64);
    if (lat) {
      const int i = e & 7, axis = e >> 4, half = (e >> 3) & 1;
      const int pos = axis ? pc : pr;
      const float c = tab[(pos * 32 + i) * 2], s = tab[(pos * 32 + i) * 2 + 1];
      v = v * c + (half ? pv : -pv) * s;
    }
    if (lane < 32) {
      KPE[(size_t)row * 32 + e] = f2bf(v);
      if (!lat) p.out()[O_L1KPE + (size_t)row * 32 + e] = v;
    }
  }
}

DI void pp_mla2(const KA& p) {
  const int tid_ = ltid(); const int lane = tid_ & 63, w = tid_ >> 6;
  const float* Z = (const float*)(p.ws() + OFF_UZ);
  u16* Q = (u16*)(p.ws() + OFF_QO);
  const float* tab = (const float*)(p.ws() + OFF_ROPE) + 2 * 64 * 32 * 2;
  for (int row = blockIdx.x * NWAVE + w; row < NTOK; row += gridDim.x * NWAVE) {
    const bool lat = row >= NCTX;
    const int t = (row - NCTX) & 1023, pr = t >> 6, pc = t & 63;
    const float* z = Z + (size_t)row * 1536;
    for (int j = 0; j < 24; ++j) {
      const int col = 64 * j + lane;
      float v = z[col];
      const float pv = __shfl_xor(v, 8, 64);
      const int d = col % 96;
      if (lat && d >= 64) {
        const int e = d - 64;
        const int i = e & 7, axis = e >> 4, half = (e >> 3) & 1;
        const int pos = axis ? pc : pr;
        const float c = tab[(pos * 32 + i) * 2], s = tab[(pos * 32 + i) * 2 + 1];
        v = v * c + (half ? pv : -pv) * s;
      }
      Q[(size_t)row * 1536 + col] = f2bf(v);
    }
  }
}

struct Seg { const u16* k1; const u16* k2; const u16* v; int ldk1, ldk2, ldv, n0, n1, mode; };

template <int HDQK, int HDV>
DI void attn_item(const u16* __restrict__ Qp, int ldq, const Seg& sA, const Seg& sB, int nseg, int qpos0,
                  float scale_l2, const float* __restrict__ rpb_h, bool has_sink, float sink_l2,
                  u16* __restrict__ Op, int ldo, char* smem) {
  constexpr int K1W = (HDQK == 96) ? 64 : HDQK;
  constexpr int KS = HDQK + 8, VS = HDV + 8;
  constexpr int KC = HDQK / 8, VC = HDV / 8;
  u16* Ks = (u16*)smem;
  u16* Vs = Ks + 64 * KS;
  float* rp = (float*)(Vs + 64 * VS);
  const int tid = ltid(), lane = tid & 63, w = tid >> 6, r = lane & 31, h = lane >> 5;
  const int q4 = (lane & 15) >> 2, p4 = lane & 3, dblk = (lane >> 4) & 1;

  __syncthreads();
  if (rpb_h) for (int e = tid; e < 465; e += NTHR) rp[e] = rpb_h[e];

  bf16x8 qf[HDQK / 16];
  {
    const u16* qrow = Qp + (size_t)(32 * w + r) * ldq + 8 * h;
#pragma unroll
    for (int kk = 0; kk < HDQK / 16; ++kk) qf[kk] = *(const bf16x8*)(qrow + 16 * kk);
  }
  f32x16 o[HDV / 32];
#pragma unroll
  for (int dt = 0; dt < HDV / 32; ++dt)
#pragma unroll
    for (int i = 0; i < 16; ++i) o[dt][i] = 0.f;
  float m = -1e30f, l = 0.f;
  const int qpos = qpos0 + 32 * w + r;
  const int qr = qpos >> 6, qc = qpos & 63;
  const int r0 = min(max(qr - 4, 0), 8), c0 = min(max(qc - 8, 0), 48);

  constexpr int KI = (64 * KC + NTHR - 1) / NTHR, VI = (64 * VC + NTHR - 1) / NTHR;
  const int TA = (sA.n1 - sA.n0) >> 6;
  const int T = TA + (nseg > 1 ? ((sB.n1 - sB.n0) >> 6) : 0);
  uint4 kreg0 = make_uint4(0, 0, 0, 0), kreg1 = kreg0, vreg0 = kreg0, vreg1 = kreg0;
#define ATT_KADDR(i, p1, p2, l1, l2, nn)                                                               \
  const int kc_##i = tid + NTHR * i; const int krow_##i = kc_##i / KC, kcc_##i = kc_##i - krow_##i * KC; \
  const u16* ksrc_##i = (kcc_##i * 8 < K1W) ? p1 + (size_t)(nn + krow_##i) * l1 + kcc_##i * 8          \
                                            : p2 + (size_t)(nn + krow_##i) * l2 + (kcc_##i * 8 - K1W);
#define ATT_FETCH(t)                                                                                   \
  {                                                                                                    \
    const bool fa = (t) < TA;                                                                          \
    const u16* fk1 = fa ? sA.k1 : sB.k1; const u16* fk2 = fa ? sA.k2 : sB.k2; const u16* fv = fa ? sA.v : sB.v; \
    const int fl1 = fa ? sA.ldk1 : sB.ldk1, fl2 = fa ? sA.ldk2 : sB.ldk2, flv = fa ? sA.ldv : sB.ldv;   \
    const int fn = fa ? sA.n0 + 64 * (t) : sB.n0 + 64 * ((t) - TA);                                    \
    { ATT_KADDR(0, fk1, fk2, fl1, fl2, fn) kreg0 = *(const uint4*)ksrc_0; }                            \
    if (KI > 1) { ATT_KADDR(1, fk1, fk2, fl1, fl2, fn) if (64 * KC % NTHR == 0 || kc_1 < 64 * KC) kreg1 = *(const uint4*)ksrc_1; } \
    { const int c = tid; const int row = c / VC, cc = c - row * VC; vreg0 = *(const uint4*)(fv + (size_t)(fn + row) * flv + cc * 8); } \
    if (VI > 1) { const int c = tid + NTHR; const int row = c / VC, cc = c - row * VC; vreg1 = *(const uint4*)(fv + (size_t)(fn + row) * flv + cc * 8); } \
  }
  ATT_FETCH(0)
  for (int t = 0; t < T; ++t) {
    {
      const bool ca = t < TA;
      const int mode = ca ? sA.mode : sB.mode;
      const int n = ca ? sA.n0 + 64 * t : sB.n0 + 64 * (t - TA);
      __syncthreads();
      { const int c = tid; const int row = c / KC, cc = c - row * KC; *(uint4*)&Ks[row * KS + cc * 8] = kreg0; }
      if (KI > 1) { const int c = tid + NTHR; if (64 * KC % NTHR == 0 || c < 64 * KC) { const int row = c / KC, cc = c - row * KC; *(uint4*)&Ks[row * KS + cc * 8] = kreg1; } }
      { const int c = tid; const int row = c / VC, cc = c - row * VC; *(uint4*)&Vs[row * VS + cc * 8] = vreg0; }
      if (VI > 1) { const int c = tid + NTHR; const int row = c / VC, cc = c - row * VC; *(uint4*)&Vs[row * VS + cc * 8] = vreg1; }
      __syncthreads();
      if (t + 1 < T) ATT_FETCH(t + 1)
      const int qw = qpos0 + 32 * w;
      bool skip = false;
      if (mode == 1) skip = (n > qw + 31 + 128) || (n + 63 < qw - 128);
      else if (mode == 2) { const int r0w = min(max((qw >> 6) - 4, 0), 8); const int kr = n >> 6; skip = (kr < r0w) || (kr >= r0w + 8); }
      if (skip) continue;
      f32x16 st[2];
#pragma unroll
      for (int kt = 0; kt < 2; ++kt) {
#pragma unroll
        for (int i = 0; i < 16; ++i) st[kt][i] = 0.f;
        const u16* kb = Ks + (32 * kt + r) * KS + 8 * h;
#pragma unroll
        for (int kk = 0; kk < HDQK / 16; ++kk) {
          const bf16x8 a = *(const bf16x8*)(kb + 16 * kk);
          st[kt] = MFMA(a, qf[kk], st[kt]);
        }
      }
      float mx = -1e30f;
      if (mode == 0) {
#pragma unroll
        for (int kt = 0; kt < 2; ++kt)
#pragma unroll
          for (int i = 0; i < 16; ++i) { const float v = st[kt][i] * scale_l2; st[kt][i] = v; mx = fmaxf(mx, v); }
      } else if (mode == 1) {
#pragma unroll
        for (int kt = 0; kt < 2; ++kt)
#pragma unroll
          for (int i = 0; i < 16; ++i) {
            const int kpos = n + 32 * kt + crow(i, h);
            const int d = qpos - kpos;
            float v = st[kt][i] * scale_l2;
            if (d > 128 || d < -128) v = -1e30f;
            st[kt][i] = v; mx = fmaxf(mx, v);
          }
      } else {
#pragma unroll
        for (int kt = 0; kt < 2; ++kt)
#pragma unroll
          for (int i = 0; i < 16; ++i) {
            const int kpos = n + 32 * kt + crow(i, h);
            const int kr = kpos >> 6, kc = kpos & 63;
            const bool ok = ((unsigned)(kr - r0) < 8u) && ((unsigned)(kc - c0) < 16u);
            const int idx = ok ? (kr - qr + 7) * 31 + (kc - qc + 15) : 0;
            const float b = rp[idx];
            float v = st[kt][i] * scale_l2 + b * LOG2E;
            if (!ok) v = -1e30f;
            st[kt][i] = v; mx = fmaxf(mx, v);
          }
      }
      mx = fmaxf(mx, __shfl_xor(mx, 32, 64));
      const float mn = fmaxf(m, mx);
      const float alpha = __builtin_amdgcn_exp2f(m - mn);
      m = mn;
      float rs = 0.f;
#pragma unroll
      for (int kt = 0; kt < 2; ++kt)
#pragma unroll
        for (int i = 0; i < 16; ++i) { const float pz = __builtin_amdgcn_exp2f(st[kt][i] - mn); st[kt][i] = pz; rs += pz; }
      rs += __shfl_xor(rs, 32, 64);
      l = l * alpha + rs;
#pragma unroll
      for (int dt = 0; dt < HDV / 32; ++dt)
#pragma unroll
        for (int i = 0; i < 16; ++i) o[dt][i] *= alpha;
#pragma unroll
      for (int kt = 0; kt < 2; ++kt)
#pragma unroll
        for (int s2 = 0; s2 < 2; ++s2) {
          unsigned pk[4];
#pragma unroll
          for (int j = 0; j < 4; ++j) pk[j] = pack2(st[kt][8 * s2 + 2 * j], st[kt][8 * s2 + 2 * j + 1]);
          bf16x8 pb;
          {
            typedef unsigned u32x4 __attribute__((ext_vector_type(4)));
            u32x4 t4 = {pk[0], pk[1], pk[2], pk[3]};
            pb = __builtin_bit_cast(bf16x8, t4);
          }
          const u16* vb = Vs + (32 * kt + 16 * s2 + 4 * h + q4) * VS + 16 * dblk + 4 * p4;
#pragma unroll
          for (int dt = 0; dt < HDV / 32; ++dt) {
            const s16x4 lo = __builtin_amdgcn_ds_read_tr16_b64_v4i16((LDS3 s16x4*)(vb + 32 * dt));
            const s16x4 hi = __builtin_amdgcn_ds_read_tr16_b64_v4i16((LDS3 s16x4*)(vb + 8 * VS + 32 * dt));
            const bf16x8 va = __builtin_shufflevector(lo, hi, 0, 1, 2, 3, 4, 5, 6, 7);
            o[dt] = MFMA(va, pb, o[dt]);
          }
        }
    }
  }
#undef ATT_FETCH
#undef ATT_KADDR
  if (has_sink) l += __builtin_amdgcn_exp2f(sink_l2 - m);
  const float inv = 1.f / l;
  u16* orow = Op + (size_t)(32 * w + r) * ldo + 4 * h;
#pragma unroll
  for (int dt = 0; dt < HDV / 32; ++dt)
#pragma unroll
    for (int g = 0; g < 4; ++g) {
      uint2 v;
      v.x = pack2(o[dt][4 * g] * inv, o[dt][4 * g + 1] * inv);
      v.y = pack2(o[dt][4 * g + 2] * inv, o[dt][4 * g + 3] * inv);
      *(uint2*)(orow + 32 * dt + 8 * g) = v;
    }
}

DI void attn_phase(const KA& p, int kind, char* smem) {
  const int Hq = kind == 0 ? 8 : 16;
  const int nlat = 8 * Hq * 4, nctx = 16 * Hq;
  u16* AO = (u16*)(p.ws() + OFF_HAO);
  const u16* QKV = (const u16*)(p.ws() + OFF_QO);
  for (int rep = 0; rep < REP_ATT; ++rep)
  for (int item = blockIdx.x; item < nlat + nctx; item += gridDim.x) {
    const bool lat = item < nlat;
    int b, hq, qt;
    if (lat) { b = item / (Hq * 4); const int rem = item - b * Hq * 4; hq = rem >> 2; qt = rem & 3; }
    else { const int it = item - nlat; b = it / Hq; hq = it - b * Hq; qt = 0; }
    const int tok0 = lat ? NCTX + b * 1024 : b * 256;
    const int S = lat ? 1024 : 256;
    const int qrow0 = tok0 + qt * 256;
    Seg sc, ss;
    sc.k2 = nullptr; sc.ldk2 = 0; ss.k2 = nullptr; ss.ldk2 = 0;
    sc.n0 = 0; sc.n1 = 512; sc.mode = 0;
    ss.n0 = 0; ss.n1 = S; ss.mode = 0;
    const u16* Qp; int ldq; float sl2; const float* rpb = nullptr; bool has_sink = false; float sink_l2 = 0.f;
    u16* Op;
    if (kind == 0) {
      const int kvh = hq >> 2;
      ss.k1 = QKV + (size_t)tok0 * 1536 + 1024 + kvh * 128; ss.ldk1 = 1536;
      ss.v = QKV + (size_t)tok0 * 1536 + 1280 + kvh * 128; ss.ldv = 1536;
      sc.k1 = (const u16*)(p.ws() + OFF_CK) + (size_t)b * 512 * 256 + kvh * 128; sc.ldk1 = 256;
      sc.v = (const u16*)(p.ws() + OFF_CV) + (size_t)b * 512 * 256 + kvh * 128; sc.ldv = 256;
      sl2 = 0.08838834764831845f * LOG2E;
      Qp = QKV + (size_t)qrow0 * 1536 + hq * 128; ldq = 1536;
      Op = AO + (size_t)qrow0 * P1024 + hq * 128;
    } else if (kind == 1) {
      const u16* KV = (const u16*)(p.ws() + OFF_KV);
      const u16* KPE = (const u16*)(p.ws() + OFF_KPE);
      ss.k1 = KV + (size_t)tok0 * 2048 + hq * 128; ss.ldk1 = 2048;
      ss.k2 = KPE + (size_t)tok0 * 32; ss.ldk2 = 32;
      ss.v = KV + (size_t)tok0 * 2048 + hq * 128 + 64; ss.ldv = 2048;
      const size_t crow0 = 12288 + (size_t)b * 512;
      sc.k1 = KV + crow0 * 2048 + hq * 128; sc.ldk1 = 2048;
      sc.k2 = KPE + crow0 * 32; sc.ldk2 = 32;
      sc.v = KV + crow0 * 2048 + hq * 128 + 64; sc.ldv = 2048;
      sl2 = 0.10206207261596575f * LOG2E;
      Qp = QKV + (size_t)qrow0 * 1536 + hq * 96; ldq = 1536;
      Op = AO + (size_t)qrow0 * P1024 + hq * 64;
    } else if (kind == 2) {
      const int kvh = hq >> 2;
      ss.k1 = QKV + (size_t)tok0 * 1536 + 1024 + kvh * 64; ss.ldk1 = 1536;
      ss.v = QKV + (size_t)tok0 * 1536 + 1280 + kvh * 64; ss.ldv = 1536;
      sc.k1 = (const u16*)(p.ws() + OFF_CK) + (size_t)b * 512 * 256 + kvh * 64; sc.ldk1 = 256;
      sc.v = (const u16*)(p.ws() + OFF_CV) + (size_t)b * 512 * 256 + kvh * 64; sc.ldv = 256;
      sl2 = 0.125f * LOG2E;
      has_sink = true; sink_l2 = p.in(28)[hq] * LOG2E;
      if (lat) { ss.n0 = max(0, qt * 256 - 128); ss.n1 = min(1024, qt * 256 + 384); ss.mode = 1; }
      Qp = QKV + (size_t)qrow0 * 1536 + hq * 64; ldq = 1536;
      Op = AO + (size_t)qrow0 * P1024 + hq * 64;
    } else {
      ss.k1 = QKV + (size_t)tok0 * 3072 + 1024 + hq * 64; ss.ldk1 = 3072;
      ss.v = QKV + (size_t)tok0 * 3072 + 2048 + hq * 64; ss.ldv = 3072;
      sc.k1 = (const u16*)(p.ws() + OFF_C3K) + (size_t)b * 512 * 1024 + hq * 64; sc.ldk1 = 1024;
      sc.v = (const u16*)(p.ws() + OFF_C3V) + (size_t)b * 512 * 1024 + hq * 64; sc.ldv = 1024;
      sl2 = 0.125f * LOG2E;
      if (lat) {
        const int r0a = min(max(4 * qt - 4, 0), 8), r0b = min(max(4 * qt - 1, 0), 8);
        ss.n0 = r0a * 64; ss.n1 = (r0b + 8) * 64; ss.mode = 2;
        rpb = p.in(31) + hq * 465;
      }
      Qp = QKV + (size_t)qrow0 * 3072 + hq * 64; ldq = 3072;
      Op = AO + (size_t)qrow0 * P1024 + hq * 64;
    }
    Seg s0;
    s0.k1 = lat ? sc.k1 : ss.k1; s0.k2 = lat ? sc.k2 : ss.k2; s0.v = lat ? sc.v : ss.v;
    s0.ldk1 = lat ? sc.ldk1 : ss.ldk1; s0.ldk2 = lat ? sc.ldk2 : ss.ldk2; s0.ldv = lat ? sc.ldv : ss.ldv;
    s0.n0 = lat ? sc.n0 : ss.n0; s0.n1 = lat ? sc.n1 : ss.n1; s0.mode = lat ? sc.mode : ss.mode;
    const int nseg = lat ? 2 : 1;
    if (kind == 0) attn_item<128, 128>(Qp, ldq, s0, ss, nseg, qt * 256, sl2, rpb, has_sink, sink_l2, Op, P1024, smem);
    else if (kind == 1) attn_item<96, 64>(Qp, ldq, s0, ss, nseg, qt * 256, sl2, rpb, has_sink, sink_l2, Op, P1024, smem);
    else attn_item<64, 64>(Qp, ldq, s0, ss, nseg, qt * 256, sl2, rpb, has_sink, sink_l2, Op, P1024, smem);
  }
}

__host__ __device__ inline bool phase_exists(int ph) {
  if (ph == 0 || ph == 41) return true;
  const int l = (ph - 1) / 10, s = (ph - 1) % 10;
  if ((s == 3 || s == 4) && l != 1) return false;
  if (s == 2 && l == 3) return false;
  return true;
}

DI void run_phase(const KA& p, int ph, char* smem) {
  if (ph == 0) { prepass(p, smem); return; }
  if (ph == 41) { norm_phase(p, 4, 2); return; }
  const int l = (ph - 1) / 10, s = (ph - 1) % 10;
  char* ws = p.ws();
  GemmDesc g0, g1;
  g0 = GemmDesc{nullptr, nullptr, nullptr, 0, 0, 0, 0, 0, 0, 0};
  g1 = g0;
  int ng = 0;
  switch (s) {
    case 0:
      norm_phase(p, l, 0);
      if (l == 2) {
        convert_f32_bf16(p.in(6), (u16*)(ws + OFF_CK), 4096ull * 256);
        convert_f32_bf16(p.in(7), (u16*)(ws + OFF_CV), 4096ull * 256);
      } else if (l == 3) {
        convert_f32_bf16(p.in(8), (u16*)(ws + OFF_C3K), 4096ull * 1024);
        convert_f32_bf16(p.in(9), (u16*)(ws + OFF_C3V), 4096ull * 1024);
      }
      break;
    case 1: {
      const u16* H = (const u16*)(ws + OFF_HAO);
      if (l == 0) g0 = GemmDesc{H, (const u16*)(ws + OFF_AQKV), ws + OFF_UZ, P1024, P1024, 1536, NTOK, 1536, 1024, EPI_F32};
      else if (l == 1) g0 = GemmDesc{H, (const u16*)(ws + OFF_MIN), ws + OFF_UZ, P1024, P1024, 768, NTOK, 768, 1024, EPI_F32};
      else if (l == 2) g0 = GemmDesc{H, (const u16*)(ws + OFF_SQKV), ws + OFF_UZ, P1024, P1024, 1536, NTOK, 1536, 1024, EPI_F32};
      else g0 = GemmDesc{H, (const u16*)(ws + OFF_NQKV), ws + OFF_QO, P1024, P1024, 3072, NTOK, 3072, 1024, EPI_NAT};
      ng = 1;
    } break;
    case 2:
      if (l == 0) pp_attn(p); else if (l == 1) pp_mla1(p); else if (l == 2) pp_swa(p);
      break;
    case 3:
      g0 = GemmDesc{(const u16*)(ws + OFF_CQ), (const u16*)(ws + OFF_MUQ), ws + OFF_UZ, P384, P384, 1536, NTOK, 1536, 384, EPI_F32};
      g1 = GemmDesc{(const u16*)(ws + OFF_CKV), (const u16*)(ws + OFF_MUKV), ws + OFF_KV, P256, P256, 2048, 16384, 2048, 256, EPI_BF16};
      ng = 2;
      break;
    case 4: pp_mla2(p); break;
    case 5: attn_phase(p, l, smem); break;
    case 6: {
      const size_t wo = l == 0 ? OFF_AO_W : (l == 1 ? OFF_MO : (l == 2 ? OFF_SO : OFF_NO));
      g0 = GemmDesc{(const u16*)(ws + OFF_HAO), (const u16*)(ws + wo), ws + OFF_QO, P1024, P1024, 1024, NTOK, 1024, 1024, EPI_BF16};
      ng = 1;
    } break;
    case 7: norm_phase(p, l, 1); break;
    case 8:
      g0 = GemmDesc{(const u16*)(ws + OFF_HAO), (const u16*)(ws + OFF_W1T + (size_t)l * W1T_SZ), ws + OFF_UZ, P1024, P1024, P4096, NTOK, 4096, 1024, EPI_RELU2};
      ng = 1;
      break;
    case 9:
      g0 = GemmDesc{(const u16*)(ws + OFF_UZ), (const u16*)(ws + OFF_W2T + (size_t)l * W2T_SZ), ws + OFF_QO, P4096, P4096, 1024, NTOK, 1024, 4096, EPI_BF16};
      ng = 1;
      break;
  }
  if (ng > 0) gemm_phase(p, g0, g1, ng, smem);
}

#define XB_TMO      128
#define XB_XCNT(j)  (256  + 64 * (j))
#define XB_XSUB(j)  (1280 + 64 * (j))
#define XB_XGEN(j)  (2304 + 64 * (j))
#define XB_TOP      3328
#define XB_TOPGEN   3392
#define XCD_BAR_WORDS 3456
#define XB_SPIN_CAP (1u << 18)
#define LAS __attribute__((address_space(3)))

__device__ __forceinline__ unsigned xb_ld(unsigned* p)              { return __hip_atomic_load(p, __ATOMIC_RELAXED, __HIP_MEMORY_SCOPE_AGENT); }
__device__ __forceinline__ unsigned xb_add(unsigned* p, unsigned v) { return __hip_atomic_fetch_add(p, v, __ATOMIC_RELAXED, __HIP_MEMORY_SCOPE_AGENT); }
__device__ __forceinline__ unsigned xb_xcc_id() { return (unsigned)__builtin_amdgcn_s_getreg((3 << 11) | 20) & 0xFu; }
#define XB_SPIN(cond, bar) do { unsigned _sp = 0; while (cond) { __builtin_amdgcn_s_sleep(1); \
    if ((++_sp & 255u) == 0u) { if (xb_ld(&(bar)[XB_TMO])) break; if (_sp > XB_SPIN_CAP) { atomicAdd(&(bar)[XB_TMO], 1u); break; } } } } while (0)

struct XcdBarrier {
    unsigned* bar; unsigned x;
    volatile LAS unsigned* st;
};

__device__ __forceinline__ XcdBarrier xcd_barrier_post(unsigned* bar, volatile LAS unsigned* st) {
    XcdBarrier b; b.bar = bar; b.x = xb_xcc_id(); b.st = st;
    if (threadIdx.x == 0) (void)xb_add(&bar[XB_XCNT(b.x)], 1u);
    return b;
}
__device__ __forceinline__ void xcd_barrier_complete(unsigned* bar, unsigned x, unsigned& nloc, unsigned& nx) {
    const unsigned G = gridDim.x * gridDim.y * gridDim.z;
    unsigned sum, cnt, mine, sp = 0u;
    for (;;) {
        sum = 0u; cnt = 0u; mine = 0u;
#pragma unroll
        for (unsigned j = 0; j < 16; ++j) { const unsigned c = xb_ld(&bar[XB_XCNT(j)]); sum += c; cnt += (c > 0u) ? 1u : 0u; mine = (j == x) ? c : mine; }
        if (sum == G) break;
        __builtin_amdgcn_s_sleep(1);
        if ((++sp & 255u) == 0u) { if (xb_ld(&bar[XB_TMO])) break; if (sp > XB_SPIN_CAP) { atomicAdd(&bar[XB_TMO], 1u); break; } }
    }
    nloc = mine > 0u ? mine : 1u; nx = cnt > 0u ? cnt : 1u;
}

__device__ __forceinline__ void xcd_barrier(const XcdBarrier& b) {
    asm volatile("s_waitcnt vmcnt(0)" ::: "memory");
    __syncthreads();
    if (threadIdx.x == 0) {
        unsigned* bar = b.bar;
        __builtin_amdgcn_s_waitcnt(0);
        unsigned nloc = b.st[0], nx = b.st[1];
        if (nloc == 0u) { xcd_barrier_complete(bar, b.x, nloc, nx); b.st[0] = nloc; b.st[1] = nx; }
        const unsigned old = xb_add(&bar[XB_XSUB(b.x)], 1u);
        const unsigned gen = old / nloc;
        if (old + 1u == (gen + 1u) * nloc) {
            __builtin_amdgcn_fence(__ATOMIC_RELEASE, "agent");
            asm volatile("s_waitcnt vmcnt(0)" ::: "memory");
            const unsigned og = xb_add(&bar[XB_TOP], 1u);
            const unsigned tg = og / nx;
            if (og + 1u == (tg + 1u) * nx) xb_add(&bar[XB_TOPGEN], 1u);
            else XB_SPIN(xb_ld(&bar[XB_TOPGEN]) == tg, bar);
            __builtin_amdgcn_fence(__ATOMIC_ACQUIRE, "agent");
            xb_add(&bar[XB_XGEN(b.x)], 1u);
            asm volatile("s_waitcnt vmcnt(0)" ::: "memory");
        } else {
            XB_SPIN(xb_ld(&bar[XB_XGEN(b.x)]) == gen, bar);
            __builtin_amdgcn_fence(__ATOMIC_ACQUIRE, "agent");
            asm volatile("s_waitcnt vmcnt(0)" ::: "memory");
        }
    }
    __syncthreads();
}

__global__ void __launch_bounds__(512, 2) mega(Params p) {
  __shared__ __attribute__((aligned(16))) char smem[129024];
  __shared__ uint4 xb_words;
  const bool coop = (p.ph1 - p.ph0) > 1;
  XcdBarrier xb;
  if (coop) {
    if (threadIdx.x == 0) xb_words = make_uint4(0u, 0u, 0u, 0u);
    __syncthreads();
    xb = xcd_barrier_post((unsigned*)(p.ws + OFF_BAR), (volatile LAS unsigned*)&xb_words);
  }
  if (p.ph1 < 0) cg::this_grid().sync();
  for (int ph = p.ph0; ph < p.ph1; ++ph) {
    if (!phase_exists(ph)) continue;
    KA q;
    q.ka = (const AS4 char*)__builtin_amdgcn_kernarg_segment_ptr();
    asm volatile("" : "+s"(q.ka));
    run_phase(q, ph, smem);
    if (ph + 1 < p.ph1) xcd_barrier(xb);
  }
}

extern "C" void kernel_launch(void* const* d_in, const int* in_sizes, int n_in, void* d_out, int out_size,
                              void* d_ws, size_t ws_size, hipStream_t stream) {
  if (n_in < 33 || ws_size < WS_NEED) { fprintf(stderr, "bad args: n_in %d ws %zu need %zu\n", n_in, ws_size, (size_t)WS_NEED); return; }
  Params p{};
  for (int i = 0; i < 33; ++i) p.in[i] = (const float*)d_in[i];
  p.out = (float*)d_out;
  p.ws = (char*)d_ws;
#if N_LAUNCH_MODE == 1
  for (int ph = 0; ph < 42; ++ph) {
    if (!phase_exists(ph)) continue;
    p.ph0 = ph; p.ph1 = ph + 1;
    hipLaunchKernelGGL(mega, dim3(256), dim3(NTHR), 0, stream, p);
  }
#else
  static int grid_blocks = 0;
  if (!grid_blocks) {
    int dev = 0, cus = 0, per_cu = 0;
    hipGetDevice(&dev);
    hipDeviceGetAttribute(&cus, hipDeviceAttributeMultiprocessorCount, dev);
    hipOccupancyMaxActiveBlocksPerMultiprocessor(&per_cu, mega, NTHR, 0);
    if (per_cu > 1) per_cu = 1;
    grid_blocks = cus * per_cu;
  }
  p.ph0 = 0; p.ph1 = 42;
  hipMemsetAsync((char*)d_ws + OFF_BAR, 0, XCD_BAR_WORDS * 4, stream);
  void* args[] = {&p};
  hipError_t e = hipLaunchCooperativeKernel((void*)mega, dim3(grid_blocks), dim3(NTHR), args, 0, stream);
  if (e != hipSuccess) fprintf(stderr, "cooperative launch failed: %s (grid %d)\n", hipGetErrorString(e), grid_blocks);
#endif
}
```

```cpp
#include <hip/hip_runtime.h>
#include <hip/hip_cooperative_groups.h>
#include <cstdio>
namespace cg = cooperative_groups;

typedef unsigned short u16;
typedef short bf16x8 __attribute__((ext_vector_type(8)));
typedef short s16x4 __attribute__((ext_vector_type(4)));
typedef float f32x16 __attribute__((ext_vector_type(16)));
typedef float f32x2 __attribute__((ext_vector_type(2)));
typedef __bf16 bfx2 __attribute__((ext_vector_type(2)));
#define DI __device__ __forceinline__
#define MFMA(a, b, c) __builtin_amdgcn_mfma_f32_32x32x16_bf16((a), (b), (c), 0, 0, 0)
#define LDS3 __attribute__((address_space(3)))

#ifndef REP_GEMM
#define REP_GEMM 1
#endif
#ifndef REP_ATT
#define REP_ATT 1
#endif
#ifndef N_LAUNCH_MODE
#define N_LAUNCH_MODE 0
#endif

constexpr int NTOK = 12288, NCTX = 4096;
constexpr int NTHR = 512, NWAVE = 8;
constexpr float LOG2E = 1.4426950408889634f;

constexpr size_t O_L0K = 12582912, O_L0V = 13631488, O_L1CKV = 14680064, O_L1KPE = 15728640,
                 O_L2K = 15859712, O_L2V = 16908288, O_L3K = 17956864, O_L3V = 22151168;

constexpr int P1024 = 1088, P4096 = 4160, P384 = 448, P256 = 320;
constexpr size_t W1T_SZ = 4096ull * P1024 * 2, W2T_SZ = 1024ull * P4096 * 2;
constexpr size_t OFF_W1T = 0;
constexpr size_t OFF_W2T = OFF_W1T + 4 * W1T_SZ;
constexpr size_t OFF_AQKV = OFF_W2T + 4 * W2T_SZ;
constexpr size_t OFF_AO_W = OFF_AQKV + 1536ull * P1024 * 2;
constexpr size_t OFF_MIN = OFF_AO_W + 1024ull * P1024 * 2;
constexpr size_t OFF_MUQ = OFF_MIN + 768ull * P1024 * 2;
constexpr size_t OFF_MUKV = OFF_MUQ + 1536ull * P384 * 2;
constexpr size_t OFF_MO = OFF_MUKV + 2048ull * P256 * 2;
constexpr size_t OFF_SQKV = OFF_MO + 1024ull * P1024 * 2;
constexpr size_t OFF_SO = OFF_SQKV + 1536ull * P1024 * 2;
constexpr size_t OFF_NQKV = OFF_SO + 1024ull * P1024 * 2;
constexpr size_t OFF_NO = OFF_NQKV + 3072ull * P1024 * 2;
constexpr size_t OFF_MOD = OFF_NO + 1024ull * P1024 * 2;
constexpr size_t OFF_ROPE = OFF_MOD + 4ull * 9 * 6144 * 4;
constexpr size_t OFF_HAO = OFF_ROPE + 3ull * 64 * 32 * 2 * 4;
constexpr size_t OFF_UZ = OFF_HAO + 12288ull * P1024 * 2;
constexpr size_t OFF_QO = OFF_UZ + 12288ull * P4096 * 2;
constexpr size_t OFF_CQ = OFF_QO + 12288ull * 3072 * 2;
constexpr size_t OFF_CKV = OFF_CQ + 12288ull * P384 * 2;
constexpr size_t OFF_KPE = OFF_CKV + 16384ull * P256 * 2;
constexpr size_t OFF_KV = OFF_KPE + 16384ull * 32 * 2;
constexpr size_t OFF_CK = OFF_KV;
constexpr size_t OFF_CV = OFF_KV + 2097152;
constexpr size_t OFF_C3K = OFF_KV + 4194304;
constexpr size_t OFF_C3V = OFF_C3K + 8388608;
constexpr size_t OFF_BAR = OFF_KV + 16384ull * 2048 * 2;
constexpr size_t WS_NEED = OFF_BAR + 16384;

struct Params {
  const float* in[33];
  float* out;
  char* ws;
  int ph0, ph1;
};

#define AS4 __attribute__((address_space(4)))
struct KA {
  const AS4 char* ka;
  DI const float* in(int i) const { return *(const float* const AS4*)(ka + 8 * i); }
  DI float* out() const { return *(float* const AS4*)(ka + 264); }
  DI char* ws() const { return *(char* const AS4*)(ka + 272); }
};

DI unsigned pack2(float a, float b) { f32x2 f = {a, b}; bfx2 v = __builtin_convertvector(f, bfx2); return __builtin_bit_cast(unsigned, v); }
DI u16 f2bf(float a) { return (u16)(pack2(a, a) & 0xffffu); }
DI float wave_sum(float v) {
#pragma unroll
  for (int o = 32; o; o >>= 1) v += __shfl_xor(v, o, 64);
  return v;
}
DI int ltid() { int t = threadIdx.x; asm volatile("" : "+v"(t)); return t; }
DI int crow(int i, int h) { return (i & 3) + 8 * (i >> 2) + 4 * h; }

__device__ const long long TJ[18][6] = {
  {15, 0ll * 1024 * 4096, 1024, 4096, 4096, (long long)(OFF_W1T + 0ull * W1T_SZ)},
  {15, 1ll * 1024 * 4096, 1024, 4096, 4096, (long long)(OFF_W1T + 1ull * W1T_SZ)},
  {15, 2ll * 1024 * 4096, 1024, 4096, 4096, (long long)(OFF_W1T + 2ull * W1T_SZ)},
  {15, 3ll * 1024 * 4096, 1024, 4096, 4096, (long long)(OFF_W1T + 3ull * W1T_SZ)},
  {16, 0ll * 1024 * 4096, 4096, 1024, 1024, (long long)(OFF_W2T + 0ull * W2T_SZ)},
  {16, 1ll * 1024 * 4096, 4096, 1024, 1024, (long long)(OFF_W2T + 1ull * W2T_SZ)},
  {16, 2ll * 1024 * 4096, 4096, 1024, 1024, (long long)(OFF_W2T + 2ull * W2T_SZ)},
  {16, 3ll * 1024 * 4096, 4096, 1024, 1024, (long long)(OFF_W2T + 3ull * W2T_SZ)},
  {17, 0, 1024, 1536, 1536, (long long)OFF_AQKV},
  {20, 0, 1024, 1024, 1024, (long long)OFF_AO_W},
  {21, 0, 1024, 672, 768, (long long)OFF_MIN},
  {24, 0, 384, 1536, 1536, (long long)OFF_MUQ},
  {25, 0, 256, 2048, 2048, (long long)OFF_MUKV},
  {26, 0, 1024, 1024, 1024, (long long)OFF_MO},
  {27, 0, 1024, 1536, 1536, (long long)OFF_SQKV},
  {29, 0, 1024, 1024, 1024, (long long)OFF_SO},
  {30, 0, 1024, 3072, 3072, (long long)OFF_NQKV},
  {32, 0, 1024, 1024, 1024, (long long)OFF_NO},
};

struct TTile { const float* src; u16* dst; int K, N, k0, n0; };
DI void tt_load(const TTile& t, int tid, float4 (&v)[8]) {
  const int n4 = tid & 63, kl = tid >> 6;
  const int n = t.n0 + 4 * n4;
#pragma unroll
  for (int j = 0; j < 8; ++j) {
    const int k = kl + 8 * j;
    v[j] = (n < t.N) ? *(const float4*)(t.src + (size_t)(t.k0 + k) * t.N + n) : make_float4(0.f, 0.f, 0.f, 0.f);
  }
}
DI void tt_store(const TTile& t, int tid, const float4 (&v)[8], char* smem) {
  float (*T)[260] = (float (*)[260])smem;
  const int n4 = tid & 63, kl = tid >> 6;
  __syncthreads();
#pragma unroll
  for (int j = 0; j < 8; ++j) *(float4*)&T[kl + 8 * j][4 * n4] = v[j];
  __syncthreads();
#pragma unroll
  for (int j = 0; j < 4; ++j) {
    const int c = tid + NTHR * j;
    const int n = c >> 3, kc = c & 7;
    uint4 o;
    o.x = pack2(T[kc * 8 + 0][n], T[kc * 8 + 1][n]);
    o.y = pack2(T[kc * 8 + 2][n], T[kc * 8 + 3][n]);
    o.z = pack2(T[kc * 8 + 4][n], T[kc * 8 + 5][n]);
    o.w = pack2(T[kc * 8 + 6][n], T[kc * 8 + 7][n]);
    *(uint4*)&t.dst[(size_t)(t.n0 + n) * (t.K + 64) + t.k0 + kc * 8] = o;
  }
}

DI void convert_f32_bf16(const float* __restrict__ src, u16* __restrict__ dst, size_t n) {
  const size_t n4 = n >> 2;
  const int tid_ = ltid();
  for (size_t i = (size_t)blockIdx.x * NTHR + tid_; i < n4; i += (size_t)gridDim.x * NTHR) {
    const float4 v = ((const float4*)src)[i];
    uint2 o; o.x = pack2(v.x, v.y); o.y = pack2(v.z, v.w);
    ((uint2*)dst)[i] = o;
  }
}

DI void convert_rows256(const float* __restrict__ src, u16* __restrict__ dst, int rows, int dpitch) {
  const int tid_ = ltid();
  for (int i = blockIdx.x * NTHR + tid_; i < rows * 64; i += gridDim.x * NTHR) {
    const int r = i >> 6, c4 = i & 63;
    const float4 v = ((const float4*)src)[i];
    uint2 o; o.x = pack2(v.x, v.y); o.y = pack2(v.z, v.w);
    *(uint2*)(dst + (size_t)r * dpitch + 4 * c4) = o;
  }
}

DI void prepass(const KA& p, char* smem) {
  {
    const int tid = ltid();
    int total = 0;
    for (int j = 0; j < 18; ++j) total += (int)((TJ[j][2] >> 6) * (TJ[j][4] >> 8));
    float4 va[8], vb[8];
    TTile ta, tb;
#define TT_DECODE(tt_, t_)                                                                     \
    {                                                                                          \
      int j = 0, tt = (t_);                                                                    \
      for (;;) { const int c = (int)((TJ[j][2] >> 6) * (TJ[j][4] >> 8)); if (tt < c) break; tt -= c; ++j; } \
      const int K = (int)TJ[j][2];                                                             \
      const int nk = K >> 6;                                                                   \
      tt_.src = p.in((int)TJ[j][0]) + TJ[j][1]; tt_.dst = (u16*)(p.ws() + TJ[j][5]);           \
      tt_.K = K; tt_.N = (int)TJ[j][3]; tt_.k0 = (tt % nk) * 64; tt_.n0 = (tt / nk) * 256;     \
    }
    int t = blockIdx.x;
    if (t < total) { TT_DECODE(ta, t) tt_load(ta, tid, va); }
    for (; t < total; t += 2 * gridDim.x) {
      const int t2 = t + gridDim.x;
      if (t2 < total) { TT_DECODE(tb, t2) tt_load(tb, tid, vb); }
      tt_store(ta, tid, va, smem);
      if (t2 < total) {
        const int t3 = t2 + gridDim.x;
        if (t3 < total) { TT_DECODE(ta, t3) tt_load(ta, tid, va); }
        tt_store(tb, tid, vb, smem);
      }
    }
#undef TT_DECODE
  }
  convert_f32_bf16(p.in(2), (u16*)(p.ws() + OFF_CK), 4096ull * 256);
  convert_f32_bf16(p.in(3), (u16*)(p.ws() + OFF_CV), 4096ull * 256);
  convert_rows256(p.in(4), (u16*)(p.ws() + OFF_CKV) + 12288ull * P256, 4096, P256);
  convert_f32_bf16(p.in(5), (u16*)(p.ws() + OFF_KPE) + 12288ull * 32, 4096ull * 32);
  {
    float* tab = (float*)(p.ws() + OFF_ROPE);
    const int tid_ = ltid();
    for (int e = blockIdx.x * NTHR + tid_; e < 3 * 64 * 32; e += gridDim.x * NTHR) {
      const int kind = e / 2048, pos = (e >> 5) & 63, i = e & 31;
      const int quarter = kind == 0 ? 32 : (kind == 1 ? 16 : 8);
      float c = 1.f, s = 0.f;
      if (i < quarter) {
        const float inv = exp2f(-(float)i / (float)quarter * 13.287712379549449f);
        const float ang = (float)pos * inv;
        c = cosf(ang); s = sinf(ang);
      }
      tab[2 * e] = c; tab[2 * e + 1] = s;
    }
  }
  {
    float* scond = (float*)smem;
    float* red = (float*)(smem + 36864);
    float* MOD = (float*)(p.ws() + OFF_MOD);
    const int tid = ltid();
    bool ready = false;
    for (int it = blockIdx.x; it < 768; it += gridDim.x) {
      __syncthreads();
      if (!ready) {
        for (int e = tid; e < 9 * 1024; e += NTHR) {
          const float c = e < 8192 ? p.in(10)[e] : p.in(11)[e - 8192];
          scond[e] = c / (1.f + __expf(-c));
        }
        ready = true;
        __syncthreads();
      }
      const int l = it / 192, n0 = (it % 192) * 32;
      const int cq = tid & 7, kg = tid >> 3;
      float acc[9][4];
#pragma unroll
      for (int c = 0; c < 9; ++c) { acc[c][0] = 0.f; acc[c][1] = 0.f; acc[c][2] = 0.f; acc[c][3] = 0.f; }
      const float* wp = p.in(12) + (size_t)l * 1024 * 6144 + n0 + 4 * cq;
      float4 wv[16];
#pragma unroll
      for (int i = 0; i < 16; ++i) wv[i] = *(const float4*)(wp + (size_t)(kg + 64 * i) * 6144);
#pragma unroll
      for (int i = 0; i < 16; ++i) {
        const int k = kg + 64 * i;
#pragma unroll
        for (int c = 0; c < 9; ++c) {
          const float sv = scond[c * 1024 + k];
          acc[c][0] += sv * wv[i].x; acc[c][1] += sv * wv[i].y; acc[c][2] += sv * wv[i].z; acc[c][3] += sv * wv[i].w;
        }
      }
#pragma unroll
      for (int c = 0; c < 9; ++c) *(float4*)&red[(kg * 9 + c) * 32 + 4 * cq] = make_float4(acc[c][0], acc[c][1], acc[c][2], acc[c][3]);
      __syncthreads();
      for (int e = tid; e < 288; e += NTHR) {
        const int c = e >> 5, cc = e & 31;
        float sum = p.in(13)[l * 6144 + n0 + cc];
#pragma unroll 8
        for (int g = 0; g < 64; ++g) sum += red[(g * 9 + c) * 32 + cc];
        MOD[(size_t)(l * 9 + c) * 6144 + n0 + cc] = sum;
      }
    }
  }
}

DI float bf2f(unsigned v16) { return __uint_as_float(v16 << 16); }

DI void norm_phase(const KA& p, int l, int mode) {
  const int tid_ = ltid(); const int lane = tid_ & 63, w = tid_ >> 6;
  float* X = p.out();
  const float* MOD = (const float*)(p.ws() + OFF_MOD);
  const u16* FF = (const u16*)(p.ws() + OFF_QO);
  u16* H = (u16*)(p.ws() + OFF_HAO);
  const float* ng = p.in(14);
  const float* xp0 = p.in(0);
  const float* xp1 = p.in(1);
  const bool x_in = (l == 0);
  const bool add = !(l == 0 && mode == 0);
  const int la = (mode == 1) ? l : l - 1;
  const int gate_w = (mode == 1) ? 2 : 5;
  const int gadd = (mode == 1) ? 1 : 3;
  const bool do_h = mode != 2;
  const int gh = (mode == 0) ? 0 : 2, scw = (mode == 0) ? 1 : 4, shw = (mode == 0) ? 0 : 3;
  const int stride = gridDim.x * NWAVE;
  const int lh = do_h ? l : 0;
  int row = blockIdx.x * NWAVE + w;
  float4 nx0, nx1, nx2, nx3;
  uint2 nf0 = make_uint2(0, 0), nf1 = nf0, nf2 = nf0, nf3 = nf0;
#define NLOAD(rw)                                                                                          \
  {                                                                                                        \
    const int rr = min((rw), NTOK - 1);                                                                    \
    const float* xs = x_in ? (rr < NCTX ? xp0 + (size_t)rr * 1024 : xp1 + (size_t)(rr - NCTX) * 1024)      \
                           : X + (size_t)rr * 1024;                                                        \
    nx0 = *(const float4*)(xs + 4 * lane); nx1 = *(const float4*)(xs + 4 * lane + 256);                    \
    nx2 = *(const float4*)(xs + 4 * lane + 512); nx3 = *(const float4*)(xs + 4 * lane + 768);              \
    if (add) {                                                                                             \
      const u16* fr = FF + (size_t)rr * 1024 + 4 * lane;                                                   \
      nf0 = *(const uint2*)(fr); nf1 = *(const uint2*)(fr + 256); nf2 = *(const uint2*)(fr + 512); nf3 = *(const uint2*)(fr + 768); \
    }                                                                                                      \
  }
  NLOAD(row)
  for (; row < NTOK; row += stride) {
    const int ci = row < NCTX ? 8 : ((row - NCTX) >> 10);
    float4 x[4] = {nx0, nx1, nx2, nx3};
    const uint2 fb[4] = {nf0, nf1, nf2, nf3};
    const float* ga = ng + (la * 4 + gadd) * 1024 + 4 * lane;
    const float* gt = MOD + (size_t)(la * 9 + ci) * 6144 + gate_w * 1024 + 4 * lane;
    const float* gp = ng + (lh * 4 + gh) * 1024 + 4 * lane;
    const float* sc = MOD + (size_t)(lh * 9 + ci) * 6144 + scw * 1024 + 4 * lane;
    const float* sh = MOD + (size_t)(lh * 9 + ci) * 6144 + shw * 1024 + 4 * lane;
    float4 ga4[4], gt4[4], g4[4], c4[4], s4[4];
#pragma unroll
    for (int j = 0; j < 4; ++j) {
      if (add) { ga4[j] = *(const float4*)(ga + 256 * j); gt4[j] = *(const float4*)(gt + 256 * j); }
      if (do_h) { g4[j] = *(const float4*)(gp + 256 * j); c4[j] = *(const float4*)(sc + 256 * j); s4[j] = *(const float4*)(sh + 256 * j); }
    }
    NLOAD(row + stride)
    if (add) {
      float f[16];
      float ss = 0.f;
#pragma unroll
      for (int j = 0; j < 4; ++j) {
        f[4 * j] = bf2f(fb[j].x & 0xffffu); f[4 * j + 1] = bf2f(fb[j].x >> 16);
        f[4 * j + 2] = bf2f(fb[j].y & 0xffffu); f[4 * j + 3] = bf2f(fb[j].y >> 16);
        ss += f[4 * j] * f[4 * j] + f[4 * j + 1] * f[4 * j + 1] + f[4 * j + 2] * f[4 * j + 2] + f[4 * j + 3] * f[4 * j + 3];
      }
      ss = wave_sum(ss);
      const float rstd = rsqrtf(ss * (1.f / 1024.f) + 1e-6f);
#pragma unroll
      for (int j = 0; j < 4; ++j) {
        x[j].x += gt4[j].x * (f[4 * j] * rstd * ga4[j].x);
        x[j].y += gt4[j].y * (f[4 * j + 1] * rstd * ga4[j].y);
        x[j].z += gt4[j].z * (f[4 * j + 2] * rstd * ga4[j].z);
        x[j].w += gt4[j].w * (f[4 * j + 3] * rstd * ga4[j].w);
        *(float4*)(X + (size_t)row * 1024 + 4 * lane + 256 * j) = x[j];
      }
    }
    if (do_h) {
      float ss = 0.f;
#pragma unroll
      for (int j = 0; j < 4; ++j) ss += x[j].x * x[j].x + x[j].y * x[j].y + x[j].z * x[j].z + x[j].w * x[j].w;
      ss = wave_sum(ss);
      const float rstd = rsqrtf(ss * (1.f / 1024.f) + 1e-6f);
#pragma unroll
      for (int j = 0; j < 4; ++j) {
        const float h0 = x[j].x * rstd * g4[j].x * (1.f + c4[j].x) + s4[j].x;
        const float h1 = x[j].y * rstd * g4[j].y * (1.f + c4[j].y) + s4[j].y;
        const float h2 = x[j].z * rstd * g4[j].z * (1.f + c4[j].z) + s4[j].z;
        const float h3 = x[j].w * rstd * g4[j].w * (1.f + c4[j].w) + s4[j].w;
        uint2 o; o.x = pack2(h0, h1); o.y = pack2(h2, h3);
        *(uint2*)(H + (size_t)row * P1024 + 4 * lane + 256 * j) = o;
      }
    }
  }
#undef NLOAD
}

enum { EPI_F32 = 0, EPI_BF16 = 1, EPI_RELU2 = 2, EPI_NAT = 3 };
struct GemmDesc { const u16* A; const u16* Bt; void* dst; int lda, ldb, ldc, M, N, K, epi; };

DI void gemm_tile(const GemmDesc& g, int m0, int n0, float* outp, char* smem) {
  constexpr int LS = 72;
  constexpr int BM = 192, BN = 256;
  u16* As = (u16*)smem;
  u16* Bs = As + 2 * BM * LS;
  const int tid = ltid(), lane = tid & 63, w = tid >> 6, r = lane & 31, h = lane >> 5;
  const int wm = w >> 2, wn = w & 3;
  const int lrow = tid >> 3, lcc = tid & 7;
  const int Mlast = g.M - 1;
  const char* Ab = (const char*)g.A;
  const char* Bb = (const char*)g.Bt;
  const unsigned ao0 = (unsigned)(min(m0 + lrow, Mlast) * g.lda + lcc * 8) * 2u;
  const unsigned ao1 = (unsigned)(min(m0 + lrow + 64, Mlast) * g.lda + lcc * 8) * 2u;
  const unsigned ao2 = (unsigned)(min(m0 + lrow + 128, Mlast) * g.lda + lcc * 8) * 2u;
  const unsigned bo0 = (unsigned)((n0 + lrow) * g.ldb + lcc * 8) * 2u;
  const unsigned bst = (unsigned)(64 * g.ldb) * 2u;
  uint4 pa0, pa1, pa2, pb0, pb1, pb2, pb3;
  f32x16 acc00, acc01, acc10, acc11, acc20, acc21;
#pragma unroll
  for (int i = 0; i < 16; ++i) { acc00[i] = 0.f; acc01[i] = 0.f; acc10[i] = 0.f; acc11[i] = 0.f; acc20[i] = 0.f; acc21[i] = 0.f; }
#define GLOAD(R, kt_)                                                                                  \
  {                                                                                                    \
    const char* ak = Ab + (size_t)(kt_) * 128; const char* bk = Bb + (size_t)(kt_) * 128;              \
    R##a0 = *(const uint4*)(ak + ao0); R##a1 = *(const uint4*)(ak + ao1); R##a2 = *(const uint4*)(ak + ao2); \
    R##b0 = *(const uint4*)(bk + bo0); R##b1 = *(const uint4*)(bk + bo0 + bst);                        \
    R##b2 = *(const uint4*)(bk + bo0 + 2 * bst); R##b3 = *(const uint4*)(bk + bo0 + 3 * bst);          \
  }
#define LSTORE(R, buf)                                                                  \
  *(uint4*)&As[(buf) * BM * LS + (lrow) * LS + lcc * 8] = R##a0;                         \
  *(uint4*)&As[(buf) * BM * LS + (lrow + 64) * LS + lcc * 8] = R##a1;                    \
  *(uint4*)&As[(buf) * BM * LS + (lrow + 128) * LS + lcc * 8] = R##a2;                   \
  *(uint4*)&Bs[(buf) * BN * LS + (lrow) * LS + lcc * 8] = R##b0;                         \
  *(uint4*)&Bs[(buf) * BN * LS + (lrow + 64) * LS + lcc * 8] = R##b1;                    \
  *(uint4*)&Bs[(buf) * BN * LS + (lrow + 128) * LS + lcc * 8] = R##b2;                   \
  *(uint4*)&Bs[(buf) * BN * LS + (lrow + 192) * LS + lcc * 8] = R##b3;
#define FRAGS(X, kk)                                                                    \
  X##a0 = *(const bf16x8*)(Ac + 16 * (kk));                                             \
  X##a1 = *(const bf16x8*)(Ac + 32 * LS + 16 * (kk));                                   \
  X##a2 = *(const bf16x8*)(Ac + 64 * LS + 16 * (kk));                                   \
  X##b0 = *(const bf16x8*)(Bc + 16 * (kk));                                             \
  X##b1 = *(const bf16x8*)(Bc + 32 * LS + 16 * (kk));
#define MMAS(X)                                                                         \
  acc00 = MFMA(X##a0, X##b0, acc00); acc01 = MFMA(X##a0, X##b1, acc01);                 \
  acc10 = MFMA(X##a1, X##b0, acc10); acc11 = MFMA(X##a1, X##b1, acc11);                 \
  acc20 = MFMA(X##a2, X##b0, acc20); acc21 = MFMA(X##a2, X##b1, acc21);
#define COMPUTE(buf)                                                                    \
  {                                                                                     \
    const u16* Ac = As + (buf) * BM * LS + (96 * wm + r) * LS + 8 * h;                  \
    const u16* Bc = Bs + (buf) * BN * LS + (64 * wn + r) * LS + 8 * h;                  \
    bf16x8 xa0, xa1, xa2, xb0, xb1, ya0, ya1, ya2, yb0, yb1;                            \
    FRAGS(x, 0) __builtin_amdgcn_sched_barrier(0);                                      \
    FRAGS(y, 1) __builtin_amdgcn_sched_barrier(0); MMAS(x) __builtin_amdgcn_sched_barrier(0); \
    FRAGS(x, 2) __builtin_amdgcn_sched_barrier(0); MMAS(y) __builtin_amdgcn_sched_barrier(0); \
    FRAGS(y, 3) __builtin_amdgcn_sched_barrier(0); MMAS(x) __builtin_amdgcn_sched_barrier(0); \
    MMAS(y)                                                                             \
  }
  const int KT = g.K >> 6;
  GLOAD(p, 0)
  LSTORE(p, 0)
  __syncthreads();
  for (int kt = 0; kt < KT; kt += 2) {
    GLOAD(p, min(kt + 1, KT - 1))
    __builtin_amdgcn_sched_barrier(0);
    COMPUTE(0)
    LSTORE(p, 1)
    __syncthreads();
    GLOAD(p, min(kt + 2, KT - 1))
    __builtin_amdgcn_sched_barrier(0);
    COMPUTE(1)
    LSTORE(p, 0)
    __syncthreads();
  }
#undef GLOAD
#undef LSTORE
#undef FRAGS
#undef MMAS
#undef COMPUTE
  const int epi = g.epi;
#define EPI_LOOP(BODY)                                                                                         \
  _Pragma("unroll") for (int mi = 0; mi < 3; ++mi)                                                             \
  _Pragma("unroll") for (int ni = 0; ni < 2; ++ni) {                                                           \
    const int col = n0 + 64 * wn + 32 * ni + r;                                                                \
    _Pragma("unroll") for (int i = 0; i < 16; ++i) {                                                           \
      const int row = m0 + 96 * wm + 32 * mi + crow(i, h);                                                     \
      const float v = mi == 0 ? (ni == 0 ? acc00[i] : acc01[i]) : (mi == 1 ? (ni == 0 ? acc10[i] : acc11[i]) : (ni == 0 ? acc20[i] : acc21[i])); \
      BODY                                                                                                     \
    }                                                                                                          \
  }
  if (epi == EPI_F32) {
    float* dst = (float*)g.dst;
    EPI_LOOP(dst[(size_t)row * g.ldc + col] = v;)
  } else if (epi == EPI_RELU2) {
    u16* dst = (u16*)g.dst;
    EPI_LOOP(const float t = v > 0.f ? v : 0.f; dst[(size_t)row * g.ldc + col] = f2bf(t * t);)
  } else if (epi == EPI_BF16) {
    u16* dst = (u16*)g.dst;
    EPI_LOOP(if (row <= Mlast) dst[(size_t)row * g.ldc + col] = f2bf(v);)
  } else {
    u16* dst = (u16*)g.dst;
    EPI_LOOP(dst[(size_t)row * g.ldc + col] = f2bf(v);
             if (row < NCTX && col >= 1024) outp[(col < 2048 ? O_L3K - 1024 : O_L3V - 2048) + (size_t)row * 1024 + col] = v;)
  }
#undef EPI_LOOP
}

DI void gemm_phase(const KA& p, const GemmDesc& g0, const GemmDesc& g1, int ng, char* smem) {
  const int nt0 = g0.N >> 8, mt0 = (g0.M + 191) / 192;
  const int CN = (nt0 & 3) == 0 ? 4 : ((nt0 & 1) == 0 ? 2 : 1), CM = 32 / CN;
  if (ng == 1 && gridDim.x == 256 && (mt0 % CM) == 0) {
    const int x = blockIdx.x & 7, s = blockIdx.x >> 3, mi = s / CN, ni = s - mi * CN;
    const int ncn = nt0 / CN, nchunks = (mt0 / CM) * ncn;
    for (int rep = 0; rep < REP_GEMM; ++rep)
    for (int c = x; c < nchunks; c += 8) {
      const int cm = c / ncn, cn = c - cm * ncn;
      gemm_tile(g0, (cm * CM + mi) * 192, (cn * CN + ni) * 256, p.out(), smem);
    }
    return;
  }
  const int t0 = mt0 * nt0;
  const int t1 = ng > 1 ? ((g1.M + 191) / 192) * (g1.N >> 8) : 0;
  for (int rep = 0; rep < REP_GEMM; ++rep)
  for (int t = blockIdx.x; t < t0 + t1; t += gridDim.x) {
    const bool first = t < t0;
    GemmDesc g;
    g.A = first ? g0.A : g1.A; g.Bt = first ? g0.Bt : g1.Bt; g.dst = first ? g0.dst : g1.dst;
    g.lda = first ? g0.lda : g1.lda; g.ldb = first ? g0.ldb : g1.ldb; g.ldc = first ? g0.ldc : g1.ldc;
    g.M = first ? g0.M : g1.M; g.N = first ? g0.N : g1.N; g.K = first ? g0.K : g1.K; g.epi = first ? g0.epi : g1.epi;
    const int tt = first ? t : t - t0;
    const int nt = g.N >> 8;
    gemm_tile(g, (tt / nt) * 192, (tt % nt) * 256, p.out(), smem);
  }
}

DI void pp_attn(const KA& p) {
  const int tid_ = ltid(); const int lane = tid_ & 63, w = tid_ >> 6;
  const float* Z = (const float*)(p.ws() + OFF_UZ);
  u16* QKV = (u16*)(p.ws() + OFF_QO);
  const float* tab = (const float*)(p.ws() + OFF_ROPE);
  const float* qn = p.in(18);
  const float* kn = p.in(19);
  for (int row = blockIdx.x * NWAVE + w; row < NTOK; row += gridDim.x * NWAVE) {
    const bool lat = row >= NCTX;
    const int t = (row - NCTX) & 1023, pr = t >> 6, pc = t & 63;
    const float* z = Z + (size_t)row * 1536;
    u16* o = QKV + (size_t)row * 1536;
    const int i = lane & 31;
    const float c0 = tab[(pr * 32 + i) * 2], s0 = tab[(pr * 32 + i) * 2 + 1];
    const float c1 = tab[(pc * 32 + i) * 2], s1 = tab[(pc * 32 + i) * 2 + 1];
    const float sg = lane < 32 ? -1.f : 1.f;
    for (int hd = 0; hd < 10; ++hd) {
      const float v0 = z[hd * 128 + lane], v1 = z[hd * 128 + 64 + lane];
      const float ss = wave_sum(v0 * v0 + v1 * v1);
      const float rstd = rsqrtf(ss * (1.f / 128.f) + 1e-6f);
      const float* g = hd < 8 ? qn : kn;
      float y0 = v0 * rstd * g[lane], y1 = v1 * rstd * g[64 + lane];
      if (hd >= 8 && !lat) {
        p.out()[O_L0K + (size_t)row * 256 + (hd - 8) * 128 + lane] = y0;
        p.out()[O_L0K + (size_t)row * 256 + (hd - 8) * 128 + 64 + lane] = y1;
      }
      const float p0 = __shfl_xor(y0, 32, 64), p1 = __shfl_xor(y1, 32, 64);
      if (lat) {
        y0 = y0 * c0 + sg * p0 * s0;
        y1 = y1 * c1 + sg * p1 * s1;
      }
      o[hd * 128 + lane] = f2bf(y0);
      o[hd * 128 + 64 + lane] = f2bf(y1);
    }
#pragma unroll
    for (int j = 0; j < 4; ++j) {
      const float v = z[1280 + 64 * j + lane];
      o[1280 + 64 * j + lane] = f2bf(v);
      if (!lat) p.out()[O_L0V + (size_t)row * 256 + 64 * j + lane] = v;
    }
  }
}

DI void pp_swa(const KA& p) {
  const int tid_ = ltid(); const int lane = tid_ & 63, w = tid_ >> 6;
  const float* Z = (const float*)(p.ws() + OFF_UZ);
  u16* QKV = (u16*)(p.ws() + OFF_QO);
  const float* tab = (const float*)(p.ws() + OFF_ROPE) + 1 * 64 * 32 * 2;
  for (int row = blockIdx.x * NWAVE + w; row < NTOK; row += gridDim.x * NWAVE) {
    const bool lat = row >= NCTX;
    const int t = (row - NCTX) & 1023, pr = t >> 6, pc = t & 63;
    const float* z = Z + (size_t)row * 1536;
    u16* o = QKV + (size_t)row * 1536;
    const int i = lane & 15, axis = lane >> 5, half = (lane >> 4) & 1;
    const int pos = axis ? pc : pr;
    const float c = tab[(pos * 32 + i) * 2], s = tab[(pos * 32 + i) * 2 + 1];
    const float sg = half ? 1.f : -1.f;
    for (int hd = 0; hd < 20; ++hd) {
      float v = z[hd * 64 + lane];
      if (hd >= 16 && !lat) p.out()[O_L2K + (size_t)row * 256 + (hd - 16) * 64 + lane] = v;
      const float pv = __shfl_xor(v, 16, 64);
      if (lat) v = v * c + sg * pv * s;
      o[hd * 64 + lane] = f2bf(v);
    }
#pragma unroll
    for (int j = 0; j < 4; ++j) {
      const float v = z[1280 + 64 * j + lane];
      o[1280 + 64 * j + lane] = f2bf(v);
      if (!lat) p.out()[O_L2V + (size_t)row * 256 + 64 * j + lane] = v;
    }
  }
}

DI void pp_mla1(const KA& p) {
  const int tid_ = ltid(); const int lane = tid_ & 63, w = tid_ >> 6;
  const float* Z = (const float*)(p.ws() + OFF_UZ);
  u16* CQ = (u16*)(p.ws() + OFF_CQ);
  u16* CKV = (u16*)(p.ws() + OFF_CKV);
  u16* KPE = (u16*)(p.ws() + OFF_KPE);
  const float* tab = (const float*)(p.ws() + OFF_ROPE) + 2 * 64 * 32 * 2;
  const float* qn = p.in(22);
  const float* kvn = p.in(23);
  for (int row = blockIdx.x * NWAVE + w; row < NTOK; row += gridDim.x * NWAVE) {
    const bool lat = row >= NCTX;
    const int t = (row - NCTX) & 1023, pr = t >> 6, pc = t & 63;
    const float* z = Z + (size_t)row * 768;
    float a[6];
    float ss = 0.f;
#pragma unroll
    for (int j = 0; j < 6; ++j) { a[j] = z[64 * j + lane]; ss += a[j] * a[j]; }
    ss = wave_sum(ss);
    float rstd = rsqrtf(ss * (1.f / 384.f) + 1e-6f);
#pragma unroll
    for (int j = 0; j < 6; ++j) CQ[(size_t)row * P384 + 64 * j + lane] = f2bf(a[j] * rstd * qn[64 * j + lane]);
    ss = 0.f;
#pragma unroll
    for (int j = 0; j < 4; ++j) { a[j] = z[384 + 64 * j + lane]; ss += a[j] * a[j]; }
    ss = wave_sum(ss);
    rstd = rsqrtf(ss * (1.f / 256.f) + 1e-6f);
#pragma unroll
    for (int j = 0; j < 4; ++j) {
      const float y = a[j] * rstd * kvn[64 * j + lane];
      CKV[(size_t)row * P256 + 64 * j + lane] = f2bf(y);
      if (!lat) p.out()[O_L1CKV + (size_t)row * 256 + 64 * j + lane] = y;
    }
    const int e = lane & 31;
    float v = z[640 + e];
    const float pv = __shfl_xor(v, 8, 64);
    if (lat) {
      const int i = e & 7, axis = e >> 4, half = (e >> 3) & 1;
      const int pos = axis ? pc : pr;
      const float c = tab[(pos * 32 + i) * 2], s = tab[(pos * 32 + i) * 2 + 1];
      v = v * c + (half ? pv : -pv) * s;
    }
    if (lane < 32) {
      KPE[(size_t)row * 32 + e] = f2bf(v);
      if (!lat) p.out()[O_L1KPE + (size_t)row * 32 + e] = v;
    }
  }
}

DI void pp_mla2(const KA& p) {
  const int tid_ = ltid(); const int lane = tid_ & 63, w = tid_ >> 6;
  const float* Z = (const float*)(p.ws() + OFF_UZ);
  u16* Q = (u16*)(p.ws() + OFF_QO);
  const float* tab = (const float*)(p.ws() + OFF_ROPE) + 2 * 64 * 32 * 2;
  for (int row = blockIdx.x * NWAVE + w; row < NTOK; row += gridDim.x * NWAVE) {
    const bool lat = row >= NCTX;
    const int t = (row - NCTX) & 1023, pr = t >> 6, pc = t & 63;
    const float* z = Z + (size_t)row * 1536;
    for (int j = 0; j < 24; ++j) {
      const int col = 64 * j + lane;
      float v = z[col];
      const float pv = __shfl_xor(v, 8, 64);
      const int d = col % 96;
      if (lat && d >= 64) {
        const int e = d - 64;
        const int i = e & 7, axis = e >> 4, half = (e >> 3) & 1;
        const int pos = axis ? pc : pr;
        const float c = tab[(pos * 32 + i) * 2], s = tab[(pos * 32 + i) * 2 + 1];
        v = v * c + (half ? pv : -pv) * s;
      }
      Q[(size_t)row * 1536 + col] = f2bf(v);
    }
  }
}

struct Seg { const u16* k1; const u16* k2; const u16* v; int ldk1, ldk2, ldv, n0, n1, mode; };

template <int HDQK, int HDV>
DI void attn_item(const u16* __restrict__ Qp, int ldq, const Seg& sA, const Seg& sB, int nseg, int qpos0,
                  float scale_l2, const float* __restrict__ rpb_h, bool has_sink, float sink_l2,
                  u16* __restrict__ Op, int ldo, char* smem) {
  constexpr int K1W = (HDQK == 96) ? 64 : HDQK;
  constexpr int KS = HDQK + 8, VS = HDV + 8;
  constexpr int KC = HDQK / 8, VC = HDV / 8;
  u16* Ks = (u16*)smem;
  u16* Vs = Ks + 64 * KS;
  float* rp = (float*)(Vs + 64 * VS);
  const int tid = ltid(), lane = tid & 63, w = tid >> 6, r = lane & 31, h = lane >> 5;
  const int q4 = (lane & 15) >> 2, p4 = lane & 3, dblk = (lane >> 4) & 1;

  __syncthreads();
  if (rpb_h) for (int e = tid; e < 465; e += NTHR) rp[e] = rpb_h[e];

  bf16x8 qf[HDQK / 16];
  {
    const u16* qrow = Qp + (size_t)(32 * w + r) * ldq + 8 * h;
#pragma unroll
    for (int kk = 0; kk < HDQK / 16; ++kk) qf[kk] = *(const bf16x8*)(qrow + 16 * kk);
  }
  f32x16 o[HDV / 32];
#pragma unroll
  for (int dt = 0; dt < HDV / 32; ++dt)
#pragma unroll
    for (int i = 0; i < 16; ++i) o[dt][i] = 0.f;
  float m = -1e30f, l = 0.f;
  const int qpos = qpos0 + 32 * w + r;
  const int qr = qpos >> 6, qc = qpos & 63;
  const int r0 = min(max(qr - 4, 0), 8), c0 = min(max(qc - 8, 0), 48);

  constexpr int KI = (64 * KC + NTHR - 1) / NTHR, VI = (64 * VC + NTHR - 1) / NTHR;
  const int TA = (sA.n1 - sA.n0) >> 6;
  const int T = TA + (nseg > 1 ? ((sB.n1 - sB.n0) >> 6) : 0);
  uint4 kreg0 = make_uint4(0, 0, 0, 0), kreg1 = kreg0, vreg0 = kreg0, vreg1 = kreg0;
#define ATT_KADDR(i, p1, p2, l1, l2, nn)                                                               \
  const int kc_##i = tid + NTHR * i; const int krow_##i = kc_##i / KC, kcc_##i = kc_##i - krow_##i * KC; \
  const u16* ksrc_##i = (kcc_##i * 8 < K1W) ? p1 + (size_t)(nn + krow_##i) * l1 + kcc_##i * 8          \
                                            : p2 + (size_t)(nn + krow_##i) * l2 + (kcc_##i * 8 - K1W);
#define ATT_FETCH(t)                                                                                   \
  {                                                                                                    \
    const bool fa = (t) < TA;                                                                          \
    const u16* fk1 = fa ? sA.k1 : sB.k1; const u16* fk2 = fa ? sA.k2 : sB.k2; const u16* fv = fa ? sA.v : sB.v; \
    const int fl1 = fa ? sA.ldk1 : sB.ldk1, fl2 = fa ? sA.ldk2 : sB.ldk2, flv = fa ? sA.ldv : sB.ldv;   \
    const int fn = fa ? sA.n0 + 64 * (t) : sB.n0 + 64 * ((t) - TA);                                    \
    { ATT_KADDR(0, fk1, fk2, fl1, fl2, fn) kreg0 = *(const uint4*)ksrc_0; }                            \
    if (KI > 1) { ATT_KADDR(1, fk1, fk2, fl1, fl2, fn) if (64 * KC % NTHR == 0 || kc_1 < 64 * KC) kreg1 = *(const uint4*)ksrc_1; } \
    { const int c = tid; const int row = c / VC, cc = c - row * VC; vreg0 = *(const uint4*)(fv + (size_t)(fn + row) * flv + cc * 8); } \
    if (VI > 1) { const int c = tid + NTHR; const int row = c / VC, cc = c - row * VC; vreg1 = *(const uint4*)(fv + (size_t)(fn + row) * flv + cc * 8); } \
  }
  ATT_FETCH(0)
  for (int t = 0; t < T; ++t) {
    {
      const bool ca = t < TA;
      const int mode = ca ? sA.mode : sB.mode;
      const int n = ca ? sA.n0 + 64 * t : sB.n0 + 64 * (t - TA);
      __syncthreads();
      { const int c = tid; const int row = c / KC, cc = c - row * KC; *(uint4*)&Ks[row * KS + cc * 8] = kreg0; }
      if (KI > 1) { const int c = tid + NTHR; if (64 * KC % NTHR == 0 || c < 64 * KC) { const int row = c / KC, cc = c - row * KC; *(uint4*)&Ks[row * KS + cc * 8] = kreg1; } }
      { const int c = tid; const int row = c / VC, cc = c - row * VC; *(uint4*)&Vs[row * VS + cc * 8] = vreg0; }
      if (VI > 1) { const int c = tid + NTHR; const int row = c / VC, cc = c - row * VC; *(uint4*)&Vs[row * VS + cc * 8] = vreg1; }
      __syncthreads();
      if (t + 1 < T) ATT_FETCH(t + 1)
      const int qw = qpos0 + 32 * w;
      bool skip = false;
      if (mode == 1) skip = (n > qw + 31 + 128) || (n + 63 < qw - 128);
      else if (mode == 2) { const int r0w = min(max((qw >> 6) - 4, 0), 8); const int kr = n >> 6; skip = (kr < r0w) || (kr >= r0w + 8); }
      if (skip) continue;
      f32x16 st[2];
#pragma unroll
      for (int kt = 0; kt < 2; ++kt) {
#pragma unroll
        for (int i = 0; i < 16; ++i) st[kt][i] = 0.f;
        const u16* kb = Ks + (32 * kt + r) * KS + 8 * h;
#pragma unroll
        for (int kk = 0; kk < HDQK / 16; ++kk) {
          const bf16x8 a = *(const bf16x8*)(kb + 16 * kk);
          st[kt] = MFMA(a, qf[kk], st[kt]);
        }
      }
      float mx = -1e30f;
      if (mode == 0) {
#pragma unroll
        for (int kt = 0; kt < 2; ++kt)
#pragma unroll
          for (int i = 0; i < 16; ++i) { const float v = st[kt][i] * scale_l2; st[kt][i] = v; mx = fmaxf(mx, v); }
      } else if (mode == 1) {
#pragma unroll
        for (int kt = 0; kt < 2; ++kt)
#pragma unroll
          for (int i = 0; i < 16; ++i) {
            const int kpos = n + 32 * kt + crow(i, h);
            const int d = qpos - kpos;
            float v = st[kt][i] * scale_l2;
            if (d > 128 || d < -128) v = -1e30f;
            st[kt][i] = v; mx = fmaxf(mx, v);
          }
      } else {
#pragma unroll
        for (int kt = 0; kt < 2; ++kt)
#pragma unroll
          for (int i = 0; i < 16; ++i) {
            const int kpos = n + 32 * kt + crow(i, h);
            const int kr = kpos >> 6, kc = kpos & 63;
            const bool ok = ((unsigned)(kr - r0) < 8u) && ((unsigned)(kc - c0) < 16u);
            const int idx = ok ? (kr - qr + 7) * 31 + (kc - qc + 15) : 0;
            const float b = rp[idx];
            float v = st[kt][i] * scale_l2 + b * LOG2E;
            if (!ok) v = -1e30f;
            st[kt][i] = v; mx = fmaxf(mx, v);
          }
      }
      mx = fmaxf(mx, __shfl_xor(mx, 32, 64));
      const float mn = fmaxf(m, mx);
      const float alpha = __builtin_amdgcn_exp2f(m - mn);
      m = mn;
      float rs = 0.f;
#pragma unroll
      for (int kt = 0; kt < 2; ++kt)
#pragma unroll
        for (int i = 0; i < 16; ++i) { const float pz = __builtin_amdgcn_exp2f(st[kt][i] - mn); st[kt][i] = pz; rs += pz; }
      rs += __shfl_xor(rs, 32, 64);
      l = l * alpha + rs;
#pragma unroll
      for (int dt = 0; dt < HDV / 32; ++dt)
#pragma unroll
        for (int i = 0; i < 16; ++i) o[dt][i] *= alpha;
#pragma unroll
      for (int kt = 0; kt < 2; ++kt)
#pragma unroll
        for (int s2 = 0; s2 < 2; ++s2) {
          unsigned pk[4];
#pragma unroll
          for (int j = 0; j < 4; ++j) pk[j] = pack2(st[kt][8 * s2 + 2 * j], st[kt][8 * s2 + 2 * j + 1]);
          bf16x8 pb;
          {
            typedef unsigned u32x4 __attribute__((ext_vector_type(4)));
            u32x4 t4 = {pk[0], pk[1], pk[2], pk[3]};
            pb = __builtin_bit_cast(bf16x8, t4);
          }
          const u16* vb = Vs + (32 * kt + 16 * s2 + 4 * h + q4) * VS + 16 * dblk + 4 * p4;
#pragma unroll
          for (int dt = 0; dt < HDV / 32; ++dt) {
            const s16x4 lo = __builtin_amdgcn_ds_read_tr16_b64_v4i16((LDS3 s16x4*)(vb + 32 * dt));
            const s16x4 hi = __builtin_amdgcn_ds_read_tr16_b64_v4i16((LDS3 s16x4*)(vb + 8 * VS + 32 * dt));
            const bf16x8 va = __builtin_shufflevector(lo, hi, 0, 1, 2, 3, 4, 5, 6, 7);
            o[dt] = MFMA(va, pb, o[dt]);
          }
        }
    }
  }
#undef ATT_FETCH
#undef ATT_KADDR
  if (has_sink) l += __builtin_amdgcn_exp2f(sink_l2 - m);
  const float inv = 1.f / l;
  u16* orow = Op + (size_t)(32 * w + r) * ldo + 4 * h;
#pragma unroll
  for (int dt = 0; dt < HDV / 32; ++dt)
#pragma unroll
    for (int g = 0; g < 4; ++g) {
      uint2 v;
      v.x = pack2(o[dt][4 * g] * inv, o[dt][4 * g + 1] * inv);
      v.y = pack2(o[dt][4 * g + 2] * inv, o[dt][4 * g + 3] * inv);
      *(uint2*)(orow + 32 * dt + 8 * g) = v;
    }
}

DI void attn_phase(const KA& p, int kind, char* smem) {
  const int Hq = kind == 0 ? 8 : 16;
  const int nlat = 8 * Hq * 4, nctx = 16 * Hq;
  u16* AO = (u16*)(p.ws() + OFF_HAO);
  const u16* QKV = (const u16*)(p.ws() + OFF_QO);
  for (int rep = 0; rep < REP_ATT; ++rep)
  for (int item = blockIdx.x; item < nlat + nctx; item += gridDim.x) {
    const bool lat = item < nlat;
    int b, hq, qt;
    if (lat) { b = item / (Hq * 4); const int rem = item - b * Hq * 4; hq = rem >> 2; qt = rem & 3; }
    else { const int it = item - nlat; b = it / Hq; hq = it - b * Hq; qt = 0; }
    const int tok0 = lat ? NCTX + b * 1024 : b * 256;
    const int S = lat ? 1024 : 256;
    const int qrow0 = tok0 + qt * 256;
    Seg sc, ss;
    sc.k2 = nullptr; sc.ldk2 = 0; ss.k2 = nullptr; ss.ldk2 = 0;
    sc.n0 = 0; sc.n1 = 512; sc.mode = 0;
    ss.n0 = 0; ss.n1 = S; ss.mode = 0;
    const u16* Qp; int ldq; float sl2; const float* rpb = nullptr; bool has_sink = false; float sink_l2 = 0.f;
    u16* Op;
    if (kind == 0) {
      const int kvh = hq >> 2;
      ss.k1 = QKV + (size_t)tok0 * 1536 + 1024 + kvh * 128; ss.ldk1 = 1536;
      ss.v = QKV + (size_t)tok0 * 1536 + 1280 + kvh * 128; ss.ldv = 1536;
      sc.k1 = (const u16*)(p.ws() + OFF_CK) + (size_t)b * 512 * 256 + kvh * 128; sc.ldk1 = 256;
      sc.v = (const u16*)(p.ws() + OFF_CV) + (size_t)b * 512 * 256 + kvh * 128; sc.ldv = 256;
      sl2 = 0.08838834764831845f * LOG2E;
      Qp = QKV + (size_t)qrow0 * 1536 + hq * 128; ldq = 1536;
      Op = AO + (size_t)qrow0 * P1024 + hq * 128;
    } else if (kind == 1) {
      const u16* KV = (const u16*)(p.ws() + OFF_KV);
      const u16* KPE = (const u16*)(p.ws() + OFF_KPE);
      ss.k1 = KV + (size_t)tok0 * 2048 + hq * 128; ss.ldk1 = 2048;
      ss.k2 = KPE + (size_t)tok0 * 32; ss.ldk2 = 32;
      ss.v = KV + (size_t)tok0 * 2048 + hq * 128 + 64; ss.ldv = 2048;
      const size_t crow0 = 12288 + (size_t)b * 512;
      sc.k1 = KV + crow0 * 2048 + hq * 128; sc.ldk1 = 2048;
      sc.k2 = KPE + crow0 * 32; sc.ldk2 = 32;
      sc.v = KV + crow0 * 2048 + hq * 128 + 64; sc.ldv = 2048;
      sl2 = 0.10206207261596575f * LOG2E;
      Qp = QKV + (size_t)qrow0 * 1536 + hq * 96; ldq = 1536;
      Op = AO + (size_t)qrow0 * P1024 + hq * 64;
    } else if (kind == 2) {
      const int kvh = hq >> 2;
      ss.k1 = QKV + (size_t)tok0 * 1536 + 1024 + kvh * 64; ss.ldk1 = 1536;
      ss.v = QKV + (size_t)tok0 * 1536 + 1280 + kvh * 64; ss.ldv = 1536;
      sc.k1 = (const u16*)(p.ws() + OFF_CK) + (size_t)b * 512 * 256 + kvh * 64; sc.ldk1 = 256;
      sc.v = (const u16*)(p.ws() + OFF_CV) + (size_t)b * 512 * 256 + kvh * 64; sc.ldv = 256;
      sl2 = 0.125f * LOG2E;
      has_sink = true; sink_l2 = p.in(28)[hq] * LOG2E;
      if (lat) { ss.n0 = max(0, qt * 256 - 128); ss.n1 = min(1024, qt * 256 + 384); ss.mode = 1; }
      Qp = QKV + (size_t)qrow0 * 1536 + hq * 64; ldq = 1536;
      Op = AO + (size_t)qrow0 * P1024 + hq * 64;
    } else {
      ss.k1 = QKV + (size_t)tok0 * 3072 + 1024 + hq * 64; ss.ldk1 = 3072;
      ss.v = QKV + (size_t)tok0 * 3072 + 2048 + hq * 64; ss.ldv = 3072;
      sc.k1 = (const u16*)(p.ws() + OFF_C3K) + (size_t)b * 512 * 1024 + hq * 64; sc.ldk1 = 1024;
      sc.v = (const u16*)(p.ws() + OFF_C3V) + (size_t)b * 512 * 1024 + hq * 64; sc.ldv = 1024;
      sl2 = 0.125f * LOG2E;
      if (lat) {
        const int r0a = min(max(4 * qt - 4, 0), 8), r0b = min(max(4 * qt - 1, 0), 8);
        ss.n0 = r0a * 64; ss.n1 = (r0b + 8) * 64; ss.mode = 2;
        rpb = p.in(31) + hq * 465;
      }
      Qp = QKV + (size_t)qrow0 * 3072 + hq * 64; ldq = 3072;
      Op = AO + (size_t)qrow0 * P1024 + hq * 64;
    }
    Seg s0;
    s0.k1 = lat ? sc.k1 : ss.k1; s0.k2 = lat ? sc.k2 : ss.k2; s0.v = lat ? sc.v : ss.v;
    s0.ldk1 = lat ? sc.ldk1 : ss.ldk1; s0.ldk2 = lat ? sc.ldk2 : ss.ldk2; s0.ldv = lat ? sc.ldv : ss.ldv;
    s0.n0 = lat ? sc.n0 : ss.n0; s0.n1 = lat ? sc.n1 : ss.n1; s0.mode = lat ? sc.mode : ss.mode;
    const int nseg = lat ? 2 : 1;
    if (kind == 0) attn_item<128, 128>(Qp, ldq, s0, ss, nseg, qt * 256, sl2, rpb, has_sink, sink_l2, Op, P1024, smem);
    else if (kind == 1) attn_item<96, 64>(Qp, ldq, s0, ss, nseg, qt * 256, sl2, rpb, has_sink, sink_l2, Op, P1024, smem);
    else attn_item<64, 64>(Qp, ldq, s0, ss, nseg, qt * 256, sl2, rpb, has_sink, sink_l2, Op, P1024, smem);
  }
}

__host__ __device__ inline bool phase_exists(int ph) {
  if (ph == 0 || ph == 41) return true;
  const int l = (ph - 1) / 10, s = (ph - 1) % 10;
  if ((s == 3 || s == 4) && l != 1) return false;
  if (s == 2 && l == 3) return false;
  return true;
}

DI void run_phase(const KA& p, int ph, char* smem) {
  if (ph == 0) { prepass(p, smem); return; }
  if (ph == 41) { norm_phase(p, 4, 2); return; }
  const int l = (ph - 1) / 10, s = (ph - 1) % 10;
  char* ws = p.ws();
  GemmDesc g0, g1;
  g0 = GemmDesc{nullptr, nullptr, nullptr, 0, 0, 0, 0, 0, 0, 0};
  g1 = g0;
  int ng = 0;
  switch (s) {
    case 0:
      norm_phase(p, l, 0);
      if (l == 2) {
        convert_f32_bf16(p.in(6), (u16*)(ws + OFF_CK), 4096ull * 256);
        convert_f32_bf16(p.in(7), (u16*)(ws + OFF_CV), 4096ull * 256);
      } else if (l == 3) {
        convert_f32_bf16(p.in(8), (u16*)(ws + OFF_C3K), 4096ull * 1024);
        convert_f32_bf16(p.in(9), (u16*)(ws + OFF_C3V), 4096ull * 1024);
      }
      break;
    case 1: {
      const u16* H = (const u16*)(ws + OFF_HAO);
      if (l == 0) g0 = GemmDesc{H, (const u16*)(ws + OFF_AQKV), ws + OFF_UZ, P1024, P1024, 1536, NTOK, 1536, 1024, EPI_F32};
      else if (l == 1) g0 = GemmDesc{H, (const u16*)(ws + OFF_MIN), ws + OFF_UZ, P1024, P1024, 768, NTOK, 768, 1024, EPI_F32};
      else if (l == 2) g0 = GemmDesc{H, (const u16*)(ws + OFF_SQKV), ws + OFF_UZ, P1024, P1024, 1536, NTOK, 1536, 1024, EPI_F32};
      else g0 = GemmDesc{H, (const u16*)(ws + OFF_NQKV), ws + OFF_QO, P1024, P1024, 3072, NTOK, 3072, 1024, EPI_NAT};
      ng = 1;
    } break;
    case 2:
      if (l == 0) pp_attn(p); else if (l == 1) pp_mla1(p); else if (l == 2) pp_swa(p);
      break;
    case 3:
      g0 = GemmDesc{(const u16*)(ws + OFF_CQ), (const u16*)(ws + OFF_MUQ), ws + OFF_UZ, P384, P384, 1536, NTOK, 1536, 384, EPI_F32};
      g1 = GemmDesc{(const u16*)(ws + OFF_CKV), (const u16*)(ws + OFF_MUKV), ws + OFF_KV, P256, P256, 2048, 16384, 2048, 256, EPI_BF16};
      ng = 2;
      break;
    case 4: pp_mla2(p); break;
    case 5: attn_phase(p, l, smem); break;
    case 6: {
      const size_t wo = l == 0 ? OFF_AO_W : (l == 1 ? OFF_MO : (l == 2 ? OFF_SO : OFF_NO));
      g0 = GemmDesc{(const u16*)(ws + OFF_HAO), (const u16*)(ws + wo), ws + OFF_QO, P1024, P1024, 1024, NTOK, 1024, 1024, EPI_BF16};
      ng = 1;
    } break;
    case 7: norm_phase(p, l, 1); break;
    case 8:
      g0 = GemmDesc{(const u16*)(ws + OFF_HAO), (const u16*)(ws + OFF_W1T + (size_t)l * W1T_SZ), ws + OFF_UZ, P1024, P1024, P4096, NTOK, 4096, 1024, EPI_RELU2};
      ng = 1;
      break;
    case 9:
      g0 = GemmDesc{(const u16*)(ws + OFF_UZ), (const u16*)(ws + OFF_W2T + (size_t)l * W2T_SZ), ws + OFF_QO, P4096, P4096, 1024, NTOK, 1024, 4096, EPI_BF16};
      ng = 1;
      break;
  }
  if (ng > 0) gemm_phase(p, g0, g1, ng, smem);
}

#define XB_TMO      128
#define XB_XCNT(j)  (256  + 64 * (j))
#define XB_XSUB(j)  (1280 + 64 * (j))
#define XB_XGEN(j)  (2304 + 64 * (j))
#define XB_TOP      3328
#define XB_TOPGEN   3392
#define XCD_BAR_WORDS 3456
#define XB_SPIN_CAP (1u << 18)
#define LAS __attribute__((address_space(3)))

__device__ __forceinline__ unsigned xb_ld(unsigned* p)              { return __hip_atomic_load(p, __ATOMIC_RELAXED, __HIP_MEMORY_SCOPE_AGENT); }
__device__ __forceinline__ unsigned xb_add(unsigned* p, unsigned v) { return __hip_atomic_fetch_add(p, v, __ATOMIC_RELAXED, __HIP_MEMORY_SCOPE_AGENT); }
__device__ __forceinline__ unsigned xb_xcc_id() { return (unsigned)__builtin_amdgcn_s_getreg((3 << 11) | 20) & 0xFu; }
#define XB_SPIN(cond, bar) do { unsigned _sp = 0; while (cond) { __builtin_amdgcn_s_sleep(1); \
    if ((++_sp & 255u) == 0u) { if (xb_ld(&(bar)[XB_TMO])) break; if (_sp > XB_SPIN_CAP) { atomicAdd(&(bar)[XB_TMO], 1u); break; } } } } while (0)

struct XcdBarrier {
    unsigned* bar; unsigned x;
    volatile LAS unsigned* st;
};

__device__ __forceinline__ XcdBarrier xcd_barrier_post(unsigned* bar, volatile LAS unsigned* st) {
    XcdBarrier b; b.bar = bar; b.x = xb_xcc_id(); b.st = st;
    if (threadIdx.x == 0) (void)xb_add(&bar[XB_XCNT(b.x)], 1u);
    return b;
}
__device__ __forceinline__ void xcd_barrier_complete(unsigned* bar, unsigned x, unsigned& nloc, unsigned& nx) {
    const unsigned G = gridDim.x * gridDim.y * gridDim.z;
    unsigned sum, cnt, mine, sp = 0u;
    for (;;) {
        sum = 0u; cnt = 0u; mine = 0u;
#pragma unroll
        for (unsigned j = 0; j < 16; ++j) { const unsigned c = xb_ld(&bar[XB_XCNT(j)]); sum += c; cnt += (c > 0u) ? 1u : 0u; mine = (j == x) ? c : mine; }
        if (sum == G) break;
        __builtin_amdgcn_s_sleep(1);
        if ((++sp & 255u) == 0u) { if (xb_ld(&bar[XB_TMO])) break; if (sp > XB_SPIN_CAP) { atomicAdd(&bar[XB_TMO], 1u); break; } }
    }
    nloc = mine > 0u ? mine : 1u; nx = cnt > 0u ? cnt : 1u;
}

__device__ __forceinline__ void xcd_barrier(const XcdBarrier& b) {
    asm volatile("s_waitcnt vmcnt(0)" ::: "memory");
    __syncthreads();
    if (threadIdx.x == 0) {
        unsigned* bar = b.bar;
        __builtin_amdgcn_s_waitcnt(0);
        unsigned nloc = b.st[0], nx = b.st[1];
        if (nloc == 0u) { xcd_barrier_complete(bar, b.x, nloc, nx); b.st[0] = nloc; b.st[1] = nx; }
        const unsigned old = xb_add(&bar[XB_XSUB(b.x)], 1u);
        const unsigned gen = old / nloc;
        if (old + 1u == (gen + 1u) * nloc) {
            __builtin_amdgcn_fence(__ATOMIC_RELEASE, "agent");
            asm volatile("s_waitcnt vmcnt(0)" ::: "memory");
            const unsigned og = xb_add(&bar[XB_TOP], 1u);
            const unsigned tg = og / nx;
            if (og + 1u == (tg + 1u) * nx) xb_add(&bar[XB_TOPGEN], 1u);
            else XB_SPIN(xb_ld(&bar[XB_TOPGEN]) == tg, bar);
            __builtin_amdgcn_fence(__ATOMIC_ACQUIRE, "agent");
            xb_add(&bar[XB_XGEN(b.x)], 1u);
            asm volatile("s_waitcnt vmcnt(0)" ::: "memory");
        } else {
            XB_SPIN(xb_ld(&bar[XB_XGEN(b.x)]) == gen, bar);
            __builtin_amdgcn_fence(__ATOMIC_ACQUIRE, "agent");
            asm volatile("s_waitcnt vmcnt(0)" ::: "memory");
        }
    }
    __syncthreads();
}

__global__ void __launch_bounds__(512, 2) mega(Params p) {
  __shared__ __attribute__((aligned(16))) char smem[129024];
  __shared__ uint4 xb_words;
  const bool coop = (p.ph1 - p.ph0) > 1;
  XcdBarrier xb;
  if (coop) {
    if (threadIdx.x == 0) xb_words = make_uint4(0u, 0u, 0u, 0u);
    __syncthreads();
    xb = xcd_barrier_post((unsigned*)(p.ws + OFF_BAR), (volatile LAS unsigned*)&xb_words);
  }
  if (p.ph1 < 0) cg::this_grid().sync();
  for (int ph = p.ph0; ph < p.ph1; ++ph) {
    if (!phase_exists(ph)) continue;
    KA q;
    q.ka = (const AS4 char*)__builtin_amdgcn_kernarg_segment_ptr();
    asm volatile("" : "+s"(q.ka));
    run_phase(q, ph, smem);
    if (ph + 1 < p.ph1) xcd_barrier(xb);
  }
}

extern "C" void kernel_launch(void* const* d_in, const int* in_sizes, int n_in, void* d_out, int out_size,
                              void* d_ws, size_t ws_size, hipStream_t stream) {
  if (n_in < 33 || ws_size < WS_NEED) { fprintf(stderr, "bad args: n_in %d ws %zu need %zu\n", n_in, ws_size, (size_t)WS_NEED); return; }
  Params p{};
  for (int i = 0; i < 33; ++i) p.in[i] = (const float*)d_in[i];
  p.out = (float*)d_out;
  p.ws = (char*)d_ws;
#if N_LAUNCH_MODE == 1
  for (int ph = 0; ph < 42; ++ph) {
    if (!phase_exists(ph)) continue;
    p.ph0 = ph; p.ph1 = ph + 1;
    hipLaunchKernelGGL(mega, dim3(256), dim3(NTHR), 0, stream, p);
  }
#else
  static int grid_blocks = 0;
  if (!grid_blocks) {
    int dev = 0, cus = 0, per_cu = 0;
    hipGetDevice(&dev);
    hipDeviceGetAttribute(&cus, hipDeviceAttributeMultiprocessorCount, dev);
    hipOccupancyMaxActiveBlocksPerMultiprocessor(&per_cu, mega, NTHR, 0);
    if (per_cu > 1) per_cu = 1;
    grid_blocks = cus * per_cu;
  }
  p.ph0 = 0; p.ph1 = 42;
  hipMemsetAsync((char*)d_ws + OFF_BAR, 0, XCD_BAR_WORDS * 4, stream);
  void* args[] = {&p};
  hipError_t e = hipLaunchCooperativeKernel((void*)mega, dim3(grid_blocks), dim3(NTHR), args, 0, stream);
  if (e != hipSuccess) fprintf(stderr, "cooperative launch failed: %s (grid %d)\n", hipGetErrorString(e), grid_blocks);
#endif
}
```

```cpp
#include <hip/hip_runtime.h>
#include <hip/hip_cooperative_groups.h>
#include <cstdio>
namespace cg = cooperative_groups;

typedef unsigned short u16;
typedef short bf16x8 __attribute__((ext_vector_type(8)));
typedef short s16x4 __attribute__((ext_vector_type(4)));
typedef float f32x16 __attribute__((ext_vector_type(16)));
typedef float f32x2 __attribute__((ext_vector_type(2)));
typedef __bf16 bfx2 __attribute__((ext_vector_type(2)));
#define DI __device__ __forceinline__
#define MFMA(a, b, c) __builtin_amdgcn_mfma_f32_32x32x16_bf16((a), (b), (c), 0, 0, 0)
#define LDS3 __attribute__((address_space(3)))

#ifndef REP_GEMM
#define REP_GEMM 1
#endif
#ifndef REP_ATT
#define REP_ATT 1
#endif
#ifndef N_LAUNCH_MODE
#define N_LAUNCH_MODE 0
#endif

constexpr int NTOK = 12288, NCTX = 4096;
constexpr int NTHR = 512, NWAVE = 8;
constexpr float LOG2E = 1.4426950408889634f;

constexpr size_t O_L0K = 12582912, O_L0V = 13631488, O_L1CKV = 14680064, O_L1KPE = 15728640,
                 O_L2K = 15859712, O_L2V = 16908288, O_L3K = 17956864, O_L3V = 22151168;

constexpr int P1024 = 1088, P4096 = 4160, P384 = 448, P256 = 320;
constexpr size_t W1T_SZ = 4096ull * P1024 * 2, W2T_SZ = 1024ull * P4096 * 2;
constexpr size_t OFF_W1T = 0;
constexpr size_t OFF_W2T = OFF_W1T + 4 * W1T_SZ;
constexpr size_t OFF_AQKV = OFF_W2T + 4 * W2T_SZ;
constexpr size_t OFF_AO_W = OFF_AQKV + 1536ull * P1024 * 2;
constexpr size_t OFF_MIN = OFF_AO_W + 1024ull * P1024 * 2;
constexpr size_t OFF_MUQ = OFF_MIN + 768ull * P1024 * 2;
constexpr size_t OFF_MUKV = OFF_MUQ + 1536ull * P384 * 2;
constexpr size_t OFF_MO = OFF_MUKV + 2048ull * P256 * 2;
constexpr size_t OFF_SQKV = OFF_MO + 1024ull * P1024 * 2;
constexpr size_t OFF_SO = OFF_SQKV + 1536ull * P1024 * 2;
constexpr size_t OFF_NQKV = OFF_SO + 1024ull * P1024 * 2;
constexpr size_t OFF_NO = OFF_NQKV + 3072ull * P1024 * 2;
constexpr size_t OFF_MOD = OFF_NO + 1024ull * P1024 * 2;
constexpr size_t OFF_ROPE = OFF_MOD + 4ull * 9 * 6144 * 4;
constexpr size_t OFF_HAO = OFF_ROPE + 3ull * 64 * 32 * 2 * 4;
constexpr size_t OFF_UZ = OFF_HAO + 12288ull * P1024 * 2;
constexpr size_t OFF_QO = OFF_UZ + 12288ull * P4096 * 2;
constexpr size_t OFF_CQ = OFF_QO + 12288ull * 3072 * 2;
constexpr size_t OFF_CKV = OFF_CQ + 12288ull * P384 * 2;
constexpr size_t OFF_KPE = OFF_CKV + 16384ull * P256 * 2;
constexpr size_t OFF_KV = OFF_KPE + 16384ull * 32 * 2;
constexpr size_t OFF_CK = OFF_KV;
constexpr size_t OFF_CV = OFF_KV + 2097152;
constexpr size_t OFF_C3K = OFF_KV + 4194304;
constexpr size_t OFF_C3V = OFF_C3K + 8388608;
constexpr size_t OFF_BAR = OFF_KV + 16384ull * 2048 * 2;
constexpr size_t WS_NEED = OFF_BAR + 16384;

struct Params {
  const float* in[33];
  float* out;
  char* ws;
  int ph0, ph1;
};

#define AS4 __attribute__((address_space(4)))
struct KA {
  const AS4 char* ka;
  DI const float* in(int i) const { return *(const float* const AS4*)(ka + 8 * i); }
  DI float* out() const { return *(float* const AS4*)(ka + 264); }
  DI char* ws() const { return *(char* const AS4*)(ka + 272); }
};

DI unsigned pack2(float a, float b) { f32x2 f = {a, b}; bfx2 v = __builtin_convertvector(f, bfx2); return __builtin_bit_cast(unsigned, v); }
DI u16 f2bf(float a) { return (u16)(pack2(a, a) & 0xffffu); }
DI float wave_sum(float v) {
#pragma unroll
  for (int o = 32; o; o >>= 1) v += __shfl_xor(v, o, 64);
  return v;
}
DI int ltid() { int t = threadIdx.x; asm volatile("" : "+v"(t)); return t; }
DI int crow(int i, int h) { return (i & 3) + 8 * (i >> 2) + 4 * h; }

__device__ const long long TJ[18][6] = {
  {15, 0ll * 1024 * 4096, 1024, 4096, 4096, (long long)(OFF_W1T + 0ull * W1T_SZ)},
  {15, 1ll * 1024 * 4096, 1024, 4096, 4096, (long long)(OFF_W1T + 1ull * W1T_SZ)},
  {15, 2ll * 1024 * 4096, 1024, 4096, 4096, (long long)(OFF_W1T + 2ull * W1T_SZ)},
  {15, 3ll * 1024 * 4096, 1024, 4096, 4096, (long long)(OFF_W1T + 3ull * W1T_SZ)},
  {16, 0ll * 1024 * 4096, 4096, 1024, 1024, (long long)(OFF_W2T + 0ull * W2T_SZ)},
  {16, 1ll * 1024 * 4096, 4096, 1024, 1024, (long long)(OFF_W2T + 1ull * W2T_SZ)},
  {16, 2ll * 1024 * 4096, 4096, 1024, 1024, (long long)(OFF_W2T + 2ull * W2T_SZ)},
  {16, 3ll * 1024 * 4096, 4096, 1024, 1024, (long long)(OFF_W2T + 3ull * W2T_SZ)},
  {17, 0, 1024, 1536, 1536, (long long)OFF_AQKV},
  {20, 0, 1024, 1024, 1024, (long long)OFF_AO_W},
  {21, 0, 1024, 672, 768, (long long)OFF_MIN},
  {24, 0, 384, 1536, 1536, (long long)OFF_MUQ},
  {25, 0, 256, 2048, 2048, (long long)OFF_MUKV},
  {26, 0, 1024, 1024, 1024, (long long)OFF_MO},
  {27, 0, 1024, 1536, 1536, (long long)OFF_SQKV},
  {29, 0, 1024, 1024, 1024, (long long)OFF_SO},
  {30, 0, 1024, 3072, 3072, (long long)OFF_NQKV},
  {32, 0, 1024, 1024, 1024, (long long)OFF_NO},
};

struct TTile { const float* src; u16* dst; int K, N, k0, n0; };
DI void tt_load(const TTile& t, int tid, float4 (&v)[8]) {
  const int n4 = tid & 63, kl = tid >> 6;
  const int n = t.n0 + 4 * n4;
#pragma unroll
  for (int j = 0; j < 8; ++j) {
    const int k = kl + 8 * j;
    v[j] = (n < t.N) ? *(const float4*)(t.src + (size_t)(t.k0 + k) * t.N + n) : make_float4(0.f, 0.f, 0.f, 0.f);
  }
}
DI void tt_store(const TTile& t, int tid, const float4 (&v)[8], char* smem) {
  float (*T)[260] = (float (*)[260])smem;
  const int n4 = tid & 63, kl = tid >> 6;
  __syncthreads();
#pragma unroll
  for (int j = 0; j < 8; ++j) *(float4*)&T[kl + 8 * j][4 * n4] = v[j];
  __syncthreads();
#pragma unroll
  for (int j = 0; j < 4; ++j) {
    const int c = tid + NTHR * j;
    const int n = c >> 3, kc = c & 7;
    uint4 o;
    o.x = pack2(T[kc * 8 + 0][n], T[kc * 8 + 1][n]);
    o.y = pack2(T[kc * 8 + 2][n], T[kc * 8 + 3][n]);
    o.z = pack2(T[kc * 8 + 4][n], T[kc * 8 + 5][n]);
    o.w = pack2(T[kc * 8 + 6][n], T[kc * 8 + 7][n]);
    *(uint4*)&t.dst[(size_t)(t.n0 + n) * (t.K + 64) + t.k0 + kc * 8] = o;
  }
}

DI void convert_f32_bf16(const float* __restrict__ src, u16* __restrict__ dst, size_t n) {
  const size_t n4 = n >> 2;
  const int tid_ = ltid();
  for (size_t i = (size_t)blockIdx.x * NTHR + tid_; i < n4; i += (size_t)gridDim.x * NTHR) {
    const float4 v = ((const float4*)src)[i];
    uint2 o; o.x = pack2(v.x, v.y); o.y = pack2(v.z, v.w);
    ((uint2*)dst)[i] = o;
  }
}

DI void convert_rows256(const float* __restrict__ src, u16* __restrict__ dst, int rows, int dpitch) {
  const int tid_ = ltid();
  for (int i = blockIdx.x * NTHR + tid_; i < rows * 64; i += gridDim.x * NTHR) {
    const int r = i >> 6, c4 = i & 63;
    const float4 v = ((const float4*)src)[i];
    uint2 o; o.x = pack2(v.x, v.y); o.y = pack2(v.z, v.w);
    *(uint2*)(dst + (size_t)r * dpitch + 4 * c4) = o;
  }
}

DI void prepass(const KA& p, char* smem) {
  {
    const int tid = ltid();
    int total = 0;
    for (int j = 0; j < 18; ++j) total += (int)((TJ[j][2] >> 6) * (TJ[j][4] >> 8));
    float4 va[8], vb[8];
    TTile ta, tb;
#define TT_DECODE(tt_, t_)                                                                     \
    {                                                                                          \
      int j = 0, tt = (t_);                                                                    \
      for (;;) { const int c = (int)((TJ[j][2] >> 6) * (TJ[j][4] >> 8)); if (tt < c) break; tt -= c; ++j; } \
      const int K = (int)TJ[j][2];                                                             \
      const int nk = K >> 6;                                                                   \
      tt_.src = p.in((int)TJ[j][0]) + TJ[j][1]; tt_.dst = (u16*)(p.ws() + TJ[j][5]);           \
      tt_.K = K; tt_.N = (int)TJ[j][3]; tt_.k0 = (tt % nk) * 64; tt_.n0 = (tt / nk) * 256;     \
    }
    int t = blockIdx.x;
    if (t < total) { TT_DECODE(ta, t) tt_load(ta, tid, va); }
    for (; t < total; t += 2 * gridDim.x) {
      const int t2 = t + gridDim.x;
      if (t2 < total) { TT_DECODE(tb, t2) tt_load(tb, tid, vb); }
      tt_store(ta, tid, va, smem);
      if (t2 < total) {
        const int t3 = t2 + gridDim.x;
        if (t3 < total) { TT_DECODE(ta, t3) tt_load(ta, tid, va); }
        tt_store(tb, tid, vb, smem);
      }
    }
#undef TT_DECODE
  }
  convert_f32_bf16(p.in(2), (u16*)(p.ws() + OFF_CK), 4096ull * 256);
  convert_f32_bf16(p.in(3), (u16*)(p.ws() + OFF_CV), 4096ull * 256);
  convert_rows256(p.in(4), (u16*)(p.ws() + OFF_CKV) + 12288ull * P256, 4096, P256);
  convert_f32_bf16(p.in(5), (u16*)(p.ws() + OFF_KPE) + 12288ull * 32, 4096ull * 32);
  {
    float* tab = (float*)(p.ws() + OFF_ROPE);
    const int tid_ = ltid();
    for (int e = blockIdx.x * NTHR + tid_; e < 3 * 64 * 32; e += gridDim.x * NTHR) {
      const int kind = e / 2048, pos = (e >> 5) & 63, i = e & 31;
      const int quarter = kind == 0 ? 32 : (kind == 1 ? 16 : 8);
      float c = 1.f, s = 0.f;
      if (i < quarter) {
        const float inv = exp2f(-(float)i / (float)quarter * 13.287712379549449f);
        const float ang = (float)pos * inv;
        c = cosf(ang); s = sinf(ang);
      }
      tab[2 * e] = c; tab[2 * e + 1] = s;
    }
  }
  {
    float* scond = (float*)smem;
    float* red = (float*)(smem + 36864);
    float* MOD = (float*)(p.ws() + OFF_MOD);
    const int tid = ltid();
    bool ready = false;
    for (int it = blockIdx.x; it < 768; it += gridDim.x) {
      __syncthreads();
      if (!ready) {
        for (int e = tid; e < 9 * 1024; e += NTHR) {
          const float c = e < 8192 ? p.in(10)[e] : p.in(11)[e - 8192];
          scond[e] = c / (1.f + __expf(-c));
        }
        ready = true;
        __syncthreads();
      }
      const int l = it / 192, n0 = (it % 192) * 32;
      const int cq = tid & 7, kg = tid >> 3;
      float acc[9][4];
#pragma unroll
      for (int c = 0; c < 9; ++c) { acc[c][0] = 0.f; acc[c][1] = 0.f; acc[c][2] = 0.f; acc[c][3] = 0.f; }
      const float* wp = p.in(12) + (size_t)l * 1024 * 6144 + n0 + 4 * cq;
      float4 wv[16];
#pragma unroll
      for (int i = 0; i < 16; ++i) wv[i] = *(const float4*)(wp + (size_t)(kg + 64 * i) * 6144);
#pragma unroll
      for (int i = 0; i < 16; ++i) {
        const int k = kg + 64 * i;
#pragma unroll
        for (int c = 0; c < 9; ++c) {
          const float sv = scond[c * 1024 + k];
          acc[c][0] += sv * wv[i].x; acc[c][1] += sv * wv[i].y; acc[c][2] += sv * wv[i].z; acc[c][3] += sv * wv[i].w;
        }
      }
#pragma unroll
      for (int c = 0; c < 9; ++c) *(float4*)&red[(kg * 9 + c) * 32 + 4 * cq] = make_float4(acc[c][0], acc[c][1], acc[c][2], acc[c][3]);
      __syncthreads();
      for (int e = tid; e < 288; e += NTHR) {
        const int c = e >> 5, cc = e & 31;
        float sum = p.in(13)[l * 6144 + n0 + cc];
#pragma unroll 8
        for (int g = 0; g < 64; ++g) sum += red[(g * 9 + c) * 32 + cc];
        MOD[(size_t)(l * 9 + c) * 6144 + n0 + cc] = sum;
      }
    }
  }
}

DI float bf2f(unsigned v16) { return __uint_as_float(v16 << 16); }

DI void norm_phase(const KA& p, int l, int mode) {
  const int tid_ = ltid(); const int lane = tid_ & 63, w = tid_ >> 6;
  float* X = p.out();
  const float* MOD = (const float*)(p.ws() + OFF_MOD);
  const u16* FF = (const u16*)(p.ws() + OFF_QO);
  u16* H = (u16*)(p.ws() + OFF_HAO);
  const float* ng = p.in(14);
  const float* xp0 = p.in(0);
  const float* xp1 = p.in(1);
  const bool x_in = (l == 0);
  const bool add = !(l == 0 && mode == 0);
  const int la = (mode == 1) ? l : l - 1;
  const int gate_w = (mode == 1) ? 2 : 5;
  const int gadd = (mode == 1) ? 1 : 3;
  const bool do_h = mode != 2;
  const int gh = (mode == 0) ? 0 : 2, scw = (mode == 0) ? 1 : 4, shw = (mode == 0) ? 0 : 3;
  const int stride = gridDim.x * NWAVE;
  const int lh = do_h ? l : 0;
  int row = blockIdx.x * NWAVE + w;
  float4 nx0, nx1, nx2, nx3;
  uint2 nf0 = make_uint2(0, 0), nf1 = nf0, nf2 = nf0, nf3 = nf0;
#define NLOAD(rw)                                                                                          \
  {                                                                                                        \
    const int rr = min((rw), NTOK - 1);                                                                    \
    const float* xs = x_in ? (rr < NCTX ? xp0 + (size_t)rr * 1024 : xp1 + (size_t)(rr - NCTX) * 1024)      \
                           : X + (size_t)rr * 1024;                                                        \
    nx0 = *(const float4*)(xs + 4 * lane); nx1 = *(const float4*)(xs + 4 * lane + 256);                    \
    nx2 = *(const float4*)(xs + 4 * lane + 512); nx3 = *(const float4*)(xs + 4 * lane + 768);              \
    if (add) {                                                                                             \
      const u16* fr = FF + (size_t)rr * 1024 + 4 * lane;                                                   \
      nf0 = *(const uint2*)(fr); nf1 = *(const uint2*)(fr + 256); nf2 = *(const uint2*)(fr + 512); nf3 = *(const uint2*)(fr + 768); \
    }                                                                                                      \
  }
  NLOAD(row)
  for (; row < NTOK; row += stride) {
    const int ci = row < NCTX ? 8 : ((row - NCTX) >> 10);
    float4 x[4] = {nx0, nx1, nx2, nx3};
    const uint2 fb[4] = {nf0, nf1, nf2, nf3};
    const float* ga = ng + (la * 4 + gadd) * 1024 + 4 * lane;
    const float* gt = MOD + (size_t)(la * 9 + ci) * 6144 + gate_w * 1024 + 4 * lane;
    const float* gp = ng + (lh * 4 + gh) * 1024 + 4 * lane;
    const float* sc = MOD + (size_t)(lh * 9 + ci) * 6144 + scw * 1024 + 4 * lane;
    const float* sh = MOD + (size_t)(lh * 9 + ci) * 6144 + shw * 1024 + 4 * lane;
    float4 ga4[4], gt4[4], g4[4], c4[4], s4[4];
#pragma unroll
    for (int j = 0; j < 4; ++j) {
      if (add) { ga4[j] = *(const float4*)(ga + 256 * j); gt4[j] = *(const float4*)(gt + 256 * j); }
      if (do_h) { g4[j] = *(const float4*)(gp + 256 * j); c4[j] = *(const float4*)(sc + 256 * j); s4[j] = *(const float4*)(sh + 256 * j); }
    }
    NLOAD(row + stride)
    if (add) {
      float f[16];
      float ss = 0.f;
#pragma unroll
      for (int j = 0; j < 4; ++j) {
        f[4 * j] = bf2f(fb[j].x & 0xffffu); f[4 * j + 1] = bf2f(fb[j].x >> 16);
        f[4 * j + 2] = bf2f(fb[j].y & 0xffffu); f[4 * j + 3] = bf2f(fb[j].y >> 16);
        ss += f[4 * j] * f[4 * j] + f[4 * j + 1] * f[4 * j + 1] + f[4 * j + 2] * f[4 * j + 2] + f[4 * j + 3] * f[4 * j + 3];
      }
      ss = wave_sum(ss);
      const float rstd = rsqrtf(ss * (1.f / 1024.f) + 1e-6f);
#pragma unroll
      for (int j = 0; j < 4; ++j) {
        x[j].x += gt4[j].x * (f[4 * j] * rstd * ga4[j].x);
        x[j].y += gt4[j].y * (f[4 * j + 1] * rstd * ga4[j].y);
        x[j].z += gt4[j].z * (f[4 * j + 2] * rstd * ga4[j].z);
        x[j].w += gt4[j].w * (f[4 * j + 3] * rstd * ga4[j].w);
        *(float4*)(X + (size_t)row * 1024 + 4 * lane + 256 * j) = x[j];
      }
    }
    if (do_h) {
      float ss = 0.f;
#pragma unroll
      for (int j = 0; j < 4; ++j) ss += x[j].x * x[j].x + x[j].y * x[j].y + x[j].z * x[j].z + x[j].w * x[j].w;
      ss = wave_sum(ss);
      const float rstd = rsqrtf(ss * (1.f / 1024.f) + 1e-6f);
#pragma unroll
      for (int j = 0; j < 4; ++j) {
        const float h0 = x[j].x * rstd * g4[j].x * (1.f + c4[j].x) + s4[j].x;
        const float h1 = x[j].y * rstd * g4[j].y * (1.f + c4[j].y) + s4[j].y;
        const float h2 = x[j].z * rstd * g4[j].z * (1.f + c4[j].z) + s4[j].z;
        const float h3 = x[j].w * rstd * g4[j].w * (1.f + c4[j].w) + s4[j].w;
        uint2 o; o.x = pack2(h0, h1); o.y = pack2(h2, h3);
        *(uint2*)(H + (size_t)row * P1024 + 4 * lane + 256 * j) = o;
      }
    }
  }
#undef NLOAD
}

enum { EPI_F32 = 0, EPI_BF16 = 1, EPI_RELU2 = 2, EPI_NAT = 3 };
struct GemmDesc { const u16* A; const u16* Bt; void* dst; int lda, ldb, ldc, M, N, K, epi; };

DI void gemm_tile(const GemmDesc& g, int m0, int n0, float* outp, char* smem) {
  constexpr int LS = 72;
  constexpr int BM = 192, BN = 256;
  u16* As = (u16*)smem;
  u16* Bs = As + 2 * BM * LS;
  const int tid = ltid(), lane = tid & 63, w = tid >> 6, r = lane & 31, h = lane >> 5;
  const int wm = w >> 2, wn = w & 3;
  const int lrow = tid >> 3, lcc = tid & 7;
  const int Mlast = g.M - 1;
  const char* Ab = (const char*)g.A;
  const char* Bb = (const char*)g.Bt;
  const unsigned ao0 = (unsigned)(min(m0 + lrow, Mlast) * g.lda + lcc * 8) * 2u;
  const unsigned ao1 = (unsigned)(min(m0 + lrow + 64, Mlast) * g.lda + lcc * 8) * 2u;
  const unsigned ao2 = (unsigned)(min(m0 + lrow + 128, Mlast) * g.lda + lcc * 8) * 2u;
  const unsigned bo0 = (unsigned)((n0 + lrow) * g.ldb + lcc * 8) * 2u;
  const unsigned bst = (unsigned)(64 * g.ldb) * 2u;
  uint4 pa0, pa1, pa2, pb0, pb1, pb2, pb3;
  f32x16 acc00, acc01, acc10, acc11, acc20, acc21;
#pragma unroll
  for (int i = 0; i < 16; ++i) { acc00[i] = 0.f; acc01[i] = 0.f; acc10[i] = 0.f; acc11[i] = 0.f; acc20[i] = 0.f; acc21[i] = 0.f; }
#define GLOAD(R, kt_)                                                                                  \
  {                                                                                                    \
    const char* ak = Ab + (size_t)(kt_) * 128; const char* bk = Bb + (size_t)(kt_) * 128;              \
    R##a0 = *(const uint4*)(ak + ao0); R##a1 = *(const uint4*)(ak + ao1); R##a2 = *(const uint4*)(ak + ao2); \
    R##b0 = *(const uint4*)(bk + bo0); R##b1 = *(const uint4*)(bk + bo0 + bst);                        \
    R##b2 = *(const uint4*)(bk + bo0 + 2 * bst); R##b3 = *(const uint4*)(bk + bo0 + 3 * bst);          \
  }
#define LSTORE(R, buf)                                                                  \
  *(uint4*)&As[(buf) * BM * LS + (lrow) * LS + lcc * 8] = R##a0;                         \
  *(uint4*)&As[(buf) * BM * LS + (lrow + 64) * LS + lcc * 8] = R##a1;                    \
  *(uint4*)&As[(buf) * BM * LS + (lrow + 128) * LS + lcc * 8] = R##a2;                   \
  *(uint4*)&Bs[(buf) * BN * LS + (lrow) * LS + lcc * 8] = R##b0;                         \
  *(uint4*)&Bs[(buf) * BN * LS + (lrow + 64) * LS + lcc * 8] = R##b1;                    \
  *(uint4*)&Bs[(buf) * BN * LS + (lrow + 128) * LS + lcc * 8] = R##b2;                   \
  *(uint4*)&Bs[(buf) * BN * LS + (lrow + 192) * LS + lcc * 8] = R##b3;
#define FRAGS(X, kk)                                                                    \
  X##a0 = *(const bf16x8*)(Ac + 16 * (kk));                                             \
  X##a1 = *(const bf16x8*)(Ac + 32 * LS + 16 * (kk));                                   \
  X##a2 = *(const bf16x8*)(Ac + 64 * LS + 16 * (kk));                                   \
  X##b0 = *(const bf16x8*)(Bc + 16 * (kk));                                             \
  X##b1 = *(const bf16x8*)(Bc + 32 * LS + 16 * (kk));
#define MMAS(X)                                                                         \
  acc00 = MFMA(X##a0, X##b0, acc00); acc01 = MFMA(X##a0, X##b1, acc01);                 \
  acc10 = MFMA(X##a1, X##b0, acc10); acc11 = MFMA(X##a1, X##b1, acc11);                 \
  acc20 = MFMA(X##a2, X##b0, acc20); acc21 = MFMA(X##a2, X##b1, acc21);
#define COMPUTE(buf)                                                                    \
  {                                                                                     \
    const u16* Ac = As + (buf) * BM * LS + (96 * wm + r) * LS + 8 * h;                  \
    const u16* Bc = Bs + (buf) * BN * LS + (64 * wn + r) * LS + 8 * h;                  \
    bf16x8 xa0, xa1, xa2, xb0, xb1, ya0, ya1, ya2, yb0, yb1;                            \
    FRAGS(x, 0) __builtin_amdgcn_sched_barrier(0);                                      \
    FRAGS(y, 1) __builtin_amdgcn_sched_barrier(0); MMAS(x) __builtin_amdgcn_sched_barrier(0); \
    FRAGS(x, 2) __builtin_amdgcn_sched_barrier(0); MMAS(y) __builtin_amdgcn_sched_barrier(0); \
    FRAGS(y, 3) __builtin_amdgcn_sched_barrier(0); MMAS(x) __builtin_amdgcn_sched_barrier(0); \
    MMAS(y)                                                                             \
  }
  const int KT = g.K >> 6;
  GLOAD(p, 0)
  LSTORE(p, 0)
  __syncthreads();
  for (int kt = 0; kt < KT; kt += 2) {
    GLOAD(p, min(kt + 1, KT - 1))
    __builtin_amdgcn_sched_barrier(0);
    COMPUTE(0)
    LSTORE(p, 1)
    __syncthreads();
    GLOAD(p, min(kt + 2, KT - 1))
    __builtin_amdgcn_sched_barrier(0);
    COMPUTE(1)
    LSTORE(p, 0)
    __syncthreads();
  }
#undef GLOAD
#undef LSTORE
#undef FRAGS
#undef MMAS
#undef COMPUTE
  const int epi = g.epi;
#define EPI_LOOP(BODY)                                                                                         \
  _Pragma("unroll") for (int mi = 0; mi < 3; ++mi)                                                             \
  _Pragma("unroll") for (int ni = 0; ni < 2; ++ni) {                                                           \
    const int col = n0 + 64 * wn + 32 * ni + r;                                                                \
    _Pragma("unroll") for (int i = 0; i < 16; ++i) {                                                           \
      const int row = m0 + 96 * wm + 32 * mi + crow(i, h);                                                     \
      const float v = mi == 0 ? (ni == 0 ? acc00[i] : acc01[i]) : (mi == 1 ? (ni == 0 ? acc10[i] : acc11[i]) : (ni == 0 ? acc20[i] : acc21[i])); \
      BODY                                                                                                     \
    }                                                                                                          \
  }
  if (epi == EPI_F32) {
    float* dst = (float*)g.dst;
    EPI_LOOP(dst[(size_t)row * g.ldc + col] = v;)
  } else if (epi == EPI_RELU2) {
    u16* dst = (u16*)g.dst;
    EPI_LOOP(const float t = v > 0.f ? v : 0.f; dst[(size_t)row * g.ldc + col] = f2bf(t * t);)
  } else if (epi == EPI_BF16) {
    u16* dst = (u16*)g.dst;
    EPI_LOOP(if (row <= Mlast) dst[(size_t)row * g.ldc + col] = f2bf(v);)
  } else {
    u16* dst = (u16*)g.dst;
    EPI_LOOP(dst[(size_t)row * g.ldc + col] = f2bf(v);
             if (row < NCTX && col >= 1024) outp[(col < 2048 ? O_L3K - 1024 : O_L3V - 2048) + (size_t)row * 1024 + col] = v;)
  }
#undef EPI_LOOP
}

DI void gemm_phase(const KA& p, const GemmDesc& g0, const GemmDesc& g1, int ng, char* smem) {
  const int nt0 = g0.N >> 8, mt0 = (g0.M + 191) / 192;
  const int CN = (nt0 & 3) == 0 ? 4 : ((nt0 & 1) == 0 ? 2 : 1), CM = 32 / CN;
  if (ng == 1 && gridDim.x == 256 && (mt0 % CM) == 0) {
    const int x = blockIdx.x & 7, s = blockIdx.x >> 3, mi = s / CN, ni = s - mi * CN;
    const int ncn = nt0 / CN, nchunks = (mt0 / CM) * ncn;
    for (int rep = 0; rep < REP_GEMM; ++rep)
    for (int c = x; c < nchunks; c += 8) {
      const int cm = c / ncn, cn = c - cm * ncn;
      gemm_tile(g0, (cm * CM + mi) * 192, (cn * CN + ni) * 256, p.out(), smem);
    }
    return;
  }
  const int t0 = mt0 * nt0;
  const int t1 = ng > 1 ? ((g1.M + 191) / 192) * (g1.N >> 8) : 0;
  for (int rep = 0; rep < REP_GEMM; ++rep)
  for (int t = blockIdx.x; t < t0 + t1; t += gridDim.x) {
    const bool first = t < t0;
    GemmDesc g;
    g.A = first ? g0.A : g1.A; g.Bt = first ? g0.Bt : g1.Bt; g.dst = first ? g0.dst : g1.dst;
    g.lda = first ? g0.lda : g1.lda; g.ldb = first ? g0.ldb : g1.ldb; g.ldc = first ? g0.ldc : g1.ldc;
    g.M = first ? g0.M : g1.M; g.N = first ? g0.N : g1.N; g.K = first ? g0.K : g1.K; g.epi = first ? g0.epi : g1.epi;
    const int tt = first ? t : t - t0;
    const int nt = g.N >> 8;
    gemm_tile(g, (tt / nt) * 192, (tt % nt) * 256, p.out(), smem);
  }
}

#define PP_LOADROW(dst, NV, PITCH, rw)                                             \
  {                                                                                \
    const float* zr_ = Z + (size_t)min((rw), NTOK - 1) * (PITCH) + lane;           \
    _Pragma("unroll") for (int j_ = 0; j_ < (NV); ++j_) dst[j_] = zr_[64 * j_];    \
  }

DI void pp_attn(const KA& p) {
  const int tid_ = ltid(); const int lane = tid_ & 63, w = tid_ >> 6;
  const float* Z = (const float*)(p.ws() + OFF_UZ);
  u16* QKV = (u16*)(p.ws() + OFF_QO);
  float* outp = p.out();
  const float* tab = (const float*)(p.ws() + OFF_ROPE);
  const float gq0 = p.in(18)[lane], gq1 = p.in(18)[64 + lane], gk0 = p.in(19)[lane], gk1 = p.in(19)[64 + lane];
  const int stride = gridDim.x * NWAVE;
  int row = blockIdx.x * NWAVE + w;
  float nv[24];
  PP_LOADROW(nv, 24, 1536, row)
  for (; row < NTOK; row += stride) {
    float v[24];
#pragma unroll
    for (int j = 0; j < 24; ++j) v[j] = nv[j];
    const bool lat = row >= NCTX;
    const int t = (row - NCTX) & 1023, pr = t >> 6, pc = t & 63;
    const int i = lane & 31;
    const float c0 = tab[(pr * 32 + i) * 2], s0 = tab[(pr * 32 + i) * 2 + 1];
    const float c1 = tab[(pc * 32 + i) * 2], s1 = tab[(pc * 32 + i) * 2 + 1];
    PP_LOADROW(nv, 24, 1536, row + stride)
    u16* o = QKV + (size_t)row * 1536;
    const float sg = lane < 32 ? -1.f : 1.f;
#pragma unroll
    for (int hd = 0; hd < 10; ++hd) {
      const float v0 = v[2 * hd], v1 = v[2 * hd + 1];
      const float ss = wave_sum(v0 * v0 + v1 * v1);
      const float rstd = rsqrtf(ss * (1.f / 128.f) + 1e-6f);
      float y0 = v0 * rstd * (hd < 8 ? gq0 : gk0), y1 = v1 * rstd * (hd < 8 ? gq1 : gk1);
      if (hd >= 8 && !lat) {
        outp[O_L0K + (size_t)row * 256 + (hd - 8) * 128 + lane] = y0;
        outp[O_L0K + (size_t)row * 256 + (hd - 8) * 128 + 64 + lane] = y1;
      }
      const float p0 = __shfl_xor(y0, 32, 64), p1 = __shfl_xor(y1, 32, 64);
      if (lat) {
        y0 = y0 * c0 + sg * p0 * s0;
        y1 = y1 * c1 + sg * p1 * s1;
      }
      o[hd * 128 + lane] = f2bf(y0);
      o[hd * 128 + 64 + lane] = f2bf(y1);
    }
#pragma unroll
    for (int j = 0; j < 4; ++j) {
      const float vv = v[20 + j];
      o[1280 + 64 * j + lane] = f2bf(vv);
      if (!lat) outp[O_L0V + (size_t)row * 256 + 64 * j + lane] = vv;
    }
  }
}

DI void pp_swa(const KA& p) {
  const int tid_ = ltid(); const int lane = tid_ & 63, w = tid_ >> 6;
  const float* Z = (const float*)(p.ws() + OFF_UZ);
  u16* QKV = (u16*)(p.ws() + OFF_QO);
  float* outp = p.out();
  const float* tab = (const float*)(p.ws() + OFF_ROPE) + 1 * 64 * 32 * 2;
  const int stride = gridDim.x * NWAVE;
  int row = blockIdx.x * NWAVE + w;
  float nv[24];
  PP_LOADROW(nv, 24, 1536, row)
  for (; row < NTOK; row += stride) {
    float v[24];
#pragma unroll
    for (int j = 0; j < 24; ++j) v[j] = nv[j];
    const bool lat = row >= NCTX;
    const int t = (row - NCTX) & 1023, pr = t >> 6, pc = t & 63;
    const int i = lane & 15, axis = lane >> 5, half = (lane >> 4) & 1;
    const int pos = axis ? pc : pr;
    const float c = tab[(pos * 32 + i) * 2], sn = tab[(pos * 32 + i) * 2 + 1];
    PP_LOADROW(nv, 24, 1536, row + stride)
    u16* o = QKV + (size_t)row * 1536;
    const float sg = half ? 1.f : -1.f;
#pragma unroll
    for (int hd = 0; hd < 20; ++hd) {
      float vv = v[hd];
      if (hd >= 16 && !lat) outp[O_L2K + (size_t)row * 256 + (hd - 16) * 64 + lane] = vv;
      const float pv = __shfl_xor(vv, 16, 64);
      if (lat) vv = vv * c + sg * pv * sn;
      o[hd * 64 + lane] = f2bf(vv);
    }
#pragma unroll
    for (int j = 0; j < 4; ++j) {
      const float vv = v[20 + j];
      o[1280 + 64 * j + lane] = f2bf(vv);
      if (!lat) outp[O_L2V + (size_t)row * 256 + 64 * j + lane] = vv;
    }
  }
}

DI void pp_mla1(const KA& p) {
  const int tid_ = ltid(); const int lane = tid_ & 63, w = tid_ >> 6;
  const float* Z = (const float*)(p.ws() + OFF_UZ);
  u16* CQ = (u16*)(p.ws() + OFF_CQ);
  u16* CKV = (u16*)(p.ws() + OFF_CKV);
  u16* KPE = (u16*)(p.ws() + OFF_KPE);
  float* outp = p.out();
  const float* tab = (const float*)(p.ws() + OFF_ROPE) + 2 * 64 * 32 * 2;
  float gq[6], gkv[4];
#pragma unroll
  for (int j = 0; j < 6; ++j) gq[j] = p.in(22)[64 * j + lane];
#pragma unroll
  for (int j = 0; j < 4; ++j) gkv[j] = p.in(23)[64 * j + lane];
  const int stride = gridDim.x * NWAVE;
  int row = blockIdx.x * NWAVE + w;
  float nv[11];
  PP_LOADROW(nv, 11, 768, row)
  for (; row < NTOK; row += stride) {
    float v[11];
#pragma unroll
    for (int j = 0; j < 11; ++j) v[j] = nv[j];
    const bool lat = row >= NCTX;
    const int t = (row - NCTX) & 1023, pr = t >> 6, pc = t & 63;
    const int e = lane & 31;
    const int ri = e & 7, axis = e >> 4, half = (e >> 3) & 1;
    const int pos = axis ? pc : pr;
    const float c = tab[(pos * 32 + ri) * 2], sn = tab[(pos * 32 + ri) * 2 + 1];
    PP_LOADROW(nv, 11, 768, row + stride)
    float ss = 0.f;
#pragma unroll
    for (int j = 0; j < 6; ++j) ss += v[j] * v[j];
    ss = wave_sum(ss);
    float rstd = rsqrtf(ss * (1.f / 384.f) + 1e-6f);
#pragma unroll
    for (int j = 0; j < 6; ++j) CQ[(size_t)row * P384 + 64 * j + lane] = f2bf(v[j] * rstd * gq[j]);
    ss = 0.f;
#pragma unroll
    for (int j = 0; j < 4; ++j) ss += v[6 + j] * v[6 + j];
    ss = wave_sum(ss);
    rstd = rsqrtf(ss * (1.f / 256.f) + 1e-6f);
#pragma unroll
    for (int j = 0; j < 4; ++j) {
      const float y = v[6 + j] * rstd * gkv[j];
      CKV[(size_t)row * P256 + 64 * j + lane] = f2bf(y);
      if (!lat) outp[O_L1CKV + (size_t)row * 256 + 64 * j + lane] = y;
    }
    float vv = v[10];
    const float pv = __shfl_xor(vv, 8, 64);
    if (lat) vv = vv * c + (half ? pv : -pv) * sn;
    if (lane < 32) {
      KPE[(size_t)row * 32 + e] = f2bf(vv);
      if (!lat) outp[O_L1KPE + (size_t)row * 32 + e] = vv;
    }
  }
}

DI void pp_mla2(const KA& p) {
  const int tid_ = ltid(); const int lane = tid_ & 63, w = tid_ >> 6;
  const float* Z = (const float*)(p.ws() + OFF_UZ);
  u16* Q = (u16*)(p.ws() + OFF_QO);
  const float* tab = (const float*)(p.ws() + OFF_ROPE) + 2 * 64 * 32 * 2;
  const int stride = gridDim.x * NWAVE;
  int row = blockIdx.x * NWAVE + w;
  float nv[24];
  PP_LOADROW(nv, 24, 1536, row)
  for (; row < NTOK; row += stride) {
    float v[24];
#pragma unroll
    for (int j = 0; j < 24; ++j) v[j] = nv[j];
    const bool lat = row >= NCTX;
    const int t = (row - NCTX) & 1023, pr = t >> 6, pc = t & 63;
    const int e = lane & 31;
    const int ri = e & 7, axis = e >> 4, half = (e >> 3) & 1;
    const int pos = axis ? pc : pr;
    const float c = tab[(pos * 32 + ri) * 2], sn = tab[(pos * 32 + ri) * 2 + 1];
    PP_LOADROW(nv, 24, 1536, row + stride)
#pragma unroll
    for (int j = 0; j < 24; ++j) {
      const int col = 64 * j + lane;
      float vv = v[j];
      const float pv = __shfl_xor(vv, 8, 64);
      const int d = col % 96;
      if (lat && d >= 64) vv = vv * c + (half ? pv : -pv) * sn;
      Q[(size_t)row * 1536 + col] = f2bf(vv);
    }
  }
}
#undef PP_LOADROW

struct Seg { const u16* k1; const u16* k2; const u16* v; int ldk1, ldk2, ldv, n0, n1, mode; };

template <int HDQK, int HDV>
DI void attn_item(const u16* __restrict__ Qp, int ldq, const Seg& sA, const Seg& sB, int nseg, int qpos0,
                  float scale_l2, const float* __restrict__ rpb_h, bool has_sink, float sink_l2,
                  u16* __restrict__ Op, int ldo, char* smem) {
  constexpr int K1W = (HDQK == 96) ? 64 : HDQK;
  constexpr int KS = HDQK + 8, VS = HDV + 8;
  constexpr int KC = HDQK / 8, VC = HDV / 8;
  u16* Ks = (u16*)smem;
  u16* Vs = Ks + 64 * KS;
  float* rp = (float*)(Vs + 64 * VS);
  const int tid = ltid(), lane = tid & 63, w = tid >> 6, r = lane & 31, h = lane >> 5;
  const int q4 = (lane & 15) >> 2, p4 = lane & 3, dblk = (lane >> 4) & 1;

  __syncthreads();
  if (rpb_h) for (int e = tid; e < 465; e += NTHR) rp[e] = rpb_h[e];

  bf16x8 qf[HDQK / 16];
  {
    const u16* qrow = Qp + (size_t)(32 * w + r) * ldq + 8 * h;
#pragma unroll
    for (int kk = 0; kk < HDQK / 16; ++kk) qf[kk] = *(const bf16x8*)(qrow + 16 * kk);
  }
  f32x16 o[HDV / 32];
#pragma unroll
  for (int dt = 0; dt < HDV / 32; ++dt)
#pragma unroll
    for (int i = 0; i < 16; ++i) o[dt][i] = 0.f;
  float m = -1e30f, l = 0.f;
  const int qpos = qpos0 + 32 * w + r;
  const int qr = qpos >> 6, qc = qpos & 63;
  const int r0 = min(max(qr - 4, 0), 8), c0 = min(max(qc - 8, 0), 48);

  constexpr int KI = (64 * KC + NTHR - 1) / NTHR, VI = (64 * VC + NTHR - 1) / NTHR;
  const int TA = (sA.n1 - sA.n0) >> 6;
  const int T = TA + (nseg > 1 ? ((sB.n1 - sB.n0) >> 6) : 0);
  uint4 kreg0 = make_uint4(0, 0, 0, 0), kreg1 = kreg0, vreg0 = kreg0, vreg1 = kreg0;
#define ATT_KADDR(i, p1, p2, l1, l2, nn)                                                               \
  const int kc_##i = tid + NTHR * i; const int krow_##i = kc_##i / KC, kcc_##i = kc_##i - krow_##i * KC; \
  const u16* ksrc_##i = (kcc_##i * 8 < K1W) ? p1 + (size_t)(nn + krow_##i) * l1 + kcc_##i * 8          \
                                            : p2 + (size_t)(nn + krow_##i) * l2 + (kcc_##i * 8 - K1W);
#define ATT_FETCH(t)                                                                                   \
  {                                                                                                    \
    const bool fa = (t) < TA;                                                                          \
    const u16* fk1 = fa ? sA.k1 : sB.k1; const u16* fk2 = fa ? sA.k2 : sB.k2; const u16* fv = fa ? sA.v : sB.v; \
    const int fl1 = fa ? sA.ldk1 : sB.ldk1, fl2 = fa ? sA.ldk2 : sB.ldk2, flv = fa ? sA.ldv : sB.ldv;   \
    const int fn = fa ? sA.n0 + 64 * (t) : sB.n0 + 64 * ((t) - TA);                                    \
    { ATT_KADDR(0, fk1, fk2, fl1, fl2, fn) kreg0 = *(const uint4*)ksrc_0; }                            \
    if (KI > 1) { ATT_KADDR(1, fk1, fk2, fl1, fl2, fn) if (64 * KC % NTHR == 0 || kc_1 < 64 * KC) kreg1 = *(const uint4*)ksrc_1; } \
    { const int c = tid; const int row = c / VC, cc = c - row * VC; vreg0 = *(const uint4*)(fv + (size_t)(fn + row) * flv + cc * 8); } \
    if (VI > 1) { const int c = tid + NTHR; const int row = c / VC, cc = c - row * VC; vreg1 = *(const uint4*)(fv + (size_t)(fn + row) * flv + cc * 8); } \
  }
  ATT_FETCH(0)
  for (int t = 0; t < T; ++t) {
    {
      const bool ca = t < TA;
      const int mode = ca ? sA.mode : sB.mode;
      const int n = ca ? sA.n0 + 64 * t : sB.n0 + 64 * (t - TA);
      __syncthreads();
      { const int c = tid; const int row = c / KC, cc = c - row * KC; *(uint4*)&Ks[row * KS + cc * 8] = kreg0; }
      if (KI > 1) { const int c = tid + NTHR; if (64 * KC % NTHR == 0 || c < 64 * KC) { const int row = c / KC, cc = c - row * KC; *(uint4*)&Ks[row * KS + cc * 8] = kreg1; } }
      { const int c = tid; const int row = c / VC, cc = c - row * VC; *(uint4*)&Vs[row * VS + cc * 8] = vreg0; }
      if (VI > 1) { const int c = tid + NTHR; const int row = c / VC, cc = c - row * VC; *(uint4*)&Vs[row * VS + cc * 8] = vreg1; }
      __syncthreads();
      if (t + 1 < T) ATT_FETCH(t + 1)
      const int qw = qpos0 + 32 * w;
      bool skip = false;
      if (mode == 1) skip = (n > qw + 31 + 128) || (n + 63 < qw - 128);
      else if (mode == 2) { const int r0w = min(max((qw >> 6) - 4, 0), 8); const int kr = n >> 6; skip = (kr < r0w) || (kr >= r0w + 8); }
      if (skip) continue;
      f32x16 st[2];
#pragma unroll
      for (int kt = 0; kt < 2; ++kt) {
#pragma unroll
        for (int i = 0; i < 16; ++i) st[kt][i] = 0.f;
        const u16* kb = Ks + (32 * kt + r) * KS + 8 * h;
#pragma unroll
        for (int kk = 0; kk < HDQK / 16; ++kk) {
          const bf16x8 a = *(const bf16x8*)(kb + 16 * kk);
          st[kt] = MFMA(a, qf[kk], st[kt]);
        }
      }
      float mx = -1e30f;
      if (mode == 0) {
#pragma unroll
        for (int kt = 0; kt < 2; ++kt)
#pragma unroll
          for (int i = 0; i < 16; ++i) { const float v = st[kt][i] * scale_l2; st[kt][i] = v; mx = fmaxf(mx, v); }
      } else if (mode == 1) {
#pragma unroll
        for (int kt = 0; kt < 2; ++kt)
#pragma unroll
          for (int i = 0; i < 16; ++i) {
            const int kpos = n + 32 * kt + crow(i, h);
            const int d = qpos - kpos;
            float v = st[kt][i] * scale_l2;
            if (d > 128 || d < -128) v = -1e30f;
            st[kt][i] = v; mx = fmaxf(mx, v);
          }
      } else {
#pragma unroll
        for (int kt = 0; kt < 2; ++kt)
#pragma unroll
          for (int i = 0; i < 16; ++i) {
            const int kpos = n + 32 * kt + crow(i, h);
            const int kr = kpos >> 6, kc = kpos & 63;
            const bool ok = ((unsigned)(kr - r0) < 8u) && ((unsigned)(kc - c0) < 16u);
            const int idx = ok ? (kr - qr + 7) * 31 + (kc - qc + 15) : 0;
            const float b = rp[idx];
            float v = st[kt][i] * scale_l2 + b * LOG2E;
            if (!ok) v = -1e30f;
            st[kt][i] = v; mx = fmaxf(mx, v);
          }
      }
      mx = fmaxf(mx, __shfl_xor(mx, 32, 64));
      const float mn = fmaxf(m, mx);
      const float alpha = __builtin_amdgcn_exp2f(m - mn);
      m = mn;
      float rs = 0.f;
#pragma unroll
      for (int kt = 0; kt < 2; ++kt)
#pragma unroll
        for (int i = 0; i < 16; ++i) { const float pz = __builtin_amdgcn_exp2f(st[kt][i] - mn); st[kt][i] = pz; rs += pz; }
      rs += __shfl_xor(rs, 32, 64);
      l = l * alpha + rs;
#pragma unroll
      for (int dt = 0; dt < HDV / 32; ++dt)
#pragma unroll
        for (int i = 0; i < 16; ++i) o[dt][i] *= alpha;
#pragma unroll
      for (int kt = 0; kt < 2; ++kt)
#pragma unroll
        for (int s2 = 0; s2 < 2; ++s2) {
          unsigned pk[4];
#pragma unroll
          for (int j = 0; j < 4; ++j) pk[j] = pack2(st[kt][8 * s2 + 2 * j], st[kt][8 * s2 + 2 * j + 1]);
          bf16x8 pb;
          {
            typedef unsigned u32x4 __attribute__((ext_vector_type(4)));
            u32x4 t4 = {pk[0], pk[1], pk[2], pk[3]};
            pb = __builtin_bit_cast(bf16x8, t4);
          }
          const u16* vb = Vs + (32 * kt + 16 * s2 + 4 * h + q4) * VS + 16 * dblk + 4 * p4;
#pragma unroll
          for (int dt = 0; dt < HDV / 32; ++dt) {
            const s16x4 lo = __builtin_amdgcn_ds_read_tr16_b64_v4i16((LDS3 s16x4*)(vb + 32 * dt));
            const s16x4 hi = __builtin_amdgcn_ds_read_tr16_b64_v4i16((LDS3 s16x4*)(vb + 8 * VS + 32 * dt));
            const bf16x8 va = __builtin_shufflevector(lo, hi, 0, 1, 2, 3, 4, 5, 6, 7);
            o[dt] = MFMA(va, pb, o[dt]);
          }
        }
    }
  }
#undef ATT_FETCH
#undef ATT_KADDR
  if (has_sink) l += __builtin_amdgcn_exp2f(sink_l2 - m);
  const float inv = 1.f / l;
  u16* orow = Op + (size_t)(32 * w + r) * ldo + 4 * h;
#pragma unroll
  for (int dt = 0; dt < HDV / 32; ++dt)
#pragma unroll
    for (int g = 0; g < 4; ++g) {
      uint2 v;
      v.x = pack2(o[dt][4 * g] * inv, o[dt][4 * g + 1] * inv);
      v.y = pack2(o[dt][4 * g + 2] * inv, o[dt][4 * g + 3] * inv);
      *(uint2*)(orow + 32 * dt + 8 * g) = v;
    }
}

DI void attn_phase(const KA& p, int kind, char* smem) {
  const int Hq = kind == 0 ? 8 : 16;
  const int nlat = 8 * Hq * 4, nctx = 16 * Hq;
  u16* AO = (u16*)(p.ws() + OFF_HAO);
  const u16* QKV = (const u16*)(p.ws() + OFF_QO);
  for (int rep = 0; rep < REP_ATT; ++rep)
  for (int item = blockIdx.x; item < nlat + nctx; item += gridDim.x) {
    const bool lat = item < nlat;
    int b, hq, qt;
    if (lat) { b = item / (Hq * 4); const int rem = item - b * Hq * 4; hq = rem >> 2; qt = rem & 3; }
    else { const int it = item - nlat; b = it / Hq; hq = it - b * Hq; qt = 0; }
    const int tok0 = lat ? NCTX + b * 1024 : b * 256;
    const int S = lat ? 1024 : 256;
    const int qrow0 = tok0 + qt * 256;
    Seg sc, ss;
    sc.k2 = nullptr; sc.ldk2 = 0; ss.k2 = nullptr; ss.ldk2 = 0;
    sc.n0 = 0; sc.n1 = 512; sc.mode = 0;
    ss.n0 = 0; ss.n1 = S; ss.mode = 0;
    const u16* Qp; int ldq; float sl2; const float* rpb = nullptr; bool has_sink = false; float sink_l2 = 0.f;
    u16* Op;
    if (kind == 0) {
      const int kvh = hq >> 2;
      ss.k1 = QKV + (size_t)tok0 * 1536 + 1024 + kvh * 128; ss.ldk1 = 1536;
      ss.v = QKV + (size_t)tok0 * 1536 + 1280 + kvh * 128; ss.ldv = 1536;
      sc.k1 = (const u16*)(p.ws() + OFF_CK) + (size_t)b * 512 * 256 + kvh * 128; sc.ldk1 = 256;
      sc.v = (const u16*)(p.ws() + OFF_CV) + (size_t)b * 512 * 256 + kvh * 128; sc.ldv = 256;
      sl2 = 0.08838834764831845f * LOG2E;
      Qp = QKV + (size_t)qrow0 * 1536 + hq * 128; ldq = 1536;
      Op = AO + (size_t)qrow0 * P1024 + hq * 128;
    } else if (kind == 1) {
      const u16* KV = (const u16*)(p.ws() + OFF_KV);
      const u16* KPE = (const u16*)(p.ws() + OFF_KPE);
      ss.k1 = KV + (size_t)tok0 * 2048 + hq * 128; ss.ldk1 = 2048;
      ss.k2 = KPE + (size_t)tok0 * 32; ss.ldk2 = 32;
      ss.v = KV + (size_t)tok0 * 2048 + hq * 128 + 64; ss.ldv = 2048;
      const size_t crow0 = 12288 + (size_t)b * 512;
      sc.k1 = KV + crow0 * 2048 + hq * 128; sc.ldk1 = 2048;
      sc.k2 = KPE + crow0 * 32; sc.ldk2 = 32;
      sc.v = KV + crow0 * 2048 + hq * 128 + 64; sc.ldv = 2048;
      sl2 = 0.10206207261596575f * LOG2E;
      Qp = QKV + (size_t)qrow0 * 1536 + hq * 96; ldq = 1536;
      Op = AO + (size_t)qrow0 * P1024 + hq * 64;
    } else if (kind == 2) {
      const int kvh = hq >> 2;
      ss.k1 = QKV + (size_t)tok0 * 1536 + 1024 + kvh * 64; ss.ldk1 = 1536;
      ss.v = QKV + (size_t)tok0 * 1536 + 1280 + kvh * 64; ss.ldv = 1536;
      sc.k1 = (const u16*)(p.ws() + OFF_CK) + (size_t)b * 512 * 256 + kvh * 64; sc.ldk1 = 256;
      sc.v = (const u16*)(p.ws() + OFF_CV) + (size_t)b * 512 * 256 + kvh * 64; sc.ldv = 256;
      sl2 = 0.125f * LOG2E;
      has_sink = true; sink_l2 = p.in(28)[hq] * LOG2E;
      if (lat) { ss.n0 = max(0, qt * 256 - 128); ss.n1 = min(1024, qt * 256 + 384); ss.mode = 1; }
      Qp = QKV + (size_t)qrow0 * 1536 + hq * 64; ldq = 1536;
      Op = AO + (size_t)qrow0 * P1024 + hq * 64;
    } else {
      ss.k1 = QKV + (size_t)tok0 * 3072 + 1024 + hq * 64; ss.ldk1 = 3072;
      ss.v = QKV + (size_t)tok0 * 3072 + 2048 + hq * 64; ss.ldv = 3072;
      sc.k1 = (const u16*)(p.ws() + OFF_C3K) + (size_t)b * 512 * 1024 + hq * 64; sc.ldk1 = 1024;
      sc.v = (const u16*)(p.ws() + OFF_C3V) + (size_t)b * 512 * 1024 + hq * 64; sc.ldv = 1024;
      sl2 = 0.125f * LOG2E;
      if (lat) {
        const int r0a = min(max(4 * qt - 4, 0), 8), r0b = min(max(4 * qt - 1, 0), 8);
        ss.n0 = r0a * 64; ss.n1 = (r0b + 8) * 64; ss.mode = 2;
        rpb = p.in(31) + hq * 465;
      }
      Qp = QKV + (size_t)qrow0 * 3072 + hq * 64; ldq = 3072;
      Op = AO + (size_t)qrow0 * P1024 + hq * 64;
    }
    Seg s0;
    s0.k1 = lat ? sc.k1 : ss.k1; s0.k2 = lat ? sc.k2 : ss.k2; s0.v = lat ? sc.v : ss.v;
    s0.ldk1 = lat ? sc.ldk1 : ss.ldk1; s0.ldk2 = lat ? sc.ldk2 : ss.ldk2; s0.ldv = lat ? sc.ldv : ss.ldv;
    s0.n0 = lat ? sc.n0 : ss.n0; s0.n1 = lat ? sc.n1 : ss.n1; s0.mode = lat ? sc.mode : ss.mode;
    const int nseg = lat ? 2 : 1;
    if (kind == 0) attn_item<128, 128>(Qp, ldq, s0, ss, nseg, qt * 256, sl2, rpb, has_sink, sink_l2, Op, P1024, smem);
    else if (kind == 1) attn_item<96, 64>(Qp, ldq, s0, ss, nseg, qt * 256, sl2, rpb, has_sink, sink_l2, Op, P1024, smem);
    else attn_item<64, 64>(Qp, ldq, s0, ss, nseg, qt * 256, sl2, rpb, has_sink, sink_l2, Op, P1024, smem);
  }
}

__host__ __device__ inline bool phase_exists(int ph) {
  if (ph == 0 || ph == 41) return true;
  const int l = (ph - 1) / 10, s = (ph - 1) % 10;
  if ((s == 3 || s == 4) && l != 1) return false;
  if (s == 2 && l == 3) return false;
  return true;
}

DI void run_phase(const KA& p, int ph, char* smem) {
  if (ph == 0) { prepass(p, smem); return; }
  if (ph == 41) { norm_phase(p, 4, 2); return; }
  const int l = (ph - 1) / 10, s = (ph - 1) % 10;
  char* ws = p.ws();
  GemmDesc g0, g1;
  g0 = GemmDesc{nullptr, nullptr, nullptr, 0, 0, 0, 0, 0, 0, 0};
  g1 = g0;
  int ng = 0;
  switch (s) {
    case 0:
      norm_phase(p, l, 0);
      if (l == 2) {
        convert_f32_bf16(p.in(6), (u16*)(ws + OFF_CK), 4096ull * 256);
        convert_f32_bf16(p.in(7), (u16*)(ws + OFF_CV), 4096ull * 256);
      } else if (l == 3) {
        convert_f32_bf16(p.in(8), (u16*)(ws + OFF_C3K), 4096ull * 1024);
        convert_f32_bf16(p.in(9), (u16*)(ws + OFF_C3V), 4096ull * 1024);
      }
      break;
    case 1: {
      const u16* H = (const u16*)(ws + OFF_HAO);
      if (l == 0) g0 = GemmDesc{H, (const u16*)(ws + OFF_AQKV), ws + OFF_UZ, P1024, P1024, 1536, NTOK, 1536, 1024, EPI_F32};
      else if (l == 1) g0 = GemmDesc{H, (const u16*)(ws + OFF_MIN), ws + OFF_UZ, P1024, P1024, 768, NTOK, 768, 1024, EPI_F32};
      else if (l == 2) g0 = GemmDesc{H, (const u16*)(ws + OFF_SQKV), ws + OFF_UZ, P1024, P1024, 1536, NTOK, 1536, 1024, EPI_F32};
      else g0 = GemmDesc{H, (const u16*)(ws + OFF_NQKV), ws + OFF_QO, P1024, P1024, 3072, NTOK, 3072, 1024, EPI_NAT};
      ng = 1;
    } break;
    case 2:
      if (l == 0) pp_attn(p); else if (l == 1) pp_mla1(p); else if (l == 2) pp_swa(p);
      break;
    case 3:
      g0 = GemmDesc{(const u16*)(ws + OFF_CQ), (const u16*)(ws + OFF_MUQ), ws + OFF_UZ, P384, P384, 1536, NTOK, 1536, 384, EPI_F32};
      g1 = GemmDesc{(const u16*)(ws + OFF_CKV), (const u16*)(ws + OFF_MUKV), ws + OFF_KV, P256, P256, 2048, 16384, 2048, 256, EPI_BF16};
      ng = 2;
      break;
    case 4: pp_mla2(p); break;
    case 5: attn_phase(p, l, smem); break;
    case 6: {
      const size_t wo = l == 0 ? OFF_AO_W : (l == 1 ? OFF_MO : (l == 2 ? OFF_SO : OFF_NO));
      g0 = GemmDesc{(const u16*)(ws + OFF_HAO), (const u16*)(ws + wo), ws + OFF_QO, P1024, P1024, 1024, NTOK, 1024, 1024, EPI_BF16};
      ng = 1;
    } break;
    case 7: norm_phase(p, l, 1); break;
    case 8:
      g0 = GemmDesc{(const u16*)(ws + OFF_HAO), (const u16*)(ws + OFF_W1T + (size_t)l * W1T_SZ), ws + OFF_UZ, P1024, P1024, P4096, NTOK, 4096, 1024, EPI_RELU2};
      ng = 1;
      break;
    case 9:
      g0 = GemmDesc{(const u16*)(ws + OFF_UZ), (const u16*)(ws + OFF_W2T + (size_t)l * W2T_SZ), ws + OFF_QO, P4096, P4096, 1024, NTOK, 1024, 4096, EPI_BF16};
      ng = 1;
      break;
  }
  if (ng > 0) gemm_phase(p, g0, g1, ng, smem);
}

#define XB_TMO      128
#define XB_XCNT(j)  (256  + 64 * (j))
#define XB_XSUB(j)  (1280 + 64 * (j))
#define XB_XGEN(j)  (2304 + 64 * (j))
#define XB_TOP      3328
#define XB_TOPGEN   3392
#define XCD_BAR_WORDS 3456
#define XB_SPIN_CAP (1u << 18)
#define LAS __attribute__((address_space(3)))

__device__ __forceinline__ unsigned xb_ld(unsigned* p)              { return __hip_atomic_load(p, __ATOMIC_RELAXED, __HIP_MEMORY_SCOPE_AGENT); }
__device__ __forceinline__ unsigned xb_add(unsigned* p, unsigned v) { return __hip_atomic_fetch_add(p, v, __ATOMIC_RELAXED, __HIP_MEMORY_SCOPE_AGENT); }
__device__ __forceinline__ unsigned xb_xcc_id() { return (unsigned)__builtin_amdgcn_s_getreg((3 << 11) | 20) & 0xFu; }
#define XB_SPIN(cond, bar) do { unsigned _sp = 0; while (cond) { __builtin_amdgcn_s_sleep(1); \
    if ((++_sp & 255u) == 0u) { if (xb_ld(&(bar)[XB_TMO])) break; if (_sp > XB_SPIN_CAP) { atomicAdd(&(bar)[XB_TMO], 1u); break; } } } } while (0)

struct XcdBarrier {
    unsigned* bar; unsigned x;
    volatile LAS unsigned* st;
};

__device__ __forceinline__ XcdBarrier xcd_barrier_post(unsigned* bar, volatile LAS unsigned* st) {
    XcdBarrier b; b.bar = bar; b.x = xb_xcc_id(); b.st = st;
    if (threadIdx.x == 0) (void)xb_add(&bar[XB_XCNT(b.x)], 1u);
    return b;
}
__device__ __forceinline__ void xcd_barrier_complete(unsigned* bar, unsigned x, unsigned& nloc, unsigned& nx) {
    const unsigned G = gridDim.x * gridDim.y * gridDim.z;
    unsigned sum, cnt, mine, sp = 0u;
    for (;;) {
        sum = 0u; cnt = 0u; mine = 0u;
#pragma unroll
        for (unsigned j = 0; j < 16; ++j) { const unsigned c = xb_ld(&bar[XB_XCNT(j)]); sum += c; cnt += (c > 0u) ? 1u : 0u; mine = (j == x) ? c : mine; }
        if (sum == G) break;
        __builtin_amdgcn_s_sleep(1);
        if ((++sp & 255u) == 0u) { if (xb_ld(&bar[XB_TMO])) break; if (sp > XB_SPIN_CAP) { atomicAdd(&bar[XB_TMO], 1u); break; } }
    }
    nloc = mine > 0u ? mine : 1u; nx = cnt > 0u ? cnt : 1u;
}

__device__ __forceinline__ void xcd_barrier(const XcdBarrier& b) {
    asm volatile("s_waitcnt vmcnt(0)" ::: "memory");
    __syncthreads();
    if (threadIdx.x == 0) {
        unsigned* bar = b.bar;
        __builtin_amdgcn_s_waitcnt(0);
        unsigned nloc = b.st[0], nx = b.st[1];
        if (nloc == 0u) { xcd_barrier_complete(bar, b.x, nloc, nx); b.st[0] = nloc; b.st[1] = nx; }
        const unsigned old = xb_add(&bar[XB_XSUB(b.x)], 1u);
        const unsigned gen = old / nloc;
        if (old + 1u == (gen + 1u) * nloc) {
            __builtin_amdgcn_fence(__ATOMIC_RELEASE, "agent");
            asm volatile("s_waitcnt vmcnt(0)" ::: "memory");
            const unsigned og = xb_add(&bar[XB_TOP], 1u);
            const unsigned tg = og / nx;
            if (og + 1u == (tg + 1u) * nx) xb_add(&bar[XB_TOPGEN], 1u);
            else XB_SPIN(xb_ld(&bar[XB_TOPGEN]) == tg, bar);
            __builtin_amdgcn_fence(__ATOMIC_ACQUIRE, "agent");
            xb_add(&bar[XB_XGEN(b.x)], 1u);
            asm volatile("s_waitcnt vmcnt(0)" ::: "memory");
        } else {
            XB_SPIN(xb_ld(&bar[XB_XGEN(b.x)]) == gen, bar);
            __builtin_amdgcn_fence(__ATOMIC_ACQUIRE, "agent");
            asm volatile("s_waitcnt vmcnt(0)" ::: "memory");
        }
    }
    __syncthreads();
}

__global__ void __launch_bounds__(512, 2) mega(Params p) {
  __shared__ __attribute__((aligned(16))) char smem[129024];
  __shared__ uint4 xb_words;
  const bool coop = (p.ph1 - p.ph0) > 1;
  XcdBarrier xb;
  if (coop) {
    if (threadIdx.x == 0) xb_words = make_uint4(0u, 0u, 0u, 0u);
    __syncthreads();
    xb = xcd_barrier_post((unsigned*)(p.ws + OFF_BAR), (volatile LAS unsigned*)&xb_words);
  }
  if (p.ph1 < 0) cg::this_grid().sync();
  for (int ph = p.ph0; ph < p.ph1; ++ph) {
    if (!phase_exists(ph)) continue;
    KA q;
    q.ka = (const AS4 char*)__builtin_amdgcn_kernarg_segment_ptr();
    asm volatile("" : "+s"(q.ka));
    run_phase(q, ph, smem);
    if (ph + 1 < p.ph1) xcd_barrier(xb);
  }
}

extern "C" void kernel_launch(void* const* d_in, const int* in_sizes, int n_in, void* d_out, int out_size,
                              void* d_ws, size_t ws_size, hipStream_t stream) {
  if (n_in < 33 || ws_size < WS_NEED) { fprintf(stderr, "bad args: n_in %d ws %zu need %zu\n", n_in, ws_size, (size_t)WS_NEED); return; }
  Params p{};
  for (int i = 0; i < 33; ++i) p.in[i] = (const float*)d_in[i];
  p.out = (float*)d_out;
  p.ws = (char*)d_ws;
#if N_LAUNCH_MODE == 1
  for (int ph = 0; ph < 42; ++ph) {
    if (!phase_exists(ph)) continue;
    p.ph0 = ph; p.ph1 = ph + 1;
    hipLaunchKernelGGL(mega, dim3(256), dim3(NTHR), 0, stream, p);
  }
#else
  static int grid_blocks = 0;
  if (!grid_blocks) {
    int dev = 0, cus = 0, per_cu = 0;
    hipGetDevice(&dev);
    hipDeviceGetAttribute(&cus, hipDeviceAttributeMultiprocessorCount, dev);
    hipOccupancyMaxActiveBlocksPerMultiprocessor(&per_cu, mega, NTHR, 0);
    if (per_cu > 1) per_cu = 1;
    grid_blocks = cus * per_cu;
  }
  p.ph0 = 0; p.ph1 = 42;
  hipMemsetAsync((char*)d_ws + OFF_BAR, 0, XCD_BAR_WORDS * 4, stream);
  void* args[] = {&p};
  hipError_t e = hipLaunchCooperativeKernel((void*)mega, dim3(grid_blocks), dim3(NTHR), args, 0, stream);
  if (e != hipSuccess) fprintf(stderr, "cooperative launch failed: %s (grid %d)\n", hipGetErrorString(e), grid_blocks);
#endif
}
```

```cpp
#include <hip/hip_runtime.h>
#include <hip/hip_cooperative_groups.h>
#include <cstdio>
namespace cg = cooperative_groups;

typedef unsigned short u16;
typedef short bf16x8 __attribute__((ext_vector_type(8)));
typedef short s16x4 __attribute__((ext_vector_type(4)));
typedef float f32x16 __attribute__((ext_vector_type(16)));
typedef float f32x2 __attribute__((ext_vector_type(2)));
typedef __bf16 bfx2 __attribute__((ext_vector_type(2)));
#define DI __device__ __forceinline__
#define MFMA(a, b, c) __builtin_amdgcn_mfma_f32_32x32x16_bf16((a), (b), (c), 0, 0, 0)
#define LDS3 __attribute__((address_space(3)))

#ifndef REP_GEMM
#define REP_GEMM 1
#endif
#ifndef REP_ATT
#define REP_ATT 1
#endif
#ifndef N_LAUNCH_MODE
#define N_LAUNCH_MODE 0
#endif

constexpr int NTOK = 12288, NCTX = 4096;
constexpr int NTHR = 512, NWAVE = 8;
constexpr float LOG2E = 1.4426950408889634f;

constexpr size_t O_L0K = 12582912, O_L0V = 13631488, O_L1CKV = 14680064, O_L1KPE = 15728640,
                 O_L2K = 15859712, O_L2V = 16908288, O_L3K = 17956864, O_L3V = 22151168;

constexpr int P1024 = 1088, P4096 = 4160, P384 = 448, P256 = 320;
constexpr size_t W1T_SZ = 4096ull * P1024 * 2, W2T_SZ = 1024ull * P4096 * 2;
constexpr size_t OFF_W1T = 0;
constexpr size_t OFF_W2T = OFF_W1T + 4 * W1T_SZ;
constexpr size_t OFF_AQKV = OFF_W2T + 4 * W2T_SZ;
constexpr size_t OFF_AO_W = OFF_AQKV + 1536ull * P1024 * 2;
constexpr size_t OFF_MIN = OFF_AO_W + 1024ull * P1024 * 2;
constexpr size_t OFF_MUQ = OFF_MIN + 768ull * P1024 * 2;
constexpr size_t OFF_MUKV = OFF_MUQ + 1536ull * P384 * 2;
constexpr size_t OFF_MO = OFF_MUKV + 2048ull * P256 * 2;
constexpr size_t OFF_SQKV = OFF_MO + 1024ull * P1024 * 2;
constexpr size_t OFF_SO = OFF_SQKV + 1536ull * P1024 * 2;
constexpr size_t OFF_NQKV = OFF_SO + 1024ull * P1024 * 2;
constexpr size_t OFF_NO = OFF_NQKV + 3072ull * P1024 * 2;
constexpr size_t OFF_MOD = OFF_NO + 1024ull * P1024 * 2;
constexpr size_t OFF_ROPE = OFF_MOD + 4ull * 9 * 6144 * 4;
constexpr size_t OFF_HAO = OFF_ROPE + 3ull * 64 * 32 * 2 * 4;
constexpr size_t OFF_UZ = OFF_HAO + 12288ull * P1024 * 2;
constexpr size_t OFF_QO = OFF_UZ + 12288ull * P4096 * 2;
constexpr size_t OFF_CQ = OFF_QO + 12288ull * 3072 * 2;
constexpr size_t OFF_CKV = OFF_CQ + 12288ull * P384 * 2;
constexpr size_t OFF_KPE = OFF_CKV + 16384ull * P256 * 2;
constexpr size_t OFF_KV = OFF_KPE + 16384ull * 32 * 2;
constexpr size_t OFF_CK = OFF_KV;
constexpr size_t OFF_CV = OFF_KV + 2097152;
constexpr size_t OFF_C3K = OFF_KV + 4194304;
constexpr size_t OFF_C3V = OFF_C3K + 8388608;
constexpr size_t OFF_BAR = OFF_KV + 16384ull * 2048 * 2;
constexpr size_t WS_NEED = OFF_BAR + 16384;

struct Params {
  const float* in[33];
  float* out;
  char* ws;
  int ph0, ph1;
};

#define AS4 __attribute__((address_space(4)))
struct KA {
  const AS4 char* ka;
  DI const float* in(int i) const { return *(const float* const AS4*)(ka + 8 * i); }
  DI float* out() const { return *(float* const AS4*)(ka + 264); }
  DI char* ws() const { return *(char* const AS4*)(ka + 272); }
};

DI unsigned pack2(float a, float b) { f32x2 f = {a, b}; bfx2 v = __builtin_convertvector(f, bfx2); return __builtin_bit_cast(unsigned, v); }
DI u16 f2bf(float a) { return (u16)(pack2(a, a) & 0xffffu); }
DI float wave_sum(float v) {
#pragma unroll
  for (int o = 32; o; o >>= 1) v += __shfl_xor(v, o, 64);
  return v;
}
DI int ltid() { int t = threadIdx.x; asm volatile("" : "+v"(t)); return t; }
DI int crow(int i, int h) { return (i & 3) + 8 * (i >> 2) + 4 * h; }

__device__ const long long TJ[18][6] = {
  {15, 0ll * 1024 * 4096, 1024, 4096, 4096, (long long)(OFF_W1T + 0ull * W1T_SZ)},
  {15, 1ll * 1024 * 4096, 1024, 4096, 4096, (long long)(OFF_W1T + 1ull * W1T_SZ)},
  {15, 2ll * 1024 * 4096, 1024, 4096, 4096, (long long)(OFF_W1T + 2ull * W1T_SZ)},
  {15, 3ll * 1024 * 4096, 1024, 4096, 4096, (long long)(OFF_W1T + 3ull * W1T_SZ)},
  {16, 0ll * 1024 * 4096, 4096, 1024, 1024, (long long)(OFF_W2T + 0ull * W2T_SZ)},
  {16, 1ll * 1024 * 4096, 4096, 1024, 1024, (long long)(OFF_W2T + 1ull * W2T_SZ)},
  {16, 2ll * 1024 * 4096, 4096, 1024, 1024, (long long)(OFF_W2T + 2ull * W2T_SZ)},
  {16, 3ll * 1024 * 4096, 4096, 1024, 1024, (long long)(OFF_W2T + 3ull * W2T_SZ)},
  {17, 0, 1024, 1536, 1536, (long long)OFF_AQKV},
  {20, 0, 1024, 1024, 1024, (long long)OFF_AO_W},
  {21, 0, 1024, 672, 768, (long long)OFF_MIN},
  {24, 0, 384, 1536, 1536, (long long)OFF_MUQ},
  {25, 0, 256, 2048, 2048, (long long)OFF_MUKV},
  {26, 0, 1024, 1024, 1024, (long long)OFF_MO},
  {27, 0, 1024, 1536, 1536, (long long)OFF_SQKV},
  {29, 0, 1024, 1024, 1024, (long long)OFF_SO},
  {30, 0, 1024, 3072, 3072, (long long)OFF_NQKV},
  {32, 0, 1024, 1024, 1024, (long long)OFF_NO},
};

struct TTile { const float* src; u16* dst; int K, N, k0, n0; };
DI void tt_load(const TTile& t, int tid, float4 (&v)[8]) {
  const int n4 = tid & 63, kl = tid >> 6;
  const int n = t.n0 + 4 * n4;
#pragma unroll
  for (int j = 0; j < 8; ++j) {
    const int k = kl + 8 * j;
    v[j] = (n < t.N) ? *(const float4*)(t.src + (size_t)(t.k0 + k) * t.N + n) : make_float4(0.f, 0.f, 0.f, 0.f);
  }
}
DI void tt_store(const TTile& t, int tid, const float4 (&v)[8], char* smem) {
  float (*T)[260] = (float (*)[260])smem;
  const int n4 = tid & 63, kl = tid >> 6;
  __syncthreads();
#pragma unroll
  for (int j = 0; j < 8; ++j) *(float4*)&T[kl + 8 * j][4 * n4] = v[j];
  __syncthreads();
#pragma unroll
  for (int j = 0; j < 4; ++j) {
    const int c = tid + NTHR * j;
    const int n = c >> 3, kc = c & 7;
    uint4 o;
    o.x = pack2(T[kc * 8 + 0][n], T[kc * 8 + 1][n]);
    o.y = pack2(T[kc * 8 + 2][n], T[kc * 8 + 3][n]);
    o.z = pack2(T[kc * 8 + 4][n], T[kc * 8 + 5][n]);
    o.w = pack2(T[kc * 8 + 6][n], T[kc * 8 + 7][n]);
    *(uint4*)&t.dst[(size_t)(t.n0 + n) * (t.K + 64) + t.k0 + kc * 8] = o;
  }
}

DI void convert_f32_bf16(const float* __restrict__ src, u16* __restrict__ dst, size_t n) {
  const size_t n4 = n >> 2;
  const int tid_ = ltid();
  for (size_t i = (size_t)blockIdx.x * NTHR + tid_; i < n4; i += (size_t)gridDim.x * NTHR) {
    const float4 v = ((const float4*)src)[i];
    uint2 o; o.x = pack2(v.x, v.y); o.y = pack2(v.z, v.w);
    ((uint2*)dst)[i] = o;
  }
}

DI void convert_rows256(const float* __restrict__ src, u16* __restrict__ dst, int rows, int dpitch) {
  const int tid_ = ltid();
  for (int i = blockIdx.x * NTHR + tid_; i < rows * 64; i += gridDim.x * NTHR) {
    const int r = i >> 6, c4 = i & 63;
    const float4 v = ((const float4*)src)[i];
    uint2 o; o.x = pack2(v.x, v.y); o.y = pack2(v.z, v.w);
    *(uint2*)(dst + (size_t)r * dpitch + 4 * c4) = o;
  }
}

DI void prepass(const KA& p, char* smem) {
  {
    const int tid = ltid();
    int total = 0;
    for (int j = 0; j < 18; ++j) total += (int)((TJ[j][2] >> 6) * (TJ[j][4] >> 8));
    float4 va[8], vb[8];
    TTile ta, tb;
#define TT_DECODE(tt_, t_)                                                                     \
    {                                                                                          \
      int j = 0, tt = (t_);                                                                    \
      for (;;) { const int c = (int)((TJ[j][2] >> 6) * (TJ[j][4] >> 8)); if (tt < c) break; tt -= c; ++j; } \
      const int K = (int)TJ[j][2];                                                             \
      const int nk = K >> 6;                                                                   \
      tt_.src = p.in((int)TJ[j][0]) + TJ[j][1]; tt_.dst = (u16*)(p.ws() + TJ[j][5]);           \
      tt_.K = K; tt_.N = (int)TJ[j][3]; tt_.k0 = (tt % nk) * 64; tt_.n0 = (tt / nk) * 256;     \
    }
    int t = blockIdx.x;
    if (t < total) { TT_DECODE(ta, t) tt_load(ta, tid, va); }
    for (; t < total; t += 2 * gridDim.x) {
      const int t2 = t + gridDim.x;
      if (t2 < total) { TT_DECODE(tb, t2) tt_load(tb, tid, vb); }
      tt_store(ta, tid, va, smem);
      if (t2 < total) {
        const int t3 = t2 + gridDim.x;
        if (t3 < total) { TT_DECODE(ta, t3) tt_load(ta, tid, va); }
        tt_store(tb, tid, vb, smem);
      }
    }
#undef TT_DECODE
  }
  convert_f32_bf16(p.in(2), (u16*)(p.ws() + OFF_CK), 4096ull * 256);
  convert_f32_bf16(p.in(3), (u16*)(p.ws() + OFF_CV), 4096ull * 256);
  convert_rows256(p.in(4), (u16*)(p.ws() + OFF_CKV) + 12288ull * P256, 4096, P256);
  convert_f32_bf16(p.in(5), (u16*)(p.ws() + OFF_KPE) + 12288ull * 32, 4096ull * 32);
  {
    float* tab = (float*)(p.ws() + OFF_ROPE);
    const int tid_ = ltid();
    for (int e = blockIdx.x * NTHR + tid_; e < 3 * 64 * 32; e += gridDim.x * NTHR) {
      const int kind = e / 2048, pos = (e >> 5) & 63, i = e & 31;
      const int quarter = kind == 0 ? 32 : (kind == 1 ? 16 : 8);
      float c = 1.f, s = 0.f;
      if (i < quarter) {
        const float inv = exp2f(-(float)i / (float)quarter * 13.287712379549449f);
        const float ang = (float)pos * inv;
        c = cosf(ang); s = sinf(ang);
      }
      tab[2 * e] = c; tab[2 * e + 1] = s;
    }
  }
  {
    float* scond = (float*)smem;
    float* red = (float*)(smem + 36864);
    float* MOD = (float*)(p.ws() + OFF_MOD);
    const int tid = ltid();
    bool ready = false;
    for (int it = blockIdx.x; it < 768; it += gridDim.x) {
      __syncthreads();
      if (!ready) {
        for (int e = tid; e < 9 * 1024; e += NTHR) {
          const float c = e < 8192 ? p.in(10)[e] : p.in(11)[e - 8192];
          scond[e] = c / (1.f + __expf(-c));
        }
        ready = true;
        __syncthreads();
      }
      const int l = it / 192, n0 = (it % 192) * 32;
      const int cq = tid & 7, kg = tid >> 3;
      float acc[9][4];
#pragma unroll
      for (int c = 0; c < 9; ++c) { acc[c][0] = 0.f; acc[c][1] = 0.f; acc[c][2] = 0.f; acc[c][3] = 0.f; }
      const float* wp = p.in(12) + (size_t)l * 1024 * 6144 + n0 + 4 * cq;
      float4 wv[16];
#pragma unroll
      for (int i = 0; i < 16; ++i) wv[i] = *(const float4*)(wp + (size_t)(kg + 64 * i) * 6144);
#pragma unroll
      for (int i = 0; i < 16; ++i) {
        const int k = kg + 64 * i;
#pragma unroll
        for (int c = 0; c < 9; ++c) {
          const float sv = scond[c * 1024 + k];
          acc[c][0] += sv * wv[i].x; acc[c][1] += sv * wv[i].y; acc[c][2] += sv * wv[i].z; acc[c][3] += sv * wv[i].w;
        }
      }
#pragma unroll
      for (int c = 0; c < 9; ++c) *(float4*)&red[(kg * 9 + c) * 32 + 4 * cq] = make_float4(acc[c][0], acc[c][1], acc[c][2], acc[c][3]);
      __syncthreads();
      for (int e = tid; e < 288; e += NTHR) {
        const int c = e >> 5, cc = e & 31;
        float sum = p.in(13)[l * 6144 + n0 + cc];
#pragma unroll 8
        for (int g = 0; g < 64; ++g) sum += red[(g * 9 + c) * 32 + cc];
        MOD[(size_t)(l * 9 + c) * 6144 + n0 + cc] = sum;
      }
    }
  }
}

DI float bf2f(unsigned v16) { return __uint_as_float(v16 << 16); }

DI void norm_phase(const KA& p, int l, int mode) {
  const int tid_ = ltid(); const int lane = tid_ & 63, w = tid_ >> 6;
  float* X = p.out();
  const float* MOD = (const float*)(p.ws() + OFF_MOD);
  const u16* FF = (const u16*)(p.ws() + OFF_QO);
  u16* H = (u16*)(p.ws() + OFF_HAO);
  const float* ng = p.in(14);
  const float* xp0 = p.in(0);
  const float* xp1 = p.in(1);
  const bool x_in = (l == 0);
  const bool add = !(l == 0 && mode == 0);
  const int la = (mode == 1) ? l : l - 1;
  const int gate_w = (mode == 1) ? 2 : 5;
  const int gadd = (mode == 1) ? 1 : 3;
  const bool do_h = mode != 2;
  const int gh = (mode == 0) ? 0 : 2, scw = (mode == 0) ? 1 : 4, shw = (mode == 0) ? 0 : 3;
  const int stride = gridDim.x * NWAVE;
  const int lh = do_h ? l : 0;
  int row = blockIdx.x * NWAVE + w;
  float4 nx0, nx1, nx2, nx3;
  uint2 nf0 = make_uint2(0, 0), nf1 = nf0, nf2 = nf0, nf3 = nf0;
#define NLOAD(rw)                                                                                          \
  {                                                                                                        \
    const int rr = min((rw), NTOK - 1);                                                                    \
    const float* xs = x_in ? (rr < NCTX ? xp0 + (size_t)rr * 1024 : xp1 + (size_t)(rr - NCTX) * 1024)      \
                           : X + (size_t)rr * 1024;                                                        \
    nx0 = *(const float4*)(xs + 4 * lane); nx1 = *(const float4*)(xs + 4 * lane + 256);                    \
    nx2 = *(const float4*)(xs + 4 * lane + 512); nx3 = *(const float4*)(xs + 4 * lane + 768);              \
    if (add) {                                                                                             \
      const u16* fr = FF + (size_t)rr * 1024 + 4 * lane;                                                   \
      nf0 = *(const uint2*)(fr); nf1 = *(const uint2*)(fr + 256); nf2 = *(const uint2*)(fr + 512); nf3 = *(const uint2*)(fr + 768); \
    }                                                                                                      \
  }
  NLOAD(row)
  for (; row < NTOK; row += stride) {
    const int ci = row < NCTX ? 8 : ((row - NCTX) >> 10);
    float4 x[4] = {nx0, nx1, nx2, nx3};
    const uint2 fb[4] = {nf0, nf1, nf2, nf3};
    const float* ga = ng + (la * 4 + gadd) * 1024 + 4 * lane;
    const float* gt = MOD + (size_t)(la * 9 + ci) * 6144 + gate_w * 1024 + 4 * lane;
    const float* gp = ng + (lh * 4 + gh) * 1024 + 4 * lane;
    const float* sc = MOD + (size_t)(lh * 9 + ci) * 6144 + scw * 1024 + 4 * lane;
    const float* sh = MOD + (size_t)(lh * 9 + ci) * 6144 + shw * 1024 + 4 * lane;
    float4 ga4[4], gt4[4], g4[4], c4[4], s4[4];
#pragma unroll
    for (int j = 0; j < 4; ++j) {
      if (add) { ga4[j] = *(const float4*)(ga + 256 * j); gt4[j] = *(const float4*)(gt + 256 * j); }
      if (do_h) { g4[j] = *(const float4*)(gp + 256 * j); c4[j] = *(const float4*)(sc + 256 * j); s4[j] = *(const float4*)(sh + 256 * j); }
    }
    NLOAD(row + stride)
    if (add) {
      float f[16];
      float ss = 0.f;
#pragma unroll
      for (int j = 0; j < 4; ++j) {
        f[4 * j] = bf2f(fb[j].x & 0xffffu); f[4 * j + 1] = bf2f(fb[j].x >> 16);
        f[4 * j + 2] = bf2f(fb[j].y & 0xffffu); f[4 * j + 3] = bf2f(fb[j].y >> 16);
        ss += f[4 * j] * f[4 * j] + f[4 * j + 1] * f[4 * j + 1] + f[4 * j + 2] * f[4 * j + 2] + f[4 * j + 3] * f[4 * j + 3];
      }
      ss = wave_sum(ss);
      const float rstd = rsqrtf(ss * (1.f / 1024.f) + 1e-6f);
#pragma unroll
      for (int j = 0; j < 4; ++j) {
        x[j].x += gt4[j].x * (f[4 * j] * rstd * ga4[j].x);
        x[j].y += gt4[j].y * (f[4 * j + 1] * rstd * ga4[j].y);
        x[j].z += gt4[j].z * (f[4 * j + 2] * rstd * ga4[j].z);
        x[j].w += gt4[j].w * (f[4 * j + 3] * rstd * ga4[j].w);
        *(float4*)(X + (size_t)row * 1024 + 4 * lane + 256 * j) = x[j];
      }
    }
    if (do_h) {
      float ss = 0.f;
#pragma unroll
      for (int j = 0; j < 4; ++j) ss += x[j].x * x[j].x + x[j].y * x[j].y + x[j].z * x[j].z + x[j].w * x[j].w;
      ss = wave_sum(ss);
      const float rstd = rsqrtf(ss * (1.f / 1024.f) + 1e-6f);
#pragma unroll
      for (int j = 0; j < 4; ++j) {
        const float h0 = x[j].x * rstd * g4[j].x * (1.f + c4[j].x) + s4[j].x;
        const float h1 = x[j].y * rstd * g4[j].y * (1.f + c4[j].y) + s4[j].y;
        const float h2 = x[j].z * rstd * g4[j].z * (1.f + c4[j].z) + s4[j].z;
        const float h3 = x[j].w * rstd * g4[j].w * (1.f + c4[j].w) + s4[j].w;
        uint2 o; o.x = pack2(h0, h1); o.y = pack2(h2, h3);
        *(uint2*)(H + (size_t)row * P1024 + 4 * lane + 256 * j) = o;
      }
    }
  }
#undef NLOAD
}

enum { EPI_F32 = 0, EPI_BF16 = 1, EPI_RELU2 = 2, EPI_NAT = 3 };
struct GemmDesc { const u16* A; const u16* Bt; void* dst; int lda, ldb, ldc, M, N, K, epi; };

DI void gemm_tile(const GemmDesc& g, int m0, int n0, float* outp, char* smem) {
  constexpr int LS = 72;
  constexpr int BM = 192, BN = 256;
  u16* As = (u16*)smem;
  u16* Bs = As + 2 * BM * LS;
  const int tid = ltid(), lane = tid & 63, w = tid >> 6, r = lane & 31, h = lane >> 5;
  const int wm = w >> 2, wn = w & 3;
  const int lrow = tid >> 3, lcc = tid & 7;
  const int Mlast = g.M - 1;
  const char* Ab = (const char*)g.A;
  const char* Bb = (const char*)g.Bt;
  const unsigned ao0 = (unsigned)(min(m0 + lrow, Mlast) * g.lda + lcc * 8) * 2u;
  const unsigned ao1 = (unsigned)(min(m0 + lrow + 64, Mlast) * g.lda + lcc * 8) * 2u;
  const unsigned ao2 = (unsigned)(min(m0 + lrow + 128, Mlast) * g.lda + lcc * 8) * 2u;
  const unsigned bo0 = (unsigned)((n0 + lrow) * g.ldb + lcc * 8) * 2u;
  const unsigned bst = (unsigned)(64 * g.ldb) * 2u;
  uint4 pa0, pa1, pa2, pb0, pb1, pb2, pb3;
  f32x16 acc00, acc01, acc10, acc11, acc20, acc21;
#pragma unroll
  for (int i = 0; i < 16; ++i) { acc00[i] = 0.f; acc01[i] = 0.f; acc10[i] = 0.f; acc11[i] = 0.f; acc20[i] = 0.f; acc21[i] = 0.f; }
#define GLOAD(R, kt_)                                                                                  \
  {                                                                                                    \
    const char* ak = Ab + (size_t)(kt_) * 128; const char* bk = Bb + (size_t)(kt_) * 128;              \
    R##a0 = *(const uint4*)(ak + ao0); R##a1 = *(const uint4*)(ak + ao1); R##a2 = *(const uint4*)(ak + ao2); \
    R##b0 = *(const uint4*)(bk + bo0); R##b1 = *(const uint4*)(bk + bo0 + bst);                        \
    R##b2 = *(const uint4*)(bk + bo0 + 2 * bst); R##b3 = *(const uint4*)(bk + bo0 + 3 * bst);          \
  }
#define LSTORE(R, buf)                                                                  \
  *(uint4*)&As[(buf) * BM * LS + (lrow) * LS + lcc * 8] = R##a0;                         \
  *(uint4*)&As[(buf) * BM * LS + (lrow + 64) * LS + lcc * 8] = R##a1;                    \
  *(uint4*)&As[(buf) * BM * LS + (lrow + 128) * LS + lcc * 8] = R##a2;                   \
  *(uint4*)&Bs[(buf) * BN * LS + (lrow) * LS + lcc * 8] = R##b0;                         \
  *(uint4*)&Bs[(buf) * BN * LS + (lrow + 64) * LS + lcc * 8] = R##b1;                    \
  *(uint4*)&Bs[(buf) * BN * LS + (lrow + 128) * LS + lcc * 8] = R##b2;                   \
  *(uint4*)&Bs[(buf) * BN * LS + (lrow + 192) * LS + lcc * 8] = R##b3;
#define FRAGS(X, kk)                                                                    \
  X##a0 = *(const bf16x8*)(Ac + 16 * (kk));                                             \
  X##a1 = *(const bf16x8*)(Ac + 32 * LS + 16 * (kk));                                   \
  X##a2 = *(const bf16x8*)(Ac + 64 * LS + 16 * (kk));                                   \
  X##b0 = *(const bf16x8*)(Bc + 16 * (kk));                                             \
  X##b1 = *(const bf16x8*)(Bc + 32 * LS + 16 * (kk));
#define MMAS(X)                                                                         \
  acc00 = MFMA(X##a0, X##b0, acc00); acc01 = MFMA(X##a0, X##b1, acc01);                 \
  acc10 = MFMA(X##a1, X##b0, acc10); acc11 = MFMA(X##a1, X##b1, acc11);                 \
  acc20 = MFMA(X##a2, X##b0, acc20); acc21 = MFMA(X##a2, X##b1, acc21);
#define COMPUTE(buf)                                                                    \
  {                                                                                     \
    const u16* Ac = As + (buf) * BM * LS + (96 * wm + r) * LS + 8 * h;                  \
    const u16* Bc = Bs + (buf) * BN * LS + (64 * wn + r) * LS + 8 * h;                  \
    bf16x8 xa0, xa1, xa2, xb0, xb1, ya0, ya1, ya2, yb0, yb1;                            \
    FRAGS(x, 0) __builtin_amdgcn_sched_barrier(0);                                      \
    FRAGS(y, 1) __builtin_amdgcn_sched_barrier(0); MMAS(x) __builtin_amdgcn_sched_barrier(0); \
    FRAGS(x, 2) __builtin_amdgcn_sched_barrier(0); MMAS(y) __builtin_amdgcn_sched_barrier(0); \
    FRAGS(y, 3) __builtin_amdgcn_sched_barrier(0); MMAS(x) __builtin_amdgcn_sched_barrier(0); \
    MMAS(y)                                                                             \
  }
  const int KT = g.K >> 6;
  GLOAD(p, 0)
  LSTORE(p, 0)
  __syncthreads();
  for (int kt = 0; kt < KT; kt += 2) {
    GLOAD(p, min(kt + 1, KT - 1))
    __builtin_amdgcn_sched_barrier(0);
    COMPUTE(0)
    LSTORE(p, 1)
    __syncthreads();
    GLOAD(p, min(kt + 2, KT - 1))
    __builtin_amdgcn_sched_barrier(0);
    COMPUTE(1)
    LSTORE(p, 0)
    __syncthreads();
  }
#undef GLOAD
#undef LSTORE
#undef FRAGS
#undef MMAS
#undef COMPUTE
  const int epi = g.epi;
#define EPI_LOOP(BODY)                                                                                         \
  _Pragma("unroll") for (int mi = 0; mi < 3; ++mi)                                                             \
  _Pragma("unroll") for (int ni = 0; ni < 2; ++ni) {                                                           \
    const int col = n0 + 64 * wn + 32 * ni + r;                                                                \
    _Pragma("unroll") for (int i = 0; i < 16; ++i) {                                                           \
      const int row = m0 + 96 * wm + 32 * mi + crow(i, h);                                                     \
      const float v = mi == 0 ? (ni == 0 ? acc00[i] : acc01[i]) : (mi == 1 ? (ni == 0 ? acc10[i] : acc11[i]) : (ni == 0 ? acc20[i] : acc21[i])); \
      BODY                                                                                                     \
    }                                                                                                          \
  }
  if (epi == EPI_F32) {
    float* dst = (float*)g.dst;
    EPI_LOOP(dst[(size_t)row * g.ldc + col] = v;)
  } else if (epi == EPI_RELU2) {
    u16* dst = (u16*)g.dst;
    EPI_LOOP(const float t = v > 0.f ? v : 0.f; dst[(size_t)row * g.ldc + col] = f2bf(t * t);)
  } else if (epi == EPI_BF16) {
    u16* dst = (u16*)g.dst;
    EPI_LOOP(if (row <= Mlast) dst[(size_t)row * g.ldc + col] = f2bf(v);)
  } else {
    u16* dst = (u16*)g.dst;
    EPI_LOOP(dst[(size_t)row * g.ldc + col] = f2bf(v);
             if (row < NCTX && col >= 1024) outp[(col < 2048 ? O_L3K - 1024 : O_L3V - 2048) + (size_t)row * 1024 + col] = v;)
  }
#undef EPI_LOOP
}

DI void gemm_phase(const KA& p, const GemmDesc& g0, const GemmDesc& g1, int ng, char* smem) {
  const int nt0 = g0.N >> 8, mt0 = (g0.M + 191) / 192;
  const int CN = (nt0 & 3) == 0 ? 4 : ((nt0 & 1) == 0 ? 2 : 1), CM = 32 / CN;
  if (ng == 1 && gridDim.x == 256 && (mt0 % CM) == 0) {
    const int x = blockIdx.x & 7, s = blockIdx.x >> 3, mi = s / CN, ni = s - mi * CN;
    const int ncn = nt0 / CN, nchunks = (mt0 / CM) * ncn;
    for (int rep = 0; rep < REP_GEMM; ++rep)
    for (int c = x; c < nchunks; c += 8) {
      const int cm = c / ncn, cn = c - cm * ncn;
      gemm_tile(g0, (cm * CM + mi) * 192, (cn * CN + ni) * 256, p.out(), smem);
    }
    return;
  }
  const int t0 = mt0 * nt0;
  const int t1 = ng > 1 ? ((g1.M + 191) / 192) * (g1.N >> 8) : 0;
  for (int rep = 0; rep < REP_GEMM; ++rep)
  for (int t = blockIdx.x; t < t0 + t1; t += gridDim.x) {
    const bool first = t < t0;
    GemmDesc g;
    g.A = first ? g0.A : g1.A; g.Bt = first ? g0.Bt : g1.Bt; g.dst = first ? g0.dst : g1.dst;
    g.lda = first ? g0.lda : g1.lda; g.ldb = first ? g0.ldb : g1.ldb; g.ldc = first ? g0.ldc : g1.ldc;
    g.M = first ? g0.M : g1.M; g.N = first ? g0.N : g1.N; g.K = first ? g0.K : g1.K; g.epi = first ? g0.epi : g1.epi;
    const int tt = first ? t : t - t0;
    const int nt = g.N >> 8;
    gemm_tile(g, (tt / nt) * 192, (tt % nt) * 256, p.out(), smem);
  }
}

#define PP_LOADROW(dst, NV, PITCH, rw)                                             \
  {                                                                                \
    const float* zr_ = Z + (size_t)min((rw), NTOK - 1) * (PITCH) + lane;           \
    _Pragma("unroll") for (int j_ = 0; j_ < (NV); ++j_) dst[j_] = zr_[64 * j_];    \
  }

DI void pp_attn(const KA& p) {
  const int tid_ = ltid(); const int lane = tid_ & 63, w = tid_ >> 6;
  const float* Z = (const float*)(p.ws() + OFF_UZ);
  u16* QKV = (u16*)(p.ws() + OFF_QO);
  float* outp = p.out();
  const float* tab = (const float*)(p.ws() + OFF_ROPE);
  const float gq0 = p.in(18)[lane], gq1 = p.in(18)[64 + lane], gk0 = p.in(19)[lane], gk1 = p.in(19)[64 + lane];
  const int stride = gridDim.x * NWAVE;
  int row = blockIdx.x * NWAVE + w;
  float nv[24];
  PP_LOADROW(nv, 24, 1536, row)
  for (; row < NTOK; row += stride) {
    float v[24];
#pragma unroll
    for (int j = 0; j < 24; ++j) v[j] = nv[j];
    const bool lat = row >= NCTX;
    const int t = (row - NCTX) & 1023, pr = t >> 6, pc = t & 63;
    const int i = lane & 31;
    const float c0 = tab[(pr * 32 + i) * 2], s0 = tab[(pr * 32 + i) * 2 + 1];
    const float c1 = tab[(pc * 32 + i) * 2], s1 = tab[(pc * 32 + i) * 2 + 1];
    PP_LOADROW(nv, 24, 1536, row + stride)
    u16* o = QKV + (size_t)row * 1536;
    const float sg = lane < 32 ? -1.f : 1.f;
#pragma unroll
    for (int hd = 0; hd < 10; ++hd) {
      const float v0 = v[2 * hd], v1 = v[2 * hd + 1];
      const float ss = wave_sum(v0 * v0 + v1 * v1);
      const float rstd = rsqrtf(ss * (1.f / 128.f) + 1e-6f);
      float y0 = v0 * rstd * (hd < 8 ? gq0 : gk0), y1 = v1 * rstd * (hd < 8 ? gq1 : gk1);
      if (hd >= 8 && !lat) {
        outp[O_L0K + (size_t)row * 256 + (hd - 8) * 128 + lane] = y0;
        outp[O_L0K + (size_t)row * 256 + (hd - 8) * 128 + 64 + lane] = y1;
      }
      const float p0 = __shfl_xor(y0, 32, 64), p1 = __shfl_xor(y1, 32, 64);
      if (lat) {
        y0 = y0 * c0 + sg * p0 * s0;
        y1 = y1 * c1 + sg * p1 * s1;
      }
      o[hd * 128 + lane] = f2bf(y0);
      o[hd * 128 + 64 + lane] = f2bf(y1);
    }
#pragma unroll
    for (int j = 0; j < 4; ++j) {
      const float vv = v[20 + j];
      o[1280 + 64 * j + lane] = f2bf(vv);
      if (!lat) outp[O_L0V + (size_t)row * 256 + 64 * j + lane] = vv;
    }
  }
}

DI void pp_swa(const KA& p) {
  const int tid_ = ltid(); const int lane = tid_ & 63, w = tid_ >> 6;
  const float* Z = (const float*)(p.ws() + OFF_UZ);
  u16* QKV = (u16*)(p.ws() + OFF_QO);
  float* outp = p.out();
  const float* tab = (const float*)(p.ws() + OFF_ROPE) + 1 * 64 * 32 * 2;
  const int stride = gridDim.x * NWAVE;
  int row = blockIdx.x * NWAVE + w;
  float nv[24];
  PP_LOADROW(nv, 24, 1536, row)
  for (; row < NTOK; row += stride) {
    float v[24];
#pragma unroll
    for (int j = 0; j < 24; ++j) v[j] = nv[j];
    const bool lat = row >= NCTX;
    const int t = (row - NCTX) & 1023, pr = t >> 6, pc = t & 63;
    const int i = lane & 15, axis = lane >> 5, half = (lane >> 4) & 1;
    const int pos = axis ? pc : pr;
    const float c = tab[(pos * 32 + i) * 2], sn = tab[(pos * 32 + i) * 2 + 1];
    PP_LOADROW(nv, 24, 1536, row + stride)
    u16* o = QKV + (size_t)row * 1536;
    const float sg = half ? 1.f : -1.f;
#pragma unroll
    for (int hd = 0; hd < 20; ++hd) {
      float vv = v[hd];
      if (hd >= 16 && !lat) outp[O_L2K + (size_t)row * 256 + (hd - 16) * 64 + lane] = vv;
      const float pv = __shfl_xor(vv, 16, 64);
      if (lat) vv = vv * c + sg * pv * sn;
      o[hd * 64 + lane] = f2bf(vv);
    }
#pragma unroll
    for (int j = 0; j < 4; ++j) {
      const float vv = v[20 + j];
      o[1280 + 64 * j + lane] = f2bf(vv);
      if (!lat) outp[O_L2V + (size_t)row * 256 + 64 * j + lane] = vv;
    }
  }
}

DI void pp_mla1(const KA& p) {
  const int tid_ = ltid(); const int lane = tid_ & 63, w = tid_ >> 6;
  const float* Z = (const float*)(p.ws() + OFF_UZ);
  u16* CQ = (u16*)(p.ws() + OFF_CQ);
  u16* CKV = (u16*)(p.ws() + OFF_CKV);
  u16* KPE = (u16*)(p.ws() + OFF_KPE);
  float* outp = p.out();
  const float* tab = (const float*)(p.ws() + OFF_ROPE) + 2 * 64 * 32 * 2;
  float gq[6], gkv[4];
#pragma unroll
  for (int j = 0; j < 6; ++j) gq[j] = p.in(22)[64 * j + lane];
#pragma unroll
  for (int j = 0; j < 4; ++j) gkv[j] = p.in(23)[64 * j + lane];
  const int stride = gridDim.x * NWAVE;
  int row = blockIdx.x * NWAVE + w;
  float nv[11];
  PP_LOADROW(nv, 11, 768, row)
  for (; row < NTOK; row += stride) {
    float v[11];
#pragma unroll
    for (int j = 0; j < 11; ++j) v[j] = nv[j];
    const bool lat = row >= NCTX;
    const int t = (row - NCTX) & 1023, pr = t >> 6, pc = t & 63;
    const int e = lane & 31;
    const int ri = e & 7, axis = e >> 4, half = (e >> 3) & 1;
    const int pos = axis ? pc : pr;
    const float c = tab[(pos * 32 + ri) * 2], sn = tab[(pos * 32 + ri) * 2 + 1];
    PP_LOADROW(nv, 11, 768, row + stride)
    float ss = 0.f;
#pragma unroll
    for (int j = 0; j < 6; ++j) ss += v[j] * v[j];
    ss = wave_sum(ss);
    float rstd = rsqrtf(ss * (1.f / 384.f) + 1e-6f);
#pragma unroll
    for (int j = 0; j < 6; ++j) CQ[(size_t)row * P384 + 64 * j + lane] = f2bf(v[j] * rstd * gq[j]);
    ss = 0.f;
#pragma unroll
    for (int j = 0; j < 4; ++j) ss += v[6 + j] * v[6 + j];
    ss = wave_sum(ss);
    rstd = rsqrtf(ss * (1.f / 256.f) + 1e-6f);
#pragma unroll
    for (int j = 0; j < 4; ++j) {
      const float y = v[6 + j] * rstd * gkv[j];
      CKV[(size_t)row * P256 + 64 * j + lane] = f2bf(y);
      if (!lat) outp[O_L1CKV + (size_t)row * 256 + 64 * j + lane] = y;
    }
    float vv = v[10];
    const float pv = __shfl_xor(vv, 8, 64);
    if (lat) vv = vv * c + (half ? pv : -pv) * sn;
    if (lane < 32) {
      KPE[(size_t)row * 32 + e] = f2bf(vv);
      if (!lat) outp[O_L1KPE + (size_t)row * 32 + e] = vv;
    }
  }
}

DI void pp_mla2(const KA& p) {
  const int tid_ = ltid(); const int lane = tid_ & 63, w = tid_ >> 6;
  const float* Z = (const float*)(p.ws() + OFF_UZ);
  u16* Q = (u16*)(p.ws() + OFF_QO);
  const float* tab = (const float*)(p.ws() + OFF_ROPE) + 2 * 64 * 32 * 2;
  const int stride = gridDim.x * NWAVE;
  int row = blockIdx.x * NWAVE + w;
  float nv[24];
  PP_LOADROW(nv, 24, 1536, row)
  for (; row < NTOK; row += stride) {
    float v[24];
#pragma unroll
    for (int j = 0; j < 24; ++j) v[j] = nv[j];
    const bool lat = row >= NCTX;
    const int t = (row - NCTX) & 1023, pr = t >> 6, pc = t & 63;
    const int e = lane & 31;
    const int ri = e & 7, axis = e >> 4, half = (e >> 3) & 1;
    const int pos = axis ? pc : pr;
    const float c = tab[(pos * 32 + ri) * 2], sn = tab[(pos * 32 + ri) * 2 + 1];
    PP_LOADROW(nv, 24, 1536, row + stride)
#pragma unroll
    for (int j = 0; j < 24; ++j) {
      const int col = 64 * j + lane;
      float vv = v[j];
      const float pv = __shfl_xor(vv, 8, 64);
      const int d = col % 96;
      if (lat && d >= 64) vv = vv * c + (half ? pv : -pv) * sn;
      Q[(size_t)row * 1536 + col] = f2bf(vv);
    }
  }
}
#undef PP_LOADROW

struct Seg { const u16* k1; const u16* k2; const u16* v; int ldk1, ldk2, ldv, n0, n1, mode; };

template <int HDQK, int HDV>
DI void attn_item(const u16* __restrict__ Qp, int ldq, const Seg& sA, const Seg& sB, int nseg, int qpos0,
                  float scale_l2, const float* __restrict__ rpb_h, const float* __restrict__ sinkp,
                  u16* __restrict__ Op, int ldo, char* smem) {
  constexpr int K1W = (HDQK == 96) ? 64 : HDQK;
  constexpr int KS = HDQK + 8, VS = HDV + 8;
  constexpr int KC = HDQK / 8, VC = HDV / 8;
  constexpr int KVB = 64 * KS + 64 * VS;
  u16* KV0 = (u16*)smem;
  float* rp = (float*)(KV0 + 2 * KVB);
  const int tid = ltid(), lane = tid & 63, w = tid >> 6, r = lane & 31, h = lane >> 5;
  const int q4 = (lane & 15) >> 2, p4 = lane & 3, dblk = (lane >> 4) & 1;

  __syncthreads();
  if (rpb_h) for (int e = tid; e < 465; e += NTHR) rp[e] = rpb_h[e];

  bf16x8 qf[HDQK / 16];
  {
    const u16* qrow = Qp + (size_t)(32 * w + r) * ldq + 8 * h;
#pragma unroll
    for (int kk = 0; kk < HDQK / 16; ++kk) qf[kk] = *(const bf16x8*)(qrow + 16 * kk);
  }
  f32x16 o[HDV / 32];
#pragma unroll
  for (int dt = 0; dt < HDV / 32; ++dt)
#pragma unroll
    for (int i = 0; i < 16; ++i) o[dt][i] = 0.f;
  float m = -1e30f, l = 0.f;
  const int qpos = qpos0 + 32 * w + r;
  const int qr = qpos >> 6, qc = qpos & 63;
  const int r0 = min(max(qr - 4, 0), 8), c0 = min(max(qc - 8, 0), 48);

  constexpr int KI = (64 * KC + NTHR - 1) / NTHR, VI = (64 * VC + NTHR - 1) / NTHR;
  const int TA = (sA.n1 - sA.n0) >> 6;
  const int T = TA + (nseg > 1 ? ((sB.n1 - sB.n0) >> 6) : 0);
  uint4 kreg0 = make_uint4(0, 0, 0, 0), kreg1 = kreg0, vreg0 = kreg0, vreg1 = kreg0;
#define ATT_KADDR(i, p1, p2, l1, l2, nn)                                                               \
  const int kc_##i = tid + NTHR * i; const int krow_##i = kc_##i / KC, kcc_##i = kc_##i - krow_##i * KC; \
  const u16* ksrc_##i = (kcc_##i * 8 < K1W) ? p1 + (size_t)(nn + krow_##i) * l1 + kcc_##i * 8          \
                                            : p2 + (size_t)(nn + krow_##i) * l2 + (kcc_##i * 8 - K1W);
#define ATT_FETCH(t)                                                                                   \
  {                                                                                                    \
    const bool fa = (t) < TA;                                                                          \
    const u16* fk1 = fa ? sA.k1 : sB.k1; const u16* fk2 = fa ? sA.k2 : sB.k2; const u16* fv = fa ? sA.v : sB.v; \
    const int fl1 = fa ? sA.ldk1 : sB.ldk1, fl2 = fa ? sA.ldk2 : sB.ldk2, flv = fa ? sA.ldv : sB.ldv;   \
    const int fn = fa ? sA.n0 + 64 * (t) : sB.n0 + 64 * ((t) - TA);                                    \
    { ATT_KADDR(0, fk1, fk2, fl1, fl2, fn) kreg0 = *(const uint4*)ksrc_0; }                            \
    if (KI > 1) { ATT_KADDR(1, fk1, fk2, fl1, fl2, fn) if (64 * KC % NTHR == 0 || kc_1 < 64 * KC) kreg1 = *(const uint4*)ksrc_1; } \
    { const int c = tid; const int row = c / VC, cc = c - row * VC; vreg0 = *(const uint4*)(fv + (size_t)(fn + row) * flv + cc * 8); } \
    if (VI > 1) { const int c = tid + NTHR; const int row = c / VC, cc = c - row * VC; vreg1 = *(const uint4*)(fv + (size_t)(fn + row) * flv + cc * 8); } \
  }
#define ATT_STORE(buf)                                                                                 \
  {                                                                                                    \
    u16* Ksw = KV0 + (buf) * KVB; u16* Vsw = Ksw + 64 * KS;                                            \
    { const int c = tid; const int row = c / KC, cc = c - row * KC; *(uint4*)&Ksw[row * KS + cc * 8] = kreg0; } \
    if (KI > 1) { const int c = tid + NTHR; if (64 * KC % NTHR == 0 || c < 64 * KC) { const int row = c / KC, cc = c - row * KC; *(uint4*)&Ksw[row * KS + cc * 8] = kreg1; } } \
    { const int c = tid; const int row = c / VC, cc = c - row * VC; *(uint4*)&Vsw[row * VS + cc * 8] = vreg0; } \
    if (VI > 1) { const int c = tid + NTHR; const int row = c / VC, cc = c - row * VC; *(uint4*)&Vsw[row * VS + cc * 8] = vreg1; } \
  }
  ATT_FETCH(0)
  ATT_STORE(0)
  if (T > 1) ATT_FETCH(1)
  __syncthreads();
  for (int t = 0; t < T; ++t) {
    {
      const bool ca = t < TA;
      const int mode = (HDQK == 64) ? (ca ? sA.mode : sB.mode) : 0;
      const int n = ca ? sA.n0 + 64 * t : sB.n0 + 64 * (t - TA);
      if (t > 0) __syncthreads();
      if (t + 1 < T) ATT_STORE((t + 1) & 1)
      if (t + 2 < T) ATT_FETCH(t + 2)
      const u16* Ks = KV0 + (t & 1) * KVB;
      const u16* Vs = Ks + 64 * KS;
      const int qw = qpos0 + 32 * w;
      bool skip = false;
      if (mode == 1) skip = (n > qw + 31 + 128) || (n + 63 < qw - 128);
      else if (mode == 2) { const int r0w = min(max((qw >> 6) - 4, 0), 8); const int kr = n >> 6; skip = (kr < r0w) || (kr >= r0w + 8); }
      if (skip) continue;
      f32x16 st[2];
#pragma unroll
      for (int kt = 0; kt < 2; ++kt) {
#pragma unroll
        for (int i = 0; i < 16; ++i) st[kt][i] = 0.f;
        const u16* kb = Ks + (32 * kt + r) * KS + 8 * h;
#pragma unroll
        for (int kk = 0; kk < HDQK / 16; ++kk) {
          const bf16x8 a = *(const bf16x8*)(kb + 16 * kk);
          st[kt] = MFMA(a, qf[kk], st[kt]);
        }
        __builtin_amdgcn_sched_barrier(0);
      }
      float mx = -1e30f;
      float esc = 1.f;
      if (mode == 0) {
#pragma unroll
        for (int kt = 0; kt < 2; ++kt)
#pragma unroll
          for (int i = 0; i < 16; ++i) mx = fmaxf(mx, st[kt][i]);
        mx *= scale_l2;
        esc = scale_l2;
      } else if (mode == 1) {
#pragma unroll
        for (int kt = 0; kt < 2; ++kt)
#pragma unroll
          for (int i = 0; i < 16; ++i) {
            const int kpos = n + 32 * kt + crow(i, h);
            const int d = qpos - kpos;
            float v = st[kt][i] * scale_l2;
            if (d > 128 || d < -128) v = -1e30f;
            st[kt][i] = v; mx = fmaxf(mx, v);
          }
      } else {
#pragma unroll
        for (int kt = 0; kt < 2; ++kt)
#pragma unroll
          for (int i = 0; i < 16; ++i) {
            const int kpos = n + 32 * kt + crow(i, h);
            const int kr = kpos >> 6, kc = kpos & 63;
            const bool ok = ((unsigned)(kr - r0) < 8u) && ((unsigned)(kc - c0) < 16u);
            const int idx = ok ? (kr - qr + 7) * 31 + (kc - qc + 15) : 0;
            const float b = rp[idx];
            float v = st[kt][i] * scale_l2 + b * LOG2E;
            if (!ok) v = -1e30f;
            st[kt][i] = v; mx = fmaxf(mx, v);
          }
      }
      mx = fmaxf(mx, __shfl_xor(mx, 32, 64));
      const float mn = fmaxf(m, mx);
      const float alpha = __builtin_amdgcn_exp2f(m - mn);
      const bool resc = __ballot(mn != m) != 0ull;
      m = mn;
      float rs = 0.f;
#pragma unroll
      for (int kt = 0; kt < 2; ++kt)
#pragma unroll
        for (int i = 0; i < 16; ++i) { const float pz = __builtin_amdgcn_exp2f(__builtin_fmaf(st[kt][i], esc, -mn)); st[kt][i] = pz; rs += pz; }
      rs += __shfl_xor(rs, 32, 64);
      l = l * alpha + rs;
      if (resc) {
#pragma unroll
        for (int dt = 0; dt < HDV / 32; ++dt)
#pragma unroll
          for (int i = 0; i < 16; ++i) o[dt][i] *= alpha;
      }
#pragma unroll
      for (int kt = 0; kt < 2; ++kt)
#pragma unroll
        for (int s2 = 0; s2 < 2; ++s2) {
          unsigned pk[4];
#pragma unroll
          for (int j = 0; j < 4; ++j) pk[j] = pack2(st[kt][8 * s2 + 2 * j], st[kt][8 * s2 + 2 * j + 1]);
          bf16x8 pb;
          {
            typedef unsigned u32x4 __attribute__((ext_vector_type(4)));
            u32x4 t4 = {pk[0], pk[1], pk[2], pk[3]};
            pb = __builtin_bit_cast(bf16x8, t4);
          }
          const u16* vb = Vs + (32 * kt + 16 * s2 + 4 * h + q4) * VS + 16 * dblk + 4 * p4;
#pragma unroll
          for (int dt = 0; dt < HDV / 32; ++dt) {
            const s16x4 lo = __builtin_amdgcn_ds_read_tr16_b64_v4i16((LDS3 s16x4*)(vb + 32 * dt));
            const s16x4 hi = __builtin_amdgcn_ds_read_tr16_b64_v4i16((LDS3 s16x4*)(vb + 8 * VS + 32 * dt));
            const bf16x8 va = __builtin_shufflevector(lo, hi, 0, 1, 2, 3, 4, 5, 6, 7);
            o[dt] = MFMA(va, pb, o[dt]);
          }
        }
    }
  }
#undef ATT_FETCH
#undef ATT_STORE
#undef ATT_KADDR
  if (sinkp) l += __builtin_amdgcn_exp2f(sinkp[0] * LOG2E - m);
  const float inv = 1.f / l;
  u16* orow = Op + (size_t)(32 * w + r) * ldo + 4 * h;
#pragma unroll
  for (int dt = 0; dt < HDV / 32; ++dt)
#pragma unroll
    for (int g = 0; g < 4; ++g) {
      uint2 v;
      v.x = pack2(o[dt][4 * g] * inv, o[dt][4 * g + 1] * inv);
      v.y = pack2(o[dt][4 * g + 2] * inv, o[dt][4 * g + 3] * inv);
      *(uint2*)(orow + 32 * dt + 8 * g) = v;
    }
}

DI void attn_phase(const KA& p, int kind, char* smem) {
  const int Hq = kind == 0 ? 8 : 16;
  const int nlat = 8 * Hq * 4, nctx = 16 * Hq;
  u16* AO = (u16*)(p.ws() + OFF_HAO);
  const u16* QKV = (const u16*)(p.ws() + OFF_QO);
  for (int rep = 0; rep < REP_ATT; ++rep)
  for (int item = blockIdx.x; item < nlat + nctx; item += gridDim.x) {
    const bool lat = item < nlat;
    int b, hq, qt;
    if (lat) { b = item / (Hq * 4); const int rem = item - b * Hq * 4; hq = rem >> 2; qt = rem & 3; }
    else { const int it = item - nlat; b = it / Hq; hq = it - b * Hq; qt = 0; }
    const int tok0 = lat ? NCTX + b * 1024 : b * 256;
    const int S = lat ? 1024 : 256;
    const int qrow0 = tok0 + qt * 256;
    Seg sc, ss;
    sc.k2 = nullptr; sc.ldk2 = 0; ss.k2 = nullptr; ss.ldk2 = 0;
    sc.n0 = 0; sc.n1 = 512; sc.mode = 0;
    ss.n0 = 0; ss.n1 = S; ss.mode = 0;
    const u16* Qp; int ldq; float sl2; const float* rpb = nullptr; const float* sinkp = nullptr;
    u16* Op;
    if (kind == 0) {
      const int kvh = hq >> 2;
      ss.k1 = QKV + (size_t)tok0 * 1536 + 1024 + kvh * 128; ss.ldk1 = 1536;
      ss.v = QKV + (size_t)tok0 * 1536 + 1280 + kvh * 128; ss.ldv = 1536;
      sc.k1 = (const u16*)(p.ws() + OFF_CK) + (size_t)b * 512 * 256 + kvh * 128; sc.ldk1 = 256;
      sc.v = (const u16*)(p.ws() + OFF_CV) + (size_t)b * 512 * 256 + kvh * 128; sc.ldv = 256;
      sl2 = 0.08838834764831845f * LOG2E;
      Qp = QKV + (size_t)qrow0 * 1536 + hq * 128; ldq = 1536;
      Op = AO + (size_t)qrow0 * P1024 + hq * 128;
    } else if (kind == 1) {
      const u16* KV = (const u16*)(p.ws() + OFF_KV);
      const u16* KPE = (const u16*)(p.ws() + OFF_KPE);
      ss.k1 = KV + (size_t)tok0 * 2048 + hq * 128; ss.ldk1 = 2048;
      ss.k2 = KPE + (size_t)tok0 * 32; ss.ldk2 = 32;
      ss.v = KV + (size_t)tok0 * 2048 + hq * 128 + 64; ss.ldv = 2048;
      const size_t crow0 = 12288 + (size_t)b * 512;
      sc.k1 = KV + crow0 * 2048 + hq * 128; sc.ldk1 = 2048;
      sc.k2 = KPE + crow0 * 32; sc.ldk2 = 32;
      sc.v = KV + crow0 * 2048 + hq * 128 + 64; sc.ldv = 2048;
      sl2 = 0.10206207261596575f * LOG2E;
      Qp = QKV + (size_t)qrow0 * 1536 + hq * 96; ldq = 1536;
      Op = AO + (size_t)qrow0 * P1024 + hq * 64;
    } else if (kind == 2) {
      const int kvh = hq >> 2;
      ss.k1 = QKV + (size_t)tok0 * 1536 + 1024 + kvh * 64; ss.ldk1 = 1536;
      ss.v = QKV + (size_t)tok0 * 1536 + 1280 + kvh * 64; ss.ldv = 1536;
      sc.k1 = (const u16*)(p.ws() + OFF_CK) + (size_t)b * 512 * 256 + kvh * 64; sc.ldk1 = 256;
      sc.v = (const u16*)(p.ws() + OFF_CV) + (size_t)b * 512 * 256 + kvh * 64; sc.ldv = 256;
      sl2 = 0.125f * LOG2E;
      sinkp = p.in(28) + hq;
      if (lat) { ss.n0 = max(0, qt * 256 - 128); ss.n1 = min(1024, qt * 256 + 384); ss.mode = 1; }
      Qp = QKV + (size_t)qrow0 * 1536 + hq * 64; ldq = 1536;
      Op = AO + (size_t)qrow0 * P1024 + hq * 64;
    } else {
      ss.k1 = QKV + (size_t)tok0 * 3072 + 1024 + hq * 64; ss.ldk1 = 3072;
      ss.v = QKV + (size_t)tok0 * 3072 + 2048 + hq * 64; ss.ldv = 3072;
      sc.k1 = (const u16*)(p.ws() + OFF_C3K) + (size_t)b * 512 * 1024 + hq * 64; sc.ldk1 = 1024;
      sc.v = (const u16*)(p.ws() + OFF_C3V) + (size_t)b * 512 * 1024 + hq * 64; sc.ldv = 1024;
      sl2 = 0.125f * LOG2E;
      if (lat) {
        const int r0a = min(max(4 * qt - 4, 0), 8), r0b = min(max(4 * qt - 1, 0), 8);
        ss.n0 = r0a * 64; ss.n1 = (r0b + 8) * 64; ss.mode = 2;
        rpb = p.in(31) + hq * 465;
      }
      Qp = QKV + (size_t)qrow0 * 3072 + hq * 64; ldq = 3072;
      Op = AO + (size_t)qrow0 * P1024 + hq * 64;
    }
    Seg s0;
    s0.k1 = lat ? sc.k1 : ss.k1; s0.k2 = lat ? sc.k2 : ss.k2; s0.v = lat ? sc.v : ss.v;
    s0.ldk1 = lat ? sc.ldk1 : ss.ldk1; s0.ldk2 = lat ? sc.ldk2 : ss.ldk2; s0.ldv = lat ? sc.ldv : ss.ldv;
    s0.n0 = lat ? sc.n0 : ss.n0; s0.n1 = lat ? sc.n1 : ss.n1; s0.mode = lat ? sc.mode : ss.mode;
    const int nseg = lat ? 2 : 1;
    if (kind == 0) attn_item<128, 128>(Qp, ldq, s0, ss, nseg, qt * 256, sl2, rpb, sinkp, Op, P1024, smem);
    else if (kind == 1) attn_item<96, 64>(Qp, ldq, s0, ss, nseg, qt * 256, sl2, rpb, sinkp, Op, P1024, smem);
    else attn_item<64, 64>(Qp, ldq, s0, ss, nseg, qt * 256, sl2, rpb, sinkp, Op, P1024, smem);
  }
}

__host__ __device__ inline bool phase_exists(int ph) {
  if (ph == 0 || ph == 41) return true;
  const int l = (ph - 1) / 10, s = (ph - 1) % 10;
  if ((s == 3 || s == 4) && l != 1) return false;
  if (s == 2 && l == 3) return false;
  return true;
}

DI void run_phase(const KA& p, int ph, char* smem) {
  if (ph == 0) { prepass(p, smem); return; }
  if (ph == 41) { norm_phase(p, 4, 2); return; }
  const int l = (ph - 1) / 10, s = (ph - 1) % 10;
  char* ws = p.ws();
  GemmDesc g0, g1;
  g0 = GemmDesc{nullptr, nullptr, nullptr, 0, 0, 0, 0, 0, 0, 0};
  g1 = g0;
  int ng = 0;
  switch (s) {
    case 0:
      norm_phase(p, l, 0);
      if (l == 2) {
        convert_f32_bf16(p.in(6), (u16*)(ws + OFF_CK), 4096ull * 256);
        convert_f32_bf16(p.in(7), (u16*)(ws + OFF_CV), 4096ull * 256);
      } else if (l == 3) {
        convert_f32_bf16(p.in(8), (u16*)(ws + OFF_C3K), 4096ull * 1024);
        convert_f32_bf16(p.in(9), (u16*)(ws + OFF_C3V), 4096ull * 1024);
      }
      break;
    case 1: {
      const u16* H = (const u16*)(ws + OFF_HAO);
      if (l == 0) g0 = GemmDesc{H, (const u16*)(ws + OFF_AQKV), ws + OFF_UZ, P1024, P1024, 1536, NTOK, 1536, 1024, EPI_F32};
      else if (l == 1) g0 = GemmDesc{H, (const u16*)(ws + OFF_MIN), ws + OFF_UZ, P1024, P1024, 768, NTOK, 768, 1024, EPI_F32};
      else if (l == 2) g0 = GemmDesc{H, (const u16*)(ws + OFF_SQKV), ws + OFF_UZ, P1024, P1024, 1536, NTOK, 1536, 1024, EPI_F32};
      else g0 = GemmDesc{H, (const u16*)(ws + OFF_NQKV), ws + OFF_QO, P1024, P1024, 3072, NTOK, 3072, 1024, EPI_NAT};
      ng = 1;
    } break;
    case 2:
      if (l == 0) pp_attn(p); else if (l == 1) pp_mla1(p); else if (l == 2) pp_swa(p);
      break;
    case 3:
      g0 = GemmDesc{(const u16*)(ws + OFF_CQ), (const u16*)(ws + OFF_MUQ), ws + OFF_UZ, P384, P384, 1536, NTOK, 1536, 384, EPI_F32};
      g1 = GemmDesc{(const u16*)(ws + OFF_CKV), (const u16*)(ws + OFF_MUKV), ws + OFF_KV, P256, P256, 2048, 16384, 2048, 256, EPI_BF16};
      ng = 2;
      break;
    case 4: pp_mla2(p); break;
    case 5: attn_phase(p, l, smem); break;
    case 6: {
      const size_t wo = l == 0 ? OFF_AO_W : (l == 1 ? OFF_MO : (l == 2 ? OFF_SO : OFF_NO));
      g0 = GemmDesc{(const u16*)(ws + OFF_HAO), (const u16*)(ws + wo), ws + OFF_QO, P1024, P1024, 1024, NTOK, 1024, 1024, EPI_BF16};
      ng = 1;
    } break;
    case 7: norm_phase(p, l, 1); break;
    case 8:
      g0 = GemmDesc{(const u16*)(ws + OFF_HAO), (const u16*)(ws + OFF_W1T + (size_t)l * W1T_SZ), ws + OFF_UZ, P1024, P1024, P4096, NTOK, 4096, 1024, EPI_RELU2};
      ng = 1;
      break;
    case 9:
      g0 = GemmDesc{(const u16*)(ws + OFF_UZ), (const u16*)(ws + OFF_W2T + (size_t)l * W2T_SZ), ws + OFF_QO, P4096, P4096, 1024, NTOK, 1024, 4096, EPI_BF16};
      ng = 1;
      break;
  }
  if (ng > 0) gemm_phase(p, g0, g1, ng, smem);
}

#define XB_TMO      128
#define XB_XCNT(j)  (256  + 64 * (j))
#define XB_XSUB(j)  (1280 + 64 * (j))
#define XB_XGEN(j)  (2304 + 64 * (j))
#define XB_TOP      3328
#define XB_TOPGEN   3392
#define XCD_BAR_WORDS 3456
#define XB_SPIN_CAP (1u << 18)
#define LAS __attribute__((address_space(3)))

__device__ __forceinline__ unsigned xb_ld(unsigned* p)              { return __hip_atomic_load(p, __ATOMIC_RELAXED, __HIP_MEMORY_SCOPE_AGENT); }
__device__ __forceinline__ unsigned xb_add(unsigned* p, unsigned v) { return __hip_atomic_fetch_add(p, v, __ATOMIC_RELAXED, __HIP_MEMORY_SCOPE_AGENT); }
__device__ __forceinline__ unsigned xb_xcc_id() { return (unsigned)__builtin_amdgcn_s_getreg((3 << 11) | 20) & 0xFu; }
#define XB_SPIN(cond, bar) do { unsigned _sp = 0; while (cond) { __builtin_amdgcn_s_sleep(1); \
    if ((++_sp & 255u) == 0u) { if (xb_ld(&(bar)[XB_TMO])) break; if (_sp > XB_SPIN_CAP) { atomicAdd(&(bar)[XB_TMO], 1u); break; } } } } while (0)

struct XcdBarrier {
    unsigned* bar; unsigned x;
    volatile LAS unsigned* st;
};

__device__ __forceinline__ XcdBarrier xcd_barrier_post(unsigned* bar, volatile LAS unsigned* st) {
    XcdBarrier b; b.bar = bar; b.x = xb_xcc_id(); b.st = st;
    if (threadIdx.x == 0) (void)xb_add(&bar[XB_XCNT(b.x)], 1u);
    return b;
}
__device__ __forceinline__ void xcd_barrier_complete(unsigned* bar, unsigned x, unsigned& nloc, unsigned& nx) {
    const unsigned G = gridDim.x * gridDim.y * gridDim.z;
    unsigned sum, cnt, mine, sp = 0u;
    for (;;) {
        sum = 0u; cnt = 0u; mine = 0u;
#pragma unroll
        for (unsigned j = 0; j < 16; ++j) { const unsigned c = xb_ld(&bar[XB_XCNT(j)]); sum += c; cnt += (c > 0u) ? 1u : 0u; mine = (j == x) ? c : mine; }
        if (sum == G) break;
        __builtin_amdgcn_s_sleep(1);
        if ((++sp & 255u) == 0u) { if (xb_ld(&bar[XB_TMO])) break; if (sp > XB_SPIN_CAP) { atomicAdd(&bar[XB_TMO], 1u); break; } }
    }
    nloc = mine > 0u ? mine : 1u; nx = cnt > 0u ? cnt : 1u;
}

__device__ __forceinline__ void xcd_barrier(const XcdBarrier& b) {
    asm volatile("s_waitcnt vmcnt(0)" ::: "memory");
    __syncthreads();
    if (threadIdx.x == 0) {
        unsigned* bar = b.bar;
        __builtin_amdgcn_s_waitcnt(0);
        unsigned nloc = b.st[0], nx = b.st[1];
        if (nloc == 0u) { xcd_barrier_complete(bar, b.x, nloc, nx); b.st[0] = nloc; b.st[1] = nx; }
        const unsigned old = xb_add(&bar[XB_XSUB(b.x)], 1u);
        const unsigned gen = old / nloc;
        if (old + 1u == (gen + 1u) * nloc) {
            __builtin_amdgcn_fence(__ATOMIC_RELEASE, "agent");
            asm volatile("s_waitcnt vmcnt(0)" ::: "memory");
            const unsigned og = xb_add(&bar[XB_TOP], 1u);
            const unsigned tg = og / nx;
            if (og + 1u == (tg + 1u) * nx) xb_add(&bar[XB_TOPGEN], 1u);
            else XB_SPIN(xb_ld(&bar[XB_TOPGEN]) == tg, bar);
            __builtin_amdgcn_fence(__ATOMIC_ACQUIRE, "agent");
            xb_add(&bar[XB_XGEN(b.x)], 1u);
            asm volatile("s_waitcnt vmcnt(0)" ::: "memory");
        } else {
            XB_SPIN(xb_ld(&bar[XB_XGEN(b.x)]) == gen, bar);
            __builtin_amdgcn_fence(__ATOMIC_ACQUIRE, "agent");
            asm volatile("s_waitcnt vmcnt(0)" ::: "memory");
        }
    }
    __syncthreads();
}

__global__ void __launch_bounds__(512, 2) mega(Params p) {
  __shared__ __attribute__((aligned(16))) char smem[129024];
  __shared__ uint4 xb_words;
  const bool coop = (p.ph1 - p.ph0) > 1;
  XcdBarrier xb;
  if (coop) {
    if (threadIdx.x == 0) xb_words = make_uint4(0u, 0u, 0u, 0u);
    __syncthreads();
    xb = xcd_barrier_post((unsigned*)(p.ws + OFF_BAR), (volatile LAS unsigned*)&xb_words);
  }
  if (p.ph1 < 0) cg::this_grid().sync();
  for (int ph = p.ph0; ph < p.ph1; ++ph) {
    if (!phase_exists(ph)) continue;
    KA q;
    q.ka = (const AS4 char*)__builtin_amdgcn_kernarg_segment_ptr();
    asm volatile("" : "+s"(q.ka));
    run_phase(q, ph, smem);
    if (ph + 1 < p.ph1) {
      unsigned zoff = 0;
      asm volatile("" : "+s"(zoff));
      XcdBarrier xl = xb;
      xl.bar = xb.bar + zoff; xl.x = xb.x + zoff;
      xcd_barrier(xl);
    }
  }
}

extern "C" void kernel_launch(void* const* d_in, const int* in_sizes, int n_in, void* d_out, int out_size,
                              void* d_ws, size_t ws_size, hipStream_t stream) {
  if (n_in < 33 || ws_size < WS_NEED) { fprintf(stderr, "bad args: n_in %d ws %zu need %zu\n", n_in, ws_size, (size_t)WS_NEED); return; }
  Params p{};
  for (int i = 0; i < 33; ++i) p.in[i] = (const float*)d_in[i];
  p.out = (float*)d_out;
  p.ws = (char*)d_ws;
#if N_LAUNCH_MODE == 1
  for (int ph = 0; ph < 42; ++ph) {
    if (!phase_exists(ph)) continue;
    p.ph0 = ph; p.ph1 = ph + 1;
    hipLaunchKernelGGL(mega, dim3(256), dim3(NTHR), 0, stream, p);
  }
#else
  static int grid_blocks = 0;
  if (!grid_blocks) {
    int dev = 0, cus = 0, per_cu = 0;
    hipGetDevice(&dev);
    hipDeviceGetAttribute(&cus, hipDeviceAttributeMultiprocessorCount, dev);
    hipOccupancyMaxActiveBlocksPerMultiprocessor(&per_cu, mega, NTHR, 0);
    if (per_cu > 1) per_cu = 1;
    grid_blocks = cus * per_cu;
  }
  p.ph0 = 0; p.ph1 = 42;
  hipMemsetAsync((char*)d_ws + OFF_BAR, 0, XCD_BAR_WORDS * 4, stream);
  void* args[] = {&p};
  hipError_t e = hipLaunchCooperativeKernel((void*)mega, dim3(grid_blocks), dim3(NTHR), args, 0, stream);
  if (e != hipSuccess) fprintf(stderr, "cooperative launch failed: %s (grid %d)\n", hipGetErrorString(e), grid_blocks);
#endif
}
```

```cpp
#include <hip/hip_runtime.h>
#include <hip/hip_cooperative_groups.h>
#include <cstdio>
namespace cg = cooperative_groups;

typedef unsigned short u16;
typedef short bf16x8 __attribute__((ext_vector_type(8)));
typedef short s16x4 __attribute__((ext_vector_type(4)));
typedef float f32x16 __attribute__((ext_vector_type(16)));
typedef float f32x2 __attribute__((ext_vector_type(2)));
typedef __bf16 bfx2 __attribute__((ext_vector_type(2)));
#define DI __device__ __forceinline__
#define MFMA(a, b, c) __builtin_amdgcn_mfma_f32_32x32x16_bf16((a), (b), (c), 0, 0, 0)
#define LDS3 __attribute__((address_space(3)))

#ifndef REP_GEMM
#define REP_GEMM 1
#endif
#ifndef REP_ATT
#define REP_ATT 1
#endif
#ifndef N_LAUNCH_MODE
#define N_LAUNCH_MODE 0
#endif

constexpr int NTOK = 12288, NCTX = 4096;
constexpr int NTHR = 512, NWAVE = 8;
constexpr float LOG2E = 1.4426950408889634f;

constexpr size_t O_L0K = 12582912, O_L0V = 13631488, O_L1CKV = 14680064, O_L1KPE = 15728640,
                 O_L2K = 15859712, O_L2V = 16908288, O_L3K = 17956864, O_L3V = 22151168;

constexpr int P1024 = 1024, P4096 = 4160, P384 = 448, P256 = 320;
constexpr size_t W1T_SZ = 4096ull * P1024 * 2, W2T_SZ = 1024ull * P4096 * 2;
constexpr size_t OFF_W1T = 0;
constexpr size_t OFF_W2T = OFF_W1T + 4 * W1T_SZ;
constexpr size_t OFF_AQKV = OFF_W2T + 4 * W2T_SZ;
constexpr size_t OFF_AO_W = OFF_AQKV + 1536ull * P1024 * 2;
constexpr size_t OFF_MIN = OFF_AO_W + 1024ull * P1024 * 2;
constexpr size_t OFF_MUQ = OFF_MIN + 768ull * P1024 * 2;
constexpr size_t OFF_MUKV = OFF_MUQ + 1536ull * P384 * 2;
constexpr size_t OFF_MO = OFF_MUKV + 2048ull * P256 * 2;
constexpr size_t OFF_SQKV = OFF_MO + 1024ull * P1024 * 2;
constexpr size_t OFF_SO = OFF_SQKV + 1536ull * P1024 * 2;
constexpr size_t OFF_NQKV = OFF_SO + 1024ull * P1024 * 2;
constexpr size_t OFF_NO = OFF_NQKV + 3072ull * P1024 * 2;
constexpr size_t OFF_MOD = OFF_NO + 1024ull * P1024 * 2;
constexpr size_t OFF_ROPE = OFF_MOD + 4ull * 9 * 6144 * 4;
constexpr size_t OFF_HAO = OFF_ROPE + 3ull * 64 * 32 * 2 * 4;
constexpr size_t OFF_UZ = OFF_HAO + 12288ull * P1024 * 2;
constexpr size_t OFF_QO = OFF_UZ + 12288ull * P4096 * 2;
constexpr size_t OFF_CQ = OFF_QO + 12288ull * 3072 * 2;
constexpr size_t OFF_CKV = OFF_CQ + 12288ull * P384 * 2;
constexpr size_t OFF_KPE = OFF_CKV + 16384ull * P256 * 2;
constexpr size_t OFF_KV = OFF_KPE + 16384ull * 32 * 2;
constexpr size_t OFF_CK = OFF_KV;
constexpr size_t OFF_CV = OFF_KV + 2097152;
constexpr size_t OFF_C3K = OFF_KV + 4194304;
constexpr size_t OFF_C3V = OFF_C3K + 8388608;
constexpr size_t OFF_BAR = OFF_KV + 16384ull * 2048 * 2;
constexpr size_t WS_NEED = OFF_BAR + 16384;

struct Params {
  const float* in[33];
  float* out;
  char* ws;
  int ph0, ph1;
};

#define AS4 __attribute__((address_space(4)))
struct KA {
  const AS4 char* ka;
  DI const float* in(int i) const { return *(const float* const AS4*)(ka + 8 * i); }
  DI float* out() const { return *(float* const AS4*)(ka + 264); }
  DI char* ws() const { return *(char* const AS4*)(ka + 272); }
};

DI unsigned pack2(float a, float b) { f32x2 f = {a, b}; bfx2 v = __builtin_convertvector(f, bfx2); return __builtin_bit_cast(unsigned, v); }
DI u16 f2bf(float a) { return (u16)(pack2(a, a) & 0xffffu); }
DI float wave_sum(float v) {
#pragma unroll
  for (int o = 32; o; o >>= 1) v += __shfl_xor(v, o, 64);
  return v;
}
DI int ltid() { int t = threadIdx.x; asm volatile("" : "+v"(t)); return t; }
template <int CTRL> DI float dpp_f(float v) {
  return __int_as_float(__builtin_amdgcn_update_dpp(0, __float_as_int(v), CTRL, 0xf, 0xf, true));
}
DI int crow(int i, int h) { return (i & 3) + 8 * (i >> 2) + 4 * h; }

__device__ const long long TJ[18][6] = {
  {15, 0ll * 1024 * 4096, 1024, 4096, 4096, (long long)(OFF_W1T + 0ull * W1T_SZ)},
  {15, 1ll * 1024 * 4096, 1024, 4096, 4096, (long long)(OFF_W1T + 1ull * W1T_SZ)},
  {15, 2ll * 1024 * 4096, 1024, 4096, 4096, (long long)(OFF_W1T + 2ull * W1T_SZ)},
  {15, 3ll * 1024 * 4096, 1024, 4096, 4096, (long long)(OFF_W1T + 3ull * W1T_SZ)},
  {16, 0ll * 1024 * 4096, 4096, 1024, 1024, (long long)(OFF_W2T + 0ull * W2T_SZ)},
  {16, 1ll * 1024 * 4096, 4096, 1024, 1024, (long long)(OFF_W2T + 1ull * W2T_SZ)},
  {16, 2ll * 1024 * 4096, 4096, 1024, 1024, (long long)(OFF_W2T + 2ull * W2T_SZ)},
  {16, 3ll * 1024 * 4096, 4096, 1024, 1024, (long long)(OFF_W2T + 3ull * W2T_SZ)},
  {17, 0, 1024, 1536, 1536, (long long)OFF_AQKV},
  {20, 0, 1024, 1024, 1024, (long long)OFF_AO_W},
  {21, 0, 1024, 672, 768, (long long)OFF_MIN},
  {24, 0, 384, 1536, 1536, (long long)OFF_MUQ},
  {25, 0, 256, 2048, 2048, (long long)OFF_MUKV},
  {26, 0, 1024, 1024, 1024, (long long)OFF_MO},
  {27, 0, 1024, 1536, 1536, (long long)OFF_SQKV},
  {29, 0, 1024, 1024, 1024, (long long)OFF_SO},
  {30, 0, 1024, 3072, 3072, (long long)OFF_NQKV},
  {32, 0, 1024, 1024, 1024, (long long)OFF_NO},
};

struct TTile { const float* src; u16* dst; int K, N, k0, n0; };
DI void tt_load(const TTile& t, int tid, float4 (&v)[8]) {
  const int n4 = tid & 63, kl = tid >> 6;
  const int n = t.n0 + 4 * n4;
#pragma unroll
  for (int j = 0; j < 8; ++j) {
    const int k = kl + 8 * j;
    v[j] = (n < t.N) ? *(const float4*)(t.src + (size_t)(t.k0 + k) * t.N + n) : make_float4(0.f, 0.f, 0.f, 0.f);
  }
}
DI void tt_store(const TTile& t, int tid, const float4 (&v)[8], char* smem) {
  float (*T)[260] = (float (*)[260])smem;
  const int n4 = tid & 63, kl = tid >> 6;
  __syncthreads();
#pragma unroll
  for (int j = 0; j < 8; ++j) *(float4*)&T[kl + 8 * j][4 * n4] = v[j];
  __syncthreads();
#pragma unroll
  for (int j = 0; j < 4; ++j) {
    const int c = tid + NTHR * j;
    const int n = c >> 3, kc = c & 7;
    uint4 o;
    o.x = pack2(T[kc * 8 + 0][n], T[kc * 8 + 1][n]);
    o.y = pack2(T[kc * 8 + 2][n], T[kc * 8 + 3][n]);
    o.z = pack2(T[kc * 8 + 4][n], T[kc * 8 + 5][n]);
    o.w = pack2(T[kc * 8 + 6][n], T[kc * 8 + 7][n]);
    *(uint4*)&t.dst[(size_t)(t.n0 + n) * (t.K == 1024 ? P1024 : t.K + 64) + t.k0 + kc * 8] = o;
  }
}

DI void convert_f32_bf16(const float* __restrict__ src, u16* __restrict__ dst, size_t n) {
  const size_t n4 = n >> 2;
  const int tid_ = ltid();
  for (size_t i = (size_t)blockIdx.x * NTHR + tid_; i < n4; i += (size_t)gridDim.x * NTHR) {
    const float4 v = ((const float4*)src)[i];
    uint2 o; o.x = pack2(v.x, v.y); o.y = pack2(v.z, v.w);
    ((uint2*)dst)[i] = o;
  }
}

DI void convert_rows256(const float* __restrict__ src, u16* __restrict__ dst, int rows, int dpitch) {
  const int tid_ = ltid();
  for (int i = blockIdx.x * NTHR + tid_; i < rows * 64; i += gridDim.x * NTHR) {
    const int r = i >> 6, c4 = i & 63;
    const float4 v = ((const float4*)src)[i];
    uint2 o; o.x = pack2(v.x, v.y); o.y = pack2(v.z, v.w);
    *(uint2*)(dst + (size_t)r * dpitch + 4 * c4) = o;
  }
}

DI void prepass(const KA& p, char* smem) {
  {
    const int tid = ltid();
    int total = 0;
    for (int j = 0; j < 18; ++j) total += (int)((TJ[j][2] >> 6) * (TJ[j][4] >> 8));
    float4 va[8], vb[8];
    TTile ta, tb;
#define TT_DECODE(tt_, t_)                                                                     \
    {                                                                                          \
      int j = 0, tt = (t_);                                                                    \
      for (;;) { const int c = (int)((TJ[j][2] >> 6) * (TJ[j][4] >> 8)); if (tt < c) break; tt -= c; ++j; } \
      const int K = (int)TJ[j][2];                                                             \
      const int nk = K >> 6;                                                                   \
      tt_.src = p.in((int)TJ[j][0]) + TJ[j][1]; tt_.dst = (u16*)(p.ws() + TJ[j][5]);           \
      tt_.K = K; tt_.N = (int)TJ[j][3]; tt_.k0 = (tt % nk) * 64; tt_.n0 = (tt / nk) * 256;     \
    }
    int t = blockIdx.x;
    if (t < total) { TT_DECODE(ta, t) tt_load(ta, tid, va); }
    for (; t < total; t += 2 * gridDim.x) {
      const int t2 = t + gridDim.x;
      if (t2 < total) { TT_DECODE(tb, t2) tt_load(tb, tid, vb); }
      tt_store(ta, tid, va, smem);
      if (t2 < total) {
        const int t3 = t2 + gridDim.x;
        if (t3 < total) { TT_DECODE(ta, t3) tt_load(ta, tid, va); }
        tt_store(tb, tid, vb, smem);
      }
    }
#undef TT_DECODE
  }
  convert_f32_bf16(p.in(2), (u16*)(p.ws() + OFF_CK), 4096ull * 256);
  convert_f32_bf16(p.in(3), (u16*)(p.ws() + OFF_CV), 4096ull * 256);
  convert_rows256(p.in(4), (u16*)(p.ws() + OFF_CKV) + 12288ull * P256, 4096, P256);
  convert_f32_bf16(p.in(5), (u16*)(p.ws() + OFF_KPE) + 12288ull * 32, 4096ull * 32);
  {
    float* tab = (float*)(p.ws() + OFF_ROPE);
    const int tid_ = ltid();
    for (int e = blockIdx.x * NTHR + tid_; e < 3 * 64 * 32; e += gridDim.x * NTHR) {
      const int kind = e / 2048, pos = (e >> 5) & 63, i = e & 31;
      const int quarter = kind == 0 ? 32 : (kind == 1 ? 16 : 8);
      float c = 1.f, s = 0.f;
      if (i < quarter) {
        const float inv = exp2f(-(float)i / (float)quarter * 13.287712379549449f);
        const float ang = (float)pos * inv;
        c = cosf(ang); s = sinf(ang);
      }
      tab[2 * e] = c; tab[2 * e + 1] = s;
    }
  }
  {
    float* scond = (float*)smem;
    float* red = (float*)(smem + 36864);
    float* MOD = (float*)(p.ws() + OFF_MOD);
    const int tid = ltid();
    bool ready = false;
    for (int it = blockIdx.x; it < 768; it += gridDim.x) {
      __syncthreads();
      if (!ready) {
        for (int e = tid; e < 9 * 1024; e += NTHR) {
          const float c = e < 8192 ? p.in(10)[e] : p.in(11)[e - 8192];
          scond[e] = c / (1.f + __expf(-c));
        }
        ready = true;
        __syncthreads();
      }
      const int l = it / 192, n0 = (it % 192) * 32;
      const int cq = tid & 7, kg = tid >> 3;
      float acc[9][4];
#pragma unroll
      for (int c = 0; c < 9; ++c) { acc[c][0] = 0.f; acc[c][1] = 0.f; acc[c][2] = 0.f; acc[c][3] = 0.f; }
      const float* wp = p.in(12) + (size_t)l * 1024 * 6144 + n0 + 4 * cq;
      float4 wv[16];
#pragma unroll
      for (int i = 0; i < 16; ++i) wv[i] = *(const float4*)(wp + (size_t)(kg + 64 * i) * 6144);
#pragma unroll
      for (int i = 0; i < 16; ++i) {
        const int k = kg + 64 * i;
#pragma unroll
        for (int c = 0; c < 9; ++c) {
          const float sv = scond[c * 1024 + k];
          acc[c][0] += sv * wv[i].x; acc[c][1] += sv * wv[i].y; acc[c][2] += sv * wv[i].z; acc[c][3] += sv * wv[i].w;
        }
      }
#pragma unroll
      for (int c = 0; c < 9; ++c) *(float4*)&red[(kg * 9 + c) * 32 + 4 * cq] = make_float4(acc[c][0], acc[c][1], acc[c][2], acc[c][3]);
      __syncthreads();
      for (int e = tid; e < 288; e += NTHR) {
        const int c = e >> 5, cc = e & 31;
        float sum = p.in(13)[l * 6144 + n0 + cc];
#pragma unroll 8
        for (int g = 0; g < 64; ++g) sum += red[(g * 9 + c) * 32 + cc];
        MOD[(size_t)(l * 9 + c) * 6144 + n0 + cc] = sum;
      }
    }
  }
}

DI float bf2f(unsigned v16) { return __uint_as_float(v16 << 16); }

DI void norm_phase(const KA& p, int l, int mode) {
  const int tid_ = ltid(); const int lane = tid_ & 63, w = tid_ >> 6;
  float* X = p.out();
  const float* MOD = (const float*)(p.ws() + OFF_MOD);
  const u16* FF = (const u16*)(p.ws() + OFF_QO);
  u16* H = (u16*)(p.ws() + OFF_HAO);
  const float* ng = p.in(14);
  const float* xp0 = p.in(0);
  const float* xp1 = p.in(1);
  const bool x_in = (l == 0);
  const bool add = !(l == 0 && mode == 0);
  const int la = (mode == 1) ? l : l - 1;
  const int gate_w = (mode == 1) ? 2 : 5;
  const int gadd = (mode == 1) ? 1 : 3;
  const bool do_h = mode != 2;
  const int gh = (mode == 0) ? 0 : 2, scw = (mode == 0) ? 1 : 4, shw = (mode == 0) ? 0 : 3;
  const int stride = gridDim.x * NWAVE;
  const int lh = do_h ? l : 0;
  int row = blockIdx.x * NWAVE + w;
  float4 nx0, nx1, nx2, nx3;
  uint2 nf0 = make_uint2(0, 0), nf1 = nf0, nf2 = nf0, nf3 = nf0;
#define NLOAD(rw)                                                                                          \
  {                                                                                                        \
    const int rr = min((rw), NTOK - 1);                                                                    \
    const float* xs = x_in ? (rr < NCTX ? xp0 + (size_t)rr * 1024 : xp1 + (size_t)(rr - NCTX) * 1024)      \
                           : X + (size_t)rr * 1024;                                                        \
    nx0 = *(const float4*)(xs + 4 * lane); nx1 = *(const float4*)(xs + 4 * lane + 256);                    \
    nx2 = *(const float4*)(xs + 4 * lane + 512); nx3 = *(const float4*)(xs + 4 * lane + 768);              \
    if (add) {                                                                                             \
      const u16* fr = FF + (size_t)rr * 1024 + 4 * lane;                                                   \
      nf0 = *(const uint2*)(fr); nf1 = *(const uint2*)(fr + 256); nf2 = *(const uint2*)(fr + 512); nf3 = *(const uint2*)(fr + 768); \
    }                                                                                                      \
  }
  NLOAD(row)
  for (; row < NTOK; row += stride) {
    const int ci = row < NCTX ? 8 : ((row - NCTX) >> 10);
    float4 x[4] = {nx0, nx1, nx2, nx3};
    const uint2 fb[4] = {nf0, nf1, nf2, nf3};
    const float* ga = ng + (la * 4 + gadd) * 1024 + 4 * lane;
    const float* gt = MOD + (size_t)(la * 9 + ci) * 6144 + gate_w * 1024 + 4 * lane;
    const float* gp = ng + (lh * 4 + gh) * 1024 + 4 * lane;
    const float* sc = MOD + (size_t)(lh * 9 + ci) * 6144 + scw * 1024 + 4 * lane;
    const float* sh = MOD + (size_t)(lh * 9 + ci) * 6144 + shw * 1024 + 4 * lane;
    float4 ga4[4], gt4[4], g4[4], c4[4], s4[4];
#pragma unroll
    for (int j = 0; j < 4; ++j) {
      if (add) { ga4[j] = *(const float4*)(ga + 256 * j); gt4[j] = *(const float4*)(gt + 256 * j); }
      if (do_h) { g4[j] = *(const float4*)(gp + 256 * j); c4[j] = *(const float4*)(sc + 256 * j); s4[j] = *(const float4*)(sh + 256 * j); }
    }
    NLOAD(row + stride)
    if (add) {
      float f[16];
      float ss = 0.f;
#pragma unroll
      for (int j = 0; j < 4; ++j) {
        f[4 * j] = bf2f(fb[j].x & 0xffffu); f[4 * j + 1] = bf2f(fb[j].x >> 16);
        f[4 * j + 2] = bf2f(fb[j].y & 0xffffu); f[4 * j + 3] = bf2f(fb[j].y >> 16);
        ss += f[4 * j] * f[4 * j] + f[4 * j + 1] * f[4 * j + 1] + f[4 * j + 2] * f[4 * j + 2] + f[4 * j + 3] * f[4 * j + 3];
      }
      ss = wave_sum(ss);
      const float rstd = rsqrtf(ss * (1.f / 1024.f) + 1e-6f);
#pragma unroll
      for (int j = 0; j < 4; ++j) {
        x[j].x += gt4[j].x * (f[4 * j] * rstd * ga4[j].x);
        x[j].y += gt4[j].y * (f[4 * j + 1] * rstd * ga4[j].y);
        x[j].z += gt4[j].z * (f[4 * j + 2] * rstd * ga4[j].z);
        x[j].w += gt4[j].w * (f[4 * j + 3] * rstd * ga4[j].w);
        *(float4*)(X + (size_t)row * 1024 + 4 * lane + 256 * j) = x[j];
      }
    }
    if (do_h) {
      float ss = 0.f;
#pragma unroll
      for (int j = 0; j < 4; ++j) ss += x[j].x * x[j].x + x[j].y * x[j].y + x[j].z * x[j].z + x[j].w * x[j].w;
      ss = wave_sum(ss);
      const float rstd = rsqrtf(ss * (1.f / 1024.f) + 1e-6f);
#pragma unroll
      for (int j = 0; j < 4; ++j) {
        const float h0 = x[j].x * rstd * g4[j].x * (1.f + c4[j].x) + s4[j].x;
        const float h1 = x[j].y * rstd * g4[j].y * (1.f + c4[j].y) + s4[j].y;
        const float h2 = x[j].z * rstd * g4[j].z * (1.f + c4[j].z) + s4[j].z;
        const float h3 = x[j].w * rstd * g4[j].w * (1.f + c4[j].w) + s4[j].w;
        uint2 o; o.x = pack2(h0, h1); o.y = pack2(h2, h3);
        *(uint2*)(H + (size_t)row * P1024 + 4 * lane + 256 * j) = o;
      }
    }
  }
#undef NLOAD
}

enum { EPI_F32 = 0, EPI_BF16 = 1, EPI_RELU2 = 2, EPI_NAT = 3, EPI_SWA = 4, EPI_MLAQ = 5, EPI_ATTN = 6 };
struct GemmDesc { const u16* A; const u16* Bt; void* dst; int lda, ldb, ldc, M, N, K, epi; };

DI void gemm_tile(const GemmDesc& g, int m0, int n0, float* outp, const float* rope, const float* qnorm, const float* knorm, char* smem) {
  constexpr int LS = 72;
  constexpr int BM = 192, BN = 256;
  u16* As = (u16*)smem;
  u16* Bs = As + 2 * BM * LS;
  const int tid = ltid(), lane = tid & 63, w = tid >> 6, r = lane & 31, h = lane >> 5;
  const int wm = w >> 2, wn = w & 3;
  const int lrow = tid >> 3, lcc = tid & 7;
  const int Mlast = g.M - 1;
  const char* Ab = (const char*)g.A;
  const char* Bb = (const char*)g.Bt;
  const unsigned ao0 = (unsigned)(min(m0 + lrow, Mlast) * g.lda + lcc * 8) * 2u;
  const unsigned ao1 = (unsigned)(min(m0 + lrow + 64, Mlast) * g.lda + lcc * 8) * 2u;
  const unsigned ao2 = (unsigned)(min(m0 + lrow + 128, Mlast) * g.lda + lcc * 8) * 2u;
  const unsigned bo0 = (unsigned)((n0 + lrow) * g.ldb + lcc * 8) * 2u;
  const unsigned bst = (unsigned)(64 * g.ldb) * 2u;
  uint4 pa0, pa1, pa2, pb0, pb1, pb2, pb3;
  f32x16 acc00, acc01, acc10, acc11, acc20, acc21;
#pragma unroll
  for (int i = 0; i < 16; ++i) { acc00[i] = 0.f; acc01[i] = 0.f; acc10[i] = 0.f; acc11[i] = 0.f; acc20[i] = 0.f; acc21[i] = 0.f; }
#define GLOAD(R, kt_)                                                                                  \
  {                                                                                                    \
    const char* ak = Ab + (size_t)(kt_) * 128; const char* bk = Bb + (size_t)(kt_) * 128;              \
    R##a0 = *(const uint4*)(ak + ao0); R##a1 = *(const uint4*)(ak + ao1); R##a2 = *(const uint4*)(ak + ao2); \
    R##b0 = *(const uint4*)(bk + bo0); R##b1 = *(const uint4*)(bk + bo0 + bst);                        \
    R##b2 = *(const uint4*)(bk + bo0 + 2 * bst); R##b3 = *(const uint4*)(bk + bo0 + 3 * bst);          \
  }
#define LSTORE(R, buf)                                                                  \
  *(uint4*)&As[(buf) * BM * LS + (lrow) * LS + lcc * 8] = R##a0;                         \
  *(uint4*)&As[(buf) * BM * LS + (lrow + 64) * LS + lcc * 8] = R##a1;                    \
  *(uint4*)&As[(buf) * BM * LS + (lrow + 128) * LS + lcc * 8] = R##a2;                   \
  *(uint4*)&Bs[(buf) * BN * LS + (lrow) * LS + lcc * 8] = R##b0;                         \
  *(uint4*)&Bs[(buf) * BN * LS + (lrow + 64) * LS + lcc * 8] = R##b1;                    \
  *(uint4*)&Bs[(buf) * BN * LS + (lrow + 128) * LS + lcc * 8] = R##b2;                   \
  *(uint4*)&Bs[(buf) * BN * LS + (lrow + 192) * LS + lcc * 8] = R##b3;
#define FRAGS(X, kk)                                                                    \
  X##a0 = *(const bf16x8*)(Ac + 16 * (kk));                                             \
  X##a1 = *(const bf16x8*)(Ac + 32 * LS + 16 * (kk));                                   \
  X##a2 = *(const bf16x8*)(Ac + 64 * LS + 16 * (kk));                                   \
  X##b0 = *(const bf16x8*)(Bc + 16 * (kk));                                             \
  X##b1 = *(const bf16x8*)(Bc + 32 * LS + 16 * (kk));
#define MMAS(X)                                                                         \
  acc00 = MFMA(X##a0, X##b0, acc00); acc01 = MFMA(X##a0, X##b1, acc01);                 \
  acc10 = MFMA(X##a1, X##b0, acc10); acc11 = MFMA(X##a1, X##b1, acc11);                 \
  acc20 = MFMA(X##a2, X##b0, acc20); acc21 = MFMA(X##a2, X##b1, acc21);
#define COMPUTE(buf)                                                                    \
  {                                                                                     \
    const u16* Ac = As + (buf) * BM * LS + (96 * wm + r) * LS + 8 * h;                  \
    const u16* Bc = Bs + (buf) * BN * LS + (64 * wn + r) * LS + 8 * h;                  \
    bf16x8 xa0, xa1, xa2, xb0, xb1, ya0, ya1, ya2, yb0, yb1;                            \
    FRAGS(x, 0) __builtin_amdgcn_sched_barrier(0);                                      \
    FRAGS(y, 1) __builtin_amdgcn_sched_barrier(0); MMAS(x) __builtin_amdgcn_sched_barrier(0); \
    FRAGS(x, 2) __builtin_amdgcn_sched_barrier(0); MMAS(y) __builtin_amdgcn_sched_barrier(0); \
    FRAGS(y, 3) __builtin_amdgcn_sched_barrier(0); MMAS(x) __builtin_amdgcn_sched_barrier(0); \
    MMAS(y)                                                                             \
  }
  const int KT = g.K >> 6;
  GLOAD(p, 0)
  LSTORE(p, 0)
  __syncthreads();
  for (int kt = 0; kt < KT; kt += 2) {
    GLOAD(p, min(kt + 1, KT - 1))
    __builtin_amdgcn_sched_barrier(0);
    COMPUTE(0)
    LSTORE(p, 1)
    __syncthreads();
    GLOAD(p, min(kt + 2, KT - 1))
    __builtin_amdgcn_sched_barrier(0);
    COMPUTE(1)
    LSTORE(p, 0)
    __syncthreads();
  }
#undef GLOAD
#undef LSTORE
#undef FRAGS
#undef MMAS
#undef COMPUTE
  const int epi = g.epi;
#define EPI_LOOP(BODY)                                                                                         \
  _Pragma("unroll") for (int mi = 0; mi < 3; ++mi)                                                             \
  _Pragma("unroll") for (int ni = 0; ni < 2; ++ni) {                                                           \
    const int col = n0 + 64 * wn + 32 * ni + r;                                                                \
    _Pragma("unroll") for (int i = 0; i < 16; ++i) {                                                           \
      const int row = m0 + 96 * wm + 32 * mi + crow(i, h);                                                     \
      const float v = mi == 0 ? (ni == 0 ? acc00[i] : acc01[i]) : (mi == 1 ? (ni == 0 ? acc10[i] : acc11[i]) : (ni == 0 ? acc20[i] : acc21[i])); \
      BODY                                                                                                     \
    }                                                                                                          \
  }
  if (epi == EPI_F32) {
    float* dst = (float*)g.dst;
    EPI_LOOP(dst[(size_t)row * g.ldc + col] = v;)
  } else if (epi == EPI_RELU2) {
    u16* dst = (u16*)g.dst;
    EPI_LOOP(const float t = v > 0.f ? v : 0.f; dst[(size_t)row * g.ldc + col] = f2bf(t * t);)
  } else if (epi == EPI_BF16) {
    u16* dst = (u16*)g.dst;
    EPI_LOOP(if (row <= Mlast) dst[(size_t)row * g.ldc + col] = f2bf(v);)
  } else if (epi == EPI_NAT) {
    u16* dst = (u16*)g.dst;
    EPI_LOOP(dst[(size_t)row * g.ldc + col] = f2bf(v);
             if (row < NCTX && col >= 1024) outp[(col < 2048 ? O_L3K - 1024 : O_L3V - 2048) + (size_t)row * 1024 + col] = v;)
  } else if (epi == EPI_ATTN) {
    u16* dst = (u16*)g.dst;
    float* part = (float*)(smem + 92160);
    const bool isv = n0 >= 1280;
    if (!isv) {
#pragma unroll
      for (int mi = 0; mi < 3; ++mi)
#pragma unroll
        for (int i = 0; i < 16; ++i) {
          const float a0 = mi == 0 ? acc00[i] : (mi == 1 ? acc10[i] : acc20[i]);
          const float a1 = mi == 0 ? acc01[i] : (mi == 1 ? acc11[i] : acc21[i]);
          float ss = a0 * a0 + a1 * a1;
          ss += dpp_f<0xB1>(ss); ss += dpp_f<0x4E>(ss); ss += dpp_f<0x141>(ss); ss += dpp_f<0x140>(ss);
          if ((r & 15) == 0) part[(96 * wm + 32 * mi + crow(i, h)) * 8 + wn * 2 + (r >> 4)] = ss;
        }
      __syncthreads();
    }
    const float* gn = n0 < 1024 ? qnorm : knorm;
    const int axis = wn & 1;
    const float gv0 = isv ? 1.f : gn[64 * axis + r], gv1 = isv ? 1.f : gn[64 * axis + 32 + r];
    const int col0 = n0 + 64 * wn + r;
#pragma unroll
    for (int mi = 0; mi < 3; ++mi)
#pragma unroll
      for (int i = 0; i < 16; ++i) {
        const int rl = 96 * wm + 32 * mi + crow(i, h), row = m0 + rl;
        const float a0 = mi == 0 ? acc00[i] : (mi == 1 ? acc10[i] : acc20[i]);
        const float a1 = mi == 0 ? acc01[i] : (mi == 1 ? acc11[i] : acc21[i]);
        const bool lat = row >= NCTX;
        float y0 = a0, y1 = a1;
        if (!isv) {
          const float4 pq = *(const float4*)&part[rl * 8 + (wn & 2) * 2];
          const float ssq = (pq.x + pq.y) + (pq.z + pq.w);
          const float rstd = rsqrtf(ssq * (1.f / 128.f) + 1e-6f);
          y0 = a0 * rstd * gv0; y1 = a1 * rstd * gv1;
          if (!lat && n0 >= 1024) { outp[O_L0K - 1024 + (size_t)row * 256 + col0] = y0; outp[O_L0K - 1024 + (size_t)row * 256 + col0 + 32] = y1; }
          if (lat) {
            const int t = (row - NCTX) & 1023; const int pos = axis ? (t & 63) : (t >> 6);
            const float2 cs = *(const float2*)(rope + (pos * 32 + r) * 2);
            const float o0 = y0 * cs.x - y1 * cs.y, o1 = y1 * cs.x + y0 * cs.y;
            y0 = o0; y1 = o1;
          }
        } else if (!lat) {
          outp[O_L0V - 1280 + (size_t)row * 256 + col0] = a0; outp[O_L0V - 1280 + (size_t)row * 256 + col0 + 32] = a1;
        }
        dst[(size_t)row * g.ldc + col0] = f2bf(y0);
        dst[(size_t)row * g.ldc + col0 + 32] = f2bf(y1);
      }
  } else if (epi == EPI_SWA) {
    u16* dst = (u16*)g.dst;
    const float* tab = rope + 1 * 64 * 32 * 2;
    const bool qk = n0 < 1280;
    EPI_LOOP(const bool lat = row >= NCTX; const int t = (row - NCTX) & 1023;
             const float pv = __shfl_xor(v, 16, 64);
             float y = v;
             if (lat && qk) { const int e = col & 63; const int pos = (e >> 5) ? (t & 63) : (t >> 6);
                              const float2 cs = *(const float2*)(tab + (pos * 32 + (e & 15)) * 2);
                              y = v * cs.x + ((e & 16) ? pv : -pv) * cs.y; }
             dst[(size_t)row * g.ldc + col] = f2bf(y);
             if (!lat && col >= 1024) outp[(col < 1280 ? O_L2K - 1024 : O_L2V - 1280) + (size_t)row * 256 + col] = v;)
  } else {
    u16* dst = (u16*)g.dst;
    const float* tab = rope + 2 * 64 * 32 * 2;
    EPI_LOOP(const bool lat = row >= NCTX; const int t = (row - NCTX) & 1023;
             const float pv = __shfl_xor(v, 8, 64);
             float y = v;
             if (lat && (col % 96) >= 64) { const int e = col & 31; const int pos = (e >> 4) ? (t & 63) : (t >> 6);
                                            const float2 cs = *(const float2*)(tab + (pos * 32 + (e & 7)) * 2);
                                            y = v * cs.x + ((e & 8) ? pv : -pv) * cs.y; }
             dst[(size_t)row * g.ldc + col] = f2bf(y);)
  }
#undef EPI_LOOP
}

DI void gemm_phase(const KA& p, const GemmDesc& g0, const GemmDesc& g1, int ng, char* smem) {
  const int nt0 = g0.N >> 8, mt0 = (g0.M + 191) / 192;
  const int CN = (nt0 & 3) == 0 ? 4 : ((nt0 & 1) == 0 ? 2 : 1), CM = 32 / CN;
  if (ng == 1 && gridDim.x == 256 && (mt0 % CM) == 0) {
    const int x = blockIdx.x & 7, s = blockIdx.x >> 3, mi = s / CN, ni = s - mi * CN;
    const int ncn = nt0 / CN, nchunks = (mt0 / CM) * ncn;
    for (int rep = 0; rep < REP_GEMM; ++rep)
    for (int c = x; c < nchunks; c += 8) {
      const int cm = c / ncn, cn = c - cm * ncn;
      gemm_tile(g0, (cm * CM + mi) * 192, (cn * CN + ni) * 256, p.out(), (const float*)(p.ws() + OFF_ROPE), p.in(18), p.in(19), smem);
    }
    return;
  }
  const int t0 = mt0 * nt0;
  const int t1 = ng > 1 ? ((g1.M + 191) / 192) * (g1.N >> 8) : 0;
  for (int rep = 0; rep < REP_GEMM; ++rep)
  for (int t = blockIdx.x; t < t0 + t1; t += gridDim.x) {
    const bool first = t < t0;
    GemmDesc g;
    g.A = first ? g0.A : g1.A; g.Bt = first ? g0.Bt : g1.Bt; g.dst = first ? g0.dst : g1.dst;
    g.lda = first ? g0.lda : g1.lda; g.ldb = first ? g0.ldb : g1.ldb; g.ldc = first ? g0.ldc : g1.ldc;
    g.M = first ? g0.M : g1.M; g.N = first ? g0.N : g1.N; g.K = first ? g0.K : g1.K; g.epi = first ? g0.epi : g1.epi;
    const int tt = first ? t : t - t0;
    const int nt = g.N >> 8;
    gemm_tile(g, (tt / nt) * 192, (tt % nt) * 256, p.out(), (const float*)(p.ws() + OFF_ROPE), p.in(18), p.in(19), smem);
  }
}

namespace pg8 {
#define PG8_LAS __attribute__((address_space(3)))
typedef unsigned short bf16_t;
typedef short bf16x8 __attribute__((ext_vector_type(8)));
typedef float f32x4 __attribute__((ext_vector_type(4)));
typedef unsigned u32x4 __attribute__((ext_vector_type(4)));
constexpr int BM = 256, BK = 64, HALF = 128, HTB = HALF * BK * 2  , STAGE_BYTES = 8 * HTB, NXCD = 8, WGM = 8;

__host__ __device__ __forceinline__ int lds_byte(int r, int c) { const int st = (r >> 4) * 2 + (c >> 5), rr = r & 15, cc = c & 31, ob = rr * 64 + cc * 2; return st * 1024 + (ob ^ (((ob >> 9) & 1) << 5)); }
__host__ __device__ __forceinline__ void stage_rc(int b, int& R, int& C) { const int st = b / 1024, sb = b % 1024, swz = sb ^ (((sb >> 9) & 1) << 5); R = (st >> 1) * 16 + swz / 64; C = (st & 1) * 32 + (swz % 64) / 2; }
__host__ __device__ __forceinline__ int perm32(int rho) { const int n = rho >> 4, i = rho & 15; return 8 * (i >> 2) + 4 * n + (i & 3); }

struct Unit { int pm, pn; };
struct Gemm { const bf16_t* A; const bf16_t* Bt; int M, N, K; };
struct StaticOrder {
    int nM, nN, nwg, G, c;
    __host__ __device__ void init(int M, int N, int G_, int c_) { nM = M / BM; nN = N / BM; nwg = nM * nN; G = G_; c = c_; }
    __host__ __device__ bool next(int i, Unit& u) const {
        const long L = (long)i * G + c; if (L >= nwg) return false;
        int wgid = (int)L; { const int q = nwg / NXCD, r = nwg % NXCD, xcd = wgid % NXCD, off = wgid / NXCD; wgid = (xcd < r ? xcd * (q + 1) : r * (q + 1) + (xcd - r) * q) + off; }
        const int nig = WGM * nN, gid = wgid / nig, fm = gid * WGM, gsz = (nM - fm) < WGM ? (nM - fm) : WGM;
        u.pm = fm + ((wgid % nig) % gsz); u.pn = (wgid % nig) / gsz; return true;
    }
    __device__ __forceinline__ void a_ready(const Unit&) const {}
    __device__ __forceinline__ void done(const Unit&) const {}
};
__device__ __forceinline__ unsigned cvt_pk_bf16(float lo, float hi) { unsigned r; asm volatile("v_cvt_pk_bf16_f32 %0, %1, %2" : "=v"(r) : "v"(lo), "v"(hi)); return r; }
struct EpiRelu2 {
    static constexpr bool PERM = true, AFTER_DRAIN = false;
    bf16_t* O; int ldc;
    __device__ __forceinline__ void operator()(const f32x4 (&acc)[2][2][4][2], const Unit& u, int wr, int wc, int fr, int fq) const {
        const int row0 = u.pm * BM + wr * 64 + fr, col0 = u.pn * BM + wc * 32 + 8 * fq;
#pragma unroll
        for (int ai = 0; ai < 2; ++ai)
#pragma unroll
            for (int m = 0; m < 4; ++m) { bf16_t* rowp = O + (size_t)(row0 + ai * HALF + m * 16) * ldc + col0;
#pragma unroll
                for (int bj = 0; bj < 2; ++bj) { f32x4 v0 = acc[ai][bj][m][0], v1 = acc[ai][bj][m][1];
#pragma unroll
                    for (int j = 0; j < 4; ++j) { const float a = v0[j] > 0.f ? v0[j] : 0.f, b = v1[j] > 0.f ? v1[j] : 0.f; v0[j] = a * a; v1[j] = b * b; }
                    u32x4 w; w.x = cvt_pk_bf16(v0[0], v0[1]); w.y = cvt_pk_bf16(v0[2], v0[3]); w.z = cvt_pk_bf16(v1[0], v1[1]); w.w = cvt_pk_bf16(v1[2], v1[3]);
                    *(u32x4*)(rowp + bj * HALF) = w; } }
    }
};
template <class Epi, class Sched, bool STAMP = false>
__device__ __forceinline__ void gemm_phase(PG8_LAS unsigned char* lds, const Gemm g, const Sched& S, const Epi& E, unsigned long long* stamps) {
    const int tid = ltid(), wid = __builtin_amdgcn_readfirstlane(tid >> 6), lane = tid & 63, wr = wid >> 2, wc = wid & 3, fr = lane & 15, fq = lane >> 4;
    const int K = g.K, nt = K / BK;
    int ts_lo = 0, ts_hi = 0, nts = 0; const unsigned long long rt_entry = STAMP ? 0ull : 0ull;
#define PG8_STAMP() do { if (STAMP && wid == 0 && nts < 64) { const unsigned long long _c = 0ull; \
        ts_lo = (lane == nts) ? (int)(unsigned)_c : ts_lo; ts_hi = (lane == nts) ? (int)(unsigned)(_c >> 32) : ts_hi; ++nts; } } while (0)
    PG8_STAMP();
    unsigned voffA[2], voffB[2];
#pragma unroll
    for (int i = 0; i < 2; ++i) { int R, C; stage_rc(tid * 16 + i * 8192, R, C); const int Rb = Epi::PERM ? ((R & ~31) + perm32(R & 31)) : R;
        voffA[i] = (unsigned)(R * K + C) * 2u; voffB[i] = (unsigned)(Rb * K + C) * 2u; }
    const size_t kstep = (size_t)(BK * 2);
    const size_t hstep = (size_t)HALF * K * 2;
    const size_t tstep = 2 * hstep;
    const unsigned ldsw = (unsigned)wid * 1024u;
    const int aoff = lds_byte(wr * 64 + fr, fq * 8), boff = lds_byte(wc * 32 + fr, fq * 8);
#define PG8_SA(b, h) (((b) * 2 + (h)) * HTB)
#define PG8_SB(b, h) ((4 + (b) * 2 + (h)) * HTB)
#define PG8_STAGE(bufoff, gbase, voff) do { _Pragma("unroll") for (int _i = 0; _i < 2; ++_i) \
        __builtin_amdgcn_global_load_lds((const unsigned*)((const char*)(gbase) + (voff)[_i]), (PG8_LAS unsigned*)(lds + (bufoff) + ldsw + _i * 8192), 16, 0, 0); } while (0)
#define PG8_LDA(dst, b, h) do { _Pragma("unroll") for (int m = 0; m < 4; ++m) _Pragma("unroll") for (int k = 0; k < 2; ++k) dst[m][k] = *(const PG8_LAS bf16x8*)(lds + PG8_SA(b, h) + aoff + m * 2048 + k * 1024); } while (0)
#define PG8_LDB(dst, b, h) do { _Pragma("unroll") for (int n = 0; n < 2; ++n) _Pragma("unroll") for (int k = 0; k < 2; ++k) dst[n][k] = *(const PG8_LAS bf16x8*)(lds + PG8_SB(b, h) + boff + n * 2048 + k * 1024); } while (0)
#define PG8_MMA(ai, bj, At, Bt) do { __builtin_amdgcn_s_setprio(1); _Pragma("unroll") for (int m = 0; m < 4; ++m) _Pragma("unroll") for (int n = 0; n < 2; ++n) _Pragma("unroll") for (int k = 0; k < 2; ++k) \
        acc[ai][bj][m][n] = __builtin_amdgcn_mfma_f32_16x16x32_bf16(Bt[n][k], At[m][k], acc[ai][bj][m][n], 0, 0, 0); __builtin_amdgcn_s_setprio(0); } while (0)
#define PG8_WAIT_V(n) asm volatile("s_waitcnt vmcnt(" #n ")" ::: "memory")
#define PG8_WAIT_L(n) asm volatile("s_waitcnt lgkmcnt(" #n ")" ::: "memory")
#define PG8_BAR __builtin_amdgcn_s_barrier()
#define PG8_SCHED __builtin_amdgcn_sched_barrier(0)
    Unit cur, nxt; int ui = 0;
    if (!S.next(0, cur)) return;
    f32x4 acc[2][2][4][2];
#pragma unroll
    for (int a = 0; a < 2; ++a)
#pragma unroll
        for (int b = 0; b < 2; ++b)
#pragma unroll
            for (int m = 0; m < 4; ++m)
#pragma unroll
                for (int n = 0; n < 2; ++n) acc[a][b][m][n] = (f32x4){0.f, 0.f, 0.f, 0.f};
    bf16x8 At[4][2], B0[2][2], B1[2][2];
    const char* cA = (const char*)g.A + (size_t)cur.pm * tstep; const char* cB = (const char*)g.Bt + (size_t)cur.pn * tstep;
    S.a_ready(cur);
    PG8_STAGE(PG8_SB(0, 0), cB, voffB); PG8_STAGE(PG8_SA(0, 0), cA, voffA); PG8_STAGE(PG8_SB(0, 1), cB + hstep, voffB); PG8_STAGE(PG8_SA(0, 1), cA + hstep, voffA);
    if (wr == 1) PG8_BAR;
    PG8_WAIT_V(4); PG8_BAR;
    PG8_STAGE(PG8_SB(1, 0), cB + kstep, voffB); PG8_STAGE(PG8_SA(1, 0), cA + kstep, voffA); PG8_STAGE(PG8_SB(1, 1), cB + hstep + kstep, voffB);
    PG8_WAIT_V(6); PG8_BAR;
    PG8_STAMP();
    for (;;) {
        const bool has_next = S.next(ui + 1, nxt);
        const char* nA = has_next ? (const char*)g.A + (size_t)nxt.pm * tstep : cA; const char* nB = has_next ? (const char*)g.Bt + (size_t)nxt.pn * tstep : cB;
        for (int t = 0; t < nt; t += 2) {
            const bool last = (t == nt - 2);
            const char* a1 = cA + (size_t)(t + 1) * kstep;
            const char* a2 = last ? nA : cA + (size_t)(t + 2) * kstep; const char* b2 = last ? nB : cB + (size_t)(t + 2) * kstep;
            const char* a3 = a2 + kstep; const char* b3 = b2 + kstep;
            if (last && has_next) S.a_ready(nxt);
            PG8_LDB(B0, 0, 0); PG8_SCHED; PG8_LDA(At, 0, 0); PG8_STAGE(PG8_SA(1, 1), a1 + hstep, voffA);
            PG8_WAIT_L(8); PG8_BAR; PG8_WAIT_L(0); PG8_MMA(0, 0, At, B0); PG8_BAR; PG8_SCHED;
            PG8_LDB(B1, 0, 1); PG8_STAGE(PG8_SB(0, 0), b2, voffB);
            PG8_BAR; PG8_WAIT_L(0); PG8_MMA(0, 1, At, B1); PG8_BAR;
            PG8_LDA(At, 0, 1); PG8_STAGE(PG8_SA(0, 0), a2, voffA);
            PG8_BAR; PG8_WAIT_L(0); PG8_MMA(1, 0, At, B0); PG8_BAR; PG8_SCHED;
            PG8_STAGE(PG8_SB(0, 1), b2 + hstep, voffB);
            PG8_WAIT_V(6); PG8_BAR; PG8_MMA(1, 1, At, B1); PG8_BAR;
            PG8_LDB(B0, 1, 0); PG8_SCHED; PG8_LDA(At, 1, 0); PG8_STAGE(PG8_SA(0, 1), a2 + hstep, voffA);
            PG8_WAIT_L(8); PG8_BAR; PG8_WAIT_L(0); PG8_MMA(0, 0, At, B0); PG8_BAR; PG8_SCHED;
            PG8_LDB(B1, 1, 1); PG8_STAGE(PG8_SB(1, 0), b3, voffB);
            PG8_BAR; PG8_WAIT_L(0); PG8_MMA(0, 1, At, B1); PG8_BAR;
            PG8_LDA(At, 1, 1); PG8_STAGE(PG8_SA(1, 0), a3, voffA);
            PG8_BAR; PG8_WAIT_L(0); PG8_MMA(1, 0, At, B0); PG8_BAR; PG8_SCHED;
            PG8_STAGE(PG8_SB(1, 1), b3 + hstep, voffB);
            PG8_WAIT_V(6); PG8_BAR; PG8_MMA(1, 1, At, B1); PG8_BAR;
        }
        PG8_STAMP();
        if constexpr (!Epi::AFTER_DRAIN) { E(acc, cur, wr, wc, fr, fq); S.done(cur); }
        PG8_STAMP();
        if (!has_next) break;
#pragma unroll
        for (int a = 0; a < 2; ++a)
#pragma unroll
            for (int b = 0; b < 2; ++b)
#pragma unroll
                for (int m = 0; m < 4; ++m)
#pragma unroll
                    for (int n = 0; n < 2; ++n) acc[a][b][m][n] = (f32x4){0.f, 0.f, 0.f, 0.f};
        cur = nxt; cA = nA; cB = nB; ++ui;
    }
    PG8_WAIT_V(0);
    if (wr == 0) PG8_BAR;
    PG8_BAR;
    if constexpr (Epi::AFTER_DRAIN) { E.fused(acc, cur, wr, wc, fr, fq, lds, wid, lane); S.done(cur); }
    PG8_STAMP();
    if (STAMP && wid == 0) { stamps[lane] = lane < nts ? (((unsigned long long)(unsigned)ts_hi << 32) | (unsigned)ts_lo) : 0ull;
        if (lane == 62) stamps[62] = rt_entry; if (lane == 63) stamps[63] = 0ull; }
#undef PG8_STAMP
#undef PG8_SA
#undef PG8_SB
#undef PG8_STAGE
#undef PG8_LDA
#undef PG8_LDB
#undef PG8_MMA
#undef PG8_WAIT_V
#undef PG8_WAIT_L
#undef PG8_BAR
#undef PG8_SCHED
}
}

#define PP_LOADROW(dst, NV, PITCH, rw)                                             \
  {                                                                                \
    const float* zr_ = Z + (size_t)min((rw), NTOK - 1) * (PITCH) + lane;           \
    _Pragma("unroll") for (int j_ = 0; j_ < (NV); ++j_) dst[j_] = zr_[64 * j_];    \
  }

DI void pp_attn(const KA& p) {
  const int tid_ = ltid(); const int lane = tid_ & 63, w = tid_ >> 6;
  const float* Z = (const float*)(p.ws() + OFF_UZ);
  u16* QKV = (u16*)(p.ws() + OFF_QO);
  float* outp = p.out();
  const float* tab = (const float*)(p.ws() + OFF_ROPE);
  const float gq0 = p.in(18)[lane], gq1 = p.in(18)[64 + lane], gk0 = p.in(19)[lane], gk1 = p.in(19)[64 + lane];
  const int stride = gridDim.x * NWAVE;
  int row = blockIdx.x * NWAVE + w;
  float nv[24];
  PP_LOADROW(nv, 24, 1536, row)
  for (; row < NTOK; row += stride) {
    float v[24];
#pragma unroll
    for (int j = 0; j < 24; ++j) v[j] = nv[j];
    const bool lat = row >= NCTX;
    const int t = (row - NCTX) & 1023, pr = t >> 6, pc = t & 63;
    const int i = lane & 31;
    const float c0 = tab[(pr * 32 + i) * 2], s0 = tab[(pr * 32 + i) * 2 + 1];
    const float c1 = tab[(pc * 32 + i) * 2], s1 = tab[(pc * 32 + i) * 2 + 1];
    PP_LOADROW(nv, 24, 1536, row + stride)
    u16* o = QKV + (size_t)row * 1536;
    const float sg = lane < 32 ? -1.f : 1.f;
#pragma unroll
    for (int hd = 0; hd < 10; ++hd) {
      const float v0 = v[2 * hd], v1 = v[2 * hd + 1];
      const float ss = wave_sum(v0 * v0 + v1 * v1);
      const float rstd = rsqrtf(ss * (1.f / 128.f) + 1e-6f);
      float y0 = v0 * rstd * (hd < 8 ? gq0 : gk0), y1 = v1 * rstd * (hd < 8 ? gq1 : gk1);
      if (hd >= 8 && !lat) {
        outp[O_L0K + (size_t)row * 256 + (hd - 8) * 128 + lane] = y0;
        outp[O_L0K + (size_t)row * 256 + (hd - 8) * 128 + 64 + lane] = y1;
      }
      const float p0 = __shfl_xor(y0, 32, 64), p1 = __shfl_xor(y1, 32, 64);
      if (lat) {
        y0 = y0 * c0 + sg * p0 * s0;
        y1 = y1 * c1 + sg * p1 * s1;
      }
      o[hd * 128 + lane] = f2bf(y0);
      o[hd * 128 + 64 + lane] = f2bf(y1);
    }
#pragma unroll
    for (int j = 0; j < 4; ++j) {
      const float vv = v[20 + j];
      o[1280 + 64 * j + lane] = f2bf(vv);
      if (!lat) outp[O_L0V + (size_t)row * 256 + 64 * j + lane] = vv;
    }
  }
}

DI void pp_swa(const KA& p) {
  const int tid_ = ltid(); const int lane = tid_ & 63, w = tid_ >> 6;
  const float* Z = (const float*)(p.ws() + OFF_UZ);
  u16* QKV = (u16*)(p.ws() + OFF_QO);
  float* outp = p.out();
  const float* tab = (const float*)(p.ws() + OFF_ROPE) + 1 * 64 * 32 * 2;
  const int stride = gridDim.x * NWAVE;
  int row = blockIdx.x * NWAVE + w;
  float nv[24];
  PP_LOADROW(nv, 24, 1536, row)
  for (; row < NTOK; row += stride) {
    float v[24];
#pragma unroll
    for (int j = 0; j < 24; ++j) v[j] = nv[j];
    const bool lat = row >= NCTX;
    const int t = (row - NCTX) & 1023, pr = t >> 6, pc = t & 63;
    const int i = lane & 15, axis = lane >> 5, half = (lane >> 4) & 1;
    const int pos = axis ? pc : pr;
    const float c = tab[(pos * 32 + i) * 2], sn = tab[(pos * 32 + i) * 2 + 1];
    PP_LOADROW(nv, 24, 1536, row + stride)
    u16* o = QKV + (size_t)row * 1536;
    const float sg = half ? 1.f : -1.f;
#pragma unroll
    for (int hd = 0; hd < 20; ++hd) {
      float vv = v[hd];
      if (hd >= 16 && !lat) outp[O_L2K + (size_t)row * 256 + (hd - 16) * 64 + lane] = vv;
      const float pv = __shfl_xor(vv, 16, 64);
      if (lat) vv = vv * c + sg * pv * sn;
      o[hd * 64 + lane] = f2bf(vv);
    }
#pragma unroll
    for (int j = 0; j < 4; ++j) {
      const float vv = v[20 + j];
      o[1280 + 64 * j + lane] = f2bf(vv);
      if (!lat) outp[O_L2V + (size_t)row * 256 + 64 * j + lane] = vv;
    }
  }
}

DI void pp_mla1(const KA& p) {
  const int tid_ = ltid(); const int lane = tid_ & 63, w = tid_ >> 6;
  const float* Z = (const float*)(p.ws() + OFF_UZ);
  u16* CQ = (u16*)(p.ws() + OFF_CQ);
  u16* CKV = (u16*)(p.ws() + OFF_CKV);
  u16* KPE = (u16*)(p.ws() + OFF_KPE);
  float* outp = p.out();
  const float* tab = (const float*)(p.ws() + OFF_ROPE) + 2 * 64 * 32 * 2;
  float gq[6], gkv[4];
#pragma unroll
  for (int j = 0; j < 6; ++j) gq[j] = p.in(22)[64 * j + lane];
#pragma unroll
  for (int j = 0; j < 4; ++j) gkv[j] = p.in(23)[64 * j + lane];
  const int stride = gridDim.x * NWAVE;
  int row = blockIdx.x * NWAVE + w;
  float nv[11];
  PP_LOADROW(nv, 11, 768, row)
  for (; row < NTOK; row += stride) {
    float v[11];
#pragma unroll
    for (int j = 0; j < 11; ++j) v[j] = nv[j];
    const bool lat = row >= NCTX;
    const int t = (row - NCTX) & 1023, pr = t >> 6, pc = t & 63;
    const int e = lane & 31;
    const int ri = e & 7, axis = e >> 4, half = (e >> 3) & 1;
    const int pos = axis ? pc : pr;
    const float c = tab[(pos * 32 + ri) * 2], sn = tab[(pos * 32 + ri) * 2 + 1];
    PP_LOADROW(nv, 11, 768, row + stride)
    float ss = 0.f;
#pragma unroll
    for (int j = 0; j < 6; ++j) ss += v[j] * v[j];
    ss = wave_sum(ss);
    float rstd = rsqrtf(ss * (1.f / 384.f) + 1e-6f);
#pragma unroll
    for (int j = 0; j < 6; ++j) CQ[(size_t)row * P384 + 64 * j + lane] = f2bf(v[j] * rstd * gq[j]);
    ss = 0.f;
#pragma unroll
    for (int j = 0; j < 4; ++j) ss += v[6 + j] * v[6 + j];
    ss = wave_sum(ss);
    rstd = rsqrtf(ss * (1.f / 256.f) + 1e-6f);
#pragma unroll
    for (int j = 0; j < 4; ++j) {
      const float y = v[6 + j] * rstd * gkv[j];
      CKV[(size_t)row * P256 + 64 * j + lane] = f2bf(y);
      if (!lat) outp[O_L1CKV + (size_t)row * 256 + 64 * j + lane] = y;
    }
    float vv = v[10];
    const float pv = __shfl_xor(vv, 8, 64);
    if (lat) vv = vv * c + (half ? pv : -pv) * sn;
    if (lane < 32) {
      KPE[(size_t)row * 32 + e] = f2bf(vv);
      if (!lat) outp[O_L1KPE + (size_t)row * 32 + e] = vv;
    }
  }
}

DI void pp_mla2(const KA& p) {
  const int tid_ = ltid(); const int lane = tid_ & 63, w = tid_ >> 6;
  const float* Z = (const float*)(p.ws() + OFF_UZ);
  u16* Q = (u16*)(p.ws() + OFF_QO);
  const float* tab = (const float*)(p.ws() + OFF_ROPE) + 2 * 64 * 32 * 2;
  const int stride = gridDim.x * NWAVE;
  int row = blockIdx.x * NWAVE + w;
  float nv[24];
  PP_LOADROW(nv, 24, 1536, row)
  for (; row < NTOK; row += stride) {
    float v[24];
#pragma unroll
    for (int j = 0; j < 24; ++j) v[j] = nv[j];
    const bool lat = row >= NCTX;
    const int t = (row - NCTX) & 1023, pr = t >> 6, pc = t & 63;
    const int e = lane & 31;
    const int ri = e & 7, axis = e >> 4, half = (e >> 3) & 1;
    const int pos = axis ? pc : pr;
    const float c = tab[(pos * 32 + ri) * 2], sn = tab[(pos * 32 + ri) * 2 + 1];
    PP_LOADROW(nv, 24, 1536, row + stride)
#pragma unroll
    for (int j = 0; j < 24; ++j) {
      const int col = 64 * j + lane;
      float vv = v[j];
      const float pv = __shfl_xor(vv, 8, 64);
      const int d = col % 96;
      if (lat && d >= 64) vv = vv * c + (half ? pv : -pv) * sn;
      Q[(size_t)row * 1536 + col] = f2bf(vv);
    }
  }
}
#undef PP_LOADROW

struct Seg { const u16* k1; const u16* k2; const u16* v; int ldk1, ldk2, ldv, n0, n1, mode; };

template <int HDQK, int HDV>
DI void attn_item(const u16* __restrict__ Qp, int ldq, const Seg& sA, const Seg& sB, int nseg, int qpos0,
                  float scale_l2, const float* __restrict__ rpb_h, const float* __restrict__ sinkp,
                  u16* __restrict__ Op, int ldo, char* smem) {
  constexpr int K1W = (HDQK == 96) ? 64 : HDQK;
  constexpr int KS = HDQK + 8, VS = HDV + 8;
  constexpr int KC = HDQK / 8, VC = HDV / 8;
  constexpr int KVB = 64 * KS + 64 * VS;
  u16* KV0 = (u16*)smem;
  float* rp = (float*)(KV0 + 2 * KVB);
  const int tid = ltid(), lane = tid & 63, w = tid >> 6, r = lane & 31, h = lane >> 5;
  const int q4 = (lane & 15) >> 2, p4 = lane & 3, dblk = (lane >> 4) & 1;

  __syncthreads();
  if (rpb_h) for (int e = tid; e < 465; e += NTHR) rp[e] = rpb_h[e] * LOG2E;

  bf16x8 qf[HDQK / 16];
  {
    const u16* qrow = Qp + (size_t)(32 * w + r) * ldq + 8 * h;
#pragma unroll
    for (int kk = 0; kk < HDQK / 16; ++kk) qf[kk] = *(const bf16x8*)(qrow + 16 * kk);
  }
  f32x16 o[HDV / 32];
#pragma unroll
  for (int dt = 0; dt < HDV / 32; ++dt)
#pragma unroll
    for (int i = 0; i < 16; ++i) o[dt][i] = 0.f;
  float m = -1e30f, l = 0.f;
  const int qpos = qpos0 + 32 * w + r;
  const int qr = qpos >> 6, qc = qpos & 63;
  const int r0 = min(max(qr - 4, 0), 8), c0 = min(max(qc - 8, 0), 48);

  constexpr int KI = (64 * KC + NTHR - 1) / NTHR, VI = (64 * VC + NTHR - 1) / NTHR;
  const int TA = (sA.n1 - sA.n0) >> 6;
  const int T = TA + (nseg > 1 ? ((sB.n1 - sB.n0) >> 6) : 0);
  uint4 kreg0 = make_uint4(0, 0, 0, 0), kreg1 = kreg0, vreg0 = kreg0, vreg1 = kreg0;
  const int kc0 = tid, kc1 = tid + NTHR;
  const int krow0 = kc0 / KC, kcc0 = kc0 - krow0 * KC, krow1 = kc1 / KC, kcc1 = kc1 - krow1 * KC;
  const bool ks0 = kcc0 * 8 >= K1W, ks1 = kcc1 * 8 >= K1W;
  const int vr0 = tid / VC, vc0 = tid - vr0 * VC, vr1 = (tid + NTHR) / VC, vc1 = (tid + NTHR) - vr1 * VC;
#define ATT_KOFF(S, row, cc, two) (unsigned)((two) ? ((row) * S.ldk2 + (cc) * 8 - K1W) * 2 : ((row) * S.ldk1 + (cc) * 8) * 2)
  const unsigned koA0 = ATT_KOFF(sA, krow0, kcc0, ks0), koB0 = ATT_KOFF(sB, krow0, kcc0, ks0);
  const unsigned koA1 = ATT_KOFF(sA, krow1, kcc1, ks1), koB1 = ATT_KOFF(sB, krow1, kcc1, ks1);
  const unsigned voA0 = (unsigned)(vr0 * sA.ldv + vc0 * 8) * 2, voB0 = (unsigned)(vr0 * sB.ldv + vc0 * 8) * 2;
  const unsigned voA1 = (unsigned)(vr1 * sA.ldv + vc1 * 8) * 2, voB1 = (unsigned)(vr1 * sB.ldv + vc1 * 8) * 2;
#undef ATT_KOFF
#define ATT_FETCH(t)                                                                                   \
  {                                                                                                    \
    const bool fa = (t) < TA;                                                                          \
    const int fn = fa ? sA.n0 + 64 * (t) : sB.n0 + 64 * ((t) - TA);                                    \
    const char* b1 = (const char*)(fa ? sA.k1 : sB.k1) + (size_t)fn * (fa ? sA.ldk1 : sB.ldk1) * 2;    \
    const char* b2 = (const char*)(fa ? sA.k2 : sB.k2) + (size_t)fn * (fa ? sA.ldk2 : sB.ldk2) * 2;    \
    const char* bv = (const char*)(fa ? sA.v : sB.v) + (size_t)fn * (fa ? sA.ldv : sB.ldv) * 2;        \
    kreg0 = *(const uint4*)((ks0 ? b2 : b1) + (fa ? koA0 : koB0));                                     \
    if (KI > 1) { if (64 * KC % NTHR == 0 || kc1 < 64 * KC) kreg1 = *(const uint4*)((ks1 ? b2 : b1) + (fa ? koA1 : koB1)); } \
    vreg0 = *(const uint4*)(bv + (fa ? voA0 : voB0));                                                  \
    if (VI > 1) vreg1 = *(const uint4*)(bv + (fa ? voA1 : voB1));                                      \
  }
#define ATT_STORE(buf)                                                                                 \
  {                                                                                                    \
    u16* Ksw = KV0 + (buf) * KVB; u16* Vsw = Ksw + 64 * KS;                                            \
    { const int c = tid; const int row = c / KC, cc = c - row * KC; *(uint4*)&Ksw[row * KS + cc * 8] = kreg0; } \
    if (KI > 1) { const int c = tid + NTHR; if (64 * KC % NTHR == 0 || c < 64 * KC) { const int row = c / KC, cc = c - row * KC; *(uint4*)&Ksw[row * KS + cc * 8] = kreg1; } } \
    { const int c = tid; const int row = c / VC, cc = c - row * VC; *(uint4*)&Vsw[row * VS + cc * 8] = vreg0; } \
    if (VI > 1) { const int c = tid + NTHR; const int row = c / VC, cc = c - row * VC; *(uint4*)&Vsw[row * VS + cc * 8] = vreg1; } \
  }
  ATT_FETCH(0)
  ATT_STORE(0)
  if (T > 1) ATT_FETCH(1)
  __syncthreads();
  for (int t = 0; t < T; ++t) {
    {
      const bool ca = t < TA;
      const int mode = (HDQK == 64) ? (ca ? sA.mode : sB.mode) : 0;
      const int n = ca ? sA.n0 + 64 * t : sB.n0 + 64 * (t - TA);
      if (t > 0) __syncthreads();
      if (t + 1 < T) ATT_STORE((t + 1) & 1)
      if (t + 2 < T) ATT_FETCH(t + 2)
      const u16* Ks = KV0 + (t & 1) * KVB;
      const u16* Vs = Ks + 64 * KS;
      const int qw = qpos0 + 32 * w;
      bool skip = false;
      if (mode == 1) skip = (n > qw + 31 + 128) || (n + 63 < qw - 128);
      else if (mode == 2) { const int r0w = min(max((qw >> 6) - 4, 0), 8); const int kr = n >> 6; skip = (kr < r0w) || (kr >= r0w + 8); }
      if (skip) continue;
      const int emode = (mode == 1 && n >= qw + 31 - 128 && n + 63 <= qw + 128) ? 0 : mode;
      f32x16 st[2];
#pragma unroll
      for (int kt = 0; kt < 2; ++kt) {
#pragma unroll
        for (int i = 0; i < 16; ++i) st[kt][i] = 0.f;
        const u16* kb = Ks + (32 * kt + r) * KS + 8 * h;
#pragma unroll
        for (int kk = 0; kk < HDQK / 16; ++kk) {
          const bf16x8 a = *(const bf16x8*)(kb + 16 * kk);
          st[kt] = MFMA(a, qf[kk], st[kt]);
        }
        __builtin_amdgcn_sched_barrier(0);
      }
      float mx = -1e30f;
      float esc = 1.f;
      if (emode == 0) {
#pragma unroll
        for (int kt = 0; kt < 2; ++kt)
#pragma unroll
          for (int i = 0; i < 16; ++i) mx = fmaxf(mx, st[kt][i]);
        mx *= scale_l2;
        esc = scale_l2;
      } else if (emode == 1) {
        const int db = qpos - n - 4 * h + 128;
#pragma unroll
        for (int kt = 0; kt < 2; ++kt)
#pragma unroll
          for (int i = 0; i < 16; ++i) {
            const int cst = 32 * kt + (i & 3) + 8 * (i >> 2);
            float v = st[kt][i] * scale_l2;
            if ((unsigned)(db - cst) > 256u) v = -1e30f;
            st[kt][i] = v; mx = fmaxf(mx, v);
          }
      } else {
        const int kr = n >> 6;
        const bool okr = (unsigned)(kr - r0) < 8u;
        const int cb = okr ? (4 * h - c0) : 1000;
        const int ib = (kr - qr + 7) * 31 + 15 - qc + 4 * h;
#pragma unroll
        for (int kt = 0; kt < 2; ++kt)
#pragma unroll
          for (int i = 0; i < 16; ++i) {
            const int cst = 32 * kt + (i & 3) + 8 * (i >> 2);
            const bool ok = (unsigned)(cst + cb) < 16u;
            const float b = rp[ok ? cst + ib : 0];
            float v = __builtin_fmaf(st[kt][i], scale_l2, b);
            if (!ok) v = -1e30f;
            st[kt][i] = v; mx = fmaxf(mx, v);
          }
      }
      mx = fmaxf(mx, __shfl_xor(mx, 32, 64));
      const float mn = fmaxf(m, mx);
      const float alpha = __builtin_amdgcn_exp2f(m - mn);
      const bool resc = __ballot(mn != m) != 0ull;
      m = mn;
      float rs = 0.f;
#pragma unroll
      for (int kt = 0; kt < 2; ++kt)
#pragma unroll
        for (int i = 0; i < 16; ++i) { const float pz = __builtin_amdgcn_exp2f(__builtin_fmaf(st[kt][i], esc, -mn)); st[kt][i] = pz; rs += pz; }
      rs += __shfl_xor(rs, 32, 64);
      l = l * alpha + rs;
      if (resc) {
#pragma unroll
        for (int dt = 0; dt < HDV / 32; ++dt)
#pragma unroll
          for (int i = 0; i < 16; ++i) o[dt][i] *= alpha;
      }
#pragma unroll
      for (int kt = 0; kt < 2; ++kt)
#pragma unroll
        for (int s2 = 0; s2 < 2; ++s2) {
          unsigned pk[4];
#pragma unroll
          for (int j = 0; j < 4; ++j) pk[j] = pack2(st[kt][8 * s2 + 2 * j], st[kt][8 * s2 + 2 * j + 1]);
          bf16x8 pb;
          {
            typedef unsigned u32x4 __attribute__((ext_vector_type(4)));
            u32x4 t4 = {pk[0], pk[1], pk[2], pk[3]};
            pb = __builtin_bit_cast(bf16x8, t4);
          }
          const u16* vb = Vs + (32 * kt + 16 * s2 + 4 * h + q4) * VS + 16 * dblk + 4 * p4;
#pragma unroll
          for (int dt = 0; dt < HDV / 32; ++dt) {
            const s16x4 lo = __builtin_amdgcn_ds_read_tr16_b64_v4i16((LDS3 s16x4*)(vb + 32 * dt));
            const s16x4 hi = __builtin_amdgcn_ds_read_tr16_b64_v4i16((LDS3 s16x4*)(vb + 8 * VS + 32 * dt));
            const bf16x8 va = __builtin_shufflevector(lo, hi, 0, 1, 2, 3, 4, 5, 6, 7);
            o[dt] = MFMA(va, pb, o[dt]);
          }
        }
    }
  }
#undef ATT_FETCH
#undef ATT_STORE
  if (sinkp) l += __builtin_amdgcn_exp2f(sinkp[0] * LOG2E - m);
  const float inv = 1.f / l;
  u16* orow = Op + (size_t)(32 * w + r) * ldo + 4 * h;
#pragma unroll
  for (int dt = 0; dt < HDV / 32; ++dt)
#pragma unroll
    for (int g = 0; g < 4; ++g) {
      uint2 v;
      v.x = pack2(o[dt][4 * g] * inv, o[dt][4 * g + 1] * inv);
      v.y = pack2(o[dt][4 * g + 2] * inv, o[dt][4 * g + 3] * inv);
      *(uint2*)(orow + 32 * dt + 8 * g) = v;
    }
}

DI void attn_phase(const KA& p, int kind, char* smem) {
  const int Hq = kind == 0 ? 8 : 16;
  const int nlat = 8 * Hq * 4, nctx = 16 * Hq;
  u16* AO = (u16*)(p.ws() + OFF_HAO);
  const u16* QKV = (const u16*)(p.ws() + OFF_QO);
  for (int rep = 0; rep < REP_ATT; ++rep)
  for (int item = blockIdx.x; item < nlat + nctx; item += gridDim.x) {
    const bool lat = item < nlat;
    int b, hq, qt;
    if (lat) {
      b = item / (Hq * 4); const int rem = item - b * Hq * 4; hq = rem >> 2; qt = rem & 3;
      if (gridDim.x == 256 && item >= 256) qt ^= 1;
    }
    else { const int it = item - nlat; b = it / Hq; hq = it - b * Hq; qt = 0; }
    const int tok0 = lat ? NCTX + b * 1024 : b * 256;
    const int S = lat ? 1024 : 256;
    const int qrow0 = tok0 + qt * 256;
    Seg sc, ss;
    sc.k2 = nullptr; sc.ldk2 = 0; ss.k2 = nullptr; ss.ldk2 = 0;
    sc.n0 = 0; sc.n1 = 512; sc.mode = 0;
    ss.n0 = 0; ss.n1 = S; ss.mode = 0;
    const u16* Qp; int ldq; float sl2; const float* rpb = nullptr; const float* sinkp = nullptr;
    u16* Op;
    if (kind == 0) {
      const int kvh = hq >> 2;
      ss.k1 = QKV + (size_t)tok0 * 1536 + 1024 + kvh * 128; ss.ldk1 = 1536;
      ss.v = QKV + (size_t)tok0 * 1536 + 1280 + kvh * 128; ss.ldv = 1536;
      sc.k1 = (const u16*)(p.ws() + OFF_CK) + (size_t)b * 512 * 256 + kvh * 128; sc.ldk1 = 256;
      sc.v = (const u16*)(p.ws() + OFF_CV) + (size_t)b * 512 * 256 + kvh * 128; sc.ldv = 256;
      sl2 = 0.08838834764831845f * LOG2E;
      Qp = QKV + (size_t)qrow0 * 1536 + hq * 128; ldq = 1536;
      Op = AO + (size_t)qrow0 * P1024 + hq * 128;
    } else if (kind == 1) {
      const u16* KV = (const u16*)(p.ws() + OFF_KV);
      const u16* KPE = (const u16*)(p.ws() + OFF_KPE);
      ss.k1 = KV + (size_t)tok0 * 2048 + hq * 128; ss.ldk1 = 2048;
      ss.k2 = KPE + (size_t)tok0 * 32; ss.ldk2 = 32;
      ss.v = KV + (size_t)tok0 * 2048 + hq * 128 + 64; ss.ldv = 2048;
      const size_t crow0 = 12288 + (size_t)b * 512;
      sc.k1 = KV + crow0 * 2048 + hq * 128; sc.ldk1 = 2048;
      sc.k2 = KPE + crow0 * 32; sc.ldk2 = 32;
      sc.v = KV + crow0 * 2048 + hq * 128 + 64; sc.ldv = 2048;
      sl2 = 0.10206207261596575f * LOG2E;
      Qp = QKV + (size_t)qrow0 * 1536 + hq * 96; ldq = 1536;
      Op = AO + (size_t)qrow0 * P1024 + hq * 64;
    } else if (kind == 2) {
      const int kvh = hq >> 2;
      ss.k1 = QKV + (size_t)tok0 * 1536 + 1024 + kvh * 64; ss.ldk1 = 1536;
      ss.v = QKV + (size_t)tok0 * 1536 + 1280 + kvh * 64; ss.ldv = 1536;
      sc.k1 = (const u16*)(p.ws() + OFF_CK) + (size_t)b * 512 * 256 + kvh * 64; sc.ldk1 = 256;
      sc.v = (const u16*)(p.ws() + OFF_CV) + (size_t)b * 512 * 256 + kvh * 64; sc.ldv = 256;
      sl2 = 0.125f * LOG2E;
      sinkp = p.in(28) + hq;
      if (lat) { ss.n0 = max(0, qt * 256 - 128); ss.n1 = min(1024, qt * 256 + 384); ss.mode = 1; }
      Qp = QKV + (size_t)qrow0 * 1536 + hq * 64; ldq = 1536;
      Op = AO + (size_t)qrow0 * P1024 + hq * 64;
    } else {
      ss.k1 = QKV + (size_t)tok0 * 3072 + 1024 + hq * 64; ss.ldk1 = 3072;
      ss.v = QKV + (size_t)tok0 * 3072 + 2048 + hq * 64; ss.ldv = 3072;
      sc.k1 = (const u16*)(p.ws() + OFF_C3K) + (size_t)b * 512 * 1024 + hq * 64; sc.ldk1 = 1024;
      sc.v = (const u16*)(p.ws() + OFF_C3V) + (size_t)b * 512 * 1024 + hq * 64; sc.ldv = 1024;
      sl2 = 0.125f * LOG2E;
      if (lat) {
        const int r0a = min(max(4 * qt - 4, 0), 8), r0b = min(max(4 * qt - 1, 0), 8);
        ss.n0 = r0a * 64; ss.n1 = (r0b + 8) * 64; ss.mode = 2;
        rpb = p.in(31) + hq * 465;
      }
      Qp = QKV + (size_t)qrow0 * 3072 + hq * 64; ldq = 3072;
      Op = AO + (size_t)qrow0 * P1024 + hq * 64;
    }
    Seg s0;
    s0.k1 = lat ? sc.k1 : ss.k1; s0.k2 = lat ? sc.k2 : ss.k2; s0.v = lat ? sc.v : ss.v;
    s0.ldk1 = lat ? sc.ldk1 : ss.ldk1; s0.ldk2 = lat ? sc.ldk2 : ss.ldk2; s0.ldv = lat ? sc.ldv : ss.ldv;
    s0.n0 = lat ? sc.n0 : ss.n0; s0.n1 = lat ? sc.n1 : ss.n1; s0.mode = lat ? sc.mode : ss.mode;
    const int nseg = lat ? 2 : 1;
    if (kind == 0) attn_item<128, 128>(Qp, ldq, s0, ss, nseg, qt * 256, sl2, rpb, sinkp, Op, P1024, smem);
    else if (kind == 1) attn_item<96, 64>(Qp, ldq, s0, ss, nseg, qt * 256, sl2, rpb, sinkp, Op, P1024, smem);
    else attn_item<64, 64>(Qp, ldq, s0, ss, nseg, qt * 256, sl2, rpb, sinkp, Op, P1024, smem);
  }
}

__host__ __device__ inline bool phase_exists(int ph) {
  if (ph == 0 || ph == 41) return true;
  const int l = (ph - 1) / 10, s = (ph - 1) % 10;
  if (s == 3 && l != 1) return false;
  if (s == 4) return false;
  if (s == 2 && l != 1) return false;
  return true;
}

DI void run_phase(const KA& p, int ph, char* smem) {
  if (ph == 0) { prepass(p, smem); return; }
  if (ph == 41) { norm_phase(p, 4, 2); return; }
  const int l = (ph - 1) / 10, s = (ph - 1) % 10;
  char* ws = p.ws();
  GemmDesc g0, g1;
  g0 = GemmDesc{nullptr, nullptr, nullptr, 0, 0, 0, 0, 0, 0, 0};
  g1 = g0;
  int ng = 0;
  switch (s) {
    case 0:
      norm_phase(p, l, 0);
      if (l == 2) {
        convert_f32_bf16(p.in(6), (u16*)(ws + OFF_CK), 4096ull * 256);
        convert_f32_bf16(p.in(7), (u16*)(ws + OFF_CV), 4096ull * 256);
      } else if (l == 3) {
        convert_f32_bf16(p.in(8), (u16*)(ws + OFF_C3K), 4096ull * 1024);
        convert_f32_bf16(p.in(9), (u16*)(ws + OFF_C3V), 4096ull * 1024);
      }
      break;
    case 1: {
      const u16* H = (const u16*)(ws + OFF_HAO);
      if (l == 0) g0 = GemmDesc{H, (const u16*)(ws + OFF_AQKV), ws + OFF_QO, P1024, P1024, 1536, NTOK, 1536, 1024, EPI_ATTN};
      else if (l == 1) g0 = GemmDesc{H, (const u16*)(ws + OFF_MIN), ws + OFF_UZ, P1024, P1024, 768, NTOK, 768, 1024, EPI_F32};
      else if (l == 2) g0 = GemmDesc{H, (const u16*)(ws + OFF_SQKV), ws + OFF_QO, P1024, P1024, 1536, NTOK, 1536, 1024, EPI_SWA};
      else g0 = GemmDesc{H, (const u16*)(ws + OFF_NQKV), ws + OFF_QO, P1024, P1024, 3072, NTOK, 3072, 1024, EPI_NAT};
      ng = 1;
    } break;
    case 2:
      if (l == 1) pp_mla1(p);
      break;
    case 3:
      g0 = GemmDesc{(const u16*)(ws + OFF_CQ), (const u16*)(ws + OFF_MUQ), ws + OFF_QO, P384, P384, 1536, NTOK, 1536, 384, EPI_MLAQ};
      g1 = GemmDesc{(const u16*)(ws + OFF_CKV), (const u16*)(ws + OFF_MUKV), ws + OFF_KV, P256, P256, 2048, 16384, 2048, 256, EPI_BF16};
      ng = 2;
      break;
    case 4: break;
    case 5: attn_phase(p, l, smem); break;
    case 6: {
      const size_t wo = l == 0 ? OFF_AO_W : (l == 1 ? OFF_MO : (l == 2 ? OFF_SO : OFF_NO));
      g0 = GemmDesc{(const u16*)(ws + OFF_HAO), (const u16*)(ws + wo), ws + OFF_QO, P1024, P1024, 1024, NTOK, 1024, 1024, EPI_BF16};
      ng = 1;
    } break;
    case 7: norm_phase(p, l, 1); break;
    case 8: {
      pg8::Gemm gg{(const u16*)(ws + OFF_HAO), (const u16*)(ws + OFF_W1T + (size_t)l * W1T_SZ), NTOK, 4096, 1024};
      pg8::StaticOrder S; S.init(NTOK, 4096, (int)gridDim.x, (int)blockIdx.x);
      pg8::EpiRelu2 E{(u16*)(ws + OFF_UZ), P4096};
      pg8::gemm_phase<pg8::EpiRelu2, pg8::StaticOrder, false>((PG8_LAS unsigned char*)smem, gg, S, E, nullptr);
    } break;
    case 9:
      g0 = GemmDesc{(const u16*)(ws + OFF_UZ), (const u16*)(ws + OFF_W2T + (size_t)l * W2T_SZ), ws + OFF_QO, P4096, P4096, 1024, NTOK, 1024, 4096, EPI_BF16};
      ng = 1;
      break;
  }
  if (ng > 0) gemm_phase(p, g0, g1, ng, smem);
}

#define XB_TMO      128
#define XB_XCNT(j)  (256  + 64 * (j))
#define XB_XSUB(j)  (1280 + 64 * (j))
#define XB_XGEN(j)  (2304 + 64 * (j))
#define XB_TOP      3328
#define XB_TOPGEN   3392
#define XCD_BAR_WORDS 3456
#define XB_SPIN_CAP (1u << 18)
#define LAS __attribute__((address_space(3)))

__device__ __forceinline__ unsigned xb_ld(unsigned* p)              { return __hip_atomic_load(p, __ATOMIC_RELAXED, __HIP_MEMORY_SCOPE_AGENT); }
__device__ __forceinline__ unsigned xb_add(unsigned* p, unsigned v) { return __hip_atomic_fetch_add(p, v, __ATOMIC_RELAXED, __HIP_MEMORY_SCOPE_AGENT); }
__device__ __forceinline__ unsigned xb_xcc_id() { return (unsigned)__builtin_amdgcn_s_getreg((3 << 11) | 20) & 0xFu; }
#define XB_SPIN(cond, bar) do { unsigned _sp = 0; while (cond) { __builtin_amdgcn_s_sleep(1); \
    if ((++_sp & 255u) == 0u) { if (xb_ld(&(bar)[XB_TMO])) break; if (_sp > XB_SPIN_CAP) { atomicAdd(&(bar)[XB_TMO], 1u); break; } } } } while (0)

struct XcdBarrier {
    unsigned* bar; unsigned x;
    volatile LAS unsigned* st;
};

__device__ __forceinline__ XcdBarrier xcd_barrier_post(unsigned* bar, volatile LAS unsigned* st) {
    XcdBarrier b; b.bar = bar; b.x = xb_xcc_id(); b.st = st;
    if (threadIdx.x == 0) (void)xb_add(&bar[XB_XCNT(b.x)], 1u);
    return b;
}
__device__ __forceinline__ void xcd_barrier_complete(unsigned* bar, unsigned x, unsigned& nloc, unsigned& nx) {
    const unsigned G = gridDim.x * gridDim.y * gridDim.z;
    unsigned sum, cnt, mine, sp = 0u;
    for (;;) {
        sum = 0u; cnt = 0u; mine = 0u;
#pragma unroll
        for (unsigned j = 0; j < 16; ++j) { const unsigned c = xb_ld(&bar[XB_XCNT(j)]); sum += c; cnt += (c > 0u) ? 1u : 0u; mine = (j == x) ? c : mine; }
        if (sum == G) break;
        __builtin_amdgcn_s_sleep(1);
        if ((++sp & 255u) == 0u) { if (xb_ld(&bar[XB_TMO])) break; if (sp > XB_SPIN_CAP) { atomicAdd(&bar[XB_TMO], 1u); break; } }
    }
    nloc = mine > 0u ? mine : 1u; nx = cnt > 0u ? cnt : 1u;
}

__device__ __forceinline__ void xcd_barrier(const XcdBarrier& b) {
    asm volatile("s_waitcnt vmcnt(0)" ::: "memory");
    __syncthreads();
    if (threadIdx.x == 0) {
        unsigned* bar = b.bar;
        __builtin_amdgcn_s_waitcnt(0);
        unsigned nloc = b.st[0], nx = b.st[1];
        if (nloc == 0u) { xcd_barrier_complete(bar, b.x, nloc, nx); b.st[0] = nloc; b.st[1] = nx; }
        const unsigned old = xb_add(&bar[XB_XSUB(b.x)], 1u);
        const unsigned gen = old / nloc;
        if (old + 1u == (gen + 1u) * nloc) {
            __builtin_amdgcn_fence(__ATOMIC_RELEASE, "agent");
            asm volatile("s_waitcnt vmcnt(0)" ::: "memory");
            const unsigned og = xb_add(&bar[XB_TOP], 1u);
            const unsigned tg = og / nx;
            if (og + 1u == (tg + 1u) * nx) xb_add(&bar[XB_TOPGEN], 1u);
            else XB_SPIN(xb_ld(&bar[XB_TOPGEN]) == tg, bar);
            __builtin_amdgcn_fence(__ATOMIC_ACQUIRE, "agent");
            xb_add(&bar[XB_XGEN(b.x)], 1u);
            asm volatile("s_waitcnt vmcnt(0)" ::: "memory");
        } else {
            XB_SPIN(xb_ld(&bar[XB_XGEN(b.x)]) == gen, bar);
            __builtin_amdgcn_fence(__ATOMIC_ACQUIRE, "agent");
            asm volatile("s_waitcnt vmcnt(0)" ::: "memory");
        }
    }
    __syncthreads();
}

__global__ void __launch_bounds__(512, 2) mega(Params p) {
  __shared__ __attribute__((aligned(16))) char smem[131072];
  __shared__ uint4 xb_words;
  const bool coop = (p.ph1 - p.ph0) > 1;
  XcdBarrier xb;
  if (coop) {
    if (threadIdx.x == 0) xb_words = make_uint4(0u, 0u, 0u, 0u);
    __syncthreads();
    xb = xcd_barrier_post((unsigned*)(p.ws + OFF_BAR), (volatile LAS unsigned*)&xb_words);
  }
  if (p.ph1 < 0) cg::this_grid().sync();
  for (int ph = p.ph0; ph < p.ph1; ++ph) {
    if (!phase_exists(ph)) continue;
    KA q;
    q.ka = (const AS4 char*)__builtin_amdgcn_kernarg_segment_ptr();
    asm volatile("" : "+s"(q.ka));
    run_phase(q, ph, smem);
    if (ph + 1 < p.ph1) {
      unsigned zoff = 0;
      asm volatile("" : "+s"(zoff));
      XcdBarrier xl = xb;
      xl.bar = xb.bar + zoff; xl.x = xb.x + zoff;
      xcd_barrier(xl);
    }
  }
}

extern "C" void kernel_launch(void* const* d_in, const int* in_sizes, int n_in, void* d_out, int out_size,
                              void* d_ws, size_t ws_size, hipStream_t stream) {
  if (n_in < 33 || ws_size < WS_NEED) { fprintf(stderr, "bad args: n_in %d ws %zu need %zu\n", n_in, ws_size, (size_t)WS_NEED); return; }
  Params p{};
  for (int i = 0; i < 33; ++i) p.in[i] = (const float*)d_in[i];
  p.out = (float*)d_out;
  p.ws = (char*)d_ws;
#if N_LAUNCH_MODE == 1
  for (int ph = 0; ph < 42; ++ph) {
    if (!phase_exists(ph)) continue;
    p.ph0 = ph; p.ph1 = ph + 1;
    hipLaunchKernelGGL(mega, dim3(256), dim3(NTHR), 0, stream, p);
  }
#else
  static int grid_blocks = 0;
  if (!grid_blocks) {
    int dev = 0, cus = 0, per_cu = 0;
    hipGetDevice(&dev);
    hipDeviceGetAttribute(&cus, hipDeviceAttributeMultiprocessorCount, dev);
    hipOccupancyMaxActiveBlocksPerMultiprocessor(&per_cu, mega, NTHR, 0);
    if (per_cu > 1) per_cu = 1;
    grid_blocks = cus * per_cu;
  }
  p.ph0 = 0; p.ph1 = 42;
  hipMemsetAsync((char*)d_ws + OFF_BAR, 0, XCD_BAR_WORDS * 4, stream);
  void* args[] = {&p};
  hipError_t e = hipLaunchCooperativeKernel((void*)mega, dim3(grid_blocks), dim3(NTHR), args, 0, stream);
  if (e != hipSuccess) fprintf(stderr, "cooperative launch failed: %s (grid %d)\n", hipGetErrorString(e), grid_blocks);
#endif
}
```

```cpp
#include <hip/hip_runtime.h>
#include <hip/hip_cooperative_groups.h>
#include <cstdio>
namespace cg = cooperative_groups;

typedef unsigned short u16;
typedef short bf16x8 __attribute__((ext_vector_type(8)));
typedef short s16x4 __attribute__((ext_vector_type(4)));
typedef float f32x16 __attribute__((ext_vector_type(16)));
typedef float f32x2 __attribute__((ext_vector_type(2)));
typedef __bf16 bfx2 __attribute__((ext_vector_type(2)));
#define DI __device__ __forceinline__
#define MFMA(a, b, c) __builtin_amdgcn_mfma_f32_32x32x16_bf16((a), (b), (c), 0, 0, 0)
#define LDS3 __attribute__((address_space(3)))

#ifndef REP_GEMM
#define REP_GEMM 1
#endif
#ifndef REP_ATT
#define REP_ATT 1
#endif
#ifndef N_LAUNCH_MODE
#define N_LAUNCH_MODE 0
#endif

constexpr int NTOK = 12288, NCTX = 4096;
constexpr int NTHR = 512, NWAVE = 8;
constexpr float LOG2E = 1.4426950408889634f;

constexpr size_t O_L0K = 12582912, O_L0V = 13631488, O_L1CKV = 14680064, O_L1KPE = 15728640,
                 O_L2K = 15859712, O_L2V = 16908288, O_L3K = 17956864, O_L3V = 22151168;

constexpr int P1024 = 1024, P4096 = 4160, P384 = 448, P256 = 320;
constexpr size_t W1T_SZ = 4096ull * P1024 * 2, W2T_SZ = 1024ull * P4096 * 2;
constexpr size_t OFF_W1T = 0;
constexpr size_t OFF_W2T = OFF_W1T + 4 * W1T_SZ;
constexpr size_t OFF_AQKV = OFF_W2T + 4 * W2T_SZ;
constexpr size_t OFF_AO_W = OFF_AQKV + 1536ull * P1024 * 2;
constexpr size_t OFF_MIN = OFF_AO_W + 1024ull * P1024 * 2;
constexpr size_t OFF_MUQ = OFF_MIN + 768ull * P1024 * 2;
constexpr size_t OFF_MUKV = OFF_MUQ + 1536ull * P384 * 2;
constexpr size_t OFF_MO = OFF_MUKV + 2048ull * P256 * 2;
constexpr size_t OFF_SQKV = OFF_MO + 1024ull * P1024 * 2;
constexpr size_t OFF_SO = OFF_SQKV + 1536ull * P1024 * 2;
constexpr size_t OFF_NQKV = OFF_SO + 1024ull * P1024 * 2;
constexpr size_t OFF_NO = OFF_NQKV + 3072ull * P1024 * 2;
constexpr size_t OFF_MOD = OFF_NO + 1024ull * P1024 * 2;
constexpr size_t OFF_ROPE = OFF_MOD + 4ull * 9 * 6144 * 4;
constexpr size_t OFF_HAO = OFF_ROPE + 3ull * 64 * 32 * 2 * 4;
constexpr size_t OFF_UZ = OFF_HAO + 12288ull * P1024 * 2;
constexpr size_t OFF_QO = OFF_UZ + 12288ull * P4096 * 2;
constexpr size_t OFF_CQ = OFF_QO + 12288ull * 3072 * 2;
constexpr size_t OFF_CKV = OFF_CQ + 12288ull * P384 * 2;
constexpr size_t OFF_KPE = OFF_CKV + 16384ull * P256 * 2;
constexpr size_t OFF_KV = OFF_KPE + 16384ull * 32 * 2;
constexpr size_t OFF_CK = OFF_KV;
constexpr size_t OFF_CV = OFF_KV + 2097152;
constexpr size_t OFF_C3K = OFF_KV + 4194304;
constexpr size_t OFF_C3V = OFF_C3K + 8388608;
constexpr size_t OFF_BAR = OFF_KV + 16384ull * 2048 * 2;
constexpr size_t WS_NEED = OFF_BAR + 16384;

struct Params {
  const float* in[33];
  float* out;
  char* ws;
  int ph0, ph1;
};

#define AS4 __attribute__((address_space(4)))
struct KA {
  const AS4 char* ka;
  DI const float* in(int i) const { return *(const float* const AS4*)(ka + 8 * i); }
  DI float* out() const { return *(float* const AS4*)(ka + 264); }
  DI char* ws() const { return *(char* const AS4*)(ka + 272); }
};

DI unsigned pack2(float a, float b) { f32x2 f = {a, b}; bfx2 v = __builtin_convertvector(f, bfx2); return __builtin_bit_cast(unsigned, v); }
DI u16 f2bf(float a) { return (u16)(pack2(a, a) & 0xffffu); }
DI float wave_sum(float v) {
#pragma unroll
  for (int o = 32; o; o >>= 1) v += __shfl_xor(v, o, 64);
  return v;
}
DI int ltid() { int t = threadIdx.x; asm volatile("" : "+v"(t)); return t; }
template <int CTRL> DI float dpp_f(float v) {
  return __int_as_float(__builtin_amdgcn_update_dpp(0, __float_as_int(v), CTRL, 0xf, 0xf, true));
}
typedef float f32x4v __attribute__((ext_vector_type(4)));
DI float4 ldg_nt4(const float* p) {
  const f32x4v v = __builtin_nontemporal_load((const f32x4v*)p);
  return make_float4(v.x, v.y, v.z, v.w);
}
DI int crow(int i, int h) { return (i & 3) + 8 * (i >> 2) + 4 * h; }

__device__ const long long TJ[18][6] = {
  {15, 0ll * 1024 * 4096, 1024, 4096, 4096, (long long)(OFF_W1T + 0ull * W1T_SZ)},
  {15, 1ll * 1024 * 4096, 1024, 4096, 4096, (long long)(OFF_W1T + 1ull * W1T_SZ)},
  {15, 2ll * 1024 * 4096, 1024, 4096, 4096, (long long)(OFF_W1T + 2ull * W1T_SZ)},
  {15, 3ll * 1024 * 4096, 1024, 4096, 4096, (long long)(OFF_W1T + 3ull * W1T_SZ)},
  {16, 0ll * 1024 * 4096, 4096, 1024, 1024, (long long)(OFF_W2T + 0ull * W2T_SZ)},
  {16, 1ll * 1024 * 4096, 4096, 1024, 1024, (long long)(OFF_W2T + 1ull * W2T_SZ)},
  {16, 2ll * 1024 * 4096, 4096, 1024, 1024, (long long)(OFF_W2T + 2ull * W2T_SZ)},
  {16, 3ll * 1024 * 4096, 4096, 1024, 1024, (long long)(OFF_W2T + 3ull * W2T_SZ)},
  {17, 0, 1024, 1536, 1536, (long long)OFF_AQKV},
  {20, 0, 1024, 1024, 1024, (long long)OFF_AO_W},
  {21, 0, 1024, 672, 768, (long long)OFF_MIN},
  {24, 0, 384, 1536, 1536, (long long)OFF_MUQ},
  {25, 0, 256, 2048, 2048, (long long)OFF_MUKV},
  {26, 0, 1024, 1024, 1024, (long long)OFF_MO},
  {27, 0, 1024, 1536, 1536, (long long)OFF_SQKV},
  {29, 0, 1024, 1024, 1024, (long long)OFF_SO},
  {30, 0, 1024, 3072, 3072, (long long)OFF_NQKV},
  {32, 0, 1024, 1024, 1024, (long long)OFF_NO},
};

struct TTile { const float* src; u16* dst; int K, N, k0, n0; };
DI void tt_load(const TTile& t, int tid, float4 (&v)[8]) {
  const int n4 = tid & 63, kl = tid >> 6;
  const int n = t.n0 + 4 * n4;
#pragma unroll
  for (int j = 0; j < 8; ++j) {
    const int k = kl + 8 * j;
    v[j] = (n < t.N) ? ldg_nt4(t.src + (size_t)(t.k0 + k) * t.N + n) : make_float4(0.f, 0.f, 0.f, 0.f);
  }
}
DI void tt_store(const TTile& t, int tid, const float4 (&v)[8], char* smem) {
  float (*T)[260] = (float (*)[260])smem;
  const int n4 = tid & 63, kl = tid >> 6;
  __syncthreads();
#pragma unroll
  for (int j = 0; j < 8; ++j) *(float4*)&T[kl + 8 * j][4 * n4] = v[j];
  __syncthreads();
#pragma unroll
  for (int j = 0; j < 4; ++j) {
    const int c = tid + NTHR * j;
    const int n = c >> 3, kc = c & 7;
    uint4 o;
    o.x = pack2(T[kc * 8 + 0][n], T[kc * 8 + 1][n]);
    o.y = pack2(T[kc * 8 + 2][n], T[kc * 8 + 3][n]);
    o.z = pack2(T[kc * 8 + 4][n], T[kc * 8 + 5][n]);
    o.w = pack2(T[kc * 8 + 6][n], T[kc * 8 + 7][n]);
    *(uint4*)&t.dst[(size_t)(t.n0 + n) * (t.K == 1024 ? P1024 : t.K + 64) + t.k0 + kc * 8] = o;
  }
}

DI void convert_f32_bf16(const float* __restrict__ src, u16* __restrict__ dst, size_t n) {
  const size_t n4 = n >> 2;
  const int tid_ = ltid();
  for (size_t i = (size_t)blockIdx.x * NTHR + tid_; i < n4; i += (size_t)gridDim.x * NTHR) {
    const float4 v = ((const float4*)src)[i];
    uint2 o; o.x = pack2(v.x, v.y); o.y = pack2(v.z, v.w);
    ((uint2*)dst)[i] = o;
  }
}

DI void convert_rows256(const float* __restrict__ src, u16* __restrict__ dst, int rows, int dpitch) {
  const int tid_ = ltid();
  for (int i = blockIdx.x * NTHR + tid_; i < rows * 64; i += gridDim.x * NTHR) {
    const int r = i >> 6, c4 = i & 63;
    const float4 v = ((const float4*)src)[i];
    uint2 o; o.x = pack2(v.x, v.y); o.y = pack2(v.z, v.w);
    *(uint2*)(dst + (size_t)r * dpitch + 4 * c4) = o;
  }
}

DI void prepass(const KA& p, char* smem) {
  {
    const int tid = ltid();
    int total = 0;
    for (int j = 0; j < 18; ++j) total += (int)((TJ[j][2] >> 6) * (TJ[j][4] >> 8));
    float4 va[8], vb[8];
    TTile ta, tb;
#define TT_DECODE(tt_, t_)                                                                     \
    {                                                                                          \
      int j = 0, tt = (t_);                                                                    \
      for (;;) { const int c = (int)((TJ[j][2] >> 6) * (TJ[j][4] >> 8)); if (tt < c) break; tt -= c; ++j; } \
      const int K = (int)TJ[j][2];                                                             \
      const int nk = K >> 6;                                                                   \
      tt_.src = p.in((int)TJ[j][0]) + TJ[j][1]; tt_.dst = (u16*)(p.ws() + TJ[j][5]);           \
      tt_.K = K; tt_.N = (int)TJ[j][3]; tt_.k0 = (tt % nk) * 64; tt_.n0 = (tt / nk) * 256;     \
    }
    int t = blockIdx.x;
    if (t < total) { TT_DECODE(ta, t) tt_load(ta, tid, va); }
    for (; t < total; t += 2 * gridDim.x) {
      const int t2 = t + gridDim.x;
      if (t2 < total) { TT_DECODE(tb, t2) tt_load(tb, tid, vb); }
      tt_store(ta, tid, va, smem);
      if (t2 < total) {
        const int t3 = t2 + gridDim.x;
        if (t3 < total) { TT_DECODE(ta, t3) tt_load(ta, tid, va); }
        tt_store(tb, tid, vb, smem);
      }
    }
#undef TT_DECODE
  }
  convert_f32_bf16(p.in(2), (u16*)(p.ws() + OFF_CK), 4096ull * 256);
  convert_f32_bf16(p.in(3), (u16*)(p.ws() + OFF_CV), 4096ull * 256);
  convert_rows256(p.in(4), (u16*)(p.ws() + OFF_CKV) + 12288ull * P256, 4096, P256);
  convert_f32_bf16(p.in(5), (u16*)(p.ws() + OFF_KPE) + 12288ull * 32, 4096ull * 32);
  {
    float* tab = (float*)(p.ws() + OFF_ROPE);
    const int tid_ = ltid();
    for (int e = blockIdx.x * NTHR + tid_; e < 3 * 64 * 32; e += gridDim.x * NTHR) {
      const int kind = e / 2048, pos = (e >> 5) & 63, i = e & 31;
      const int quarter = kind == 0 ? 32 : (kind == 1 ? 16 : 8);
      float c = 1.f, s = 0.f;
      if (i < quarter) {
        const float inv = exp2f(-(float)i / (float)quarter * 13.287712379549449f);
        const float ang = (float)pos * inv;
        c = cosf(ang); s = sinf(ang);
      }
      tab[2 * e] = c; tab[2 * e + 1] = s;
    }
  }
  {
    float* scond = (float*)smem;
    float* red = (float*)(smem + 36864);
    float* MOD = (float*)(p.ws() + OFF_MOD);
    const int tid = ltid();
    bool ready = false;
    for (int it = blockIdx.x; it < 768; it += gridDim.x) {
      __syncthreads();
      if (!ready) {
        for (int e = tid; e < 9 * 1024; e += NTHR) {
          const float c = e < 8192 ? p.in(10)[e] : p.in(11)[e - 8192];
          scond[e] = c / (1.f + __expf(-c));
        }
        ready = true;
        __syncthreads();
      }
      const int l = it / 192, n0 = (it % 192) * 32;
      const int cq = tid & 7, kg = tid >> 3;
      float acc[9][4];
#pragma unroll
      for (int c = 0; c < 9; ++c) { acc[c][0] = 0.f; acc[c][1] = 0.f; acc[c][2] = 0.f; acc[c][3] = 0.f; }
      const float* wp = p.in(12) + (size_t)l * 1024 * 6144 + n0 + 4 * cq;
      float4 wv[16];
#pragma unroll
      for (int i = 0; i < 16; ++i) wv[i] = ldg_nt4(wp + (size_t)(kg + 64 * i) * 6144);
#pragma unroll
      for (int i = 0; i < 16; ++i) {
        const int k = kg + 64 * i;
#pragma unroll
        for (int c = 0; c < 9; ++c) {
          const float sv = scond[c * 1024 + k];
          acc[c][0] += sv * wv[i].x; acc[c][1] += sv * wv[i].y; acc[c][2] += sv * wv[i].z; acc[c][3] += sv * wv[i].w;
        }
      }
#pragma unroll
      for (int c = 0; c < 9; ++c) *(float4*)&red[(kg * 9 + c) * 32 + 4 * cq] = make_float4(acc[c][0], acc[c][1], acc[c][2], acc[c][3]);
      __syncthreads();
      for (int e = tid; e < 288; e += NTHR) {
        const int c = e >> 5, cc = e & 31;
        float sum = p.in(13)[l * 6144 + n0 + cc];
#pragma unroll 8
        for (int g = 0; g < 64; ++g) sum += red[(g * 9 + c) * 32 + cc];
        MOD[(size_t)(l * 9 + c) * 6144 + n0 + cc] = sum;
      }
    }
  }
}

DI float bf2f(unsigned v16) { return __uint_as_float(v16 << 16); }

DI void norm_phase(const KA& p, int l, int mode) {
  const int tid_ = ltid(); const int lane = tid_ & 63, w = tid_ >> 6;
  float* X = p.out();
  const float* MOD = (const float*)(p.ws() + OFF_MOD);
  const u16* FF = (const u16*)(p.ws() + OFF_QO);
  u16* H = (u16*)(p.ws() + OFF_HAO);
  const float* ng = p.in(14);
  const float* xp0 = p.in(0);
  const float* xp1 = p.in(1);
  const bool x_in = (l == 0);
  const bool add = !(l == 0 && mode == 0);
  const int la = (mode == 1) ? l : l - 1;
  const int gate_w = (mode == 1) ? 2 : 5;
  const int gadd = (mode == 1) ? 1 : 3;
  const bool do_h = mode != 2;
  const int gh = (mode == 0) ? 0 : 2, scw = (mode == 0) ? 1 : 4, shw = (mode == 0) ? 0 : 3;
  const int stride = gridDim.x * NWAVE;
  const int lh = do_h ? l : 0;
  int row = blockIdx.x * NWAVE + w;
  float4 nx0, nx1, nx2, nx3;
  uint2 nf0 = make_uint2(0, 0), nf1 = nf0, nf2 = nf0, nf3 = nf0;
#define NLOAD(rw)                                                                                          \
  {                                                                                                        \
    const int rr = min((rw), NTOK - 1);                                                                    \
    const float* xs = x_in ? (rr < NCTX ? xp0 + (size_t)rr * 1024 : xp1 + (size_t)(rr - NCTX) * 1024)      \
                           : X + (size_t)rr * 1024;                                                        \
    nx0 = *(const float4*)(xs + 4 * lane); nx1 = *(const float4*)(xs + 4 * lane + 256);                    \
    nx2 = *(const float4*)(xs + 4 * lane + 512); nx3 = *(const float4*)(xs + 4 * lane + 768);              \
    if (add) {                                                                                             \
      const u16* fr = FF + (size_t)rr * 1024 + 4 * lane;                                                   \
      nf0 = *(const uint2*)(fr); nf1 = *(const uint2*)(fr + 256); nf2 = *(const uint2*)(fr + 512); nf3 = *(const uint2*)(fr + 768); \
    }                                                                                                      \
  }
  NLOAD(row)
  for (; row < NTOK; row += stride) {
    const int ci = row < NCTX ? 8 : ((row - NCTX) >> 10);
    float4 x[4] = {nx0, nx1, nx2, nx3};
    const uint2 fb[4] = {nf0, nf1, nf2, nf3};
    const float* ga = ng + (la * 4 + gadd) * 1024 + 4 * lane;
    const float* gt = MOD + (size_t)(la * 9 + ci) * 6144 + gate_w * 1024 + 4 * lane;
    const float* gp = ng + (lh * 4 + gh) * 1024 + 4 * lane;
    const float* sc = MOD + (size_t)(lh * 9 + ci) * 6144 + scw * 1024 + 4 * lane;
    const float* sh = MOD + (size_t)(lh * 9 + ci) * 6144 + shw * 1024 + 4 * lane;
    float4 ga4[4], gt4[4], g4[4], c4[4], s4[4];
#pragma unroll
    for (int j = 0; j < 4; ++j) {
      if (add) { ga4[j] = *(const float4*)(ga + 256 * j); gt4[j] = *(const float4*)(gt + 256 * j); }
      if (do_h) { g4[j] = *(const float4*)(gp + 256 * j); c4[j] = *(const float4*)(sc + 256 * j); s4[j] = *(const float4*)(sh + 256 * j); }
    }
    NLOAD(row + stride)
    if (add) {
      float f[16];
      float ss = 0.f;
#pragma unroll
      for (int j = 0; j < 4; ++j) {
        f[4 * j] = bf2f(fb[j].x & 0xffffu); f[4 * j + 1] = bf2f(fb[j].x >> 16);
        f[4 * j + 2] = bf2f(fb[j].y & 0xffffu); f[4 * j + 3] = bf2f(fb[j].y >> 16);
        ss += f[4 * j] * f[4 * j] + f[4 * j + 1] * f[4 * j + 1] + f[4 * j + 2] * f[4 * j + 2] + f[4 * j + 3] * f[4 * j + 3];
      }
      ss = wave_sum(ss);
      const float rstd = rsqrtf(ss * (1.f / 1024.f) + 1e-6f);
#pragma unroll
      for (int j = 0; j < 4; ++j) {
        x[j].x += gt4[j].x * (f[4 * j] * rstd * ga4[j].x);
        x[j].y += gt4[j].y * (f[4 * j + 1] * rstd * ga4[j].y);
        x[j].z += gt4[j].z * (f[4 * j + 2] * rstd * ga4[j].z);
        x[j].w += gt4[j].w * (f[4 * j + 3] * rstd * ga4[j].w);
        *(float4*)(X + (size_t)row * 1024 + 4 * lane + 256 * j) = x[j];
      }
    }
    if (do_h) {
      float ss = 0.f;
#pragma unroll
      for (int j = 0; j < 4; ++j) ss += x[j].x * x[j].x + x[j].y * x[j].y + x[j].z * x[j].z + x[j].w * x[j].w;
      ss = wave_sum(ss);
      const float rstd = rsqrtf(ss * (1.f / 1024.f) + 1e-6f);
#pragma unroll
      for (int j = 0; j < 4; ++j) {
        const float h0 = x[j].x * rstd * g4[j].x * (1.f + c4[j].x) + s4[j].x;
        const float h1 = x[j].y * rstd * g4[j].y * (1.f + c4[j].y) + s4[j].y;
        const float h2 = x[j].z * rstd * g4[j].z * (1.f + c4[j].z) + s4[j].z;
        const float h3 = x[j].w * rstd * g4[j].w * (1.f + c4[j].w) + s4[j].w;
        uint2 o; o.x = pack2(h0, h1); o.y = pack2(h2, h3);
        *(uint2*)(H + (size_t)row * P1024 + 4 * lane + 256 * j) = o;
      }
    }
  }
#undef NLOAD
}

enum { EPI_F32 = 0, EPI_BF16 = 1, EPI_RELU2 = 2, EPI_NAT = 3, EPI_SWA = 4, EPI_MLAQ = 5, EPI_ATTN = 6 };
struct GemmDesc { const u16* A; const u16* Bt; void* dst; int lda, ldb, ldc, M, N, K, epi; };

DI void gemm_tile(const GemmDesc& g, int m0, int n0, float* outp, const float* rope, const float* qnorm, const float* knorm, char* smem) {
  constexpr int LS = 72;
  constexpr int BM = 192, BN = 256;
  u16* As = (u16*)smem;
  u16* Bs = As + 2 * BM * LS;
  const int tid = ltid(), lane = tid & 63, w = tid >> 6, r = lane & 31, h = lane >> 5;
  const int wm = w >> 2, wn = w & 3;
  const int lrow = tid >> 3, lcc = tid & 7;
  const int Mlast = g.M - 1;
  const char* Ab = (const char*)g.A;
  const char* Bb = (const char*)g.Bt;
  const unsigned ao0 = (unsigned)(min(m0 + lrow, Mlast) * g.lda + lcc * 8) * 2u;
  const unsigned ao1 = (unsigned)(min(m0 + lrow + 64, Mlast) * g.lda + lcc * 8) * 2u;
  const unsigned ao2 = (unsigned)(min(m0 + lrow + 128, Mlast) * g.lda + lcc * 8) * 2u;
  const unsigned bo0 = (unsigned)((n0 + lrow) * g.ldb + lcc * 8) * 2u;
  const unsigned bst = (unsigned)(64 * g.ldb) * 2u;
  uint4 pa0, pa1, pa2, pb0, pb1, pb2, pb3;
  f32x16 acc00, acc01, acc10, acc11, acc20, acc21;
#pragma unroll
  for (int i = 0; i < 16; ++i) { acc00[i] = 0.f; acc01[i] = 0.f; acc10[i] = 0.f; acc11[i] = 0.f; acc20[i] = 0.f; acc21[i] = 0.f; }
#define GLOAD(R, kt_)                                                                                  \
  {                                                                                                    \
    const char* ak = Ab + (size_t)(kt_) * 128; const char* bk = Bb + (size_t)(kt_) * 128;              \
    R##a0 = *(const uint4*)(ak + ao0); R##a1 = *(const uint4*)(ak + ao1); R##a2 = *(const uint4*)(ak + ao2); \
    R##b0 = *(const uint4*)(bk + bo0); R##b1 = *(const uint4*)(bk + bo0 + bst);                        \
    R##b2 = *(const uint4*)(bk + bo0 + 2 * bst); R##b3 = *(const uint4*)(bk + bo0 + 3 * bst);          \
  }
#define LSTORE(R, buf)                                                                  \
  *(uint4*)&As[(buf) * BM * LS + (lrow) * LS + lcc * 8] = R##a0;                         \
  *(uint4*)&As[(buf) * BM * LS + (lrow + 64) * LS + lcc * 8] = R##a1;                    \
  *(uint4*)&As[(buf) * BM * LS + (lrow + 128) * LS + lcc * 8] = R##a2;                   \
  *(uint4*)&Bs[(buf) * BN * LS + (lrow) * LS + lcc * 8] = R##b0;                         \
  *(uint4*)&Bs[(buf) * BN * LS + (lrow + 64) * LS + lcc * 8] = R##b1;                    \
  *(uint4*)&Bs[(buf) * BN * LS + (lrow + 128) * LS + lcc * 8] = R##b2;                   \
  *(uint4*)&Bs[(buf) * BN * LS + (lrow + 192) * LS + lcc * 8] = R##b3;
#define FRAGS(X, kk)                                                                    \
  X##a0 = *(const bf16x8*)(Ac + 16 * (kk));                                             \
  X##a1 = *(const bf16x8*)(Ac + 32 * LS + 16 * (kk));                                   \
  X##a2 = *(const bf16x8*)(Ac + 64 * LS + 16 * (kk));                                   \
  X##b0 = *(const bf16x8*)(Bc + 16 * (kk));                                             \
  X##b1 = *(const bf16x8*)(Bc + 32 * LS + 16 * (kk));
#define MMAS(X)                                                                         \
  acc00 = MFMA(X##a0, X##b0, acc00); acc01 = MFMA(X##a0, X##b1, acc01);                 \
  acc10 = MFMA(X##a1, X##b0, acc10); acc11 = MFMA(X##a1, X##b1, acc11);                 \
  acc20 = MFMA(X##a2, X##b0, acc20); acc21 = MFMA(X##a2, X##b1, acc21);
#define COMPUTE(buf)                                                                    \
  {                                                                                     \
    const u16* Ac = As + (buf) * BM * LS + (96 * wm + r) * LS + 8 * h;                  \
    const u16* Bc = Bs + (buf) * BN * LS + (64 * wn + r) * LS + 8 * h;                  \
    bf16x8 xa0, xa1, xa2, xb0, xb1, ya0, ya1, ya2, yb0, yb1;                            \
    FRAGS(x, 0) __builtin_amdgcn_sched_barrier(0);                                      \
    FRAGS(y, 1) __builtin_amdgcn_sched_barrier(0); MMAS(x) __builtin_amdgcn_sched_barrier(0); \
    FRAGS(x, 2) __builtin_amdgcn_sched_barrier(0); MMAS(y) __builtin_amdgcn_sched_barrier(0); \
    FRAGS(y, 3) __builtin_amdgcn_sched_barrier(0); MMAS(x) __builtin_amdgcn_sched_barrier(0); \
    MMAS(y)                                                                             \
  }
  const int KT = g.K >> 6;
  GLOAD(p, 0)
  LSTORE(p, 0)
  __syncthreads();
  for (int kt = 0; kt < KT; kt += 2) {
    GLOAD(p, min(kt + 1, KT - 1))
    __builtin_amdgcn_sched_barrier(0);
    COMPUTE(0)
    LSTORE(p, 1)
    __syncthreads();
    GLOAD(p, min(kt + 2, KT - 1))
    __builtin_amdgcn_sched_barrier(0);
    COMPUTE(1)
    LSTORE(p, 0)
    __syncthreads();
  }
#undef GLOAD
#undef LSTORE
#undef FRAGS
#undef MMAS
#undef COMPUTE
  const int epi = g.epi;
#define EPI_LOOP(BODY)                                                                                         \
  _Pragma("unroll") for (int mi = 0; mi < 3; ++mi)                                                             \
  _Pragma("unroll") for (int ni = 0; ni < 2; ++ni) {                                                           \
    const int col = n0 + 64 * wn + 32 * ni + r;                                                                \
    _Pragma("unroll") for (int i = 0; i < 16; ++i) {                                                           \
      const int row = m0 + 96 * wm + 32 * mi + crow(i, h);                                                     \
      const float v = mi == 0 ? (ni == 0 ? acc00[i] : acc01[i]) : (mi == 1 ? (ni == 0 ? acc10[i] : acc11[i]) : (ni == 0 ? acc20[i] : acc21[i])); \
      BODY                                                                                                     \
    }                                                                                                          \
  }
  if (epi == EPI_F32) {
    float* dst = (float*)g.dst;
    EPI_LOOP(dst[(size_t)row * g.ldc + col] = v;)
  } else if (epi == EPI_RELU2) {
    u16* dst = (u16*)g.dst;
    EPI_LOOP(const float t = v > 0.f ? v : 0.f; dst[(size_t)row * g.ldc + col] = f2bf(t * t);)
  } else if (epi == EPI_BF16) {
    u16* dst = (u16*)g.dst;
    EPI_LOOP(if (row <= Mlast) dst[(size_t)row * g.ldc + col] = f2bf(v);)
  } else if (epi == EPI_NAT) {
    u16* dst = (u16*)g.dst;
    EPI_LOOP(dst[(size_t)row * g.ldc + col] = f2bf(v);
             if (row < NCTX && col >= 1024) outp[(col < 2048 ? O_L3K - 1024 : O_L3V - 2048) + (size_t)row * 1024 + col] = v;)
  } else if (epi == EPI_ATTN) {
    u16* dst = (u16*)g.dst;
    float* part = (float*)(smem + 92160);
    const bool isv = n0 >= 1280;
    if (!isv) {
#pragma unroll
      for (int mi = 0; mi < 3; ++mi)
#pragma unroll
        for (int i = 0; i < 16; ++i) {
          const float a0 = mi == 0 ? acc00[i] : (mi == 1 ? acc10[i] : acc20[i]);
          const float a1 = mi == 0 ? acc01[i] : (mi == 1 ? acc11[i] : acc21[i]);
          float ss = a0 * a0 + a1 * a1;
          ss += dpp_f<0xB1>(ss); ss += dpp_f<0x4E>(ss); ss += dpp_f<0x141>(ss); ss += dpp_f<0x140>(ss);
          if ((r & 15) == 0) part[(96 * wm + 32 * mi + crow(i, h)) * 8 + wn * 2 + (r >> 4)] = ss;
        }
      __syncthreads();
    }
    const float* gn = n0 < 1024 ? qnorm : knorm;
    const int axis = wn & 1;
    const float gv0 = isv ? 1.f : gn[64 * axis + r], gv1 = isv ? 1.f : gn[64 * axis + 32 + r];
    const int col0 = n0 + 64 * wn + r;
#pragma unroll
    for (int mi = 0; mi < 3; ++mi)
#pragma unroll
      for (int i = 0; i < 16; ++i) {
        const int rl = 96 * wm + 32 * mi + crow(i, h), row = m0 + rl;
        const float a0 = mi == 0 ? acc00[i] : (mi == 1 ? acc10[i] : acc20[i]);
        const float a1 = mi == 0 ? acc01[i] : (mi == 1 ? acc11[i] : acc21[i]);
        const bool lat = row >= NCTX;
        float y0 = a0, y1 = a1;
        if (!isv) {
          const float4 pq = *(const float4*)&part[rl * 8 + (wn & 2) * 2];
          const float ssq = (pq.x + pq.y) + (pq.z + pq.w);
          const float rstd = rsqrtf(ssq * (1.f / 128.f) + 1e-6f);
          y0 = a0 * rstd * gv0; y1 = a1 * rstd * gv1;
          if (!lat && n0 >= 1024) { outp[O_L0K - 1024 + (size_t)row * 256 + col0] = y0; outp[O_L0K - 1024 + (size_t)row * 256 + col0 + 32] = y1; }
          if (lat) {
            const int t = (row - NCTX) & 1023; const int pos = axis ? (t & 63) : (t >> 6);
            const float2 cs = *(const float2*)(rope + (pos * 32 + r) * 2);
            const float o0 = y0 * cs.x - y1 * cs.y, o1 = y1 * cs.x + y0 * cs.y;
            y0 = o0; y1 = o1;
          }
        } else if (!lat) {
          outp[O_L0V - 1280 + (size_t)row * 256 + col0] = a0; outp[O_L0V - 1280 + (size_t)row * 256 + col0 + 32] = a1;
        }
        dst[(size_t)row * g.ldc + col0] = f2bf(y0);
        dst[(size_t)row * g.ldc + col0 + 32] = f2bf(y1);
      }
  } else if (epi == EPI_SWA) {
    u16* dst = (u16*)g.dst;
    const float* tab = rope + 1 * 64 * 32 * 2;
    const bool qk = n0 < 1280;
    EPI_LOOP(const bool lat = row >= NCTX; const int t = (row - NCTX) & 1023;
             const float pv = __shfl_xor(v, 16, 64);
             float y = v;
             if (lat && qk) { const int e = col & 63; const int pos = (e >> 5) ? (t & 63) : (t >> 6);
                              const float2 cs = *(const float2*)(tab + (pos * 32 + (e & 15)) * 2);
                              y = v * cs.x + ((e & 16) ? pv : -pv) * cs.y; }
             dst[(size_t)row * g.ldc + col] = f2bf(y);
             if (!lat && col >= 1024) outp[(col < 1280 ? O_L2K - 1024 : O_L2V - 1280) + (size_t)row * 256 + col] = v;)
  } else {
    u16* dst = (u16*)g.dst;
    const float* tab = rope + 2 * 64 * 32 * 2;
    EPI_LOOP(const bool lat = row >= NCTX; const int t = (row - NCTX) & 1023;
             const float pv = __shfl_xor(v, 8, 64);
             float y = v;
             if (lat && (col % 96) >= 64) { const int e = col & 31; const int pos = (e >> 4) ? (t & 63) : (t >> 6);
                                            const float2 cs = *(const float2*)(tab + (pos * 32 + (e & 7)) * 2);
                                            y = v * cs.x + ((e & 8) ? pv : -pv) * cs.y; }
             dst[(size_t)row * g.ldc + col] = f2bf(y);)
  }
#undef EPI_LOOP
}

DI void gemm_phase(const KA& p, const GemmDesc& g0, const GemmDesc& g1, int ng, char* smem) {
  const int nt0 = g0.N >> 8, mt0 = (g0.M + 191) / 192;
  const int CN = (nt0 & 3) == 0 ? 4 : ((nt0 & 1) == 0 ? 2 : 1), CM = 32 / CN;
  if (ng == 1 && gridDim.x == 256 && (mt0 % CM) == 0) {
    const int x = blockIdx.x & 7, s = blockIdx.x >> 3, mi = s / CN, ni = s - mi * CN;
    const int ncn = nt0 / CN, nchunks = (mt0 / CM) * ncn;
    for (int rep = 0; rep < REP_GEMM; ++rep)
    for (int c = x; c < nchunks; c += 8) {
      const int cm = c / ncn, cn = c - cm * ncn;
      gemm_tile(g0, (cm * CM + mi) * 192, (cn * CN + ni) * 256, p.out(), (const float*)(p.ws() + OFF_ROPE), p.in(18), p.in(19), smem);
    }
    return;
  }
  const int t0 = mt0 * nt0;
  const int t1 = ng > 1 ? ((g1.M + 191) / 192) * (g1.N >> 8) : 0;
  for (int rep = 0; rep < REP_GEMM; ++rep)
  for (int t = blockIdx.x; t < t0 + t1; t += gridDim.x) {
    const bool first = t < t0;
    GemmDesc g;
    g.A = first ? g0.A : g1.A; g.Bt = first ? g0.Bt : g1.Bt; g.dst = first ? g0.dst : g1.dst;
    g.lda = first ? g0.lda : g1.lda; g.ldb = first ? g0.ldb : g1.ldb; g.ldc = first ? g0.ldc : g1.ldc;
    g.M = first ? g0.M : g1.M; g.N = first ? g0.N : g1.N; g.K = first ? g0.K : g1.K; g.epi = first ? g0.epi : g1.epi;
    const int tt = first ? t : t - t0;
    const int nt = g.N >> 8;
    gemm_tile(g, (tt / nt) * 192, (tt % nt) * 256, p.out(), (const float*)(p.ws() + OFF_ROPE), p.in(18), p.in(19), smem);
  }
}

namespace pg8 {
#define PG8_LAS __attribute__((address_space(3)))
typedef unsigned short bf16_t;
typedef short bf16x8 __attribute__((ext_vector_type(8)));
typedef float f32x4 __attribute__((ext_vector_type(4)));
typedef unsigned u32x4 __attribute__((ext_vector_type(4)));
constexpr int BM = 256, BK = 64, HALF = 128, HTB = HALF * BK * 2  , STAGE_BYTES = 8 * HTB, NXCD = 8, WGM = 8;

__host__ __device__ __forceinline__ int lds_byte(int r, int c) { const int st = (r >> 4) * 2 + (c >> 5), rr = r & 15, cc = c & 31, ob = rr * 64 + cc * 2; return st * 1024 + (ob ^ (((ob >> 9) & 1) << 5)); }
__host__ __device__ __forceinline__ void stage_rc(int b, int& R, int& C) { const int st = b / 1024, sb = b % 1024, swz = sb ^ (((sb >> 9) & 1) << 5); R = (st >> 1) * 16 + swz / 64; C = (st & 1) * 32 + (swz % 64) / 2; }
__host__ __device__ __forceinline__ int perm32(int rho) { const int n = rho >> 4, i = rho & 15; return 8 * (i >> 2) + 4 * n + (i & 3); }

struct Unit { int pm, pn; };
struct Gemm { const bf16_t* A; const bf16_t* Bt; int M, N, K; };
struct StaticOrder {
    int nM, nN, nwg, G, c;
    __host__ __device__ void init(int M, int N, int G_, int c_) { nM = M / BM; nN = N / BM; nwg = nM * nN; G = G_; c = c_; }
    __host__ __device__ bool next(int i, Unit& u) const {
        const long L = (long)i * G + c; if (L >= nwg) return false;
        int wgid = (int)L; { const int q = nwg / NXCD, r = nwg % NXCD, xcd = wgid % NXCD, off = wgid / NXCD; wgid = (xcd < r ? xcd * (q + 1) : r * (q + 1) + (xcd - r) * q) + off; }
        const int nig = WGM * nN, gid = wgid / nig, fm = gid * WGM, gsz = (nM - fm) < WGM ? (nM - fm) : WGM;
        u.pm = fm + ((wgid % nig) % gsz); u.pn = (wgid % nig) / gsz; return true;
    }
    __device__ __forceinline__ void a_ready(const Unit&) const {}
    __device__ __forceinline__ void done(const Unit&) const {}
};
__device__ __forceinline__ unsigned cvt_pk_bf16(float lo, float hi) { unsigned r; asm volatile("v_cvt_pk_bf16_f32 %0, %1, %2" : "=v"(r) : "v"(lo), "v"(hi)); return r; }
struct EpiRelu2 {
    static constexpr bool PERM = true, AFTER_DRAIN = false;
    bf16_t* O; int ldc;
    __device__ __forceinline__ void operator()(const f32x4 (&acc)[2][2][4][2], const Unit& u, int wr, int wc, int fr, int fq) const {
        const int row0 = u.pm * BM + wr * 64 + fr, col0 = u.pn * BM + wc * 32 + 8 * fq;
#pragma unroll
        for (int ai = 0; ai < 2; ++ai)
#pragma unroll
            for (int m = 0; m < 4; ++m) { bf16_t* rowp = O + (size_t)(row0 + ai * HALF + m * 16) * ldc + col0;
#pragma unroll
                for (int bj = 0; bj < 2; ++bj) { f32x4 v0 = acc[ai][bj][m][0], v1 = acc[ai][bj][m][1];
#pragma unroll
                    for (int j = 0; j < 4; ++j) { const float a = v0[j] > 0.f ? v0[j] : 0.f, b = v1[j] > 0.f ? v1[j] : 0.f; v0[j] = a * a; v1[j] = b * b; }
                    u32x4 w; w.x = cvt_pk_bf16(v0[0], v0[1]); w.y = cvt_pk_bf16(v0[2], v0[3]); w.z = cvt_pk_bf16(v1[0], v1[1]); w.w = cvt_pk_bf16(v1[2], v1[3]);
                    *(u32x4*)(rowp + bj * HALF) = w; } }
    }
};
template <class Epi, class Sched, bool STAMP = false>
__device__ __forceinline__ void gemm_phase(PG8_LAS unsigned char* lds, const Gemm g, const Sched& S, const Epi& E, unsigned long long* stamps) {
    const int tid = ltid(), wid = __builtin_amdgcn_readfirstlane(tid >> 6), lane = tid & 63, wr = wid >> 2, wc = wid & 3, fr = lane & 15, fq = lane >> 4;
    const int K = g.K, nt = K / BK;
    int ts_lo = 0, ts_hi = 0, nts = 0; const unsigned long long rt_entry = STAMP ? 0ull : 0ull;
#define PG8_STAMP() do { if (STAMP && wid == 0 && nts < 64) { const unsigned long long _c = 0ull; \
        ts_lo = (lane == nts) ? (int)(unsigned)_c : ts_lo; ts_hi = (lane == nts) ? (int)(unsigned)(_c >> 32) : ts_hi; ++nts; } } while (0)
    PG8_STAMP();
    unsigned voffA[2], voffB[2];
#pragma unroll
    for (int i = 0; i < 2; ++i) { int R, C; stage_rc(tid * 16 + i * 8192, R, C); const int Rb = Epi::PERM ? ((R & ~31) + perm32(R & 31)) : R;
        voffA[i] = (unsigned)(R * K + C) * 2u; voffB[i] = (unsigned)(Rb * K + C) * 2u; }
    const size_t kstep = (size_t)(BK * 2);
    const size_t hstep = (size_t)HALF * K * 2;
    const size_t tstep = 2 * hstep;
    const unsigned ldsw = (unsigned)wid * 1024u;
    const int aoff = lds_byte(wr * 64 + fr, fq * 8), boff = lds_byte(wc * 32 + fr, fq * 8);
#define PG8_SA(b, h) (((b) * 2 + (h)) * HTB)
#define PG8_SB(b, h) ((4 + (b) * 2 + (h)) * HTB)
#define PG8_STAGE(bufoff, gbase, voff) do { _Pragma("unroll") for (int _i = 0; _i < 2; ++_i) \
        __builtin_amdgcn_global_load_lds((const unsigned*)((const char*)(gbase) + (voff)[_i]), (PG8_LAS unsigned*)(lds + (bufoff) + ldsw + _i * 8192), 16, 0, 0); } while (0)
#define PG8_LDA(dst, b, h) do { _Pragma("unroll") for (int m = 0; m < 4; ++m) _Pragma("unroll") for (int k = 0; k < 2; ++k) dst[m][k] = *(const PG8_LAS bf16x8*)(lds + PG8_SA(b, h) + aoff + m * 2048 + k * 1024); } while (0)
#define PG8_LDB(dst, b, h) do { _Pragma("unroll") for (int n = 0; n < 2; ++n) _Pragma("unroll") for (int k = 0; k < 2; ++k) dst[n][k] = *(const PG8_LAS bf16x8*)(lds + PG8_SB(b, h) + boff + n * 2048 + k * 1024); } while (0)
#define PG8_MMA(ai, bj, At, Bt) do { __builtin_amdgcn_s_setprio(1); _Pragma("unroll") for (int m = 0; m < 4; ++m) _Pragma("unroll") for (int n = 0; n < 2; ++n) _Pragma("unroll") for (int k = 0; k < 2; ++k) \
        acc[ai][bj][m][n] = __builtin_amdgcn_mfma_f32_16x16x32_bf16(Bt[n][k], At[m][k], acc[ai][bj][m][n], 0, 0, 0); __builtin_amdgcn_s_setprio(0); } while (0)
#define PG8_WAIT_V(n) asm volatile("s_waitcnt vmcnt(" #n ")" ::: "memory")
#define PG8_WAIT_L(n) asm volatile("s_waitcnt lgkmcnt(" #n ")" ::: "memory")
#define PG8_BAR __builtin_amdgcn_s_barrier()
#define PG8_SCHED __builtin_amdgcn_sched_barrier(0)
    Unit cur, nxt; int ui = 0;
    if (!S.next(0, cur)) return;
    f32x4 acc[2][2][4][2];
#pragma unroll
    for (int a = 0; a < 2; ++a)
#pragma unroll
        for (int b = 0; b < 2; ++b)
#pragma unroll
            for (int m = 0; m < 4; ++m)
#pragma unroll
                for (int n = 0; n < 2; ++n) acc[a][b][m][n] = (f32x4){0.f, 0.f, 0.f, 0.f};
    bf16x8 At[4][2], B0[2][2], B1[2][2];
    const char* cA = (const char*)g.A + (size_t)cur.pm * tstep; const char* cB = (const char*)g.Bt + (size_t)cur.pn * tstep;
    S.a_ready(cur);
    PG8_STAGE(PG8_SB(0, 0), cB, voffB); PG8_STAGE(PG8_SA(0, 0), cA, voffA); PG8_STAGE(PG8_SB(0, 1), cB + hstep, voffB); PG8_STAGE(PG8_SA(0, 1), cA + hstep, voffA);
    if (wr == 1) PG8_BAR;
    PG8_WAIT_V(4); PG8_BAR;
    PG8_STAGE(PG8_SB(1, 0), cB + kstep, voffB); PG8_STAGE(PG8_SA(1, 0), cA + kstep, voffA); PG8_STAGE(PG8_SB(1, 1), cB + hstep + kstep, voffB);
    PG8_WAIT_V(6); PG8_BAR;
    PG8_STAMP();
    for (;;) {
        const bool has_next = S.next(ui + 1, nxt);
        const char* nA = has_next ? (const char*)g.A + (size_t)nxt.pm * tstep : cA; const char* nB = has_next ? (const char*)g.Bt + (size_t)nxt.pn * tstep : cB;
        for (int t = 0; t < nt; t += 2) {
            const bool last = (t == nt - 2);
            const char* a1 = cA + (size_t)(t + 1) * kstep;
            const char* a2 = last ? nA : cA + (size_t)(t + 2) * kstep; const char* b2 = last ? nB : cB + (size_t)(t + 2) * kstep;
            const char* a3 = a2 + kstep; const char* b3 = b2 + kstep;
            if (last && has_next) S.a_ready(nxt);
            PG8_LDB(B0, 0, 0); PG8_SCHED; PG8_LDA(At, 0, 0); PG8_STAGE(PG8_SA(1, 1), a1 + hstep, voffA);
            PG8_WAIT_L(8); PG8_BAR; PG8_WAIT_L(0); PG8_MMA(0, 0, At, B0); PG8_BAR; PG8_SCHED;
            PG8_LDB(B1, 0, 1); PG8_STAGE(PG8_SB(0, 0), b2, voffB);
            PG8_BAR; PG8_WAIT_L(0); PG8_MMA(0, 1, At, B1); PG8_BAR;
            PG8_LDA(At, 0, 1); PG8_STAGE(PG8_SA(0, 0), a2, voffA);
            PG8_BAR; PG8_WAIT_L(0); PG8_MMA(1, 0, At, B0); PG8_BAR; PG8_SCHED;
            PG8_STAGE(PG8_SB(0, 1), b2 + hstep, voffB);
            PG8_WAIT_V(6); PG8_BAR; PG8_MMA(1, 1, At, B1); PG8_BAR;
            PG8_LDB(B0, 1, 0); PG8_SCHED; PG8_LDA(At, 1, 0); PG8_STAGE(PG8_SA(0, 1), a2 + hstep, voffA);
            PG8_WAIT_L(8); PG8_BAR; PG8_WAIT_L(0); PG8_MMA(0, 0, At, B0); PG8_BAR; PG8_SCHED;
            PG8_LDB(B1, 1, 1); PG8_STAGE(PG8_SB(1, 0), b3, voffB);
            PG8_BAR; PG8_WAIT_L(0); PG8_MMA(0, 1, At, B1); PG8_BAR;
            PG8_LDA(At, 1, 1); PG8_STAGE(PG8_SA(1, 0), a3, voffA);
            PG8_BAR; PG8_WAIT_L(0); PG8_MMA(1, 0, At, B0); PG8_BAR; PG8_SCHED;
            PG8_STAGE(PG8_SB(1, 1), b3 + hstep, voffB);
            PG8_WAIT_V(6); PG8_BAR; PG8_MMA(1, 1, At, B1); PG8_BAR;
        }
        PG8_STAMP();
        if constexpr (!Epi::AFTER_DRAIN) { E(acc, cur, wr, wc, fr, fq); S.done(cur); }
        PG8_STAMP();
        if (!has_next) break;
#pragma unroll
        for (int a = 0; a < 2; ++a)
#pragma unroll
            for (int b = 0; b < 2; ++b)
#pragma unroll
                for (int m = 0; m < 4; ++m)
#pragma unroll
                    for (int n = 0; n < 2; ++n) acc[a][b][m][n] = (f32x4){0.f, 0.f, 0.f, 0.f};
        cur = nxt; cA = nA; cB = nB; ++ui;
    }
    PG8_WAIT_V(0);
    if (wr == 0) PG8_BAR;
    PG8_BAR;
    if constexpr (Epi::AFTER_DRAIN) { E.fused(acc, cur, wr, wc, fr, fq, lds, wid, lane); S.done(cur); }
    PG8_STAMP();
    if (STAMP && wid == 0) { stamps[lane] = lane < nts ? (((unsigned long long)(unsigned)ts_hi << 32) | (unsigned)ts_lo) : 0ull;
        if (lane == 62) stamps[62] = rt_entry; if (lane == 63) stamps[63] = 0ull; }
#undef PG8_STAMP
#undef PG8_SA
#undef PG8_SB
#undef PG8_STAGE
#undef PG8_LDA
#undef PG8_LDB
#undef PG8_MMA
#undef PG8_WAIT_V
#undef PG8_WAIT_L
#undef PG8_BAR
#undef PG8_SCHED
}
}

#define PP_LOADROW(dst, NV, PITCH, rw)                                             \
  {                                                                                \
    const float* zr_ = Z + (size_t)min((rw), NTOK - 1) * (PITCH) + lane;           \
    _Pragma("unroll") for (int j_ = 0; j_ < (NV); ++j_) dst[j_] = zr_[64 * j_];    \
  }

DI void pp_attn(const KA& p) {
  const int tid_ = ltid(); const int lane = tid_ & 63, w = tid_ >> 6;
  const float* Z = (const float*)(p.ws() + OFF_UZ);
  u16* QKV = (u16*)(p.ws() + OFF_QO);
  float* outp = p.out();
  const float* tab = (const float*)(p.ws() + OFF_ROPE);
  const float gq0 = p.in(18)[lane], gq1 = p.in(18)[64 + lane], gk0 = p.in(19)[lane], gk1 = p.in(19)[64 + lane];
  const int stride = gridDim.x * NWAVE;
  int row = blockIdx.x * NWAVE + w;
  float nv[24];
  PP_LOADROW(nv, 24, 1536, row)
  for (; row < NTOK; row += stride) {
    float v[24];
#pragma unroll
    for (int j = 0; j < 24; ++j) v[j] = nv[j];
    const bool lat = row >= NCTX;
    const int t = (row - NCTX) & 1023, pr = t >> 6, pc = t & 63;
    const int i = lane & 31;
    const float c0 = tab[(pr * 32 + i) * 2], s0 = tab[(pr * 32 + i) * 2 + 1];
    const float c1 = tab[(pc * 32 + i) * 2], s1 = tab[(pc * 32 + i) * 2 + 1];
    PP_LOADROW(nv, 24, 1536, row + stride)
    u16* o = QKV + (size_t)row * 1536;
    const float sg = lane < 32 ? -1.f : 1.f;
#pragma unroll
    for (int hd = 0; hd < 10; ++hd) {
      const float v0 = v[2 * hd], v1 = v[2 * hd + 1];
      const float ss = wave_sum(v0 * v0 + v1 * v1);
      const float rstd = rsqrtf(ss * (1.f / 128.f) + 1e-6f);
      float y0 = v0 * rstd * (hd < 8 ? gq0 : gk0), y1 = v1 * rstd * (hd < 8 ? gq1 : gk1);
      if (hd >= 8 && !lat) {
        outp[O_L0K + (size_t)row * 256 + (hd - 8) * 128 + lane] = y0;
        outp[O_L0K + (size_t)row * 256 + (hd - 8) * 128 + 64 + lane] = y1;
      }
      const float p0 = __shfl_xor(y0, 32, 64), p1 = __shfl_xor(y1, 32, 64);
      if (lat) {
        y0 = y0 * c0 + sg * p0 * s0;
        y1 = y1 * c1 + sg * p1 * s1;
      }
      o[hd * 128 + lane] = f2bf(y0);
      o[hd * 128 + 64 + lane] = f2bf(y1);
    }
#pragma unroll
    for (int j = 0; j < 4; ++j) {
      const float vv = v[20 + j];
      o[1280 + 64 * j + lane] = f2bf(vv);
      if (!lat) outp[O_L0V + (size_t)row * 256 + 64 * j + lane] = vv;
    }
  }
}

DI void pp_swa(const KA& p) {
  const int tid_ = ltid(); const int lane = tid_ & 63, w = tid_ >> 6;
  const float* Z = (const float*)(p.ws() + OFF_UZ);
  u16* QKV = (u16*)(p.ws() + OFF_QO);
  float* outp = p.out();
  const float* tab = (const float*)(p.ws() + OFF_ROPE) + 1 * 64 * 32 * 2;
  const int stride = gridDim.x * NWAVE;
  int row = blockIdx.x * NWAVE + w;
  float nv[24];
  PP_LOADROW(nv, 24, 1536, row)
  for (; row < NTOK; row += stride) {
    float v[24];
#pragma unroll
    for (int j = 0; j < 24; ++j) v[j] = nv[j];
    const bool lat = row >= NCTX;
    const int t = (row - NCTX) & 1023, pr = t >> 6, pc = t & 63;
    const int i = lane & 15, axis = lane >> 5, half = (lane >> 4) & 1;
    const int pos = axis ? pc : pr;
    const float c = tab[(pos * 32 + i) * 2], sn = tab[(pos * 32 + i) * 2 + 1];
    PP_LOADROW(nv, 24, 1536, row + stride)
    u16* o = QKV + (size_t)row * 1536;
    const float sg = half ? 1.f : -1.f;
#pragma unroll
    for (int hd = 0; hd < 20; ++hd) {
      float vv = v[hd];
      if (hd >= 16 && !lat) outp[O_L2K + (size_t)row * 256 + (hd - 16) * 64 + lane] = vv;
      const float pv = __shfl_xor(vv, 16, 64);
      if (lat) vv = vv * c + sg * pv * sn;
      o[hd * 64 + lane] = f2bf(vv);
    }
#pragma unroll
    for (int j = 0; j < 4; ++j) {
      const float vv = v[20 + j];
      o[1280 + 64 * j + lane] = f2bf(vv);
      if (!lat) outp[O_L2V + (size_t)row * 256 + 64 * j + lane] = vv;
    }
  }
}

DI void pp_mla1(const KA& p) {
  const int tid_ = ltid(); const int lane = tid_ & 63, w = tid_ >> 6;
  const float* Z = (const float*)(p.ws() + OFF_UZ);
  u16* CQ = (u16*)(p.ws() + OFF_CQ);
  u16* CKV = (u16*)(p.ws() + OFF_CKV);
  u16* KPE = (u16*)(p.ws() + OFF_KPE);
  float* outp = p.out();
  const float* tab = (const float*)(p.ws() + OFF_ROPE) + 2 * 64 * 32 * 2;
  float gq[6], gkv[4];
#pragma unroll
  for (int j = 0; j < 6; ++j) gq[j] = p.in(22)[64 * j + lane];
#pragma unroll
  for (int j = 0; j < 4; ++j) gkv[j] = p.in(23)[64 * j + lane];
  const int stride = gridDim.x * NWAVE;
  int row = blockIdx.x * NWAVE + w;
  float nv[11];
  PP_LOADROW(nv, 11, 768, row)
  for (; row < NTOK; row += stride) {
    float v[11];
#pragma unroll
    for (int j = 0; j < 11; ++j) v[j] = nv[j];
    const bool lat = row >= NCTX;
    const int t = (row - NCTX) & 1023, pr = t >> 6, pc = t & 63;
    const int e = lane & 31;
    const int ri = e & 7, axis = e >> 4, half = (e >> 3) & 1;
    const int pos = axis ? pc : pr;
    const float c = tab[(pos * 32 + ri) * 2], sn = tab[(pos * 32 + ri) * 2 + 1];
    PP_LOADROW(nv, 11, 768, row + stride)
    float ss = 0.f;
#pragma unroll
    for (int j = 0; j < 6; ++j) ss += v[j] * v[j];
    ss = wave_sum(ss);
    float rstd = rsqrtf(ss * (1.f / 384.f) + 1e-6f);
#pragma unroll
    for (int j = 0; j < 6; ++j) CQ[(size_t)row * P384 + 64 * j + lane] = f2bf(v[j] * rstd * gq[j]);
    ss = 0.f;
#pragma unroll
    for (int j = 0; j < 4; ++j) ss += v[6 + j] * v[6 + j];
    ss = wave_sum(ss);
    rstd = rsqrtf(ss * (1.f / 256.f) + 1e-6f);
#pragma unroll
    for (int j = 0; j < 4; ++j) {
      const float y = v[6 + j] * rstd * gkv[j];
      CKV[(size_t)row * P256 + 64 * j + lane] = f2bf(y);
      if (!lat) outp[O_L1CKV + (size_t)row * 256 + 64 * j + lane] = y;
    }
    float vv = v[10];
    const float pv = __shfl_xor(vv, 8, 64);
    if (lat) vv = vv * c + (half ? pv : -pv) * sn;
    if (lane < 32) {
      KPE[(size_t)row * 32 + e] = f2bf(vv);
      if (!lat) outp[O_L1KPE + (size_t)row * 32 + e] = vv;
    }
  }
}

DI void pp_mla2(const KA& p) {
  const int tid_ = ltid(); const int lane = tid_ & 63, w = tid_ >> 6;
  const float* Z = (const float*)(p.ws() + OFF_UZ);
  u16* Q = (u16*)(p.ws() + OFF_QO);
  const float* tab = (const float*)(p.ws() + OFF_ROPE) + 2 * 64 * 32 * 2;
  const int stride = gridDim.x * NWAVE;
  int row = blockIdx.x * NWAVE + w;
  float nv[24];
  PP_LOADROW(nv, 24, 1536, row)
  for (; row < NTOK; row += stride) {
    float v[24];
#pragma unroll
    for (int j = 0; j < 24; ++j) v[j] = nv[j];
    const bool lat = row >= NCTX;
    const int t = (row - NCTX) & 1023, pr = t >> 6, pc = t & 63;
    const int e = lane & 31;
    const int ri = e & 7, axis = e >> 4, half = (e >> 3) & 1;
    const int pos = axis ? pc : pr;
    const float c = tab[(pos * 32 + ri) * 2], sn = tab[(pos * 32 + ri) * 2 + 1];
    PP_LOADROW(nv, 24, 1536, row + stride)
#pragma unroll
    for (int j = 0; j < 24; ++j) {
      const int col = 64 * j + lane;
      float vv = v[j];
      const float pv = __shfl_xor(vv, 8, 64);
      const int d = col % 96;
      if (lat && d >= 64) vv = vv * c + (half ? pv : -pv) * sn;
      Q[(size_t)row * 1536 + col] = f2bf(vv);
    }
  }
}
#undef PP_LOADROW

struct Seg { const u16* k1; const u16* k2; const u16* v; int ldk1, ldk2, ldv, n0, n1, mode; };

template <int HDQK, int HDV>
DI void attn_item(const u16* __restrict__ Qp, int ldq, const Seg& sA, const Seg& sB, int nseg, int qpos0,
                  float scale_l2, const float* __restrict__ rpb_h, const float* __restrict__ sinkp,
                  u16* __restrict__ Op, int ldo, char* smem) {
  constexpr int K1W = (HDQK == 96) ? 64 : HDQK;
  constexpr int KS = HDQK + 8, VS = HDV + 8;
  constexpr int KC = HDQK / 8, VC = HDV / 8;
  constexpr int KVB = 64 * KS + 64 * VS;
  u16* KV0 = (u16*)smem;
  float* rp = (float*)(KV0 + 2 * KVB);
  const int tid = ltid(), lane = tid & 63, w = tid >> 6, r = lane & 31, h = lane >> 5;
  const int q4 = (lane & 15) >> 2, p4 = lane & 3, dblk = (lane >> 4) & 1;

  __syncthreads();
  if (rpb_h) for (int e = tid; e < 465; e += NTHR) rp[e] = rpb_h[e] * LOG2E;

  bf16x8 qf[HDQK / 16];
  {
    const u16* qrow = Qp + (size_t)(32 * w + r) * ldq + 8 * h;
#pragma unroll
    for (int kk = 0; kk < HDQK / 16; ++kk) qf[kk] = *(const bf16x8*)(qrow + 16 * kk);
  }
  f32x16 o[HDV / 32];
#pragma unroll
  for (int dt = 0; dt < HDV / 32; ++dt)
#pragma unroll
    for (int i = 0; i < 16; ++i) o[dt][i] = 0.f;
  float m = -1e30f, l = 0.f;
  const int qpos = qpos0 + 32 * w + r;
  const int qr = qpos >> 6, qc = qpos & 63;
  const int r0 = min(max(qr - 4, 0), 8), c0 = min(max(qc - 8, 0), 48);

  constexpr int KI = (64 * KC + NTHR - 1) / NTHR, VI = (64 * VC + NTHR - 1) / NTHR;
  const int TA = (sA.n1 - sA.n0) >> 6;
  const int T = TA + (nseg > 1 ? ((sB.n1 - sB.n0) >> 6) : 0);
  uint4 kreg0 = make_uint4(0, 0, 0, 0), kreg1 = kreg0, vreg0 = kreg0, vreg1 = kreg0;
  const int kc0 = tid, kc1 = tid + NTHR;
  const int krow0 = kc0 / KC, kcc0 = kc0 - krow0 * KC, krow1 = kc1 / KC, kcc1 = kc1 - krow1 * KC;
  const bool ks0 = kcc0 * 8 >= K1W, ks1 = kcc1 * 8 >= K1W;
  const int vr0 = tid / VC, vc0 = tid - vr0 * VC, vr1 = (tid + NTHR) / VC, vc1 = (tid + NTHR) - vr1 * VC;
#define ATT_KOFF(S, row, cc, two) (unsigned)((two) ? ((row) * S.ldk2 + (cc) * 8 - K1W) * 2 : ((row) * S.ldk1 + (cc) * 8) * 2)
  const unsigned koA0 = ATT_KOFF(sA, krow0, kcc0, ks0), koB0 = ATT_KOFF(sB, krow0, kcc0, ks0);
  const unsigned koA1 = ATT_KOFF(sA, krow1, kcc1, ks1), koB1 = ATT_KOFF(sB, krow1, kcc1, ks1);
  const unsigned voA0 = (unsigned)(vr0 * sA.ldv + vc0 * 8) * 2, voB0 = (unsigned)(vr0 * sB.ldv + vc0 * 8) * 2;
  const unsigned voA1 = (unsigned)(vr1 * sA.ldv + vc1 * 8) * 2, voB1 = (unsigned)(vr1 * sB.ldv + vc1 * 8) * 2;
#undef ATT_KOFF
#define ATT_FETCH(t)                                                                                   \
  {                                                                                                    \
    const bool fa = (t) < TA;                                                                          \
    const int fn = fa ? sA.n0 + 64 * (t) : sB.n0 + 64 * ((t) - TA);                                    \
    const char* b1 = (const char*)(fa ? sA.k1 : sB.k1) + (size_t)fn * (fa ? sA.ldk1 : sB.ldk1) * 2;    \
    const char* b2 = (const char*)(fa ? sA.k2 : sB.k2) + (size_t)fn * (fa ? sA.ldk2 : sB.ldk2) * 2;    \
    const char* bv = (const char*)(fa ? sA.v : sB.v) + (size_t)fn * (fa ? sA.ldv : sB.ldv) * 2;        \
    kreg0 = *(const uint4*)((ks0 ? b2 : b1) + (fa ? koA0 : koB0));                                     \
    if (KI > 1) { if (64 * KC % NTHR == 0 || kc1 < 64 * KC) kreg1 = *(const uint4*)((ks1 ? b2 : b1) + (fa ? koA1 : koB1)); } \
    vreg0 = *(const uint4*)(bv + (fa ? voA0 : voB0));                                                  \
    if (VI > 1) vreg1 = *(const uint4*)(bv + (fa ? voA1 : voB1));                                      \
  }
#define ATT_STORE(buf)                                                                                 \
  {                                                                                                    \
    u16* Ksw = KV0 + (buf) * KVB; u16* Vsw = Ksw + 64 * KS;                                            \
    { const int c = tid; const int row = c / KC, cc = c - row * KC; *(uint4*)&Ksw[row * KS + cc * 8] = kreg0; } \
    if (KI > 1) { const int c = tid + NTHR; if (64 * KC % NTHR == 0 || c < 64 * KC) { const int row = c / KC, cc = c - row * KC; *(uint4*)&Ksw[row * KS + cc * 8] = kreg1; } } \
    { const int c = tid; const int row = c / VC, cc = c - row * VC; *(uint4*)&Vsw[row * VS + cc * 8] = vreg0; } \
    if (VI > 1) { const int c = tid + NTHR; const int row = c / VC, cc = c - row * VC; *(uint4*)&Vsw[row * VS + cc * 8] = vreg1; } \
  }
  ATT_FETCH(0)
  ATT_STORE(0)
  if (T > 1) ATT_FETCH(1)
  __syncthreads();
  for (int t = 0; t < T; ++t) {
    {
      const bool ca = t < TA;
      const int mode = (HDQK == 64) ? (ca ? sA.mode : sB.mode) : 0;
      const int n = ca ? sA.n0 + 64 * t : sB.n0 + 64 * (t - TA);
      if (t > 0) __syncthreads();
      if (t + 1 < T) ATT_STORE((t + 1) & 1)
      if (t + 2 < T) ATT_FETCH(t + 2)
      const u16* Ks = KV0 + (t & 1) * KVB;
      const u16* Vs = Ks + 64 * KS;
      const int qw = qpos0 + 32 * w;
      bool skip = false;
      if (mode == 1) skip = (n > qw + 31 + 128) || (n + 63 < qw - 128);
      else if (mode == 2) { const int r0w = min(max((qw >> 6) - 4, 0), 8); const int kr = n >> 6; skip = (kr < r0w) || (kr >= r0w + 8); }
      if (skip) continue;
      f32x16 st[2];
#pragma unroll
      for (int kt = 0; kt < 2; ++kt) {
#pragma unroll
        for (int i = 0; i < 16; ++i) st[kt][i] = 0.f;
        const u16* kb = Ks + (32 * kt + r) * KS + 8 * h;
#pragma unroll
        for (int kk = 0; kk < HDQK / 16; ++kk) {
          const bf16x8 a = *(const bf16x8*)(kb + 16 * kk);
          st[kt] = MFMA(a, qf[kk], st[kt]);
        }
        __builtin_amdgcn_sched_barrier(0);
      }
      float mx = -1e30f;
      float esc = 1.f;
      if (mode == 0) {
#pragma unroll
        for (int kt = 0; kt < 2; ++kt)
#pragma unroll
          for (int i = 0; i < 16; ++i) mx = fmaxf(mx, st[kt][i]);
        mx *= scale_l2;
        esc = scale_l2;
      } else if (mode == 1) {
#pragma unroll
        for (int kt = 0; kt < 2; ++kt)
#pragma unroll
          for (int i = 0; i < 16; ++i) {
            const int kpos = n + 32 * kt + crow(i, h);
            const int d = qpos - kpos;
            float v = st[kt][i] * scale_l2;
            if (d > 128 || d < -128) v = -1e30f;
            st[kt][i] = v; mx = fmaxf(mx, v);
          }
      } else {
        const int kr = n >> 6;
        const bool okr = (unsigned)(kr - r0) < 8u;
        const int cb = okr ? (4 * h - c0) : 1000;
        const int ib = (kr - qr + 7) * 31 + 15 - qc + 4 * h;
#pragma unroll
        for (int kt = 0; kt < 2; ++kt)
#pragma unroll
          for (int i = 0; i < 16; ++i) {
            const int cst = 32 * kt + (i & 3) + 8 * (i >> 2);
            const bool ok = (unsigned)(cst + cb) < 16u;
            const float b = rp[ok ? cst + ib : 0];
            float v = __builtin_fmaf(st[kt][i], scale_l2, b);
            if (!ok) v = -1e30f;
            st[kt][i] = v; mx = fmaxf(mx, v);
          }
      }
      mx = fmaxf(mx, __shfl_xor(mx, 32, 64));
      const float mn = fmaxf(m, mx);
      const float alpha = __builtin_amdgcn_exp2f(m - mn);
      const bool resc = __ballot(mn != m) != 0ull;
      m = mn;
      float rs = 0.f;
#pragma unroll
      for (int kt = 0; kt < 2; ++kt)
#pragma unroll
        for (int i = 0; i < 16; ++i) { const float pz = __builtin_amdgcn_exp2f(__builtin_fmaf(st[kt][i], esc, -mn)); st[kt][i] = pz; rs += pz; }
      rs += __shfl_xor(rs, 32, 64);
      l = l * alpha + rs;
      if (resc) {
#pragma unroll
        for (int dt = 0; dt < HDV / 32; ++dt)
#pragma unroll
          for (int i = 0; i < 16; ++i) o[dt][i] *= alpha;
      }
#pragma unroll
      for (int kt = 0; kt < 2; ++kt)
#pragma unroll
        for (int s2 = 0; s2 < 2; ++s2) {
          unsigned pk[4];
#pragma unroll
          for (int j = 0; j < 4; ++j) pk[j] = pack2(st[kt][8 * s2 + 2 * j], st[kt][8 * s2 + 2 * j + 1]);
          bf16x8 pb;
          {
            typedef unsigned u32x4 __attribute__((ext_vector_type(4)));
            u32x4 t4 = {pk[0], pk[1], pk[2], pk[3]};
            pb = __builtin_bit_cast(bf16x8, t4);
          }
          const u16* vb = Vs + (32 * kt + 16 * s2 + 4 * h + q4) * VS + 16 * dblk + 4 * p4;
#pragma unroll
          for (int dt = 0; dt < HDV / 32; ++dt) {
            const s16x4 lo = __builtin_amdgcn_ds_read_tr16_b64_v4i16((LDS3 s16x4*)(vb + 32 * dt));
            const s16x4 hi = __builtin_amdgcn_ds_read_tr16_b64_v4i16((LDS3 s16x4*)(vb + 8 * VS + 32 * dt));
            const bf16x8 va = __builtin_shufflevector(lo, hi, 0, 1, 2, 3, 4, 5, 6, 7);
            o[dt] = MFMA(va, pb, o[dt]);
          }
        }
    }
  }
#undef ATT_FETCH
#undef ATT_STORE
  if (sinkp) l += __builtin_amdgcn_exp2f(sinkp[0] * LOG2E - m);
  const float inv = 1.f / l;
  u16* orow = Op + (size_t)(32 * w + r) * ldo + 4 * h;
#pragma unroll
  for (int dt = 0; dt < HDV / 32; ++dt)
#pragma unroll
    for (int g = 0; g < 4; ++g) {
      uint2 v;
      v.x = pack2(o[dt][4 * g] * inv, o[dt][4 * g + 1] * inv);
      v.y = pack2(o[dt][4 * g + 2] * inv, o[dt][4 * g + 3] * inv);
      *(uint2*)(orow + 32 * dt + 8 * g) = v;
    }
}

DI void attn_phase(const KA& p, int kind, char* smem) {
  const int Hq = kind == 0 ? 8 : 16;
  const int nlat = 8 * Hq * 4, nctx = 16 * Hq;
  u16* AO = (u16*)(p.ws() + OFF_HAO);
  const u16* QKV = (const u16*)(p.ws() + OFF_QO);
  for (int rep = 0; rep < REP_ATT; ++rep)
  for (int item = blockIdx.x; item < nlat + nctx; item += gridDim.x) {
    const bool lat = item < nlat;
    int b, hq, qt;
    if (lat) { b = item / (Hq * 4); const int rem = item - b * Hq * 4; hq = rem >> 2; qt = rem & 3; }
    else { const int it = item - nlat; b = it / Hq; hq = it - b * Hq; qt = 0; }
    const int tok0 = lat ? NCTX + b * 1024 : b * 256;
    const int S = lat ? 1024 : 256;
    const int qrow0 = tok0 + qt * 256;
    Seg sc, ss;
    sc.k2 = nullptr; sc.ldk2 = 0; ss.k2 = nullptr; ss.ldk2 = 0;
    sc.n0 = 0; sc.n1 = 512; sc.mode = 0;
    ss.n0 = 0; ss.n1 = S; ss.mode = 0;
    const u16* Qp; int ldq; float sl2; const float* rpb = nullptr; const float* sinkp = nullptr;
    u16* Op;
    if (kind == 0) {
      const int kvh = hq >> 2;
      ss.k1 = QKV + (size_t)tok0 * 1536 + 1024 + kvh * 128; ss.ldk1 = 1536;
      ss.v = QKV + (size_t)tok0 * 1536 + 1280 + kvh * 128; ss.ldv = 1536;
      sc.k1 = (const u16*)(p.ws() + OFF_CK) + (size_t)b * 512 * 256 + kvh * 128; sc.ldk1 = 256;
      sc.v = (const u16*)(p.ws() + OFF_CV) + (size_t)b * 512 * 256 + kvh * 128; sc.ldv = 256;
      sl2 = 0.08838834764831845f * LOG2E;
      Qp = QKV + (size_t)qrow0 * 1536 + hq * 128; ldq = 1536;
      Op = AO + (size_t)qrow0 * P1024 + hq * 128;
    } else if (kind == 1) {
      const u16* KV = (const u16*)(p.ws() + OFF_KV);
      const u16* KPE = (const u16*)(p.ws() + OFF_KPE);
      ss.k1 = KV + (size_t)tok0 * 2048 + hq * 128; ss.ldk1 = 2048;
      ss.k2 = KPE + (size_t)tok0 * 32; ss.ldk2 = 32;
      ss.v = KV + (size_t)tok0 * 2048 + hq * 128 + 64; ss.ldv = 2048;
      const size_t crow0 = 12288 + (size_t)b * 512;
      sc.k1 = KV + crow0 * 2048 + hq * 128; sc.ldk1 = 2048;
      sc.k2 = KPE + crow0 * 32; sc.ldk2 = 32;
      sc.v = KV + crow0 * 2048 + hq * 128 + 64; sc.ldv = 2048;
      sl2 = 0.10206207261596575f * LOG2E;
      Qp = QKV + (size_t)qrow0 * 1536 + hq * 96; ldq = 1536;
      Op = AO + (size_t)qrow0 * P1024 + hq * 64;
    } else if (kind == 2) {
      const int kvh = hq >> 2;
      ss.k1 = QKV + (size_t)tok0 * 1536 + 1024 + kvh * 64; ss.ldk1 = 1536;
      ss.v = QKV + (size_t)tok0 * 1536 + 1280 + kvh * 64; ss.ldv = 1536;
      sc.k1 = (const u16*)(p.ws() + OFF_CK) + (size_t)b * 512 * 256 + kvh * 64; sc.ldk1 = 256;
      sc.v = (const u16*)(p.ws() + OFF_CV) + (size_t)b * 512 * 256 + kvh * 64; sc.ldv = 256;
      sl2 = 0.125f * LOG2E;
      sinkp = p.in(28) + hq;
      if (lat) { ss.n0 = max(0, qt * 256 - 128); ss.n1 = min(1024, qt * 256 + 384); ss.mode = 1; }
      Qp = QKV + (size_t)qrow0 * 1536 + hq * 64; ldq = 1536;
      Op = AO + (size_t)qrow0 * P1024 + hq * 64;
    } else {
      ss.k1 = QKV + (size_t)tok0 * 3072 + 1024 + hq * 64; ss.ldk1 = 3072;
      ss.v = QKV + (size_t)tok0 * 3072 + 2048 + hq * 64; ss.ldv = 3072;
      sc.k1 = (const u16*)(p.ws() + OFF_C3K) + (size_t)b * 512 * 1024 + hq * 64; sc.ldk1 = 1024;
      sc.v = (const u16*)(p.ws() + OFF_C3V) + (size_t)b * 512 * 1024 + hq * 64; sc.ldv = 1024;
      sl2 = 0.125f * LOG2E;
      if (lat) {
        const int r0a = min(max(4 * qt - 4, 0), 8), r0b = min(max(4 * qt - 1, 0), 8);
        ss.n0 = r0a * 64; ss.n1 = (r0b + 8) * 64; ss.mode = 2;
        rpb = p.in(31) + hq * 465;
      }
      Qp = QKV + (size_t)qrow0 * 3072 + hq * 64; ldq = 3072;
      Op = AO + (size_t)qrow0 * P1024 + hq * 64;
    }
    Seg s0;
    s0.k1 = lat ? sc.k1 : ss.k1; s0.k2 = lat ? sc.k2 : ss.k2; s0.v = lat ? sc.v : ss.v;
    s0.ldk1 = lat ? sc.ldk1 : ss.ldk1; s0.ldk2 = lat ? sc.ldk2 : ss.ldk2; s0.ldv = lat ? sc.ldv : ss.ldv;
    s0.n0 = lat ? sc.n0 : ss.n0; s0.n1 = lat ? sc.n1 : ss.n1; s0.mode = lat ? sc.mode : ss.mode;
    const int nseg = lat ? 2 : 1;
    if (kind == 0) attn_item<128, 128>(Qp, ldq, s0, ss, nseg, qt * 256, sl2, rpb, sinkp, Op, P1024, smem);
    else if (kind == 1) attn_item<96, 64>(Qp, ldq, s0, ss, nseg, qt * 256, sl2, rpb, sinkp, Op, P1024, smem);
    else attn_item<64, 64>(Qp, ldq, s0, ss, nseg, qt * 256, sl2, rpb, sinkp, Op, P1024, smem);
  }
}

__host__ __device__ inline bool phase_exists(int ph) {
  if (ph == 0 || ph == 41) return true;
  const int l = (ph - 1) / 10, s = (ph - 1) % 10;
  if (s == 3 && l != 1) return false;
  if (s == 4) return false;
  if (s == 2 && l != 1) return false;
  return true;
}

DI void run_phase(const KA& p, int ph, char* smem) {
  if (ph == 0) { prepass(p, smem); return; }
  if (ph == 41) { norm_phase(p, 4, 2); return; }
  const int l = (ph - 1) / 10, s = (ph - 1) % 10;
  char* ws = p.ws();
  GemmDesc g0, g1;
  g0 = GemmDesc{nullptr, nullptr, nullptr, 0, 0, 0, 0, 0, 0, 0};
  g1 = g0;
  int ng = 0;
  switch (s) {
    case 0:
      norm_phase(p, l, 0);
      if (l == 2) {
        convert_f32_bf16(p.in(6), (u16*)(ws + OFF_CK), 4096ull * 256);
        convert_f32_bf16(p.in(7), (u16*)(ws + OFF_CV), 4096ull * 256);
      } else if (l == 3) {
        convert_f32_bf16(p.in(8), (u16*)(ws + OFF_C3K), 4096ull * 1024);
        convert_f32_bf16(p.in(9), (u16*)(ws + OFF_C3V), 4096ull * 1024);
      }
      break;
    case 1: {
      const u16* H = (const u16*)(ws + OFF_HAO);
      if (l == 0) g0 = GemmDesc{H, (const u16*)(ws + OFF_AQKV), ws + OFF_QO, P1024, P1024, 1536, NTOK, 1536, 1024, EPI_ATTN};
      else if (l == 1) g0 = GemmDesc{H, (const u16*)(ws + OFF_MIN), ws + OFF_UZ, P1024, P1024, 768, NTOK, 768, 1024, EPI_F32};
      else if (l == 2) g0 = GemmDesc{H, (const u16*)(ws + OFF_SQKV), ws + OFF_QO, P1024, P1024, 1536, NTOK, 1536, 1024, EPI_SWA};
      else g0 = GemmDesc{H, (const u16*)(ws + OFF_NQKV), ws + OFF_QO, P1024, P1024, 3072, NTOK, 3072, 1024, EPI_NAT};
      ng = 1;
    } break;
    case 2:
      if (l == 1) pp_mla1(p);
      break;
    case 3:
      g0 = GemmDesc{(const u16*)(ws + OFF_CQ), (const u16*)(ws + OFF_MUQ), ws + OFF_QO, P384, P384, 1536, NTOK, 1536, 384, EPI_MLAQ};
      g1 = GemmDesc{(const u16*)(ws + OFF_CKV), (const u16*)(ws + OFF_MUKV), ws + OFF_KV, P256, P256, 2048, 16384, 2048, 256, EPI_BF16};
      ng = 2;
      break;
    case 4: break;
    case 5: attn_phase(p, l, smem); break;
    case 6: {
      const size_t wo = l == 0 ? OFF_AO_W : (l == 1 ? OFF_MO : (l == 2 ? OFF_SO : OFF_NO));
      g0 = GemmDesc{(const u16*)(ws + OFF_HAO), (const u16*)(ws + wo), ws + OFF_QO, P1024, P1024, 1024, NTOK, 1024, 1024, EPI_BF16};
      ng = 1;
    } break;
    case 7: norm_phase(p, l, 1); break;
    case 8: {
      pg8::Gemm gg{(const u16*)(ws + OFF_HAO), (const u16*)(ws + OFF_W1T + (size_t)l * W1T_SZ), NTOK, 4096, 1024};
      pg8::StaticOrder S; S.init(NTOK, 4096, (int)gridDim.x, (int)blockIdx.x);
      pg8::EpiRelu2 E{(u16*)(ws + OFF_UZ), P4096};
      pg8::gemm_phase<pg8::EpiRelu2, pg8::StaticOrder, false>((PG8_LAS unsigned char*)smem, gg, S, E, nullptr);
    } break;
    case 9:
      g0 = GemmDesc{(const u16*)(ws + OFF_UZ), (const u16*)(ws + OFF_W2T + (size_t)l * W2T_SZ), ws + OFF_QO, P4096, P4096, 1024, NTOK, 1024, 4096, EPI_BF16};
      ng = 1;
      break;
  }
  if (ng > 0) gemm_phase(p, g0, g1, ng, smem);
}

#define XB_TMO      128
#define XB_XCNT(j)  (256  + 64 * (j))
#define XB_XSUB(j)  (1280 + 64 * (j))
#define XB_XGEN(j)  (2304 + 64 * (j))
#define XB_TOP      3328
#define XB_TOPGEN   3392
#define XCD_BAR_WORDS 3456
#define XB_SPIN_CAP (1u << 18)
#define LAS __attribute__((address_space(3)))

__device__ __forceinline__ unsigned xb_ld(unsigned* p)              { return __hip_atomic_load(p, __ATOMIC_RELAXED, __HIP_MEMORY_SCOPE_AGENT); }
__device__ __forceinline__ unsigned xb_add(unsigned* p, unsigned v) { return __hip_atomic_fetch_add(p, v, __ATOMIC_RELAXED, __HIP_MEMORY_SCOPE_AGENT); }
__device__ __forceinline__ unsigned xb_xcc_id() { return (unsigned)__builtin_amdgcn_s_getreg((3 << 11) | 20) & 0xFu; }
#define XB_SPIN(cond, bar) do { unsigned _sp = 0; while (cond) { __builtin_amdgcn_s_sleep(1); \
    if ((++_sp & 255u) == 0u) { if (xb_ld(&(bar)[XB_TMO])) break; if (_sp > XB_SPIN_CAP) { atomicAdd(&(bar)[XB_TMO], 1u); break; } } } } while (0)

struct XcdBarrier {
    unsigned* bar; unsigned x;
    volatile LAS unsigned* st;
};

__device__ __forceinline__ XcdBarrier xcd_barrier_post(unsigned* bar, volatile LAS unsigned* st) {
    XcdBarrier b; b.bar = bar; b.x = xb_xcc_id(); b.st = st;
    if (threadIdx.x == 0) (void)xb_add(&bar[XB_XCNT(b.x)], 1u);
    return b;
}
__device__ __forceinline__ void xcd_barrier_complete(unsigned* bar, unsigned x, unsigned& nloc, unsigned& nx) {
    const unsigned G = gridDim.x * gridDim.y * gridDim.z;
    unsigned sum, cnt, mine, sp = 0u;
    for (;;) {
        sum = 0u; cnt = 0u; mine = 0u;
#pragma unroll
        for (unsigned j = 0; j < 16; ++j) { const unsigned c = xb_ld(&bar[XB_XCNT(j)]); sum += c; cnt += (c > 0u) ? 1u : 0u; mine = (j == x) ? c : mine; }
        if (sum == G) break;
        __builtin_amdgcn_s_sleep(1);
        if ((++sp & 255u) == 0u) { if (xb_ld(&bar[XB_TMO])) break; if (sp > XB_SPIN_CAP) { atomicAdd(&bar[XB_TMO], 1u); break; } }
    }
    nloc = mine > 0u ? mine : 1u; nx = cnt > 0u ? cnt : 1u;
}

__device__ __forceinline__ void xcd_barrier(const XcdBarrier& b) {
    asm volatile("s_waitcnt vmcnt(0)" ::: "memory");
    __syncthreads();
    if (threadIdx.x == 0) {
        unsigned* bar = b.bar;
        __builtin_amdgcn_s_waitcnt(0);
        unsigned nloc = b.st[0], nx = b.st[1];
        if (nloc == 0u) { xcd_barrier_complete(bar, b.x, nloc, nx); b.st[0] = nloc; b.st[1] = nx; }
        const unsigned old = xb_add(&bar[XB_XSUB(b.x)], 1u);
        const unsigned gen = old / nloc;
        if (old + 1u == (gen + 1u) * nloc) {
            __builtin_amdgcn_fence(__ATOMIC_RELEASE, "agent");
            asm volatile("s_waitcnt vmcnt(0)" ::: "memory");
            const unsigned og = xb_add(&bar[XB_TOP], 1u);
            const unsigned tg = og / nx;
            if (og + 1u == (tg + 1u) * nx) xb_add(&bar[XB_TOPGEN], 1u);
            else XB_SPIN(xb_ld(&bar[XB_TOPGEN]) == tg, bar);
            __builtin_amdgcn_fence(__ATOMIC_ACQUIRE, "agent");
            xb_add(&bar[XB_XGEN(b.x)], 1u);
            asm volatile("s_waitcnt vmcnt(0)" ::: "memory");
        } else {
            XB_SPIN(xb_ld(&bar[XB_XGEN(b.x)]) == gen, bar);
            __builtin_amdgcn_fence(__ATOMIC_ACQUIRE, "agent");
            asm volatile("s_waitcnt vmcnt(0)" ::: "memory");
        }
    }
    __syncthreads();
}

__global__ void __launch_bounds__(512, 2) mega(Params p) {
  __shared__ __attribute__((aligned(16))) char smem[131072];
  __shared__ uint4 xb_words;
  const bool coop = (p.ph1 - p.ph0) > 1;
  XcdBarrier xb;
  if (coop) {
    if (threadIdx.x == 0) xb_words = make_uint4(0u, 0u, 0u, 0u);
    __syncthreads();
    xb = xcd_barrier_post((unsigned*)(p.ws + OFF_BAR), (volatile LAS unsigned*)&xb_words);
  }
  if (p.ph1 < 0) cg::this_grid().sync();
  for (int ph = p.ph0; ph < p.ph1; ++ph) {
    if (!phase_exists(ph)) continue;
    KA q;
    q.ka = (const AS4 char*)__builtin_amdgcn_kernarg_segment_ptr();
    asm volatile("" : "+s"(q.ka));
    run_phase(q, ph, smem);
    if (ph + 1 < p.ph1) {
      unsigned zoff = 0;
      asm volatile("" : "+s"(zoff));
      XcdBarrier xl = xb;
      xl.bar = xb.bar + zoff; xl.x = xb.x + zoff;
      xcd_barrier(xl);
    }
  }
}

extern "C" void kernel_launch(void* const* d_in, const int* in_sizes, int n_in, void* d_out, int out_size,
                              void* d_ws, size_t ws_size, hipStream_t stream) {
  if (n_in < 33 || ws_size < WS_NEED) { fprintf(stderr, "bad args: n_in %d ws %zu need %zu\n", n_in, ws_size, (size_t)WS_NEED); return; }
  Params p{};
  for (int i = 0; i < 33; ++i) p.in[i] = (const float*)d_in[i];
  p.out = (float*)d_out;
  p.ws = (char*)d_ws;
#if N_LAUNCH_MODE == 1
  for (int ph = 0; ph < 42; ++ph) {
    if (!phase_exists(ph)) continue;
    p.ph0 = ph; p.ph1 = ph + 1;
    hipLaunchKernelGGL(mega, dim3(256), dim3(NTHR), 0, stream, p);
  }
#else
  static int grid_blocks = 0;
  if (!grid_blocks) {
    int dev = 0, cus = 0, per_cu = 0;
    hipGetDevice(&dev);
    hipDeviceGetAttribute(&cus, hipDeviceAttributeMultiprocessorCount, dev);
    hipOccupancyMaxActiveBlocksPerMultiprocessor(&per_cu, mega, NTHR, 0);
    if (per_cu > 1) per_cu = 1;
    grid_blocks = cus * per_cu;
  }
  p.ph0 = 0; p.ph1 = 42;
  hipMemsetAsync((char*)d_ws + OFF_BAR, 0, XCD_BAR_WORDS * 4, stream);
  void* args[] = {&p};
  hipError_t e = hipLaunchCooperativeKernel((void*)mega, dim3(grid_blocks), dim3(NTHR), args, 0, stream);
  if (e != hipSuccess) fprintf(stderr, "cooperative launch failed: %s (grid %d)\n", hipGetErrorString(e), grid_blocks);
#endif
}
```
